# Optimizing an MI355X kernel written in HIP

```python
import math
import jax, jax.numpy as jnp
from jax import lax
import numpy as np

D_MODEL = 2048
BATCH = 4
SEQ = 8192
DEPTH = 4
DEC_BATCH = 8
DEC_SEQ = 2048
PAST_LEN = 128

N_MIXERS = 2
N_ATTN_LAYERS = (DEPTH + 1) // 2
N_HYENA_LAYERS = DEPTH // 2
HEAD_DIM = 128
N_SLOTS = D_MODEL // HEAD_DIM
DILATED_GROUPS = ((128, 1), (512, 4), (2048, 16))
N_GROUPS = len(DILATED_GROUPS)
ATTN_WIDTH = N_SLOTS * HEAD_DIM
QKV_WIDTH = 3 * N_GROUPS * ATTN_WIDTH
BAND_BLOCK = 64
NEG_INF = -1e30
D_FF = 5632
HYENA_ORDER = 2
SHORT_CONV = 3
FILTER_BANDS = 16
FILTER_EMB = 2 * FILTER_BANDS + 1
FILTER_HIDDEN = 64
DECAY_TARGET = 1e-2
DECAY_FAST = 0.3
DECAY_SLOW = 1.5
MAX_DECAY = math.log(DECAY_TARGET) / DECAY_FAST
MIN_DECAY = math.log(DECAY_TARGET) / DECAY_SLOW
DN_ALPHA = (2.0 * DEPTH) ** 0.25
DN_BETA = (8.0 * DEPTH) ** -0.25
LN_EPS = 1e-5

kernel_name = 'hybrid_dilated_attn_hyena_encoder'


def _layer_norm(x, g, b):
    x32 = x.astype(jnp.float32)
    mu = jnp.mean(x32, axis=-1, keepdims=True)
    var = jnp.mean(jnp.square(x32 - mu), axis=-1, keepdims=True)
    y = (x32 - mu) * lax.rsqrt(var + LN_EPS) * g.astype(jnp.float32) + b.astype(jnp.float32)
    return y.astype(x.dtype)


def _swiglu(x, w_in, w_out):
    gate, up = jnp.split(x @ w_in, 2, axis=-1)
    return (jax.nn.silu(gate) * up) @ w_out


def _alibi_slopes():
    return jnp.exp2(-8.0 * jnp.arange(1, N_SLOTS + 1, dtype=jnp.float32) / N_SLOTS)


def _banded_dilated_attention(q, k, v, dilation, half, slopes):
    B, S, H, dh = q.shape
    d = dilation
    ls = S // d
    nb = -(-ls // BAND_BLOCK)
    lp = nb * BAND_BLOCK
    z = B * d

    def to_residue(t):
        t = t.reshape(B, ls, d, H, dh).transpose(0, 2, 1, 3, 4).reshape(z, ls, H, dh)
        return jnp.pad(t, ((0, 0), (0, lp - ls), (0, 0), (0, 0)))

    def band(t):
        t = jnp.pad(t, ((0, 0), (BAND_BLOCK, BAND_BLOCK), (0, 0), (0, 0))).reshape(z, nb + 2, BAND_BLOCK, H, dh)
        return jnp.concatenate([t[:, :-2], t[:, 1:-1], t[:, 2:]], axis=2)

    qb = to_residue(q).reshape(z, nb, BAND_BLOCK, H, dh)
    kb = band(to_residue(k))
    vb = band(to_residue(v))
    scores = jnp.einsum('znqhd,znkhd->znhqk', qb, kb, preferred_element_type=jnp.float32) * (dh ** -0.5)
    qi = jnp.arange(BAND_BLOCK)
    ki = jnp.arange(3 * BAND_BLOCK)
    rel = ki[None, :] - BAND_BLOCK - qi[:, None]
    key_pos = jnp.arange(nb)[:, None] * BAND_BLOCK - BAND_BLOCK + ki[None, :]
    valid = (jnp.abs(rel) <= half)[None] & ((key_pos >= 0) & (key_pos < ls))[:, None, :]
    alibi = -slopes[:, None, None] * (jnp.abs(rel) * d).astype(jnp.float32)[None]
    scores = jnp.where(valid[None, :, None], scores + alibi[None, None], NEG_INF)
    mx = jnp.max(scores, axis=-1)
    p = jnp.exp(scores - mx[..., None])
    den = jnp.sum(p, axis=-1)
    o = jnp.einsum('znhqk,znkhd->znqhd', p.astype(vb.dtype), vb, preferred_element_type=jnp.float32)
    mx = jnp.moveaxis(mx, 2, 3)
    den = jnp.moveaxis(den, 2, 3)
    o = o / den[..., None]

    def from_residue(t):
        rest = t.shape[4:]
        t = t.reshape((z, lp, H) + rest)[:, :ls]
        t = jnp.swapaxes(t.reshape((B, d, ls, H) + rest), 1, 2)
        return t.reshape((B, S, H) + rest)

    return from_residue(o), from_residue(mx), from_residue(den)


def _dilated_attention(x, w_qkv, w_o):
    B, S, _ = x.shape
    qkv = (x @ w_qkv).reshape(B, S, 3, N_GROUPS, N_SLOTS, HEAD_DIM)
    slopes = _alibi_slopes()
    outs, maxes, dens = [], [], []
    for g, (window, dilation) in enumerate(DILATED_GROUPS):
        o, mx, den = _banded_dilated_attention(qkv[:, :, 0, g], qkv[:, :, 1, g], qkv[:, :, 2, g],
                                               dilation, window // (2 * dilation), slopes)
        outs.append(o)
        maxes.append(mx)
        dens.append(den)
    o = jnp.stack(outs)
    mx = jnp.stack(maxes)
    den = jnp.stack(dens)
    wts = den * jnp.exp(mx - jnp.max(mx, axis=0, keepdims=True))
    out = jnp.sum(wts[..., None] * o, axis=0) / jnp.sum(wts, axis=0)[..., None]
    return out.reshape(B, S, ATTN_WIDTH).astype(x.dtype) @ w_o


def _short_conv(u, conv_w, conv_b):
    L = u.shape[1]
    pad = SHORT_CONV // 2
    up = jnp.pad(u, ((0, 0), (pad, SHORT_CONV - 1 - pad), (0, 0)))
    return sum(up[:, j:j + L] * conv_w[j] for j in range(SHORT_CONV)) + conv_b


def _hyena_filters(L, f_w1, f_b1, f_w2, f_b2, f_freq, f_w3):
    f32 = jnp.float32
    t = jnp.linspace(0.0, 1.0, L, dtype=f32)[:, None]
    w = 2.0 * math.pi * jnp.arange(L, dtype=f32)[:, None] / L
    bands = jnp.linspace(1e-4, FILTER_BANDS - 1, FILTER_BANDS, dtype=f32)[None, :]
    pos = jnp.concatenate([t, jnp.cos(bands * w), -jnp.sin(bands * w)], axis=-1)
    freq = f_freq.astype(f32)
    h = jnp.sin(freq * (pos @ f_w1.astype(f32) + f_b1.astype(f32)))
    h = jnp.sin(freq * (h @ f_w2.astype(f32) + f_b2.astype(f32)))
    h = (h @ f_w3.astype(f32)).reshape(L, HYENA_ORDER, 2, D_MODEL)
    deltas = jnp.abs(jnp.linspace(MIN_DECAY, MAX_DECAY, D_MODEL, dtype=f32))
    h = h * jnp.exp(-t * deltas)[:, None, None, :]
    return h / jnp.sum(jnp.abs(h), axis=(0, 2), keepdims=True)


def _bidir_fft_conv(u, h_fwd, h_bwd, skip):
    L = u.shape[1]
    c = jnp.concatenate([h_fwd.at[0].add(h_bwd[0]), jnp.zeros_like(h_fwd[:1]), h_bwd[:0:-1]], axis=0)
    u32 = u.astype(jnp.float32)
    uf = jnp.fft.rfft(u32, n=2 * L, axis=1)
    y = jnp.fft.irfft(uf * jnp.fft.rfft(c, axis=0)[None], n=2 * L, axis=1)[:, :L]
    return y + u32 * skip.astype(jnp.float32)


def _hyena_mixer(x, w_in, b_in, conv_w, conv_b, f_w1, f_b1, f_w2, f_b2, f_freq, f_w3, skip, w_out, b_out):
    L = x.shape[1]
    u = _short_conv(x @ w_in + b_in, conv_w, conv_b)
    v, g1, g2 = jnp.split(u, 3, axis=-1)
    h = _hyena_filters(L, f_w1, f_b1, f_w2, f_b2, f_freq, f_w3)
    z = g1.astype(jnp.float32) * _bidir_fft_conv(v, h[:, 0, 0], h[:, 0, 1], skip[0])
    z = g2.astype(jnp.float32) * _bidir_fft_conv(z, h[:, 1, 0], h[:, 1, 1], skip[1])
    return z.astype(x.dtype) @ w_out + b_out


def _trunk(x, ln_g, ln_b, ffn_w_in, ffn_w_out, attn_w_qkv, attn_w_o,
           hy_w_in, hy_b_in, hy_conv_w, hy_conv_b, hy_f_w1, hy_f_b1, hy_f_w2,
           hy_f_b2, hy_f_freq, hy_f_w3, hy_skip, hy_w_out, hy_b_out):
    for i in range(DEPTH):
        x = _layer_norm(DN_ALPHA * x + 0.5 * _swiglu(x, ffn_w_in[i, 0], ffn_w_out[i, 0]), ln_g[i, 0], ln_b[i, 0])
        j = i // N_MIXERS
        if i % N_MIXERS == 0:
            mix = _dilated_attention(x, attn_w_qkv[j], attn_w_o[j])
        else:
            mix = _hyena_mixer(x, hy_w_in[j], hy_b_in[j], hy_conv_w[j], hy_conv_b[j], hy_f_w1[j], hy_f_b1[j],
                               hy_f_w2[j], hy_f_b2[j], hy_f_freq[j], hy_f_w3[j], hy_skip[j], hy_w_out[j], hy_b_out[j])
        x = _layer_norm(DN_ALPHA * x + mix, ln_g[i, 1], ln_b[i, 1])
        x = _layer_norm(DN_ALPHA * x + 0.5 * _swiglu(x, ffn_w_in[i, 1], ffn_w_out[i, 1]), ln_g[i, 2], ln_b[i, 2])
    return x


def setup_inputs(seed: int = 0) -> dict:
    key = jax.random.key(seed)
    ks = jax.random.split(key, 24)
    f32 = jnp.float32

    def nrm(k, shape, scale):
        return jax.random.normal(k, shape, f32) * scale

    qkv_scale = jnp.array([1.0, 1.0, DN_BETA], f32)[:, None]
    attn_w_qkv = (nrm(ks[6], (N_ATTN_LAYERS, D_MODEL, 3, N_GROUPS * ATTN_WIDTH), D_MODEL ** -0.5)
                  * qkv_scale).reshape(N_ATTN_LAYERS, D_MODEL, QKV_WIDTH)
    return {
        'x_prompt': nrm(ks[0], (BATCH, SEQ, D_MODEL), 1.0),
        'x_sample': nrm(ks[1], (DEC_BATCH, DEC_SEQ, D_MODEL), 1.0),
        'ln_g': 1.0 + nrm(ks[2], (DEPTH, 3, D_MODEL), 0.02),
        'ln_b': nrm(ks[3], (DEPTH, 3, D_MODEL), 0.02),
        'ffn_w_in': nrm(ks[4], (DEPTH, 2, D_MODEL, 2 * D_FF), D_MODEL ** -0.5),
        'ffn_w_out': nrm(ks[5], (DEPTH, 2, D_FF, D_MODEL), D_FF ** -0.5 * DN_BETA),
        'attn_w_qkv': attn_w_qkv,
        'attn_w_o': nrm(ks[7], (N_ATTN_LAYERS, ATTN_WIDTH, D_MODEL), ATTN_WIDTH ** -0.5 * DN_BETA),
        'hy_w_in': nrm(ks[8], (N_HYENA_LAYERS, D_MODEL, 3 * D_MODEL), D_MODEL ** -0.5),
        'hy_b_in': nrm(ks[9], (N_HYENA_LAYERS, 3 * D_MODEL), 0.02),
        'hy_conv_w': nrm(ks[10], (N_HYENA_LAYERS, SHORT_CONV, 3 * D_MODEL), SHORT_CONV ** -0.5),
        'hy_conv_b': nrm(ks[11], (N_HYENA_LAYERS, 3 * D_MODEL), 0.02),
        'hy_f_w1': nrm(ks[12], (N_HYENA_LAYERS, FILTER_EMB, FILTER_HIDDEN), FILTER_EMB ** -0.5),
        'hy_f_b1': nrm(ks[13], (N_HYENA_LAYERS, FILTER_HIDDEN), 0.02),
        'hy_f_w2': nrm(ks[14], (N_HYENA_LAYERS, FILTER_HIDDEN, FILTER_HIDDEN), FILTER_HIDDEN ** -0.5),
        'hy_f_b2': nrm(ks[15], (N_HYENA_LAYERS, FILTER_HIDDEN), 0.02),
        'hy_f_freq': 1.0 + nrm(ks[16], (N_HYENA_LAYERS, FILTER_HIDDEN), 0.02),
        'hy_f_w3': nrm(ks[17], (N_HYENA_LAYERS, FILTER_HIDDEN, HYENA_ORDER * 2 * D_MODEL), FILTER_HIDDEN ** -0.5),
        'hy_skip': nrm(ks[18], (N_HYENA_LAYERS, HYENA_ORDER, D_MODEL), 1.0),
        'hy_w_out': nrm(ks[19], (N_HYENA_LAYERS, D_MODEL, D_MODEL), D_MODEL ** -0.5 * DN_BETA),
        'hy_b_out': nrm(ks[20], (N_HYENA_LAYERS, D_MODEL), 0.02),
    }


def reference(x_prompt, x_sample, ln_g, ln_b, ffn_w_in, ffn_w_out, attn_w_qkv, attn_w_o,
              hy_w_in, hy_b_in, hy_conv_w, hy_conv_b, hy_f_w1, hy_f_b1, hy_f_w2, hy_f_b2,
              hy_f_freq, hy_f_w3, hy_skip, hy_w_out, hy_b_out):
    y_prompt = _trunk(x_prompt, ln_g, ln_b, ffn_w_in, ffn_w_out, attn_w_qkv, attn_w_o,
                      hy_w_in, hy_b_in, hy_conv_w, hy_conv_b, hy_f_w1, hy_f_b1, hy_f_w2, hy_f_b2,
                      hy_f_freq, hy_f_w3, hy_skip, hy_w_out, hy_b_out)
    y_sample = _trunk(x_sample, ln_g, ln_b, ffn_w_in, ffn_w_out, attn_w_qkv, attn_w_o,
                      hy_w_in, hy_b_in, hy_conv_w, hy_conv_b, hy_f_w1, hy_f_b1, hy_f_w2, hy_f_b2,
                      hy_f_freq, hy_f_w3, hy_skip, hy_w_out, hy_b_out)
    return (y_prompt, y_sample)
```

```cpp
#include <hip/hip_runtime.h>
#include <cstdio>
#include <cstdint>
namespace pg8 {
#define PG8_LAS __attribute__((address_space(3)))
typedef unsigned short bf16_t;
typedef short bf16x8 __attribute__((ext_vector_type(8)));
typedef float f32x4 __attribute__((ext_vector_type(4)));
typedef unsigned u32x4 __attribute__((ext_vector_type(4)));
constexpr int BM = 256, BK = 64, HALF = 128, HTB = HALF * BK * 2  , STAGE_BYTES = 8 * HTB, NXCD = 8, WGM = 8;

__host__ __device__ __forceinline__ int lds_byte(int r, int c) { const int st = (r >> 4) * 2 + (c >> 5), rr = r & 15, cc = c & 31, ob = rr * 64 + cc * 2; return st * 1024 + (ob ^ (((ob >> 9) & 1) << 5)); }
__host__ __device__ __forceinline__ void stage_rc(int b, int& R, int& C) { const int st = b / 1024, sb = b % 1024, swz = sb ^ (((sb >> 9) & 1) << 5); R = (st >> 1) * 16 + swz / 64; C = (st & 1) * 32 + (swz % 64) / 2; }
__host__ __device__ __forceinline__ int perm32(int rho) { const int n = rho >> 4, i = rho & 15; return 8 * (i >> 2) + 4 * n + (i & 3); }

struct Unit { int pm, pn; };
struct Gemm { const bf16_t* A; const bf16_t* Bt; int M, N, K; };

struct StaticOrder {
    int nM, nN, nwg, G, c;
    __host__ __device__ void init(int M, int N, int G_, int c_) { nM = M / BM; nN = N / BM; nwg = nM * nN; G = G_; c = c_; }
    __host__ __device__ bool next(int i, Unit& u) const {
        const long L = (long)i * G + c; if (L >= nwg) return false;
        int wgid = (int)L; { const int q = nwg / NXCD, r = nwg % NXCD, xcd = wgid % NXCD, off = wgid / NXCD; wgid = (xcd < r ? xcd * (q + 1) : r * (q + 1) + (xcd - r) * q) + off; }
        const int nig = WGM * nN, gid = wgid / nig, fm = gid * WGM, gsz = (nM - fm) < WGM ? (nM - fm) : WGM;
        u.pm = fm + ((wgid % nig) % gsz); u.pn = (wgid % nig) / gsz; return true;
    }
    __device__ __forceinline__ void a_ready(const Unit&) const {}
    __device__ __forceinline__ void done(const Unit&) const {}
};

__device__ __forceinline__ unsigned cvt_pk_bf16(float lo, float hi) { unsigned r; asm volatile("v_cvt_pk_bf16_f32 %0, %1, %2" : "=v"(r) : "v"(lo), "v"(hi)); return r; }
typedef float f32x2 __attribute__((ext_vector_type(2)));
typedef float f32x2v __attribute__((ext_vector_type(2)));
typedef unsigned u32x2v __attribute__((ext_vector_type(2)));
constexpr float DN_ALPHA_F = 1.6817928305074292f;

__device__ __forceinline__ float xor32_sum(float x) { const auto r = __builtin_amdgcn_permlane32_swap(__float_as_uint(x), __float_as_uint(x), false, false); const unsigned r0 = r[0], r1 = r[1]; return __uint_as_float(r0) + __uint_as_float(r1); }
__device__ __forceinline__ float xor32_max(float x) { const auto r = __builtin_amdgcn_permlane32_swap(__float_as_uint(x), __float_as_uint(x), false, false); const unsigned r0 = r[0], r1 = r[1]; return fmaxf(__uint_as_float(r0), __uint_as_float(r1)); }
template <int MASK> __device__ __forceinline__ float swz_xor(float x) { return __builtin_bit_cast(float, __builtin_amdgcn_ds_swizzle(__builtin_bit_cast(int, x), (MASK << 10) | 0x1F)); }
__device__ __forceinline__ float wave_sum64(float v) { v += swz_xor<1>(v); v += swz_xor<2>(v); v += swz_xor<4>(v); v += swz_xor<8>(v); v += swz_xor<16>(v); return xor32_sum(v); }

struct EpiLnBf16 {
    static constexpr bool PERM = true, AFTER_DRAIN = false;
    bf16_t* O; int ldc; const float* stats; const float* cvec; const float* dvec;
    __device__ __forceinline__ void operator()(const f32x4 (&acc)[2][2][4][2], const Unit& u, int wr, int wc, int fr, int fq) const {
        const int row0 = u.pm * BM + wr * 64 + fr, col0 = u.pn * BM + wc * 32 + 8 * fq;
        f32x4 cv[2][2], dv[2][2];
#pragma unroll
        for (int bj = 0; bj < 2; ++bj)
#pragma unroll
            for (int n = 0; n < 2; ++n) { cv[bj][n] = *(const f32x4*)(cvec + col0 + bj * HALF + 4 * n); dv[bj][n] = *(const f32x4*)(dvec + col0 + bj * HALF + 4 * n); }
#pragma unroll
        for (int ai = 0; ai < 2; ++ai)
#pragma unroll
            for (int m = 0; m < 4; ++m) { const int row = row0 + ai * HALF + m * 16; const f32x2v st = *(const f32x2v*)(stats + 2 * (size_t)row);
                bf16_t* rowp = O + (size_t)row * ldc + col0;
#pragma unroll
                for (int bj = 0; bj < 2; ++bj) { const f32x4 v0 = (acc[ai][bj][m][0] - st.x * cv[bj][0]) * st.y + dv[bj][0], v1 = (acc[ai][bj][m][1] - st.x * cv[bj][1]) * st.y + dv[bj][1];
                    u32x4 w; w.x = cvt_pk_bf16(v0[0], v0[1]); w.y = cvt_pk_bf16(v0[2], v0[3]); w.z = cvt_pk_bf16(v1[0], v1[1]); w.w = cvt_pk_bf16(v1[2], v1[3]);
                    *(u32x4*)(rowp + bj * HALF) = w; } }
    }
};
__device__ __forceinline__ float silu_mul(float g, float up) { const float e = __builtin_amdgcn_exp2f(-1.4426950408889634f * g); return g * __builtin_amdgcn_rcpf(1.0f + e) * up; }
struct EpiSwiglu {
    static constexpr bool PERM = true, AFTER_DRAIN = false;
    bf16_t* O; int ldc; const float* stats; const float* cvec; const float* dvec;
    __device__ __forceinline__ void operator()(const f32x4 (&acc)[2][2][4][2], const Unit& u, int wr, int wc, int fr, int fq) const {
        const int row0 = u.pm * BM + wr * 64 + fr, col0 = u.pn * BM + wc * 32 + 8 * fq, ocol = u.pn * HALF + wc * 32 + 8 * fq;
        f32x4 cv[2][2], dv[2][2];
#pragma unroll
        for (int bj = 0; bj < 2; ++bj)
#pragma unroll
            for (int n = 0; n < 2; ++n) { cv[bj][n] = *(const f32x4*)(cvec + col0 + bj * HALF + 4 * n); dv[bj][n] = *(const f32x4*)(dvec + col0 + bj * HALF + 4 * n); }
#pragma unroll
        for (int ai = 0; ai < 2; ++ai)
#pragma unroll
            for (int m = 0; m < 4; ++m) { const int row = row0 + ai * HALF + m * 16; const f32x2v st = *(const f32x2v*)(stats + 2 * (size_t)row);
                f32x4 h[2];
#pragma unroll
                for (int n = 0; n < 2; ++n) { const f32x4 g = (acc[ai][0][m][n] - st.x * cv[0][n]) * st.y + dv[0][n], up = (acc[ai][1][m][n] - st.x * cv[1][n]) * st.y + dv[1][n];
                    h[n] = (f32x4){silu_mul(g[0], up[0]), silu_mul(g[1], up[1]), silu_mul(g[2], up[2]), silu_mul(g[3], up[3])}; }
                u32x4 w; w.x = cvt_pk_bf16(h[0][0], h[0][1]); w.y = cvt_pk_bf16(h[0][2], h[0][3]); w.z = cvt_pk_bf16(h[1][0], h[1][1]); w.w = cvt_pk_bf16(h[1][2], h[1][3]);
                *(u32x4*)(O + (size_t)row * ldc + ocol) = w; }
    }
};
struct EpiResid {
    static constexpr bool PERM = true, AFTER_DRAIN = false;
    float* Z; bf16_t* ZB; const float* stats; const float* gprev; const float* bprev; const float* bias; float* part; float scale; int pad;
    __device__ __forceinline__ void operator()(const f32x4 (&acc)[2][2][4][2], const Unit& u, int wr, int wc, int fr, int fq) const {
        const int row0 = u.pm * BM + wr * 64 + fr, col0 = u.pn * BM + wc * 32 + 8 * fq;
#pragma unroll
        for (int bj = 0; bj < 2; ++bj) {
            f32x4 gv[2], bv[2];
#pragma unroll
            for (int n = 0; n < 2; ++n) { const int c = col0 + bj * HALF + 4 * n; gv[n] = DN_ALPHA_F * *(const f32x4*)(gprev + c); bv[n] = DN_ALPHA_F * *(const f32x4*)(bprev + c) + scale * *(const f32x4*)(bias + c); }
#pragma unroll
            for (int ai = 0; ai < 2; ++ai)
#pragma unroll
                for (int m = 0; m < 4; ++m) { const int row = row0 + ai * HALF + m * 16; const f32x2v st = *(const f32x2v*)(stats + 2 * (size_t)row);
                    float* zp = Z + (size_t)row * 2048 + col0 + bj * HALF;
                    const f32x4 z0 = *(const f32x4*)zp, z1 = *(const f32x4*)(zp + 4);
                    const f32x4 n0 = (z0 - st.x) * st.y * gv[0] + bv[0] + scale * acc[ai][bj][m][0];
                    const f32x4 n1 = (z1 - st.x) * st.y * gv[1] + bv[1] + scale * acc[ai][bj][m][1];
                    *(f32x4*)zp = n0; *(f32x4*)(zp + 4) = n1;
                    u32x4 w; w.x = cvt_pk_bf16(n0[0], n0[1]); w.y = cvt_pk_bf16(n0[2], n0[3]); w.z = cvt_pk_bf16(n1[0], n1[1]); w.w = cvt_pk_bf16(n1[2], n1[3]);
                    *(u32x4*)(ZB + (size_t)row * 2048 + col0 + bj * HALF) = w;
                    float s = ((n0[0] + n0[1]) + (n0[2] + n0[3])) + ((n1[0] + n1[1]) + (n1[2] + n1[3]));
                    float q = ((n0[0] * n0[0] + n0[1] * n0[1]) + (n0[2] * n0[2] + n0[3] * n0[3])) + ((n1[0] * n1[0] + n1[1] * n1[1]) + (n1[2] * n1[2] + n1[3] * n1[3]));
                    s += swz_xor<16>(s); s = xor32_sum(s); q += swz_xor<16>(q); q = xor32_sum(q);
                    if (fq == 0) *(f32x2v*)(part + ((size_t)row * 64 + u.pn * 8 + wc * 2 + bj) * 2) = (f32x2v){s, q}; }
        }
    }
};

template <class Epi, class Sched, bool ALIGN_EPI = false, bool SP2 = false>
__device__ __forceinline__ void gemm_phase(PG8_LAS unsigned char* lds, const Gemm g, const Sched& S, const Epi& E, const int tid_in) {
    int tid_ = tid_in; asm volatile("" : "+v"(tid_));
    const int tid = tid_, wid = __builtin_amdgcn_readfirstlane(tid >> 6), lane = tid & 63, wr = wid >> 2, wc = wid & 3, fr = lane & 15, fq = lane >> 4;
    const int K = g.K, nt = K / BK;
    unsigned voffA[2], voffB[2];
#pragma unroll
    for (int i = 0; i < 2; ++i) { int R, C; stage_rc(tid * 16 + i * 8192, R, C); const int Rb = Epi::PERM ? ((R & ~31) + perm32(R & 31)) : R;
        voffA[i] = (unsigned)(R * K + C) * 2u; voffB[i] = (unsigned)(Rb * K + C) * 2u; }
    const size_t kstep = (size_t)(BK * 2);
    const size_t hstep = (size_t)HALF * K * 2;
    const size_t tstep = 2 * hstep;
    const unsigned ldsw = (unsigned)wid * 1024u;
    const int aoff = lds_byte(wr * 64 + fr, fq * 8), boff = lds_byte(wc * 32 + fr, fq * 8);
#define PG8_SA(b, h) (((b) * 2 + (h)) * HTB)
#define PG8_SB(b, h) ((4 + (b) * 2 + (h)) * HTB)
#define PG8_STAGE(bufoff, gbase, voff) do { _Pragma("unroll") for (int _i = 0; _i < 2; ++_i) \
        __builtin_amdgcn_global_load_lds((const unsigned*)((const char*)(gbase) + (voff)[_i]), (PG8_LAS unsigned*)(lds + (bufoff) + ldsw + _i * 8192), 16, 0, 0); } while (0)
#define PG8_LDA(dst, b, h) do { _Pragma("unroll") for (int m = 0; m < 4; ++m) _Pragma("unroll") for (int k = 0; k < 2; ++k) dst[m][k] = *(const PG8_LAS bf16x8*)(lds + PG8_SA(b, h) + aoff + m * 2048 + k * 1024); } while (0)
#define PG8_LDB(dst, b, h) do { _Pragma("unroll") for (int n = 0; n < 2; ++n) _Pragma("unroll") for (int k = 0; k < 2; ++k) dst[n][k] = *(const PG8_LAS bf16x8*)(lds + PG8_SB(b, h) + boff + n * 2048 + k * 1024); } while (0)
#define PG8_MMA(ai, bj, At, Bt) do { __builtin_amdgcn_s_setprio(1); _Pragma("unroll") for (int m = 0; m < 4; ++m) _Pragma("unroll") for (int n = 0; n < 2; ++n) _Pragma("unroll") for (int k = 0; k < 2; ++k) \
        acc[ai][bj][m][n] = __builtin_amdgcn_mfma_f32_16x16x32_bf16(Bt[n][k], At[m][k], acc[ai][bj][m][n], 0, 0, 0); __builtin_amdgcn_s_setprio(0); } while (0)
#define PG8_WAIT_V(n) asm volatile("s_waitcnt vmcnt(" #n ")" ::: "memory")
#define PG8_WAIT_L(n) asm volatile("s_waitcnt lgkmcnt(" #n ")" ::: "memory")
#define PG8_BAR __builtin_amdgcn_s_barrier()
#define PG8_SCHED __builtin_amdgcn_sched_barrier(0)
    Unit cur, nxt; int ui = 0;
    if (!S.next(0, cur)) return;
    f32x4 acc[2][2][4][2];
#pragma unroll
    for (int a = 0; a < 2; ++a)
#pragma unroll
        for (int b = 0; b < 2; ++b)
#pragma unroll
            for (int m = 0; m < 4; ++m)
#pragma unroll
                for (int n = 0; n < 2; ++n) acc[a][b][m][n] = (f32x4){0.f, 0.f, 0.f, 0.f};
    bf16x8 At[4][2], B0[2][2], B1[2][2];
    const char* cA = (const char*)g.A + (size_t)cur.pm * tstep; const char* cB = (const char*)g.Bt + (size_t)cur.pn * tstep;
    S.a_ready(cur);
    if constexpr (SP2) {
        PG8_STAGE(PG8_SB(0, 0), cB, voffB); PG8_STAGE(PG8_SB(0, 1), cB + hstep, voffB); PG8_STAGE(PG8_SA(0, 0), cA, voffA); PG8_STAGE(PG8_SA(0, 1), cA + hstep, voffA);
        if (wr == 1) PG8_BAR;
        PG8_WAIT_V(2); PG8_BAR;
        PG8_STAGE(PG8_SB(1, 0), cB + kstep, voffB); PG8_STAGE(PG8_SA(1, 0), cA + kstep, voffA); PG8_STAGE(PG8_SB(1, 1), cB + hstep + kstep, voffB);
        PG8_WAIT_V(6); PG8_BAR;
    } else {
        PG8_STAGE(PG8_SB(0, 0), cB, voffB); PG8_STAGE(PG8_SA(0, 0), cA, voffA); PG8_STAGE(PG8_SB(0, 1), cB + hstep, voffB); PG8_STAGE(PG8_SA(0, 1), cA + hstep, voffA);
        if (wr == 1) PG8_BAR;
        PG8_WAIT_V(4); PG8_BAR;
        PG8_STAGE(PG8_SB(1, 0), cB + kstep, voffB); PG8_STAGE(PG8_SA(1, 0), cA + kstep, voffA); PG8_STAGE(PG8_SB(1, 1), cB + hstep + kstep, voffB);
        PG8_WAIT_V(6); PG8_BAR;
    }
    for (;;) {
        const bool has_next = S.next(ui + 1, nxt);
        const char* nA = has_next ? (const char*)g.A + (size_t)nxt.pm * tstep : cA; const char* nB = has_next ? (const char*)g.Bt + (size_t)nxt.pn * tstep : cB;
        for (int t = 0; t < nt; t += 2) {
            const bool last = (t == nt - 2);
            const char* a1 = cA + (size_t)(t + 1) * kstep;
            const char* a2 = last ? nA : cA + (size_t)(t + 2) * kstep; const char* b2 = last ? nB : cB + (size_t)(t + 2) * kstep;
            const char* a3 = a2 + kstep; const char* b3 = b2 + kstep;
            if (last && has_next) S.a_ready(nxt);
            if constexpr (SP2) {
            PG8_LDB(B0, 0, 0); PG8_LDB(B1, 0, 1); PG8_SCHED; PG8_LDA(At, 0, 0); PG8_STAGE(PG8_SA(1, 1), a1 + hstep, voffA);
            PG8_WAIT_V(8); PG8_WAIT_L(0); PG8_BAR; PG8_MMA(0, 0, At, B0); PG8_MMA(0, 1, At, B1); PG8_BAR; PG8_SCHED;
            PG8_LDA(At, 0, 1); PG8_STAGE(PG8_SB(0, 0), b2, voffB); PG8_STAGE(PG8_SB(0, 1), b2 + hstep, voffB); PG8_STAGE(PG8_SA(0, 0), a2, voffA);
            PG8_WAIT_V(8); PG8_WAIT_L(0); PG8_BAR; PG8_MMA(1, 0, At, B0); PG8_MMA(1, 1, At, B1); PG8_BAR; PG8_SCHED;
            PG8_LDB(B0, 1, 0); PG8_LDB(B1, 1, 1); PG8_SCHED; PG8_LDA(At, 1, 0); PG8_STAGE(PG8_SA(0, 1), a2 + hstep, voffA);
            PG8_WAIT_V(8); PG8_WAIT_L(0); PG8_BAR; PG8_MMA(0, 0, At, B0); PG8_MMA(0, 1, At, B1); PG8_BAR; PG8_SCHED;
            PG8_LDA(At, 1, 1); PG8_STAGE(PG8_SB(1, 0), b3, voffB); PG8_STAGE(PG8_SB(1, 1), b3 + hstep, voffB); PG8_STAGE(PG8_SA(1, 0), a3, voffA);
            PG8_WAIT_V(8); PG8_WAIT_L(0); PG8_BAR; PG8_MMA(1, 0, At, B0); PG8_MMA(1, 1, At, B1); PG8_BAR; PG8_SCHED;
            } else {
            PG8_LDB(B0, 0, 0); PG8_SCHED; PG8_LDA(At, 0, 0); PG8_STAGE(PG8_SA(1, 1), a1 + hstep, voffA);
            PG8_WAIT_L(8); PG8_BAR; PG8_WAIT_L(0); PG8_MMA(0, 0, At, B0); PG8_BAR; PG8_SCHED;
            PG8_LDB(B1, 0, 1); PG8_STAGE(PG8_SB(0, 0), b2, voffB);
            PG8_BAR; PG8_WAIT_L(0); PG8_MMA(0, 1, At, B1); PG8_BAR;
            PG8_LDA(At, 0, 1); PG8_STAGE(PG8_SA(0, 0), a2, voffA);
            PG8_BAR; PG8_WAIT_L(0); PG8_MMA(1, 0, At, B0); PG8_BAR; PG8_SCHED;
            PG8_STAGE(PG8_SB(0, 1), b2 + hstep, voffB);
            PG8_WAIT_V(6); PG8_BAR; PG8_MMA(1, 1, At, B1); PG8_BAR;
            PG8_LDB(B0, 1, 0); PG8_SCHED; PG8_LDA(At, 1, 0); PG8_STAGE(PG8_SA(0, 1), a2 + hstep, voffA);
            PG8_WAIT_L(8); PG8_BAR; PG8_WAIT_L(0); PG8_MMA(0, 0, At, B0); PG8_BAR; PG8_SCHED;
            PG8_LDB(B1, 1, 1); PG8_STAGE(PG8_SB(1, 0), b3, voffB);
            PG8_BAR; PG8_WAIT_L(0); PG8_MMA(0, 1, At, B1); PG8_BAR;
            PG8_LDA(At, 1, 1); PG8_STAGE(PG8_SA(1, 0), a3, voffA);
            PG8_BAR; PG8_WAIT_L(0); PG8_MMA(1, 0, At, B0); PG8_BAR; PG8_SCHED;
            PG8_STAGE(PG8_SB(1, 1), b3 + hstep, voffB);
            PG8_WAIT_V(6); PG8_BAR; PG8_MMA(1, 1, At, B1); PG8_BAR;
            }
        }
        if constexpr (ALIGN_EPI) { if (wr == 0) PG8_BAR; }
        if constexpr (!Epi::AFTER_DRAIN) { E(acc, cur, wr, wc, fr, fq); S.done(cur); }
        if (!has_next) break;
#pragma unroll
        for (int a = 0; a < 2; ++a)
#pragma unroll
            for (int b = 0; b < 2; ++b)
#pragma unroll
                for (int m = 0; m < 4; ++m)
#pragma unroll
                    for (int n = 0; n < 2; ++n) acc[a][b][m][n] = (f32x4){0.f, 0.f, 0.f, 0.f};
        cur = nxt; cA = nA; cB = nB; ++ui;
        if constexpr (ALIGN_EPI) { if (wr == 1) PG8_BAR; }
    }
    PG8_WAIT_V(0);
    if constexpr (!ALIGN_EPI) { if (wr == 0) PG8_BAR; }
    PG8_BAR;
    if constexpr (Epi::AFTER_DRAIN) { E.fused(acc, cur, wr, wc, fr, fq, lds, wid, lane); S.done(cur); }
#undef PG8_SA
#undef PG8_SB
#undef PG8_STAGE
#undef PG8_LDA
#undef PG8_LDB
#undef PG8_MMA
#undef PG8_WAIT_V
#undef PG8_WAIT_L
#undef PG8_BAR
#undef PG8_SCHED
}
}

#ifndef PG8_SP2
#define PG8_SP2 true
#endif
#ifndef PG8_ALIGN
#define PG8_ALIGN true
#endif
#define XB_TMO      128
#define XB_XCNT(j)  (256  + 64 * (j))
#define XB_XSUB(j)  (1280 + 64 * (j))
#define XB_XGEN(j)  (2304 + 64 * (j))
#define XB_TOP      3328
#define XB_TOPGEN   3392
#define XCD_BAR_WORDS 3456
#define XB_SPIN_CAP (1u << 18)
#define LAS __attribute__((address_space(3)))

__device__ __forceinline__ unsigned xb_ld(unsigned* p)              { return __hip_atomic_load(p, __ATOMIC_RELAXED, __HIP_MEMORY_SCOPE_AGENT); }
__device__ __forceinline__ unsigned xb_add(unsigned* p, unsigned v) { return __hip_atomic_fetch_add(p, v, __ATOMIC_RELAXED, __HIP_MEMORY_SCOPE_AGENT); }
__device__ __forceinline__ unsigned xb_xcc_id() { return (unsigned)__builtin_amdgcn_s_getreg((3 << 11) | 20) & 0xFu; }
#define XB_SPIN(cond, bar) do { unsigned _sp = 0; while (cond) { __builtin_amdgcn_s_sleep(1); \
    if ((++_sp & 255u) == 0u) { if (xb_ld(&(bar)[XB_TMO])) break; if (_sp > XB_SPIN_CAP) { atomicAdd(&(bar)[XB_TMO], 1u); break; } } } } while (0)

struct XcdBarrier {
    unsigned* bar; unsigned x;
    unsigned w0;
    volatile LAS unsigned* st;
};

__device__ __forceinline__ XcdBarrier xcd_barrier_post(unsigned* bar, volatile LAS unsigned* st) {
    XcdBarrier b; b.bar = bar; b.x = xb_xcc_id(); b.st = st; b.w0 = (unsigned)__builtin_amdgcn_readfirstlane(threadIdx.x >> 6);
    if (threadIdx.x == 0) (void)xb_add(&bar[XB_XCNT(b.x)], 1u);
    return b;
}
__device__ __forceinline__ void xcd_barrier_complete(unsigned* bar, unsigned x, unsigned& nloc, unsigned& nx) {
    const unsigned G = gridDim.x * gridDim.y * gridDim.z;
    unsigned sum, cnt, mine, sp = 0u;
    for (;;) {
        sum = 0u; cnt = 0u; mine = 0u;
#pragma unroll
        for (unsigned j = 0; j < 16; ++j) { const unsigned c = xb_ld(&bar[XB_XCNT(j)]); sum += c; cnt += (c > 0u) ? 1u : 0u; mine = (j == x) ? c : mine; }
        if (sum == G) break;
        __builtin_amdgcn_s_sleep(1);
        if ((++sp & 255u) == 0u) { if (xb_ld(&bar[XB_TMO])) break; if (sp > XB_SPIN_CAP) { atomicAdd(&bar[XB_TMO], 1u); break; } }
    }
    nloc = mine > 0u ? mine : 1u; nx = cnt > 0u ? cnt : 1u;
}

__device__ __forceinline__ void xcd_barrier(const XcdBarrier& b) {
    asm volatile("s_waitcnt vmcnt(0)" ::: "memory");
    __syncthreads();
    if (b.w0 == 0u && __builtin_amdgcn_mbcnt_hi(~0u, __builtin_amdgcn_mbcnt_lo(~0u, 0u)) == 0u) {
        unsigned* bar = b.bar;
        __builtin_amdgcn_s_waitcnt(0);
        unsigned nloc = b.st[0], nx = b.st[1];
        if (nloc == 0u) { xcd_barrier_complete(bar, b.x, nloc, nx); b.st[0] = nloc; b.st[1] = nx; }
        const unsigned old = xb_add(&bar[XB_XSUB(b.x)], 1u);
        const unsigned gen = old / nloc;
        if (old + 1u == (gen + 1u) * nloc) {
            __builtin_amdgcn_fence(__ATOMIC_RELEASE, "agent");
            asm volatile("s_waitcnt vmcnt(0)" ::: "memory");
            const unsigned og = xb_add(&bar[XB_TOP], 1u);
            const unsigned tg = og / nx;
            if (og + 1u == (tg + 1u) * nx) xb_add(&bar[XB_TOPGEN], 1u);
            else XB_SPIN(xb_ld(&bar[XB_TOPGEN]) == tg, bar);
            __builtin_amdgcn_fence(__ATOMIC_ACQUIRE, "agent");
            xb_add(&bar[XB_XGEN(b.x)], 1u);
            asm volatile("s_waitcnt vmcnt(0)" ::: "memory");
        } else {
            XB_SPIN(xb_ld(&bar[XB_XGEN(b.x)]) == gen, bar);
            __builtin_amdgcn_fence(__ATOMIC_ACQUIRE, "agent");
            asm volatile("s_waitcnt vmcnt(0)" ::: "memory");
        }
    }
    __syncthreads();
}
constexpr int NWAVES = 8;
constexpr int D = 2048, FF = 5632, NFF2 = 2 * FF, NQKV = 18432, NHY = 6144, DEPTH = 4;
constexpr int T_PROMPT = 4 * 8192, T = 49152;
constexpr float LN_EPS = 1e-5f;
constexpr float QSCALE = 0.12751743082459868f;
constexpr float LOG2E = 1.4426950408889634f;
constexpr float MIN_DECAY = -3.0701134573253946f, MAX_DECAY = -15.350567286626973f;

constexpr size_t MiB = 1u << 20;
constexpr size_t WS_CTL = 0, CTL_ZERO_BYTES = 64 * 1024;
constexpr size_t WS_IDG = 1 * MiB, WS_IDB = 1 * MiB + 32768, WS_DUMP = 1 * MiB + 32768 + 131072;
constexpr size_t WS_CD = 2 * MiB;
constexpr size_t WS_STATS = 3 * MiB;
constexpr size_t WS_H2T = 4 * MiB;
constexpr size_t WS_PART = 8 * MiB;
constexpr size_t WS_W = 32 * MiB;
constexpr size_t W_IN1 = WS_W, W_OUT1 = W_IN1 + 44 * MiB, W_IN2 = W_OUT1 + 22 * MiB, W_OUT2 = W_IN2 + 44 * MiB, W_MIN = W_OUT2 + 22 * MiB, W_MOUT = W_MIN + 72 * MiB;
constexpr size_t WS_ZB = W_MOUT + 8 * MiB;
constexpr size_t WS_BIG = WS_ZB + 192 * MiB;
constexpr size_t BIG_HID = 0;
constexpr size_t BIG_QKV = 0, BIG_AO = 1728 * MiB;
constexpr size_t BIG_U = 0, BIG_Z2T = 0, BIG_Z2 = 192 * MiB, BIG_UT = 576 * MiB, BIG_SPEC0 = 1152 * MiB, BIG_SPEC1 = 1664 * MiB;
constexpr size_t WS_END = WS_BIG + 1920 * MiB;
static_assert(WS_ZB == 244 * MiB && WS_BIG == 436 * MiB && (size_t)T * 64 * 8 <= 24 * MiB && WS_END <= 2816 * MiB, "ws map");
static_assert((size_t)T * FF * 2 <= 528 * MiB && (size_t)T * NQKV * 2 <= 1728 * MiB && (size_t)T * NHY * 2 <= 576 * MiB && BIG_SPEC1 + 128 * MiB <= 1920 * MiB, "ws map");

constexpr int RING_OFF = 0;
constexpr int FFT_BYTES = (16384 + 512) * 8;
constexpr int SCR_OFF = FFT_BYTES;
constexpr int MISC_OFF = SCR_OFF + 1024;
constexpr int PTR_OFF = MISC_OFF + 256;
constexpr int LDS_BYTES = PTR_OFF + 256;

#define GAS __attribute__((address_space(1)))
#define LAS __attribute__((address_space(3)))
typedef unsigned short bf16;
typedef unsigned v4u __attribute__((ext_vector_type(4)));
typedef unsigned v2u __attribute__((ext_vector_type(2)));
typedef float f32x4 __attribute__((ext_vector_type(4)));
typedef float f32x2 __attribute__((ext_vector_type(2)));
typedef float f32x16 __attribute__((ext_vector_type(16)));
typedef short bf16x8 __attribute__((ext_vector_type(8)));
typedef short s16x4 __attribute__((ext_vector_type(4)));
#define LDS_WAIT() asm volatile("s_waitcnt lgkmcnt(0)" ::: "memory")
#define VM_WAIT() asm volatile("s_waitcnt vmcnt(0)" ::: "memory")
__device__ __forceinline__ unsigned f2bf(float f) { unsigned u = __builtin_bit_cast(unsigned, f); return (u + 0x7fffu + ((u >> 16) & 1u)) >> 16; }
__device__ __forceinline__ unsigned pk2(float lo, float hi) { return f2bf(lo) | (f2bf(hi) << 16); }
__device__ __forceinline__ float bf2f(unsigned b) { return __builtin_bit_cast(float, b << 16); }
__device__ __forceinline__ float bfround(float f) { return bf2f(f2bf(f)); }

#ifndef FFT_HD
#define FFT_HD __host__ __device__ __forceinline__
#endif
#if defined(__clang__)
typedef float cpx __attribute__((ext_vector_type(2)));
#else
struct cpx { float x, y; };
#endif
FFT_HD cpx cmul(cpx a, cpx b) { return cpx{a.x * b.x - a.y * b.y, a.x * b.y + a.y * b.x}; }
FFT_HD cpx cmulc(cpx a, cpx b) { return cpx{a.x * b.x + a.y * b.y, a.y * b.x - a.x * b.y}; }
FFT_HD cpx cadd(cpx a, cpx b) { return cpx{a.x + b.x, a.y + b.y}; }
FFT_HD cpx csub(cpx a, cpx b) { return cpx{a.x - b.x, a.y - b.y}; }
FFT_HD int pidx(int i) { return i + (i >> 5); }
FFT_HD cpx cis_neg_rev(float rev) {
    const float x8 = rev * 8.0f; int oct = (int)x8; oct = oct > 7 ? 7 : oct; const float f = x8 - (float)oct;
    const float a = (oct & 1) ? (1.0f - f) : f, phi = a * 0.78539816339744831f, p2 = phi * phi;
    const float s = phi * (1.0f + p2 * (-1.6666666666666666e-1f + p2 * (8.3333333333333332e-3f + p2 * (-1.9841269841269841e-4f + p2 * 2.7557319223985893e-6f))));
    const float c = 1.0f + p2 * (-0.5f + p2 * (4.1666666666666664e-2f + p2 * (-1.3888888888888889e-3f + p2 * (2.4801587301587302e-5f + p2 * -2.7557319223985888e-7f))));
    const bool sw = ((oct + 1) & 2) != 0;
    float cc = sw ? s : c, ss = sw ? c : s;
    if (oct >= 2 && oct <= 5) cc = -cc;
    if (oct >= 4) ss = -ss;
    return cpx{cc, -ss};
}
FFT_HD float sin_acc(float x) { float rev = x * 0.15915494309189535f; rev -= floorf(rev); const cpx e = cis_neg_rev(rev); return -e.y; }
FFT_HD float cos_rev(float rev) { rev -= floorf(rev); return cis_neg_rev(rev).x; }
FFT_HD float sin_rev(float rev) { rev -= floorf(rev); return -cis_neg_rev(rev).y; }
FFT_HD cpx w16(int k) {
    constexpr float C1 = 0.92387953251128674f, S1 = 0.38268343236508977f, R2 = 0.70710678118654752f;
    switch (k) { case 0: return cpx{1.f, 0.f}; case 1: return cpx{C1, -S1}; case 2: return cpx{R2, -R2}; case 3: return cpx{S1, -C1};
                 case 4: return cpx{0.f, -1.f}; case 5: return cpx{-S1, -C1}; case 6: return cpx{-R2, -R2}; default: return cpx{-C1, -S1}; }
}
template <int R> FFT_HD constexpr int bitrev(int i) { int r = 0; for (int b = 1, c = R >> 1; b < R; b <<= 1, c >>= 1) if (i & b) r |= c; return r; }
template <int R> FFT_HD void dif_regs(cpx (&a)[R]) {
#pragma unroll
    for (int len = R; len >= 2; len >>= 1) { const int half = len >> 1;
#pragma unroll
        for (int b0 = 0; b0 < R; b0 += len)
#pragma unroll
            for (int j = 0; j < half; ++j) { const cpx u = a[b0 + j], v = a[b0 + j + half]; a[b0 + j] = cadd(u, v); const cpx d = csub(u, v); a[b0 + j + half] = (j == 0) ? d : cmul(d, w16(j * (16 / len))); } }
}
template <int R> FFT_HD void dit_regs(cpx (&a)[R]) {
#pragma unroll
    for (int len = 2; len <= R; len <<= 1) { const int half = len >> 1;
#pragma unroll
        for (int b0 = 0; b0 < R; b0 += len)
#pragma unroll
            for (int j = 0; j < half; ++j) { const cpx u = a[b0 + j]; const cpx v = (j == 0) ? a[b0 + j + half] : cmulc(a[b0 + j + half], w16(j * (16 / len))); a[b0 + j] = cadd(u, v); a[b0 + j + half] = csub(u, v); } }
}
template <int R> FFT_HD void twiddle_powers(cpx w1, cpx (&pw)[R]) {
    pw[0] = cpx{1.f, 0.f}; pw[1] = w1; pw[2] = cmul(w1, w1); pw[3] = cmul(pw[2], w1);
    if constexpr (R > 4) { pw[4] = cmul(pw[2], pw[2]); pw[5] = cmul(pw[4], pw[1]); pw[6] = cmul(pw[4], pw[2]); pw[7] = cmul(pw[4], pw[3]); }
    if constexpr (R > 8) { pw[8] = cmul(pw[4], pw[4]);
#pragma unroll
        for (int k = 1; k < 8; ++k) pw[8 + k] = cmul(pw[8], pw[k]); }
}
template <int R, bool INV, class P> FFT_HD void fft_pass(P X, int tid, int nthr, int logM) {
    constexpr int LOGR = (R == 16) ? 4 : 2;
    const int logs = logM - LOGR, s = 1 << logs;
#pragma unroll 1
    for (int blk = tid; blk < 16384 / R; blk += nthr) {
        const int base = blk & (s - 1), idx0 = ((blk >> logs) << logM) + base;
        cpx a[R], pw[R];
        if (logs > 0) twiddle_powers<R>(cis_neg_rev((float)base / (float)(1 << logM)), pw);
        if (!INV) {
#pragma unroll
            for (int j = 0; j < R; ++j) a[j] = X[pidx(idx0 + (j << logs))];
            dif_regs<R>(a);
#pragma unroll
            for (int i = 0; i < R; ++i) { const int k1 = bitrev<R>(i); cpx v = a[i]; if (logs > 0 && k1 != 0) v = cmul(v, pw[k1]); X[pidx(idx0 + (k1 << logs))] = v; }
        } else {
#pragma unroll
            for (int i = 0; i < R; ++i) { const int k1 = bitrev<R>(i); cpx v = X[pidx(idx0 + (k1 << logs))]; if (logs > 0 && k1 != 0) v = cmulc(v, pw[k1]); a[i] = v; }
            dit_regs<R>(a);
#pragma unroll
            for (int j = 0; j < R; ++j) X[pidx(idx0 + (j << logs))] = a[j];
        }
    }
}
struct Frame {
    LAS unsigned char* lds;
    int tid, lane, wave;
    int vcu, G, bx;
    unsigned char* ws; float* z;
};
__device__ __forceinline__ Frame make_frame(unsigned char* lds_generic, unsigned char* ws, float* out, int wave0) {
    Frame F;
    int lane = (int)__builtin_amdgcn_mbcnt_hi(~0u, __builtin_amdgcn_mbcnt_lo(~0u, 0u)), bx = blockIdx.x, G = gridDim.x;
    asm volatile("" : "+v"(lane)); asm volatile("" : "+s"(bx)); asm volatile("" : "+s"(G)); asm volatile("" : "+s"(wave0));
    const int tid = wave0 * 64 + lane;
    unsigned long long w = (unsigned long long)ws, o = (unsigned long long)out; asm volatile("" : "+s"(w)); asm volatile("" : "+s"(o));
    F.lds = (LAS unsigned char*)lds_generic;
    F.tid = tid; F.lane = lane; F.wave = wave0;
    F.G = G; F.bx = bx; F.vcu = (G % 8 == 0) ? (bx % 8) * (G / 8) + bx / 8 : bx;
    F.ws = (unsigned char*)(GAS unsigned char*)w; F.z = (float*)(GAS float*)o;
    return F;
}
__device__ __forceinline__ const float* inp(const Frame& F, int i) {
    const LAS unsigned* t = (const LAS unsigned*)(F.lds + PTR_OFF) + 2 * i;
    const unsigned lo = __builtin_amdgcn_readfirstlane(t[0]), hi = __builtin_amdgcn_readfirstlane(t[1]);
    return (const float*)(const GAS float*)(((unsigned long long)hi << 32) | lo);
}
__device__ __forceinline__ float wave_sum(float v) { return pg8::wave_sum64(v); }
__device__ __forceinline__ void block_sum2(Frame& F, float& a, float& b) {
    LAS float* scr = (LAS float*)(F.lds + SCR_OFF);
    a = wave_sum(a); b = wave_sum(b);
    __syncthreads();
    if (F.lane == 0) { scr[F.wave * 2] = a; scr[F.wave * 2 + 1] = b; }
    __syncthreads();
    float sa = 0.f, sb = 0.f;
#pragma unroll
    for (int w = 0; w < NWAVES; ++w) { sa += scr[w * 2]; sb += scr[w * 2 + 1]; }
    a = sa; b = sb;
}

__device__ __forceinline__ void phase_init(Frame& F) {
    const int gw = F.vcu * NWAVES + F.wave, NGW = F.G * NWAVES;
    bf16* zb = (bf16*)(F.ws + WS_ZB); float* stats = (float*)(F.ws + WS_STATS);
    const float* x0 = inp(F, 0); const float* x1 = inp(F, 1);
    for (int m = gw; m < T; m += NGW) {
        const float* src = (m < T_PROMPT) ? x0 + (size_t)m * D : x1 + (size_t)(m - T_PROMPT) * D;
        const GAS f32x4* s4 = (const GAS f32x4*)src + F.lane; GAS f32x4* d4 = (GAS f32x4*)(F.z + (size_t)m * D) + F.lane; GAS v2u* b4 = (GAS v2u*)(zb + (size_t)m * D) + F.lane;
#pragma unroll
        for (int j = 0; j < 8; ++j) { const f32x4 v = s4[64 * j]; d4[64 * j] = v; v2u o; o.x = pk2(v.x, v.y); o.y = pk2(v.z, v.w); b4[64 * j] = o; }
        if (F.lane == 0) { stats[2 * m] = 0.f; stats[2 * m + 1] = 1.f; }
    }
    const int gt = F.vcu * (NWAVES * 64) + F.tid;
    if (gt < 8192) ((float*)(F.ws + WS_IDG))[gt] = 1.f;
    if (gt < 32768) ((float*)(F.ws + WS_IDB))[gt] = 0.f;
}

struct ConvJob { const float* W; int K, N; bf16* WT; const float* gk; const float* bk; float* cvec; float* dvec; const float* ebias; int mode; };
__device__ __forceinline__ void conv_item(const float* W, int K, int N, bf16* WT, const float* gk, const float* bk, float* cvec, float* dvec, const float* ebias, int mode, int nb, LAS float* scr, int lane) {
    const int n0 = 32 * nb, n = lane & 31, kh = lane >> 5;
    const float colscale = (mode == 2 && n0 < 6144) ? QSCALE : 1.0f;
    int rbase = n0;
    if (mode == 1) { rbase = (n0 < FF) ? (n0 / 128) * 256 + (n0 % 128) : ((n0 - FF) / 128) * 256 + 128 + ((n0 - FF) % 128); }
    float csum = 0.f, dsum = 0.f;
    for (int k0 = 0; k0 < K; k0 += 64) {
#pragma unroll 8
        for (int i = 0; i < 32; ++i) { const int kk = 2 * i + kh; const float w = W[(size_t)(k0 + kk) * N + n0 + n] * colscale;
            const float v = bfround(w * gk[k0 + kk]); scr[kk * 33 + n] = v; csum += v; dsum += bk[k0 + kk] * w; }
        LDS_WAIT(); asm volatile("" ::: "memory");
        const int c = lane & 7;
#pragma unroll
        for (int j = 0; j < 4; ++j) { const int nn = (lane >> 3) + 8 * j; const LAS float* s = scr + (8 * c) * 33 + nn;
            v4u o; o.x = pk2(s[0 * 33], s[1 * 33]); o.y = pk2(s[2 * 33], s[3 * 33]); o.z = pk2(s[4 * 33], s[5 * 33]); o.w = pk2(s[6 * 33], s[7 * 33]);
            *(GAS v4u*)(WT + (size_t)(rbase + nn) * K + k0 + 8 * c) = o; }
        LDS_WAIT(); asm volatile("" ::: "memory");
    }
    csum = pg8::xor32_sum(csum); dsum = pg8::xor32_sum(dsum);
    if (lane < 32) { cvec[rbase + n] = csum; dvec[rbase + n] = dsum + ebias[n0 + n]; }
}
__device__ __forceinline__ void filt_pos(Frame& F, int jl, int var, int t) {
    const int L = var ? 2048 : 8192, lane = F.lane;
    const float* w1 = inp(F, 12) + (size_t)jl * 33 * 64; const float* b1 = inp(F, 13) + jl * 64; const float* w2 = inp(F, 14) + (size_t)jl * 64 * 64; const float* b2 = inp(F, 15) + jl * 64; const float* fr = inp(F, 16) + jl * 64;
    float feat = 0.f;
    if (lane == 0) feat = (float)t / (float)(L - 1);
    else if (lane < 33) { const int bi = (lane - 1) & 15; const float band = 1e-4f + (float)bi * ((15.0f - 1e-4f) / 15.0f); const float rev = band * ((float)t / (float)L);
        feat = (lane < 17) ? cos_rev(rev) : -sin_rev(rev); }
    float acc = b1[lane];
    for (int k = 0; k < 33; ++k) acc += __builtin_bit_cast(float, __builtin_amdgcn_readlane(__builtin_bit_cast(int, feat), k)) * w1[k * 64 + lane];
    const float fq = fr[lane];
    const float h1 = sin_acc(fq * acc);
    float acc2 = b2[lane];
    for (int k = 0; k < 64; ++k) acc2 += __builtin_bit_cast(float, __builtin_amdgcn_readlane(__builtin_bit_cast(int, h1), k)) * w2[k * 64 + lane];
    const float h2 = sin_acc(fq * acc2);
    float* h2T = (float*)(F.ws + WS_H2T) + (var ? 64 * 8192 : 0);
    h2T[(size_t)lane * L + t] = h2;
}
__device__ __forceinline__ void phase_convert(Frame& F, int layer) {
    LAS float* scr = (LAS float*)(F.lds + RING_OFF + F.wave * 16384);
    const int gw = F.vcu * NWAVES + F.wave, NGW = F.G * NWAVES;
    const int jl = layer >> 1; const bool hy = (layer & 1) != 0;
    const float* ln_g = inp(F, 2); const float* ln_b = inp(F, 3);
    const float* ones = (const float*)(F.ws + WS_IDG); const float* zeros = (const float*)(F.ws + WS_IDB); float* dump = (float*)(F.ws + WS_DUMP);
    float* cd = (float*)(F.ws + WS_CD);
    float* c1 = cd, *d1 = cd + NFF2, *cm = cd + 2 * NFF2, *dm = cm + NQKV, *c2 = dm + NQKV, *d2 = c2 + NFF2;
    const int nb1 = D / 32, nb0 = NFF2 / 32, nb4 = (hy ? NHY : NQKV) / 32, nb5 = D / 32;
    const int total = 2 * nb1 + 2 * nb0 + nb4 + nb5;
    for (int it = gw; it < total; it += NGW) {
        int r = it;
        if (r < 2 * nb1) { const int f = r / nb1; r -= f * nb1;
            conv_item(inp(F, 5) + (size_t)(layer * 2 + f) * FF * D, FF, D, (bf16*)(F.ws + (f ? W_OUT2 : W_OUT1)), ones, zeros, dump, dump + NQKV, zeros, 0, r, scr, F.lane); continue; }
        r -= 2 * nb1;
        if (r < 2 * nb0) { const int f = r / nb0; r -= f * nb0;
            const float* gk = f ? ln_g + (size_t)(layer * 3 + 1) * D : (layer ? ln_g + (size_t)((layer - 1) * 3 + 2) * D : ones);
            const float* bk = f ? ln_b + (size_t)(layer * 3 + 1) * D : (layer ? ln_b + (size_t)((layer - 1) * 3 + 2) * D : zeros);
            conv_item(inp(F, 4) + (size_t)(layer * 2 + f) * D * NFF2, D, NFF2, (bf16*)(F.ws + (f ? W_IN2 : W_IN1)), gk, bk, f ? c2 : c1, f ? d2 : d1, zeros, 1, r, scr, F.lane); continue; }
        r -= 2 * nb0;
        if (r < nb4) {
            const float* gk = ln_g + (size_t)(layer * 3) * D; const float* bk = ln_b + (size_t)(layer * 3) * D;
            if (hy) conv_item(inp(F, 8) + (size_t)jl * D * NHY, D, NHY, (bf16*)(F.ws + W_MIN), gk, bk, cm, dm, inp(F, 9) + (size_t)jl * NHY, 0, r, scr, F.lane);
            else conv_item(inp(F, 6) + (size_t)jl * D * NQKV, D, NQKV, (bf16*)(F.ws + W_MIN), gk, bk, cm, dm, zeros, 2, r, scr, F.lane);
            continue; }
        r -= nb4;
        conv_item((hy ? inp(F, 19) : inp(F, 7)) + (size_t)jl * D * D, D, D, (bf16*)(F.ws + W_MOUT), ones, zeros, dump, dump + NQKV, zeros, 0, r, scr, F.lane);
    }
    if (hy) { for (int p = gw; p < 8192 + 2048; p += NGW) { if (p < 8192) filt_pos(F, jl, 0, p); else filt_pos(F, jl, 1, p - 8192); } }
}

__device__ __forceinline__ void phase_finalize(Frame& F) {
    const float* part = (const float*)(F.ws + WS_PART); float* stats = (float*)(F.ws + WS_STATS);
    for (int row = F.vcu * (NWAVES * 64) + F.tid; row < T; row += F.G * NWAVES * 64) {
        const GAS f32x4* p = (const GAS f32x4*)(part + (size_t)row * 128);
        float s = 0.f, q = 0.f;
#pragma unroll 8
        for (int j = 0; j < 32; ++j) { const f32x4 v = p[j]; s += v.x + v.z; q += v.y + v.w; }
        const float mean = s * (1.0f / D); const float var = fmaxf(q * (1.0f / D) - mean * mean, 0.f);
        *(GAS f32x2*)(stats + 2 * (size_t)row) = (f32x2){mean, 1.0f / sqrtf(var + LN_EPS)};
    }
}

#ifdef DBG_CHECK
__device__ __forceinline__ void phase_check_qkv(Frame& F) {
    const int gw = F.vcu * NWAVES + F.wave, NGW = F.G * NWAVES;
    const float* W = inp(F, 6); const float* g = inp(F, 2); const float* b = inp(F, 3);
    const float* stats = (const float*)(F.ws + WS_STATS); const bf16* QKV = (const bf16*)(F.ws + WS_BIG + BIG_QKV);
#ifndef DBG_ROW0
#define DBG_ROW0 0
#define DBG_ROW1 T
#endif
#ifndef DBG_COL0
#define DBG_COL0 0
#define DBG_COL1 NQKV
#endif
    float worst = 0.f; unsigned nbad = 0;
#ifdef CHK_ROWS
    {
        const bf16* zbp = (const bf16*)(F.ws + WS_ZB);
        for (int s = gw; s < 8192; s += NGW) {
            const unsigned hsh = (unsigned)s * 2654435761u; const int row = (int)(hsh % (unsigned)T);
            float sm = 0.f, sq = 0.f, dz = 0.f;
            for (int k = F.lane; k < D; k += 64) { const float v = F.z[(size_t)row * D + k]; sm += v; sq += v * v; dz = fmaxf(dz, fabsf(bf2f(zbp[(size_t)row * D + k]) - v)); }
            sm = wave_sum(sm); sq = wave_sum(sq); dz = fmaxf(dz, pg8::xor32_max(dz)); dz = fmaxf(dz, pg8::swz_xor<16>(dz)); dz = fmaxf(dz, pg8::swz_xor<8>(dz)); dz = fmaxf(dz, pg8::swz_xor<4>(dz)); dz = fmaxf(dz, pg8::swz_xor<2>(dz)); dz = fmaxf(dz, pg8::swz_xor<1>(dz));
            const float mean = sm * (1.0f / D), var = sq * (1.0f / D) - mean * mean, rstd = 1.0f / sqrtf(var + LN_EPS);
            const bool bad = (CHK_ROWS == 1) ? (fabsf(mean - stats[2 * row]) > CHK_MTOL || fabsf(rstd - stats[2 * row + 1]) > CHK_RTOL * rstd) : (dz > 0.05f);
            nbad += bad ? 1u : 0u;
        }
        if (F.lane == 0 && nbad) atomicAdd((unsigned*)(F.ws + WS_CTL) + 15000, nbad);
        return;
    }
#endif
    for (int s = gw; s < 8192; s += NGW) {
        const unsigned hsh = (unsigned)s * 2654435761u; const int row = DBG_ROW0 + (int)(hsh % (unsigned)(DBG_ROW1 - DBG_ROW0)), col = DBG_COL0 + (int)((hsh >> 7) % (unsigned)(DBG_COL1 - DBG_COL0));
#ifdef CHK_HYP
        const float mean = 0.f, rstd = 1.f;
#else
        const float mean = stats[2 * row], rstd = stats[2 * row + 1];
#endif
        float acc = 0.f;
        for (int k = F.lane; k < D; k += 64) acc += ((F.z[(size_t)row * D + k] - mean) * rstd * g[k] + b[k]) * W[(size_t)k * NQKV + col];
        acc = wave_sum(acc) * (col < 6144 ? QSCALE : 1.0f);
        const float got = bf2f(QKV[(size_t)row * NQKV + col]);
        worst = fmaxf(worst, fabsf(got - acc)); nbad += (fabsf(got - acc) > DBG_THR) ? 1u : 0u;
    }
#ifdef DBG_COUNT
    if (F.lane == 0 && nbad) atomicAdd((unsigned*)(F.ws + WS_CTL) + 15000, nbad);
#else
    if (F.lane == 0) atomicMax((unsigned*)(F.ws + WS_CTL) + 15000, __builtin_bit_cast(unsigned, worst));
#endif
}
#endif
__device__ __forceinline__ void phase_final_ln(Frame& F) {
    const int gw = F.vcu * NWAVES + F.wave, NGW = F.G * NWAVES;
    const float* stats = (const float*)(F.ws + WS_STATS);
    const float* g = inp(F, 2) + (size_t)(3 * 3 + 2) * D; const float* b = inp(F, 3) + (size_t)(3 * 3 + 2) * D;
    for (int m = gw; m < T; m += NGW) {
        const float mean = stats[2 * m], rstd = stats[2 * m + 1];
        GAS f32x4* d4 = (GAS f32x4*)(F.z + (size_t)m * D) + F.lane; const GAS f32x4* g4 = (const GAS f32x4*)g + F.lane; const GAS f32x4* b4 = (const GAS f32x4*)b + F.lane;
        float dbg = 0.f;
#ifdef DBG_CHECK
        #ifdef DBG_COUNT
        const float dbgval = (float)((const unsigned*)(F.ws + WS_CTL))[15000] * DBG_CHECK_SCALE;
#else
        const float dbgval = __builtin_bit_cast(float, ((const unsigned*)(F.ws + WS_CTL))[15000]) * DBG_CHECK_SCALE;
#endif
#endif
#ifdef DBG_BUF
        {
            const bf16* bp = (const bf16*)(F.ws + WS_BIG + DBG_OFF) + (size_t)m * DBG_PITCH; float s = 0.f;
            for (int c = F.lane; c < DBG_COLS; c += 64) s += bf2f(bp[c]) * (float)(1 + (c & 7));
            dbg = wave_sum(s) * 0.01f;
        }
#endif
#pragma unroll
        for (int j = 0; j < 8; ++j) { const f32x4 v = d4[64 * j] + dbg; d4[64 * j] = (v - mean) * rstd * g4[64 * j] + b4[64 * j];
#ifdef DBG_CHECK
            d4[64 * j] = (f32x4){dbgval, dbgval, dbgval, dbgval};
#endif
        }
    }
}

__device__ __forceinline__ void transpose_tile(const bf16* src, size_t sp, bf16* dst, size_t dp, int r0, int c0, LAS unsigned char* scr, int lane) {
#pragma unroll
    for (int i = 0; i < 8; ++i) { const int row = (lane >> 3) + 8 * i, ch = lane & 7;
        const v4u v = *(const GAS v4u*)(src + (size_t)(r0 + row) * sp + c0 + 8 * ch);
        LAS unsigned* w = (LAS unsigned*)(scr + row * 132 + ch * 16); w[0] = v.x; w[1] = v.y; w[2] = v.z; w[3] = v.w; }
    LDS_WAIT(); asm volatile("" ::: "memory");
    const LAS unsigned short* rd = (const LAS unsigned short*)(scr + lane * 132);
#pragma unroll 8
    for (int c = 0; c < 64; ++c) dst[(size_t)(c0 + c) * dp + r0 + lane] = rd[c];
    LDS_WAIT(); asm volatile("" ::: "memory");
}
__device__ __forceinline__ void phase_transpose(Frame& F, const bf16* src, int R, int C, bf16* dst) {
    LAS unsigned char* scr = F.lds + RING_OFF + F.wave * 16384;
    const int gw = F.vcu * NWAVES + F.wave, NGW = F.G * NWAVES, tr = R / 64, tc = C / 64;
    for (int it = gw; it < tr * tc; it += NGW) { const int a = it / tc, b = it % tc; transpose_tile(src, (size_t)C, dst, (size_t)R, 64 * a, 64 * b, scr, F.lane); }
}
__device__ __forceinline__ void fft_forward(LAS cpx* X, int tid, int logN) {
    int logM = logN;
    for (; logM >= 4; logM -= 4) { fft_pass<16, false>(X, tid, NWAVES * 64, logM); __syncthreads(); }
    if (logM == 2) { fft_pass<4, false>(X, tid, NWAVES * 64, 2); __syncthreads(); }
}
__device__ __forceinline__ void fft_inverse(LAS cpx* X, int tid, int logN) {
    const int rem = logN & 3;
    if (rem == 2) { fft_pass<4, true>(X, tid, NWAVES * 64, 2); __syncthreads(); }
    for (int logM = 4 + rem; logM <= logN; logM += 4) { fft_pass<16, true>(X, tid, NWAVES * 64, logM); __syncthreads(); }
}
template <int VAR> __device__ __forceinline__ void spec_unit(Frame& F, int jl, int c) {
    constexpr int L = VAR ? 2048 : 8192, N = 2 * L, LOGN = VAR ? 12 : 14, NP = L / 512;
    LAS cpx* X = (LAS cpx*)(F.lds + RING_OFF);
    int tid = F.tid; asm volatile("" : "+v"(tid));
    const float* h2T = (const float*)(F.ws + WS_H2T) + (VAR ? 64 * 8192 : 0);
    const float* w3 = inp(F, 17) + (size_t)jl * 64 * 8192 + c;
    float acc[NP][4];
#pragma unroll
    for (int k = 0; k < NP; ++k) { acc[k][0] = 0.f; acc[k][1] = 0.f; acc[k][2] = 0.f; acc[k][3] = 0.f; }
#pragma unroll 1
    for (int j = 0; j < 64; ++j) {
        const float wa = w3[(size_t)j * 8192], wb = w3[(size_t)j * 8192 + 2048], wc = w3[(size_t)j * 8192 + 4096], wd = w3[(size_t)j * 8192 + 6144];
#pragma unroll
        for (int k = 0; k < NP; ++k) { const float hv = h2T[(size_t)j * L + tid + 512 * k]; acc[k][0] += hv * wa; acc[k][1] += hv * wb; acc[k][2] += hv * wc; acc[k][3] += hv * wd; }
    }
    const float delta = fabsf(MIN_DECAY + (float)c * ((MAX_DECAY - MIN_DECAY) / 2047.0f));
    float n0 = 0.f, n1 = 0.f;
#pragma unroll
    for (int k = 0; k < NP; ++k) { const float tl = (float)(tid + 512 * k) * (1.0f / (float)(L - 1)); const float dec = __builtin_amdgcn_exp2f(-tl * delta * LOG2E);
        acc[k][0] *= dec; acc[k][1] *= dec; acc[k][2] *= dec; acc[k][3] *= dec; n0 += fabsf(acc[k][0]) + fabsf(acc[k][1]); n1 += fabsf(acc[k][2]) + fabsf(acc[k][3]); }
    block_sum2(F, n0, n1);
    const float i0 = 1.0f / n0, i1 = 1.0f / n1;
#pragma unroll
    for (int k = 0; k < NP; ++k) { acc[k][0] *= i0; acc[k][1] *= i0; acc[k][2] *= i1; acc[k][3] *= i1; }
    cpx* spec = (cpx*)(F.ws + WS_BIG + (VAR ? BIG_SPEC1 : BIG_SPEC0));
    if (VAR == 0) {
        float* tmp = (float*)(spec + ((size_t)1 * D + c) * N);
#pragma unroll
        for (int k = 0; k < NP; ++k) *(GAS f32x2*)(tmp + 2 * (tid + 512 * k)) = (f32x2){acc[k][2], acc[k][3]};
        __syncthreads();
#pragma unroll
        for (int k = 0; k < NP; ++k) { const int t = tid + 512 * k; const float hf = acc[k][0], hb = acc[k][1];
            if (t == 0) { X[pidx(0)] = cpx{hf + hb, 0.f}; X[pidx(L)] = cpx{0.f, 0.f}; }
            else { X[pidx(t)] = cpx{hf, 0.f}; X[pidx(N - t)] = cpx{hb, 0.f}; } }
        __syncthreads();
        fft_forward(X, tid, LOGN);
        { cpx* dst = spec + ((size_t)0 * D + c) * N; for (int p = tid; p < N; p += 512) dst[p] = X[pidx(p)]; }
        float h1[NP][2];
#pragma unroll
        for (int k = 0; k < NP; ++k) { const f32x2 v = *(const GAS f32x2*)(tmp + 2 * (tid + 512 * k)); h1[k][0] = v.x; h1[k][1] = v.y; }
        __syncthreads();
#pragma unroll
        for (int k = 0; k < NP; ++k) { const int t = tid + 512 * k; const float hf = h1[k][0], hb = h1[k][1];
            if (t == 0) { X[pidx(0)] = cpx{hf + hb, 0.f}; X[pidx(L)] = cpx{0.f, 0.f}; }
            else { X[pidx(t)] = cpx{hf, 0.f}; X[pidx(N - t)] = cpx{hb, 0.f}; } }
        __syncthreads();
        fft_forward(X, tid, LOGN);
        { cpx* dst = spec + ((size_t)1 * D + c) * N; for (int p = tid; p < N; p += 512) dst[p] = X[pidx(p)]; }
    } else {
        __syncthreads();
#pragma unroll
        for (int k = 0; k < NP; ++k) { const int t = tid + 512 * k;
#pragma unroll
            for (int o = 0; o < 2; ++o) { const float hf = acc[k][2 * o], hb = acc[k][2 * o + 1];
                if (t == 0) { X[pidx(o * N)] = cpx{hf + hb, 0.f}; X[pidx(o * N + L)] = cpx{0.f, 0.f}; }
                else { X[pidx(o * N + t)] = cpx{hf, 0.f}; X[pidx(o * N + N - t)] = cpx{hb, 0.f}; } } }
        for (int p = 2 * N + tid; p < 16384; p += 512) X[pidx(p)] = cpx{0.f, 0.f};
        __syncthreads();
        fft_forward(X, tid, LOGN);
#pragma unroll
        for (int o = 0; o < 2; ++o) { cpx* dst = spec + ((size_t)o * D + c) * N; for (int p = tid; p < N; p += 512) dst[p] = X[pidx(o * N + p)]; }
    }
}
__device__ __forceinline__ void phase_spectra(Frame& F, int jl) {
    for (int u = F.vcu; u < 2 * D; u += F.G) { if (u < D) spec_unit<0>(F, jl, u); else spec_unit<1>(F, jl, u - D); }
    __syncthreads();
}
__device__ __forceinline__ void load_conv16(const bf16* seq, int t0, int L, float w0, float w1, float w2, float cb, float (&out)[16]) {
    const v4u a = *(const GAS v4u*)(seq + t0), b = *(const GAS v4u*)(seq + t0 + 8);
    float u[18];
    u[0] = (t0 > 0) ? bf2f(seq[t0 - 1]) : 0.f; u[17] = (t0 + 16 < L) ? bf2f(seq[t0 + 16]) : 0.f;
    u[1] = bf2f(a.x & 0xffffu); u[2] = bf2f(a.x >> 16); u[3] = bf2f(a.y & 0xffffu); u[4] = bf2f(a.y >> 16); u[5] = bf2f(a.z & 0xffffu); u[6] = bf2f(a.z >> 16); u[7] = bf2f(a.w & 0xffffu); u[8] = bf2f(a.w >> 16);
    u[9] = bf2f(b.x & 0xffffu); u[10] = bf2f(b.x >> 16); u[11] = bf2f(b.y & 0xffffu); u[12] = bf2f(b.y >> 16); u[13] = bf2f(b.z & 0xffffu); u[14] = bf2f(b.z >> 16); u[15] = bf2f(b.w & 0xffffu); u[16] = bf2f(b.w >> 16);
#pragma unroll
    for (int i = 0; i < 16; ++i) out[i] = w0 * u[i] + w1 * u[i + 1] + w2 * u[i + 2] + cb;
}
template <int VAR> __device__ __forceinline__ void conv_unit(Frame& F, int jl, int c, int pair) {
    constexpr int L = VAR ? 2048 : 8192, N = 2 * L, LOGN = VAR ? 12 : 14, TPS = VAR ? 128 : 512;
    LAS cpx* X = (LAS cpx*)(F.lds + RING_OFF);
    int tid = F.tid; asm volatile("" : "+v"(tid));
    const int seg = tid / TPS, t0 = (tid % TPS) * 16;
    const int rowA = VAR ? T_PROMPT + (2 * seg) * L : (2 * pair) * L, rowB = rowA + L;
    const bf16* UT = (const bf16*)(F.ws + WS_BIG + BIG_UT); bf16* Z2T = (bf16*)(F.ws + WS_BIG + BIG_Z2T);
    const float* cw = inp(F, 10) + (size_t)jl * 3 * NHY; const float* cbv = inp(F, 11) + (size_t)jl * NHY; const float* skip = inp(F, 18) + (size_t)jl * 2 * D;
    const cpx* spec = (const cpx*)(F.ws + WS_BIG + (VAR ? BIG_SPEC1 : BIG_SPEC0));
#ifndef CONV_SCALE
#define CONV_SCALE 1.0f
#endif
    const float invN = CONV_SCALE / (float)N;
    float va[16], vb[16];
    { const int ch = c; const float w0 = cw[ch], w1 = cw[NHY + ch], w2 = cw[2 * NHY + ch], cb = cbv[ch];
      load_conv16(UT + (size_t)ch * T + rowA, t0, L, w0, w1, w2, cb, va); load_conv16(UT + (size_t)ch * T + rowB, t0, L, w0, w1, w2, cb, vb); }
    __syncthreads();
#pragma unroll
    for (int i = 0; i < 16; ++i) { X[pidx(seg * N + t0 + i)] = cpx{va[i], vb[i]}; X[pidx(seg * N + L + t0 + i)] = cpx{0.f, 0.f}; }
    __syncthreads();
    fft_forward(X, tid, LOGN);
    { const cpx* H = spec + ((size_t)0 * D + c) * N; for (int p = tid; p < 16384; p += 512) X[pidx(p)] = cmul(X[pidx(p)], H[p & (N - 1)]); }
    __syncthreads();
    fft_inverse(X, tid, LOGN);
    {   float ga[16], gb[16];
        const int ch = D + c; const float w0 = cw[ch], w1 = cw[NHY + ch], w2 = cw[2 * NHY + ch], cb = cbv[ch];
        load_conv16(UT + (size_t)ch * T + rowA, t0, L, w0, w1, w2, cb, ga); load_conv16(UT + (size_t)ch * T + rowB, t0, L, w0, w1, w2, cb, gb);
        const float sk = skip[c];
#pragma unroll
        for (int i = 0; i < 16; ++i) { const cpx y = X[pidx(seg * N + t0 + i)]; va[i] = ga[i] * (y.x * invN + sk * va[i]); vb[i] = gb[i] * (y.y * invN + sk * vb[i]); }
#pragma unroll
        for (int i = 0; i < 16; ++i) { X[pidx(seg * N + t0 + i)] = cpx{va[i], vb[i]}; X[pidx(seg * N + L + t0 + i)] = cpx{0.f, 0.f}; }
    }
    __syncthreads();
    fft_forward(X, tid, LOGN);
    { const cpx* H = spec + ((size_t)1 * D + c) * N; for (int p = tid; p < 16384; p += 512) X[pidx(p)] = cmul(X[pidx(p)], H[p & (N - 1)]); }
    __syncthreads();
    fft_inverse(X, tid, LOGN);
    {   float ga[16], gb[16];
        const int ch = 2 * D + c; const float w0 = cw[ch], w1 = cw[NHY + ch], w2 = cw[2 * NHY + ch], cb = cbv[ch];
        load_conv16(UT + (size_t)ch * T + rowA, t0, L, w0, w1, w2, cb, ga); load_conv16(UT + (size_t)ch * T + rowB, t0, L, w0, w1, w2, cb, gb);
        const float sk = skip[D + c];
        float ra[16], rb[16];
#pragma unroll
        for (int i = 0; i < 16; ++i) { const cpx y = X[pidx(seg * N + t0 + i)]; ra[i] = ga[i] * (y.x * invN + sk * va[i]); rb[i] = gb[i] * (y.y * invN + sk * vb[i]); }
        v4u o0, o1;
        o0.x = pk2(ra[0], ra[1]); o0.y = pk2(ra[2], ra[3]); o0.z = pk2(ra[4], ra[5]); o0.w = pk2(ra[6], ra[7]); o1.x = pk2(ra[8], ra[9]); o1.y = pk2(ra[10], ra[11]); o1.z = pk2(ra[12], ra[13]); o1.w = pk2(ra[14], ra[15]);
        GAS v4u* da = (GAS v4u*)(Z2T + (size_t)c * T + rowA + t0); da[0] = o0; da[1] = o1;
        o0.x = pk2(rb[0], rb[1]); o0.y = pk2(rb[2], rb[3]); o0.z = pk2(rb[4], rb[5]); o0.w = pk2(rb[6], rb[7]); o1.x = pk2(rb[8], rb[9]); o1.y = pk2(rb[10], rb[11]); o1.z = pk2(rb[12], rb[13]); o1.w = pk2(rb[14], rb[15]);
        GAS v4u* db = (GAS v4u*)(Z2T + (size_t)c * T + rowB + t0); db[0] = o0; db[1] = o1;
    }
}
__device__ __forceinline__ void phase_conv(Frame& F, int jl) {
    for (int u = F.vcu; u < 3 * D; u += F.G) { if (u < 2 * D) conv_unit<0>(F, jl, u >> 1, u & 1); else conv_unit<1>(F, jl, u - 2 * D, 0); }
    __syncthreads();
}
__device__ __forceinline__ unsigned voff_b(unsigned row, unsigned ch) { return 256u * row + 16u * (ch ^ (((row & 3u) << 2) | ((row >> 2) & 3u))); }
__device__ __forceinline__ s16x4 vtr(const LAS unsigned char* p) { typedef short v4i16_t __attribute__((ext_vector_type(4))); return __builtin_bit_cast(s16x4, __builtin_amdgcn_ds_read_tr16_b64_v4i16((LAS v4i16_t*)p)); }
__device__ __forceinline__ unsigned cvtpk(float lo, float hi) { typedef __bf16 bf16x2_t __attribute__((ext_vector_type(2))); f32x2 v = {lo, hi}; bf16x2_t b = __builtin_convertvector(v, bf16x2_t); return __builtin_bit_cast(unsigned, b); }
struct TileDesc { int g, kt0; };
__device__ __forceinline__ TileDesc attn_tile(int it, int T0w) {
    TileDesc t;
    if (it < 8) { t.g = 0; t.kt0 = T0w - 64 + 32 * it; }
    else if (it < 13) { t.g = 1; t.kt0 = T0w - 256 + 128 * (it - 8); }
    else { const int e = it - 13, ch = e / 5, tl = e % 5; t.g = 2; t.kt0 = T0w + 4 * ch - 1024 + 512 * tl; }
    return t;
}
__device__ __forceinline__ void attn_wave_task(const bf16* QKV, bf16* AO, LAS unsigned char* vimg, int blk, int h, int w, int lane) {
    const int r = lane & 31, hh = lane >> 5;
    const int T0 = blk * 128;
    int seq_start, seq_len;
    if (T0 < T_PROMPT) { seq_start = T0 & ~8191; seq_len = 8192; } else { seq_start = T_PROMPT + ((T0 - T_PROMPT) & ~2047); seq_len = 2048; }
    const int seq_end = seq_start + seq_len;
    const int T0w = T0 + w, qt = T0w + 4 * r;
    const float slope2 = __builtin_amdgcn_exp2f(-0.5f * (float)(h + 1)) * LOG2E;
    f32x16 o[4];
#pragma unroll
    for (int dt = 0; dt < 4; ++dt)
#pragma unroll
        for (int i = 0; i < 16; ++i) o[dt][i] = 0.f;
    float m_run = -1e30f, l_run = 0.f;
    bf16x8 qf[8], kf[8];
    const bf16* hb = QKV + h * 128;
    auto issue_tile = [&](const TileDesc& td, LAS unsigned char* img_dst) {
        const int d = 1 << (2 * td.g);
        const bf16* Kb = hb + 6144 + td.g * 2048; const bf16* Vb = hb + 12288 + td.g * 2048;
#pragma unroll
        for (int i = 0; i < 8; ++i) { const int row = 4 * i + (lane >> 4); int vt = td.kt0 + row * d; vt = vt < seq_start ? seq_start : (vt >= seq_end ? seq_end - 1 : vt);
            const int lch = (lane & 15) ^ (((row & 3) << 2) | ((row >> 2) & 3));
            __builtin_amdgcn_global_load_lds((const unsigned*)(Vb + (size_t)vt * NQKV + 8 * lch), (LAS unsigned*)(img_dst + i * 1024), 16, 0, 0); }
        int kt = td.kt0 + r * d; kt = kt < seq_start ? seq_start : (kt >= seq_end ? seq_end - 1 : kt);
        const bf16* kp = Kb + (size_t)kt * NQKV + 8 * hh;
#pragma unroll
        for (int s = 0; s < 8; ++s) kf[s] = *(const GAS bf16x8*)(kp + 16 * s);
    };
    auto load_q = [&](int g) { const bf16* qp = hb + g * 2048 + (size_t)qt * NQKV + 8 * hh;
#pragma unroll
        for (int s = 0; s < 8; ++s) qf[s] = *(const GAS bf16x8*)(qp + 16 * s); };
    TileDesc cur = attn_tile(0, T0w);
    load_q(0);
    issue_tile(cur, vimg);
    for (int it = 0; it < 33; ++it) {
        LAS unsigned char* img = vimg + (it & 1) * 8192;
        const int d = 1 << (2 * cur.g), win = 64 * d, kt0 = cur.kt0;
        f32x16 st;
#pragma unroll
        for (int i = 0; i < 16; ++i) st[i] = 0.f;
#pragma unroll
        for (int s = 0; s < 8; ++s) st = __builtin_amdgcn_mfma_f32_32x32x16_bf16(kf[s], qf[s], st, 0, 0, 0);
        if (it + 1 < 33) { const TileDesc nx = attn_tile(it + 1, T0w); if (nx.g != cur.g) load_q(nx.g); issue_tile(nx, vimg + ((it + 1) & 1) * 8192); cur = nx; }
        float mloc = -1e30f;
#pragma unroll
        for (int i = 0; i < 16; ++i) { const int kk = (i & 3) + 8 * (i >> 2) + 4 * hh; const int kt = kt0 + kk * d; const int dl = kt - qt; const int ad = dl < 0 ? -dl : dl;
            const bool ok = ((dl & (d - 1)) == 0) && (ad <= win) && (kt >= seq_start) && (kt < seq_end);
            const float s = ok ? st[i] - slope2 * (float)ad : -1e30f; st[i] = s; mloc = fmaxf(mloc, s); }
        mloc = pg8::xor32_max(mloc);
        const float m_new = fmaxf(m_run, mloc);
        const float alpha = __builtin_amdgcn_exp2f(m_run - m_new);
        float ls = 0.f;
#pragma unroll
        for (int i = 0; i < 16; ++i) { const float pv = (st[i] > -1e29f) ? __builtin_amdgcn_exp2f(st[i] - m_new) : 0.f; st[i] = pv; ls += pv; }
        ls = pg8::xor32_sum(ls);
        l_run = l_run * alpha + ls; m_run = m_new;
#pragma unroll
        for (int dt = 0; dt < 4; ++dt)
#pragma unroll
            for (int i = 0; i < 16; ++i) o[dt][i] *= alpha;
        bf16x8 pb[2];
#pragma unroll
        for (int s2 = 0; s2 < 2; ++s2) { v4u w; w.x = cvtpk(st[8 * s2 + 0], st[8 * s2 + 1]); w.y = cvtpk(st[8 * s2 + 2], st[8 * s2 + 3]); w.z = cvtpk(st[8 * s2 + 4], st[8 * s2 + 5]); w.w = cvtpk(st[8 * s2 + 6], st[8 * s2 + 7]); pb[s2] = __builtin_bit_cast(bf16x8, w); }
        const int q4 = (lane & 15) >> 2, p4 = lane & 3, blk16 = (lane >> 4) & 1;
#pragma unroll
        for (int dt = 0; dt < 4; ++dt)
#pragma unroll
            for (int s2 = 0; s2 < 2; ++s2) {
                const unsigned chn = 4 * dt + 2 * blk16 + (p4 >> 1);
                const s16x4 lo = vtr(img + voff_b(16 * s2 + 4 * hh + q4, chn) + 8 * (p4 & 1));
                const s16x4 hi = vtr(img + voff_b(16 * s2 + 8 + 4 * hh + q4, chn) + 8 * (p4 & 1));
                const bf16x8 va = __builtin_shufflevector(lo, hi, 0, 1, 2, 3, 4, 5, 6, 7);
                o[dt] = __builtin_amdgcn_mfma_f32_32x32x16_bf16(va, pb[s2], o[dt], 0, 0, 0);
            }
    }
    const float inv = 1.0f / l_run;
    bf16* op = AO + (size_t)qt * D + h * 128 + 4 * hh;
#pragma unroll
    for (int dt = 0; dt < 4; ++dt)
#pragma unroll
        for (int i4 = 0; i4 < 4; ++i4) { v2u w; w.x = cvtpk(o[dt][4 * i4] * inv, o[dt][4 * i4 + 1] * inv); w.y = cvtpk(o[dt][4 * i4 + 2] * inv, o[dt][4 * i4 + 3] * inv);
            *(GAS v2u*)(op + 32 * dt + 8 * i4) = w; }
}
__device__ __forceinline__ void phase_attention(Frame& F) {
    const bf16* QKV = (const bf16*)(F.ws + WS_BIG + BIG_QKV); bf16* AO = (bf16*)(F.ws + WS_BIG + BIG_AO);
    LAS unsigned char* vimg = F.lds + RING_OFF + F.wave * 16384;
    for (int j = F.vcu; j < (T / 128) * 16 * 4 / NWAVES; j += F.G) {
        const int wt = j * NWAVES + F.wave, w = wt & 3, h = (wt >> 2) & 15, blk = wt >> 6;
        attn_wave_task(QKV, AO, vimg, blk, h, w, F.lane);
    }
}

#ifdef ATTN_NAIVE
__device__ __forceinline__ void phase_attention_naive(Frame& F) {
    const bf16* QKV = (const bf16*)(F.ws + WS_BIG + BIG_QKV); bf16* AO = (bf16*)(F.ws + WS_BIG + BIG_AO);
    const int gw = F.vcu * NWAVES + F.wave, NGW = F.G * NWAVES, lane = F.lane;
    for (int p = gw; p < T * 16; p += NGW) {
        const int tok = p >> 4, h = p & 15;
        int seq_start, seq_len;
        if (tok < T_PROMPT) { seq_start = tok & ~8191; seq_len = 8192; } else { seq_start = T_PROMPT + ((tok - T_PROMPT) & ~2047); seq_len = 2048; }
        const int seq_end = seq_start + seq_len;
        const float slope2 = __builtin_amdgcn_exp2f(-0.5f * (float)(h + 1)) * LOG2E;
        float m = -1e30f, l = 0.f, o0 = 0.f, o1 = 0.f;
        for (int g = 0; g < 3; ++g) {
            const int d = 1 << (2 * g);
            const unsigned qw = *(const GAS unsigned*)(QKV + (size_t)tok * NQKV + g * 2048 + h * 128 + 2 * lane);
            const float q0 = bf2f(qw & 0xffffu), q1 = bf2f(qw >> 16);
            for (int j = -64; j <= 64; ++j) {
                const int kt = tok + j * d;
                if (kt < seq_start || kt >= seq_end) continue;
                const unsigned kw = *(const GAS unsigned*)(QKV + (size_t)kt * NQKV + 6144 + g * 2048 + h * 128 + 2 * lane);
                const unsigned vw = *(const GAS unsigned*)(QKV + (size_t)kt * NQKV + 12288 + g * 2048 + h * 128 + 2 * lane);
                const float s = wave_sum(q0 * bf2f(kw & 0xffffu) + q1 * bf2f(kw >> 16)) - slope2 * (float)((j < 0 ? -j : j) * d);
                const float mn = fmaxf(m, s), al = __builtin_amdgcn_exp2f(m - mn), pv = __builtin_amdgcn_exp2f(s - mn);
                l = l * al + pv; o0 = o0 * al + pv * bf2f(vw & 0xffffu); o1 = o1 * al + pv * bf2f(vw >> 16); m = mn;
            }
        }
        const float inv = 1.0f / l;
        *(GAS unsigned*)(AO + (size_t)tok * D + h * 128 + 2 * lane) = pk2(o0 * inv, o1 * inv);
    }
}
#endif
constexpr int NPHASE = 54;
#ifndef ZERO_HY
#define ZERO_HY 0
#endif
#ifndef ZERO_AT
#define ZERO_AT 0
#endif
#ifndef AT_SCALE
#define AT_SCALE 1.0f
#endif
#ifndef HY_SCALE
#define HY_SCALE 1.0f
#endif
#define MIXSCALE(hy) ((hy) ? (ZERO_HY ? 0.0f : HY_SCALE) : (ZERO_AT ? 0.0f : AT_SCALE))
struct Args { const float* in[21]; float* out; unsigned char* ws; int ph_lo, ph_hi; };
static_assert(sizeof(Args) == 21 * 8 + 8 + 8 + 8, "Args has no padding");
__global__ void __launch_bounds__(NWAVES * 64, 2) fwd_kernel(Args args) {
    extern __shared__ __attribute__((aligned(16))) unsigned char lds[];
    unsigned char* const ws0 = args.ws;
    const int wave0 = __builtin_amdgcn_readfirstlane(threadIdx.x >> 6);
    volatile LAS unsigned* MISC = (volatile LAS unsigned*)((LAS unsigned char*)lds + MISC_OFF);
    if (threadIdx.x < 64) MISC[threadIdx.x] = 0u;
    if (threadIdx.x == 64) {
#pragma unroll
        for (int i = 0; i < 21; ++i) ((LAS unsigned long long*)((LAS unsigned char*)lds + PTR_OFF))[i] = (unsigned long long)args.in[i];
    }
    __syncthreads();
    XcdBarrier bar = xcd_barrier_post((unsigned*)(ws0 + WS_CTL), MISC);
#define FRAME() Frame F = make_frame(lds, args.ws, args.out, wave0)
    const int lo = args.ph_lo, hi = args.ph_hi;
#define RUN(id) (lo <= (id) && (id) < hi)
#define SEAM(id) do { if ((id) + 1 < hi) xcd_barrier(bar); } while (0)

#define ZB ((bf16*)(F.ws + WS_ZB))
#define STATS ((float*)(F.ws + WS_STATS))
#define PART ((float*)(F.ws + WS_PART))
#define CDV(off) ((float*)(F.ws + WS_CD) + (off))
#define HID ((bf16*)(F.ws + WS_BIG + BIG_HID))
    constexpr int O_C1 = 0, O_D1 = NFF2, O_CM = 2 * NFF2, O_DM = 2 * NFF2 + NQKV, O_C2 = 2 * NFF2 + 2 * NQKV, O_D2 = 3 * NFF2 + 2 * NQKV;

    if (RUN(0)) { FRAME(); phase_init(F); SEAM(0); }

    for (int layer = 0; layer < DEPTH; ++layer) {
        const int pb = 1 + 13 * layer; const bool hy = (layer & 1) != 0; const int jl = layer >> 1;
        if (RUN(pb + 0)) { FRAME(); phase_convert(F, layer); SEAM(pb + 0); }

        if (RUN(pb + 1)) {
            FRAME();
            pg8::Gemm g{ZB, (const bf16*)(F.ws + W_IN1), T, NFF2, D}; pg8::StaticOrder S; S.init(T, NFF2, F.G, F.bx);
            pg8::EpiSwiglu E{HID, FF, STATS, CDV(O_C1), CDV(O_D1)};
            pg8::gemm_phase<pg8::EpiSwiglu, pg8::StaticOrder, PG8_ALIGN, PG8_SP2>(F.lds + RING_OFF, g, S, E, F.tid);
            SEAM(pb + 1);
        }
        if (RUN(pb + 2)) {
            FRAME();
            pg8::Gemm g{HID, (const bf16*)(F.ws + W_OUT1), T, D, FF}; pg8::StaticOrder S; S.init(T, D, F.G, F.bx);
            const float* g0 = layer ? inp(F, 2) + (size_t)((layer - 1) * 3 + 2) * D : (const float*)(F.ws + WS_IDG); const float* b0 = layer ? inp(F, 3) + (size_t)((layer - 1) * 3 + 2) * D : (const float*)(F.ws + WS_IDB);
            pg8::EpiResid E{F.z, ZB, STATS, g0, b0, (const float*)(F.ws + WS_IDB), PART, 0.5f, 0};
            pg8::gemm_phase<pg8::EpiResid, pg8::StaticOrder, PG8_ALIGN, PG8_SP2>(F.lds + RING_OFF, g, S, E, F.tid);
            SEAM(pb + 2);
        }
        if (RUN(pb + 3)) { FRAME(); phase_finalize(F); SEAM(pb + 3); }

        if (RUN(pb + 4)) {
            FRAME(); const int N = hy ? NHY : NQKV;
            pg8::Gemm g{ZB, (const bf16*)(F.ws + W_MIN), T, N, D}; pg8::StaticOrder S; S.init(T, N, F.G, F.bx);
            pg8::EpiLnBf16 E{(bf16*)(F.ws + WS_BIG), N, STATS, CDV(O_CM), CDV(O_DM)};
            pg8::gemm_phase<pg8::EpiLnBf16, pg8::StaticOrder, PG8_ALIGN, PG8_SP2>(F.lds + RING_OFF, g, S, E, F.tid);
            SEAM(pb + 4);
        }
        if (RUN(pb + 5)) {
            FRAME();
#ifdef ATTN_NAIVE
            if (!hy) phase_attention_naive(F);
#else
            if (!hy) phase_attention(F);
#endif
            else { phase_spectra(F, jl); phase_transpose(F, (const bf16*)(F.ws + WS_BIG + BIG_U), T, NHY, (bf16*)(F.ws + WS_BIG + BIG_UT)); }
            SEAM(pb + 5);
        }
        if (hy) {
            if (RUN(pb + 6)) { FRAME(); phase_conv(F, jl); SEAM(pb + 6); }
            if (RUN(pb + 7)) { FRAME(); phase_transpose(F, (const bf16*)(F.ws + WS_BIG + BIG_Z2T), D, T, (bf16*)(F.ws + WS_BIG + BIG_Z2)); SEAM(pb + 7); }
        }
        if (RUN(pb + 8)) {
            FRAME();
            const bf16* A = hy ? (const bf16*)(F.ws + WS_BIG + BIG_Z2) : (const bf16*)(F.ws + WS_BIG + BIG_AO);
            pg8::Gemm g{A, (const bf16*)(F.ws + W_MOUT), T, D, D}; pg8::StaticOrder S; S.init(T, D, F.G, F.bx);
            pg8::EpiResid E{F.z, ZB, STATS, inp(F, 2) + (size_t)(layer * 3) * D, inp(F, 3) + (size_t)(layer * 3) * D, hy ? inp(F, 20) + (size_t)jl * D : (const float*)(F.ws + WS_IDB), PART, MIXSCALE(hy), 0};
            pg8::gemm_phase<pg8::EpiResid, pg8::StaticOrder, PG8_ALIGN, PG8_SP2>(F.lds + RING_OFF, g, S, E, F.tid);
            SEAM(pb + 8);
        }
        if (RUN(pb + 9)) { FRAME(); phase_finalize(F); SEAM(pb + 9); }

        if (RUN(pb + 10)) {
            FRAME();
            pg8::Gemm g{ZB, (const bf16*)(F.ws + W_IN2), T, NFF2, D}; pg8::StaticOrder S; S.init(T, NFF2, F.G, F.bx);
            pg8::EpiSwiglu E{HID, FF, STATS, CDV(O_C2), CDV(O_D2)};
            pg8::gemm_phase<pg8::EpiSwiglu, pg8::StaticOrder, PG8_ALIGN, PG8_SP2>(F.lds + RING_OFF, g, S, E, F.tid);
            SEAM(pb + 10);
        }
        if (RUN(pb + 11)) {
            FRAME();
            pg8::Gemm g{HID, (const bf16*)(F.ws + W_OUT2), T, D, FF}; pg8::StaticOrder S; S.init(T, D, F.G, F.bx);
            pg8::EpiResid E{F.z, ZB, STATS, inp(F, 2) + (size_t)(layer * 3 + 1) * D, inp(F, 3) + (size_t)(layer * 3 + 1) * D, (const float*)(F.ws + WS_IDB), PART, 0.5f, 0};
            pg8::gemm_phase<pg8::EpiResid, pg8::StaticOrder, PG8_ALIGN, PG8_SP2>(F.lds + RING_OFF, g, S, E, F.tid);
            SEAM(pb + 11);
        }
        if (RUN(pb + 12)) { FRAME(); phase_finalize(F); SEAM(pb + 12); }
    }
#ifdef DBG_CHECK
    if (RUN(NPHASE - 2)) { FRAME(); phase_check_qkv(F); SEAM(NPHASE - 2); }
#endif
    if (RUN(NPHASE - 1)) { FRAME(); phase_final_ln(F); }
#undef RUN
#undef SEAM
#undef FRAME
}


#ifdef PHASE_PROBE
#define PROBE_FRAME() extern __shared__ __attribute__((aligned(16))) unsigned char lds[]; Frame F = make_frame(lds, args.ws, args.out, __builtin_amdgcn_readfirstlane(threadIdx.x >> 6));
__global__ void __launch_bounds__(NWAVES * 64, 2) probe_init(Args args) { PROBE_FRAME(); phase_init(F); }
__global__ void __launch_bounds__(NWAVES * 64, 2) probe_convert(Args args) { PROBE_FRAME(); phase_convert(F, args.ph_lo); }
__global__ void __launch_bounds__(NWAVES * 64, 2) probe_finalize(Args args) { PROBE_FRAME(); phase_finalize(F); phase_final_ln(F); }
__global__ void __launch_bounds__(NWAVES * 64, 2) probe_transpose(Args args) { PROBE_FRAME(); phase_transpose(F, (const bf16*)(F.ws + WS_BIG + BIG_U), T, NHY, (bf16*)(F.ws + WS_BIG + BIG_UT)); }
__global__ void __launch_bounds__(NWAVES * 64, 2) probe_spectra(Args args) { PROBE_FRAME(); phase_spectra(F, args.ph_lo); }
__global__ void __launch_bounds__(NWAVES * 64, 2) probe_conv(Args args) { PROBE_FRAME(); phase_conv(F, args.ph_lo); }
__global__ void __launch_bounds__(NWAVES * 64, 2) probe_attn(Args args) { PROBE_FRAME(); phase_attention(F); }
__global__ void __launch_bounds__(NWAVES * 64, 2) probe_gemm_swiglu(Args args) { PROBE_FRAME(); pg8::Gemm g{(const bf16*)F.ws, (const bf16*)(F.ws + W_IN1), T, NFF2, D}; pg8::StaticOrder S; S.init(T, NFF2, F.G, F.bx); pg8::EpiSwiglu E{(bf16*)(F.ws + WS_BIG), FF, (float*)(F.ws + WS_STATS), (float*)(F.ws + WS_CD), (float*)(F.ws + WS_CD)}; pg8::gemm_phase<pg8::EpiSwiglu, pg8::StaticOrder, PG8_ALIGN, PG8_SP2>(F.lds + RING_OFF, g, S, E, F.tid); }
__global__ void __launch_bounds__(NWAVES * 64, 2) probe_gemm_resid(Args args) { PROBE_FRAME(); pg8::Gemm g{(const bf16*)F.ws, (const bf16*)(F.ws + W_IN1), T, D, FF}; pg8::StaticOrder S; S.init(T, D, F.G, F.bx); pg8::EpiResid E{F.z, (bf16*)(F.ws + WS_ZB), (float*)(F.ws + WS_STATS), inp(F, 2), inp(F, 3), args.ph_lo ? inp(F, 20) : (const float*)(F.ws + WS_IDB), (float*)(F.ws + WS_PART), 0.5f, 0}; pg8::gemm_phase<pg8::EpiResid, pg8::StaticOrder, PG8_ALIGN, PG8_SP2>(F.lds + RING_OFF, g, S, E, F.tid); }
__global__ void __launch_bounds__(NWAVES * 64, 2) probe_gemm_ln(Args args) { PROBE_FRAME(); pg8::Gemm g{(const bf16*)F.ws, (const bf16*)(F.ws + W_IN1), T, NQKV, D}; pg8::StaticOrder S; S.init(T, NQKV, F.G, F.bx); pg8::EpiLnBf16 E{(bf16*)(F.ws + WS_BIG), NQKV, (float*)(F.ws + WS_STATS), (float*)(F.ws + WS_CD), (float*)(F.ws + WS_CD)}; pg8::gemm_phase<pg8::EpiLnBf16, pg8::StaticOrder, PG8_ALIGN, PG8_SP2>(F.lds + RING_OFF, g, S, E, F.tid); }
#endif
#ifndef MK_MULTI
#define MK_MULTI 0
#endif
extern "C" void kernel_launch(void* const* d_in, const int* in_sizes, int n_in, void* d_out, int out_size, void* d_ws, size_t ws_size, hipStream_t stream) {
    static int grid = 0;
    if (grid == 0) {
        if (n_in != 21 || out_size != T * D || ws_size < WS_END) { fprintf(stderr, "kernel_launch: unexpected shapes (n_in %d, out %d, ws %zu, need %zu)\n", n_in, out_size, ws_size, (size_t)WS_END); grid = -1; return; }
        int dev = 0, cus = 0, per_cu = 0;
        if (hipGetDevice(&dev) != hipSuccess || hipDeviceGetAttribute(&cus, hipDeviceAttributeMultiprocessorCount, dev) != hipSuccess) { grid = -1; return; }
        if (hipFuncSetAttribute((const void*)fwd_kernel, hipFuncAttributeMaxDynamicSharedMemorySize, LDS_BYTES) != hipSuccess) { fprintf(stderr, "kernel_launch: hipFuncSetAttribute failed\n"); grid = -1; return; }
        if (hipOccupancyMaxActiveBlocksPerMultiprocessor(&per_cu, (const void*)fwd_kernel, NWAVES * 64, LDS_BYTES) != hipSuccess || per_cu < 1) fprintf(stderr, "kernel_launch: occupancy query reports %d\n", per_cu);
        (void)hipGetLastError();
        grid = cus;
    }
    if (grid < 0) return;
    if (hipMemsetAsync((char*)d_ws + WS_CTL, 0, CTL_ZERO_BYTES, stream) != hipSuccess) return;
    Args a{};
    for (int i = 0; i < 21; ++i) a.in[i] = (const float*)d_in[i];
    a.out = (float*)d_out; a.ws = (unsigned char*)d_ws;
#ifndef STOP_AFTER
#define STOP_AFTER (NPHASE - 1)
#endif
#ifdef DBG_CHECK
#define DBGCHK_ON 1
#else
#define DBGCHK_ON 0
#endif
#if MK_MULTI
    for (int p = 0; p < NPHASE; ++p) { if (p >= STOP_AFTER && p != NPHASE - 1 && !(DBGCHK_ON && p == NPHASE - 2)) continue; a.ph_lo = p; a.ph_hi = p + 1; hipLaunchKernelGGL(fwd_kernel, dim3(grid), dim3(NWAVES * 64), LDS_BYTES, stream, a); }
#else
    a.ph_lo = 0; a.ph_hi = NPHASE;
    hipLaunchKernelGGL(fwd_kernel, dim3(grid), dim3(NWAVES * 64), LDS_BYTES, stream, a);
#endif
}
```

```cpp
#include <hip/hip_runtime.h>
#include <cstdio>
#include <cstdint>
namespace pg8 {
#define PG8_LAS __attribute__((address_space(3)))
typedef unsigned short bf16_t;
typedef short bf16x8 __attribute__((ext_vector_type(8)));
typedef float f32x4 __attribute__((ext_vector_type(4)));
typedef unsigned u32x4 __attribute__((ext_vector_type(4)));
constexpr int BM = 256, BK = 64, HALF = 128, HTB = HALF * BK * 2  , STAGE_BYTES = 8 * HTB, NXCD = 8, WGM = 8;

__host__ __device__ __forceinline__ int lds_byte(int r, int c) { const int st = (r >> 4) * 2 + (c >> 5), rr = r & 15, cc = c & 31, ob = rr * 64 + cc * 2; return st * 1024 + (ob ^ (((ob >> 9) & 1) << 5)); }
__host__ __device__ __forceinline__ void stage_rc(int b, int& R, int& C) { const int st = b / 1024, sb = b % 1024, swz = sb ^ (((sb >> 9) & 1) << 5); R = (st >> 1) * 16 + swz / 64; C = (st & 1) * 32 + (swz % 64) / 2; }
__host__ __device__ __forceinline__ int perm32(int rho) { const int n = rho >> 4, i = rho & 15; return 8 * (i >> 2) + 4 * n + (i & 3); }

struct Unit { int pm, pn; };
struct Gemm { const bf16_t* A; const bf16_t* Bt; int M, N, K; };

struct StaticOrder {
    int nM, nN, nwg, G, c;
    __host__ __device__ void init(int M, int N, int G_, int c_) { nM = M / BM; nN = N / BM; nwg = nM * nN; G = G_; c = c_; }
    __host__ __device__ bool next(int i, Unit& u) const {
        const long L = (long)i * G + c; if (L >= nwg) return false;
        int wgid = (int)L; { const int q = nwg / NXCD, r = nwg % NXCD, xcd = wgid % NXCD, off = wgid / NXCD; wgid = (xcd < r ? xcd * (q + 1) : r * (q + 1) + (xcd - r) * q) + off; }
        const int nig = WGM * nN, gid = wgid / nig, fm = gid * WGM, gsz = (nM - fm) < WGM ? (nM - fm) : WGM;
        u.pm = fm + ((wgid % nig) % gsz); u.pn = (wgid % nig) / gsz; return true;
    }
    __device__ __forceinline__ void a_ready(const Unit&) const {}
    __device__ __forceinline__ void done(const Unit&) const {}
};

__device__ __forceinline__ unsigned cvt_pk_bf16(float lo, float hi) { unsigned r; asm volatile("v_cvt_pk_bf16_f32 %0, %1, %2" : "=v"(r) : "v"(lo), "v"(hi)); return r; }
typedef float f32x2 __attribute__((ext_vector_type(2)));
typedef float f32x2v __attribute__((ext_vector_type(2)));
typedef unsigned u32x2v __attribute__((ext_vector_type(2)));
constexpr float DN_ALPHA_F = 1.6817928305074292f;

__device__ __forceinline__ float xor32_sum(float x) { const auto r = __builtin_amdgcn_permlane32_swap(__float_as_uint(x), __float_as_uint(x), false, false); const unsigned r0 = r[0], r1 = r[1]; return __uint_as_float(r0) + __uint_as_float(r1); }
__device__ __forceinline__ float xor32_max(float x) { const auto r = __builtin_amdgcn_permlane32_swap(__float_as_uint(x), __float_as_uint(x), false, false); const unsigned r0 = r[0], r1 = r[1]; return fmaxf(__uint_as_float(r0), __uint_as_float(r1)); }
template <int MASK> __device__ __forceinline__ float swz_xor(float x) { return __builtin_bit_cast(float, __builtin_amdgcn_ds_swizzle(__builtin_bit_cast(int, x), (MASK << 10) | 0x1F)); }
__device__ __forceinline__ float wave_sum64(float v) { v += swz_xor<1>(v); v += swz_xor<2>(v); v += swz_xor<4>(v); v += swz_xor<8>(v); v += swz_xor<16>(v); return xor32_sum(v); }

struct EpiLnBf16 {
    static constexpr bool PERM = true, AFTER_DRAIN = false;
    bf16_t* O; int ldc; const float* stats; const float* cvec; const float* dvec;
    __device__ __forceinline__ void operator()(const f32x4 (&acc)[2][2][4][2], const Unit& u, int wr, int wc, int fr, int fq) const {
        const int row0 = u.pm * BM + wr * 64 + fr, col0 = u.pn * BM + wc * 32 + 8 * fq;
        f32x4 cv[2][2], dv[2][2];
#pragma unroll
        for (int bj = 0; bj < 2; ++bj)
#pragma unroll
            for (int n = 0; n < 2; ++n) { cv[bj][n] = *(const f32x4*)(cvec + col0 + bj * HALF + 4 * n); dv[bj][n] = *(const f32x4*)(dvec + col0 + bj * HALF + 4 * n); }
#pragma unroll
        for (int ai = 0; ai < 2; ++ai)
#pragma unroll
            for (int m = 0; m < 4; ++m) { const int row = row0 + ai * HALF + m * 16; const f32x2v st = *(const f32x2v*)(stats + 2 * (size_t)row);
                bf16_t* rowp = O + (size_t)row * ldc + col0;
#pragma unroll
                for (int bj = 0; bj < 2; ++bj) { const f32x4 v0 = (acc[ai][bj][m][0] - st.x * cv[bj][0]) * st.y + dv[bj][0], v1 = (acc[ai][bj][m][1] - st.x * cv[bj][1]) * st.y + dv[bj][1];
                    u32x4 w; w.x = cvt_pk_bf16(v0[0], v0[1]); w.y = cvt_pk_bf16(v0[2], v0[3]); w.z = cvt_pk_bf16(v1[0], v1[1]); w.w = cvt_pk_bf16(v1[2], v1[3]);
                    *(u32x4*)(rowp + bj * HALF) = w; } }
    }
};
__device__ __forceinline__ float silu_mul(float g, float up) { const float e = __builtin_amdgcn_exp2f(-1.4426950408889634f * g); return g * __builtin_amdgcn_rcpf(1.0f + e) * up; }
struct EpiSwiglu {
    static constexpr bool PERM = true, AFTER_DRAIN = false;
    bf16_t* O; int ldc; const float* stats; const float* cvec; const float* dvec;
    __device__ __forceinline__ void operator()(const f32x4 (&acc)[2][2][4][2], const Unit& u, int wr, int wc, int fr, int fq) const {
        const int row0 = u.pm * BM + wr * 64 + fr, col0 = u.pn * BM + wc * 32 + 8 * fq, ocol = u.pn * HALF + wc * 32 + 8 * fq;
        f32x4 cv[2][2], dv[2][2];
#pragma unroll
        for (int bj = 0; bj < 2; ++bj)
#pragma unroll
            for (int n = 0; n < 2; ++n) { cv[bj][n] = *(const f32x4*)(cvec + col0 + bj * HALF + 4 * n); dv[bj][n] = *(const f32x4*)(dvec + col0 + bj * HALF + 4 * n); }
#pragma unroll
        for (int ai = 0; ai < 2; ++ai)
#pragma unroll
            for (int m = 0; m < 4; ++m) { const int row = row0 + ai * HALF + m * 16; const f32x2v st = *(const f32x2v*)(stats + 2 * (size_t)row);
                f32x4 h[2];
#pragma unroll
                for (int n = 0; n < 2; ++n) { const f32x4 g = (acc[ai][0][m][n] - st.x * cv[0][n]) * st.y + dv[0][n], up = (acc[ai][1][m][n] - st.x * cv[1][n]) * st.y + dv[1][n];
                    h[n] = (f32x4){silu_mul(g[0], up[0]), silu_mul(g[1], up[1]), silu_mul(g[2], up[2]), silu_mul(g[3], up[3])}; }
                u32x4 w; w.x = cvt_pk_bf16(h[0][0], h[0][1]); w.y = cvt_pk_bf16(h[0][2], h[0][3]); w.z = cvt_pk_bf16(h[1][0], h[1][1]); w.w = cvt_pk_bf16(h[1][2], h[1][3]);
                *(u32x4*)(O + (size_t)row * ldc + ocol) = w; }
    }
};
struct EpiResid {
    static constexpr bool PERM = true, AFTER_DRAIN = false;
    float* Z; bf16_t* ZB; const float* stats; const float* gprev; const float* bprev; const float* bias; float* part; float scale; int pad;
    __device__ __forceinline__ void operator()(const f32x4 (&acc)[2][2][4][2], const Unit& u, int wr, int wc, int fr, int fq) const {
        const int row0 = u.pm * BM + wr * 64 + fr, col0 = u.pn * BM + wc * 32 + 8 * fq;
#pragma unroll
        for (int bj = 0; bj < 2; ++bj) {
            f32x4 gv[2], bv[2];
#pragma unroll
            for (int n = 0; n < 2; ++n) { const int c = col0 + bj * HALF + 4 * n; gv[n] = DN_ALPHA_F * *(const f32x4*)(gprev + c); bv[n] = DN_ALPHA_F * *(const f32x4*)(bprev + c) + scale * *(const f32x4*)(bias + c); }
#pragma unroll
            for (int ai = 0; ai < 2; ++ai)
#pragma unroll
                for (int m = 0; m < 4; ++m) { const int row = row0 + ai * HALF + m * 16; const f32x2v st = *(const f32x2v*)(stats + 2 * (size_t)row);
                    float* zp = Z + (size_t)row * 2048 + col0 + bj * HALF;
                    const f32x4 z0 = *(const f32x4*)zp, z1 = *(const f32x4*)(zp + 4);
                    const f32x4 n0 = (z0 - st.x) * st.y * gv[0] + bv[0] + scale * acc[ai][bj][m][0];
                    const f32x4 n1 = (z1 - st.x) * st.y * gv[1] + bv[1] + scale * acc[ai][bj][m][1];
                    *(f32x4*)zp = n0; *(f32x4*)(zp + 4) = n1;
                    u32x4 w; w.x = cvt_pk_bf16(n0[0], n0[1]); w.y = cvt_pk_bf16(n0[2], n0[3]); w.z = cvt_pk_bf16(n1[0], n1[1]); w.w = cvt_pk_bf16(n1[2], n1[3]);
                    *(u32x4*)(ZB + (size_t)row * 2048 + col0 + bj * HALF) = w;
                    float s = ((n0[0] + n0[1]) + (n0[2] + n0[3])) + ((n1[0] + n1[1]) + (n1[2] + n1[3]));
                    float q = ((n0[0] * n0[0] + n0[1] * n0[1]) + (n0[2] * n0[2] + n0[3] * n0[3])) + ((n1[0] * n1[0] + n1[1] * n1[1]) + (n1[2] * n1[2] + n1[3] * n1[3]));
                    s += swz_xor<16>(s); s = xor32_sum(s); q += swz_xor<16>(q); q = xor32_sum(q);
                    if (fq == 0) *(f32x2v*)(part + ((size_t)row * 64 + u.pn * 8 + wc * 2 + bj) * 2) = (f32x2v){s, q}; }
        }
    }
};

struct EpiTaps {
    static constexpr bool PERM = false, AFTER_DRAIN = false;
    float* O; float min_decay, dstep;
    __device__ __forceinline__ void operator()(const f32x4 (&acc)[2][2][4][2], const Unit& u, int wr, int wc, int fr, int fq) const {
        int stride = 10240; float i0 = 1.0f / 8191.0f, i1 = 1.0f / 2047.0f; asm volatile("" : "+s"(stride), "+s"(i0), "+s"(i1));
        const int row0 = u.pm * BM + wr * 64 + fr, col0 = u.pn * BM + wc * 32 + 4 * fq;
        const int tbase = (u.pn < 32) ? 0 : 8192; const float ilm1 = (u.pn < 32) ? i0 : i1;
        const float t0 = (float)(col0 - tbase);
#pragma unroll
        for (int ai = 0; ai < 2; ++ai)
#pragma unroll
            for (int m = 0; m < 4; ++m) { const int row = row0 + ai * HALF + m * 16;
                const float a = -1.4426950408889634f * __builtin_fabsf(min_decay + (float)(row & 2047) * dstep) * ilm1;
                const float e0 = __builtin_amdgcn_exp2f(a * t0), s1 = __builtin_amdgcn_exp2f(a), s16 = __builtin_amdgcn_exp2f(16.0f * a), s128 = __builtin_amdgcn_exp2f(128.0f * a);
                float* rowp = O + (size_t)row * stride + col0;
#pragma unroll
                for (int bj = 0; bj < 2; ++bj) { const float eb = bj ? e0 * s128 : e0;
#pragma unroll
                    for (int n = 0; n < 2; ++n) { const float en = n ? eb * s16 : eb, en1 = en * s1, en2 = en1 * s1, en3 = en2 * s1; const f32x4 v = acc[ai][bj][m][n];
                        *(f32x4*)(rowp + bj * HALF + n * 16) = (f32x4){v[0] * en, v[1] * en1, v[2] * en2, v[3] * en3}; } } }
    }
};

template <class Epi, class Sched, bool ALIGN_EPI = false, bool SP2 = false>
__device__ __forceinline__ void gemm_phase(PG8_LAS unsigned char* lds, const Gemm g, const Sched& S, const Epi& E, const int tid_in) {
    int tid_ = tid_in; asm volatile("" : "+v"(tid_));
    const int tid = tid_, wid = __builtin_amdgcn_readfirstlane(tid >> 6), lane = tid & 63, wr = wid >> 2, wc = wid & 3, fr = lane & 15, fq = lane >> 4;
    const int K = g.K, nt = K / BK;
    unsigned voffA[2], voffB[2];
#pragma unroll
    for (int i = 0; i < 2; ++i) { int R, C; stage_rc(tid * 16 + i * 8192, R, C); const int Rb = Epi::PERM ? ((R & ~31) + perm32(R & 31)) : R;
        voffA[i] = (unsigned)(R * K + C) * 2u; voffB[i] = (unsigned)(Rb * K + C) * 2u; }
    const size_t kstep = (size_t)(BK * 2);
    const size_t hstep = (size_t)HALF * K * 2;
    const size_t tstep = 2 * hstep;
    const unsigned ldsw = (unsigned)wid * 1024u;
    const int aoff = lds_byte(wr * 64 + fr, fq * 8), boff = lds_byte(wc * 32 + fr, fq * 8);
#define PG8_SA(b, h) (((b) * 2 + (h)) * HTB)
#define PG8_SB(b, h) ((4 + (b) * 2 + (h)) * HTB)
#define PG8_STAGE(bufoff, gbase, voff) do { _Pragma("unroll") for (int _i = 0; _i < 2; ++_i) \
        __builtin_amdgcn_global_load_lds((const unsigned*)((const char*)(gbase) + (voff)[_i]), (PG8_LAS unsigned*)(lds + (bufoff) + ldsw + _i * 8192), 16, 0, 0); } while (0)
#define PG8_LDA(dst, b, h) do { _Pragma("unroll") for (int m = 0; m < 4; ++m) _Pragma("unroll") for (int k = 0; k < 2; ++k) dst[m][k] = *(const PG8_LAS bf16x8*)(lds + PG8_SA(b, h) + aoff + m * 2048 + k * 1024); } while (0)
#define PG8_LDB(dst, b, h) do { _Pragma("unroll") for (int n = 0; n < 2; ++n) _Pragma("unroll") for (int k = 0; k < 2; ++k) dst[n][k] = *(const PG8_LAS bf16x8*)(lds + PG8_SB(b, h) + boff + n * 2048 + k * 1024); } while (0)
#define PG8_MMA(ai, bj, At, Bt) do { __builtin_amdgcn_s_setprio(1); _Pragma("unroll") for (int m = 0; m < 4; ++m) _Pragma("unroll") for (int n = 0; n < 2; ++n) _Pragma("unroll") for (int k = 0; k < 2; ++k) \
        acc[ai][bj][m][n] = __builtin_amdgcn_mfma_f32_16x16x32_bf16(Bt[n][k], At[m][k], acc[ai][bj][m][n], 0, 0, 0); __builtin_amdgcn_s_setprio(0); } while (0)
#define PG8_WAIT_V(n) asm volatile("s_waitcnt vmcnt(" #n ")" ::: "memory")
#define PG8_WAIT_L(n) asm volatile("s_waitcnt lgkmcnt(" #n ")" ::: "memory")
#define PG8_BAR __builtin_amdgcn_s_barrier()
#define PG8_SCHED __builtin_amdgcn_sched_barrier(0)
    Unit cur, nxt; int ui = 0;
    if (!S.next(0, cur)) return;
    f32x4 acc[2][2][4][2];
    float zero_; asm volatile("v_mov_b32 %0, 0" : "=v"(zero_));
#pragma unroll
    for (int a = 0; a < 2; ++a)
#pragma unroll
        for (int b = 0; b < 2; ++b)
#pragma unroll
            for (int m = 0; m < 4; ++m)
#pragma unroll
                for (int n = 0; n < 2; ++n) acc[a][b][m][n] = (f32x4){zero_, zero_, zero_, zero_};
    bf16x8 At[4][2], B0[2][2], B1[2][2];
    const char* cA = (const char*)g.A + (size_t)cur.pm * tstep; const char* cB = (const char*)g.Bt + (size_t)cur.pn * tstep;
    S.a_ready(cur);
    if constexpr (SP2) {
        PG8_STAGE(PG8_SB(0, 0), cB, voffB); PG8_STAGE(PG8_SB(0, 1), cB + hstep, voffB); PG8_STAGE(PG8_SA(0, 0), cA, voffA); PG8_STAGE(PG8_SA(0, 1), cA + hstep, voffA);
        if (wr == 1) PG8_BAR;
        PG8_WAIT_V(2); PG8_BAR;
        PG8_STAGE(PG8_SB(1, 0), cB + kstep, voffB); PG8_STAGE(PG8_SA(1, 0), cA + kstep, voffA); PG8_STAGE(PG8_SB(1, 1), cB + hstep + kstep, voffB);
        PG8_WAIT_V(6); PG8_BAR;
    } else {
        PG8_STAGE(PG8_SB(0, 0), cB, voffB); PG8_STAGE(PG8_SA(0, 0), cA, voffA); PG8_STAGE(PG8_SB(0, 1), cB + hstep, voffB); PG8_STAGE(PG8_SA(0, 1), cA + hstep, voffA);
        if (wr == 1) PG8_BAR;
        PG8_WAIT_V(4); PG8_BAR;
        PG8_STAGE(PG8_SB(1, 0), cB + kstep, voffB); PG8_STAGE(PG8_SA(1, 0), cA + kstep, voffA); PG8_STAGE(PG8_SB(1, 1), cB + hstep + kstep, voffB);
        PG8_WAIT_V(6); PG8_BAR;
    }
    for (;;) {
        const bool has_next = S.next(ui + 1, nxt);
        const char* nA = has_next ? (const char*)g.A + (size_t)nxt.pm * tstep : cA; const char* nB = has_next ? (const char*)g.Bt + (size_t)nxt.pn * tstep : cB;
        for (int t = 0; t < nt; t += 2) {
            const bool last = (t == nt - 2);
            const char* a1 = cA + (size_t)(t + 1) * kstep;
            const char* a2 = last ? nA : cA + (size_t)(t + 2) * kstep; const char* b2 = last ? nB : cB + (size_t)(t + 2) * kstep;
            const char* a3 = a2 + kstep; const char* b3 = b2 + kstep;
            if (last && has_next) S.a_ready(nxt);
            if constexpr (SP2) {
            PG8_LDB(B0, 0, 0); PG8_LDB(B1, 0, 1); PG8_SCHED; PG8_LDA(At, 0, 0); PG8_STAGE(PG8_SA(1, 1), a1 + hstep, voffA);
            PG8_WAIT_V(8); PG8_WAIT_L(0); PG8_BAR; PG8_MMA(0, 0, At, B0); PG8_MMA(0, 1, At, B1); PG8_BAR; PG8_SCHED;
            PG8_LDA(At, 0, 1); PG8_STAGE(PG8_SB(0, 0), b2, voffB); PG8_STAGE(PG8_SB(0, 1), b2 + hstep, voffB); PG8_STAGE(PG8_SA(0, 0), a2, voffA);
            PG8_WAIT_V(8); PG8_WAIT_L(0); PG8_BAR; PG8_MMA(1, 0, At, B0); PG8_MMA(1, 1, At, B1); PG8_BAR; PG8_SCHED;
            PG8_LDB(B0, 1, 0); PG8_LDB(B1, 1, 1); PG8_SCHED; PG8_LDA(At, 1, 0); PG8_STAGE(PG8_SA(0, 1), a2 + hstep, voffA);
            PG8_WAIT_V(8); PG8_WAIT_L(0); PG8_BAR; PG8_MMA(0, 0, At, B0); PG8_MMA(0, 1, At, B1); PG8_BAR; PG8_SCHED;
            PG8_LDA(At, 1, 1); PG8_STAGE(PG8_SB(1, 0), b3, voffB); PG8_STAGE(PG8_SB(1, 1), b3 + hstep, voffB); PG8_STAGE(PG8_SA(1, 0), a3, voffA);
            PG8_WAIT_V(8); PG8_WAIT_L(0); PG8_BAR; PG8_MMA(1, 0, At, B0); PG8_MMA(1, 1, At, B1); PG8_BAR; PG8_SCHED;
            } else {
            PG8_LDB(B0, 0, 0); PG8_SCHED; PG8_LDA(At, 0, 0); PG8_STAGE(PG8_SA(1, 1), a1 + hstep, voffA);
            PG8_WAIT_L(8); PG8_BAR; PG8_WAIT_L(0); PG8_MMA(0, 0, At, B0); PG8_BAR; PG8_SCHED;
            PG8_LDB(B1, 0, 1); PG8_STAGE(PG8_SB(0, 0), b2, voffB);
            PG8_BAR; PG8_WAIT_L(0); PG8_MMA(0, 1, At, B1); PG8_BAR;
            PG8_LDA(At, 0, 1); PG8_STAGE(PG8_SA(0, 0), a2, voffA);
            PG8_BAR; PG8_WAIT_L(0); PG8_MMA(1, 0, At, B0); PG8_BAR; PG8_SCHED;
            PG8_STAGE(PG8_SB(0, 1), b2 + hstep, voffB);
            PG8_WAIT_V(6); PG8_BAR; PG8_MMA(1, 1, At, B1); PG8_BAR;
            PG8_LDB(B0, 1, 0); PG8_SCHED; PG8_LDA(At, 1, 0); PG8_STAGE(PG8_SA(0, 1), a2 + hstep, voffA);
            PG8_WAIT_L(8); PG8_BAR; PG8_WAIT_L(0); PG8_MMA(0, 0, At, B0); PG8_BAR; PG8_SCHED;
            PG8_LDB(B1, 1, 1); PG8_STAGE(PG8_SB(1, 0), b3, voffB);
            PG8_BAR; PG8_WAIT_L(0); PG8_MMA(0, 1, At, B1); PG8_BAR;
            PG8_LDA(At, 1, 1); PG8_STAGE(PG8_SA(1, 0), a3, voffA);
            PG8_BAR; PG8_WAIT_L(0); PG8_MMA(1, 0, At, B0); PG8_BAR; PG8_SCHED;
            PG8_STAGE(PG8_SB(1, 1), b3 + hstep, voffB);
            PG8_WAIT_V(6); PG8_BAR; PG8_MMA(1, 1, At, B1); PG8_BAR;
            }
        }
        if constexpr (ALIGN_EPI) { if (wr == 0) PG8_BAR; }
        if constexpr (!Epi::AFTER_DRAIN) { E(acc, cur, wr, wc, fr, fq); S.done(cur); }
        if (!has_next) break;
        asm volatile("v_mov_b32 %0, 0" : "=v"(zero_));
#pragma unroll
        for (int a = 0; a < 2; ++a)
#pragma unroll
            for (int b = 0; b < 2; ++b)
#pragma unroll
                for (int m = 0; m < 4; ++m)
#pragma unroll
                    for (int n = 0; n < 2; ++n) acc[a][b][m][n] = (f32x4){zero_, zero_, zero_, zero_};
        cur = nxt; cA = nA; cB = nB; ++ui;
        if constexpr (ALIGN_EPI) { if (wr == 1) PG8_BAR; }
    }
    PG8_WAIT_V(0);
    if constexpr (!ALIGN_EPI) { if (wr == 0) PG8_BAR; }
    PG8_BAR;
    if constexpr (Epi::AFTER_DRAIN) { E.fused(acc, cur, wr, wc, fr, fq, lds, wid, lane); S.done(cur); }
#undef PG8_SA
#undef PG8_SB
#undef PG8_STAGE
#undef PG8_LDA
#undef PG8_LDB
#undef PG8_MMA
#undef PG8_WAIT_V
#undef PG8_WAIT_L
#undef PG8_BAR
#undef PG8_SCHED
}
}

#ifndef PG8_SP2
#define PG8_SP2 true
#endif
#ifndef PG8_ALIGN
#define PG8_ALIGN true
#endif
#define XB_TMO      128
#define XB_XCNT(j)  (256  + 64 * (j))
#define XB_XSUB(j)  (1280 + 64 * (j))
#define XB_XGEN(j)  (2304 + 64 * (j))
#define XB_TOP      3328
#define XB_TOPGEN   3392
#define XCD_BAR_WORDS 3456
#define XB_SPIN_CAP (1u << 18)
#define LAS __attribute__((address_space(3)))

__device__ __forceinline__ unsigned xb_ld(unsigned* p)              { return __hip_atomic_load(p, __ATOMIC_RELAXED, __HIP_MEMORY_SCOPE_AGENT); }
__device__ __forceinline__ unsigned xb_add(unsigned* p, unsigned v) { return __hip_atomic_fetch_add(p, v, __ATOMIC_RELAXED, __HIP_MEMORY_SCOPE_AGENT); }
__device__ __forceinline__ unsigned xb_xcc_id() { return (unsigned)__builtin_amdgcn_s_getreg((3 << 11) | 20) & 0xFu; }
#define XB_SPIN(cond, bar) do { unsigned _sp = 0; while (cond) { __builtin_amdgcn_s_sleep(1); \
    if ((++_sp & 255u) == 0u) { if (xb_ld(&(bar)[XB_TMO])) break; if (_sp > XB_SPIN_CAP) { atomicAdd(&(bar)[XB_TMO], 1u); break; } } } } while (0)

struct XcdBarrier {
    unsigned* bar; unsigned x;
    unsigned w0;
    volatile LAS unsigned* st;
};

__device__ __forceinline__ XcdBarrier xcd_barrier_post(unsigned* bar, volatile LAS unsigned* st) {
    XcdBarrier b; b.bar = bar; b.x = xb_xcc_id(); b.st = st; b.w0 = (unsigned)__builtin_amdgcn_readfirstlane(threadIdx.x >> 6);
    if (threadIdx.x == 0) (void)xb_add(&bar[XB_XCNT(b.x)], 1u);
    return b;
}
__device__ __forceinline__ void xcd_barrier_complete(unsigned* bar, unsigned x, unsigned& nloc, unsigned& nx) {
    const unsigned G = gridDim.x * gridDim.y * gridDim.z;
    unsigned sum, cnt, mine, sp = 0u;
    for (;;) {
        sum = 0u; cnt = 0u; mine = 0u;
#pragma unroll
        for (unsigned j = 0; j < 16; ++j) { const unsigned c = xb_ld(&bar[XB_XCNT(j)]); sum += c; cnt += (c > 0u) ? 1u : 0u; mine = (j == x) ? c : mine; }
        if (sum == G) break;
        __builtin_amdgcn_s_sleep(1);
        if ((++sp & 255u) == 0u) { if (xb_ld(&bar[XB_TMO])) break; if (sp > XB_SPIN_CAP) { atomicAdd(&bar[XB_TMO], 1u); break; } }
    }
    nloc = mine > 0u ? mine : 1u; nx = cnt > 0u ? cnt : 1u;
}

__device__ __forceinline__ void xcd_barrier(const XcdBarrier& b) {
    asm volatile("s_waitcnt vmcnt(0)" ::: "memory");
    __syncthreads();
    unsigned xb_lane; asm volatile("v_mbcnt_lo_u32_b32 %0, -1, 0\n\tv_mbcnt_hi_u32_b32 %0, -1, %0" : "=v"(xb_lane));
    if (b.w0 == 0u && xb_lane == 0u) {
        unsigned* bar = b.bar;
        __builtin_amdgcn_s_waitcnt(0);
        unsigned nloc = b.st[0], nx = b.st[1];
        if (nloc == 0u) { xcd_barrier_complete(bar, b.x, nloc, nx); b.st[0] = nloc; b.st[1] = nx; }
        const unsigned old = xb_add(&bar[XB_XSUB(b.x)], 1u);
        const unsigned gen = old / nloc;
        if (old + 1u == (gen + 1u) * nloc) {
            __builtin_amdgcn_fence(__ATOMIC_RELEASE, "agent");
            asm volatile("s_waitcnt vmcnt(0)" ::: "memory");
            const unsigned og = xb_add(&bar[XB_TOP], 1u);
            const unsigned tg = og / nx;
            if (og + 1u == (tg + 1u) * nx) xb_add(&bar[XB_TOPGEN], 1u);
            else XB_SPIN(xb_ld(&bar[XB_TOPGEN]) == tg, bar);
            __builtin_amdgcn_fence(__ATOMIC_ACQUIRE, "agent");
            xb_add(&bar[XB_XGEN(b.x)], 1u);
            asm volatile("s_waitcnt vmcnt(0)" ::: "memory");
        } else {
            XB_SPIN(xb_ld(&bar[XB_XGEN(b.x)]) == gen, bar);
            __builtin_amdgcn_fence(__ATOMIC_ACQUIRE, "agent");
            asm volatile("s_waitcnt vmcnt(0)" ::: "memory");
        }
    }
    __syncthreads();
}
constexpr int NWAVES = 8;
constexpr int D = 2048, FF = 5632, NFF2 = 2 * FF, NQKV = 18432, NHY = 6144, DEPTH = 4;
constexpr int T_PROMPT = 4 * 8192, T = 49152;
constexpr float LN_EPS = 1e-5f;
constexpr float QSCALE = 0.12751743082459868f;
constexpr float LOG2E = 1.4426950408889634f;
constexpr float MIN_DECAY = -3.0701134573253946f, MAX_DECAY = -15.350567286626973f;

constexpr size_t MiB = 1u << 20;
constexpr size_t WS_CTL = 0, CTL_ZERO_BYTES = 64 * 1024;
constexpr size_t WS_IDG = 1 * MiB, WS_IDB = 1 * MiB + 32768, WS_DUMP = 1 * MiB + 32768 + 131072;
constexpr size_t WS_CD = 2 * MiB;
constexpr size_t WS_STATS = 3 * MiB;
constexpr size_t WS_H2T = 4 * MiB;
constexpr size_t WS_PART = 8 * MiB;
constexpr size_t WS_W = 32 * MiB;
constexpr size_t W_IN1 = WS_W, W_OUT1 = W_IN1 + 44 * MiB, W_IN2 = W_OUT1 + 22 * MiB, W_OUT2 = W_IN2 + 44 * MiB, W_MIN = W_OUT2 + 22 * MiB, W_MOUT = W_MIN + 72 * MiB;
constexpr size_t WS_ZB = W_MOUT + 8 * MiB;
constexpr size_t WS_BIG = WS_ZB + 192 * MiB;
constexpr size_t BIG_HID = 0;
constexpr size_t BIG_QKV = 0, BIG_AO = 1728 * MiB;
constexpr size_t BIG_U = 0, BIG_Z2T = 0, BIG_Z2 = 192 * MiB, BIG_UT = 576 * MiB, BIG_SPEC0 = 1152 * MiB, BIG_SPEC1 = 1664 * MiB;
constexpr size_t WS_TAPS = WS_BIG + 1920 * MiB;
constexpr size_t WS_H2B = WS_TAPS + 320 * MiB, WS_W3T = WS_H2B + 6 * MiB;
constexpr size_t WS_END = WS_W3T + 4 * MiB;
static_assert(WS_ZB == 244 * MiB && WS_BIG == 436 * MiB && (size_t)T * 64 * 8 <= 24 * MiB && WS_END <= 2816 * MiB && (size_t)8192 * 10240 * 4 <= 320 * MiB, "ws map");
static_assert((size_t)T * FF * 2 <= 528 * MiB && (size_t)T * NQKV * 2 <= 1728 * MiB && (size_t)T * NHY * 2 <= 576 * MiB && BIG_SPEC1 + 128 * MiB <= 1920 * MiB, "ws map");

constexpr int RING_OFF = 0;
constexpr int FFT_BYTES = (16384 + 512) * 8;
constexpr int SCR_OFF = FFT_BYTES;
constexpr int MISC_OFF = SCR_OFF + 1024;
constexpr int PTR_OFF = MISC_OFF + 256;
constexpr int LDS_BYTES = PTR_OFF + 256;

#define GAS __attribute__((address_space(1)))
#define LAS __attribute__((address_space(3)))
typedef unsigned short bf16;
typedef unsigned v4u __attribute__((ext_vector_type(4)));
typedef unsigned v2u __attribute__((ext_vector_type(2)));
typedef float f32x4 __attribute__((ext_vector_type(4)));
typedef float f32x2 __attribute__((ext_vector_type(2)));
typedef float f32x16 __attribute__((ext_vector_type(16)));
typedef short bf16x8 __attribute__((ext_vector_type(8)));
typedef short s16x4 __attribute__((ext_vector_type(4)));
#define LDS_WAIT() asm volatile("s_waitcnt lgkmcnt(0)" ::: "memory")
#define VM_WAIT() asm volatile("s_waitcnt vmcnt(0)" ::: "memory")
__device__ __forceinline__ unsigned f2bf(float f) { unsigned u = __builtin_bit_cast(unsigned, f); return (u + 0x7fffu + ((u >> 16) & 1u)) >> 16; }
__device__ __forceinline__ unsigned pk2(float lo, float hi) { return f2bf(lo) | (f2bf(hi) << 16); }
__device__ __forceinline__ float bf2f(unsigned b) { return __builtin_bit_cast(float, b << 16); }
__device__ __forceinline__ float bfround(float f) { return bf2f(f2bf(f)); }

#ifndef FFT_HD
#define FFT_HD __host__ __device__ __forceinline__
#endif
#if defined(__clang__)
typedef float cpx __attribute__((ext_vector_type(2)));
#else
struct cpx { float x, y; };
#endif
FFT_HD cpx cmul(cpx a, cpx b) { return cpx{a.x * b.x - a.y * b.y, a.x * b.y + a.y * b.x}; }
FFT_HD cpx cmulc(cpx a, cpx b) { return cpx{a.x * b.x + a.y * b.y, a.y * b.x - a.x * b.y}; }
FFT_HD cpx cadd(cpx a, cpx b) { return cpx{a.x + b.x, a.y + b.y}; }
FFT_HD cpx csub(cpx a, cpx b) { return cpx{a.x - b.x, a.y - b.y}; }
FFT_HD int pidx(int i) { return i + (i >> 5); }
FFT_HD cpx cis_neg_rev(float rev) {
    const float x8 = rev * 8.0f; int oct = (int)x8; oct = oct > 7 ? 7 : oct; const float f = x8 - (float)oct;
    const float a = (oct & 1) ? (1.0f - f) : f, phi = a * 0.78539816339744831f, p2 = phi * phi;
    const float s = phi * (1.0f + p2 * (-1.6666666666666666e-1f + p2 * (8.3333333333333332e-3f + p2 * (-1.9841269841269841e-4f + p2 * 2.7557319223985893e-6f))));
    const float c = 1.0f + p2 * (-0.5f + p2 * (4.1666666666666664e-2f + p2 * (-1.3888888888888889e-3f + p2 * (2.4801587301587302e-5f + p2 * -2.7557319223985888e-7f))));
    const bool sw = ((oct + 1) & 2) != 0;
    float cc = sw ? s : c, ss = sw ? c : s;
    if (oct >= 2 && oct <= 5) cc = -cc;
    if (oct >= 4) ss = -ss;
    return cpx{cc, -ss};
}
FFT_HD float sin_acc(float x) { float rev = x * 0.15915494309189535f; rev -= floorf(rev); const cpx e = cis_neg_rev(rev); return -e.y; }
FFT_HD float cos_rev(float rev) { rev -= floorf(rev); return cis_neg_rev(rev).x; }
FFT_HD float sin_rev(float rev) { rev -= floorf(rev); return -cis_neg_rev(rev).y; }
FFT_HD cpx w16(int k) {
    constexpr float C1 = 0.92387953251128674f, S1 = 0.38268343236508977f, R2 = 0.70710678118654752f;
    switch (k) { case 0: return cpx{1.f, 0.f}; case 1: return cpx{C1, -S1}; case 2: return cpx{R2, -R2}; case 3: return cpx{S1, -C1};
                 case 4: return cpx{0.f, -1.f}; case 5: return cpx{-S1, -C1}; case 6: return cpx{-R2, -R2}; default: return cpx{-C1, -S1}; }
}
template <int R> FFT_HD constexpr int bitrev(int i) { int r = 0; for (int b = 1, c = R >> 1; b < R; b <<= 1, c >>= 1) if (i & b) r |= c; return r; }
template <int R> FFT_HD void dif_regs(cpx (&a)[R]) {
#pragma unroll
    for (int len = R; len >= 2; len >>= 1) { const int half = len >> 1;
#pragma unroll
        for (int b0 = 0; b0 < R; b0 += len)
#pragma unroll
            for (int j = 0; j < half; ++j) { const cpx u = a[b0 + j], v = a[b0 + j + half]; a[b0 + j] = cadd(u, v); const cpx d = csub(u, v); a[b0 + j + half] = (j == 0) ? d : cmul(d, w16(j * (16 / len))); } }
}
template <int R> FFT_HD void dit_regs(cpx (&a)[R]) {
#pragma unroll
    for (int len = 2; len <= R; len <<= 1) { const int half = len >> 1;
#pragma unroll
        for (int b0 = 0; b0 < R; b0 += len)
#pragma unroll
            for (int j = 0; j < half; ++j) { const cpx u = a[b0 + j]; const cpx v = (j == 0) ? a[b0 + j + half] : cmulc(a[b0 + j + half], w16(j * (16 / len))); a[b0 + j] = cadd(u, v); a[b0 + j + half] = csub(u, v); } }
}
template <int R> FFT_HD void twiddle_powers(cpx w1, cpx (&pw)[R]) {
    pw[0] = cpx{1.f, 0.f}; pw[1] = w1; pw[2] = cmul(w1, w1); pw[3] = cmul(pw[2], w1);
    if constexpr (R > 4) { pw[4] = cmul(pw[2], pw[2]); pw[5] = cmul(pw[4], pw[1]); pw[6] = cmul(pw[4], pw[2]); pw[7] = cmul(pw[4], pw[3]); }
    if constexpr (R > 8) { pw[8] = cmul(pw[4], pw[4]);
#pragma unroll
        for (int k = 1; k < 8; ++k) pw[8 + k] = cmul(pw[8], pw[k]); }
}
template <int R, bool INV, class P> FFT_HD void fft_pass(P X, int tid, int nthr, int logM) {
    constexpr int LOGR = (R == 16) ? 4 : 2;
    const int logs = logM - LOGR, s = 1 << logs;
#pragma unroll 1
    for (int blk = tid; blk < 16384 / R; blk += nthr) {
        const int base = blk & (s - 1), idx0 = ((blk >> logs) << logM) + base;
        cpx a[R], pw[R];
        if (logs > 0) twiddle_powers<R>(cis_neg_rev((float)base / (float)(1 << logM)), pw);
        if (!INV) {
#pragma unroll
            for (int j = 0; j < R; ++j) a[j] = X[pidx(idx0 + (j << logs))];
            dif_regs<R>(a);
#pragma unroll
            for (int i = 0; i < R; ++i) { const int k1 = bitrev<R>(i); cpx v = a[i]; if (logs > 0 && k1 != 0) v = cmul(v, pw[k1]); X[pidx(idx0 + (k1 << logs))] = v; }
        } else {
#pragma unroll
            for (int i = 0; i < R; ++i) { const int k1 = bitrev<R>(i); cpx v = X[pidx(idx0 + (k1 << logs))]; if (logs > 0 && k1 != 0) v = cmulc(v, pw[k1]); a[i] = v; }
            dit_regs<R>(a);
#pragma unroll
            for (int j = 0; j < R; ++j) X[pidx(idx0 + (j << logs))] = a[j];
        }
    }
}
struct Frame {
    LAS unsigned char* lds;
    int tid, lane, wave;
    int vcu, G, bx;
    unsigned char* ws; float* z;
};
__device__ __forceinline__ Frame make_frame(unsigned char* lds_generic, unsigned char* ws, float* out, int wave0) {
    Frame F;
    int lane; asm volatile("v_mbcnt_lo_u32_b32 %0, -1, 0\n\tv_mbcnt_hi_u32_b32 %0, -1, %0" : "=v"(lane));
    int bx = blockIdx.x, G = gridDim.x;
    asm volatile("" : "+v"(lane)); asm volatile("" : "+s"(bx)); asm volatile("" : "+s"(G)); asm volatile("" : "+s"(wave0));
    const int tid = wave0 * 64 + lane;
    unsigned long long w = (unsigned long long)ws, o = (unsigned long long)out; asm volatile("" : "+s"(w)); asm volatile("" : "+s"(o));
    F.lds = (LAS unsigned char*)lds_generic;
    F.tid = tid; F.lane = lane; F.wave = wave0;
    F.G = G; F.bx = bx; F.vcu = (G % 8 == 0) ? (bx % 8) * (G / 8) + bx / 8 : bx;
    F.ws = (unsigned char*)(GAS unsigned char*)w; F.z = (float*)(GAS float*)o;
    return F;
}
__device__ __forceinline__ const float* inp(const Frame& F, int i) {
    const LAS unsigned* t = (const LAS unsigned*)(F.lds + PTR_OFF) + 2 * i;
    const unsigned lo = __builtin_amdgcn_readfirstlane(t[0]), hi = __builtin_amdgcn_readfirstlane(t[1]);
    return (const float*)(const GAS float*)(((unsigned long long)hi << 32) | lo);
}
__device__ __forceinline__ float wave_sum(float v) { return pg8::wave_sum64(v); }
__device__ __forceinline__ void block_sum2(Frame& F, float& a, float& b) {
    LAS float* scr = (LAS float*)(F.lds + SCR_OFF);
    a = wave_sum(a); b = wave_sum(b);
    __syncthreads();
    if (F.lane == 0) { scr[F.wave * 2] = a; scr[F.wave * 2 + 1] = b; }
    __syncthreads();
    float sa = 0.f, sb = 0.f;
#pragma unroll
    for (int w = 0; w < NWAVES; ++w) { sa += scr[w * 2]; sb += scr[w * 2 + 1]; }
    a = sa; b = sb;
}

__device__ __forceinline__ void phase_init(Frame& F) {
    const int gw = F.vcu * NWAVES + F.wave, NGW = F.G * NWAVES;
    bf16* zb = (bf16*)(F.ws + WS_ZB); float* stats = (float*)(F.ws + WS_STATS);
    const float* x0 = inp(F, 0); const float* x1 = inp(F, 1);
    for (int m = gw; m < T; m += NGW) {
        const float* src = (m < T_PROMPT) ? x0 + (size_t)m * D : x1 + (size_t)(m - T_PROMPT) * D;
        const GAS f32x4* s4 = (const GAS f32x4*)src + F.lane; GAS f32x4* d4 = (GAS f32x4*)(F.z + (size_t)m * D) + F.lane; GAS v2u* b4 = (GAS v2u*)(zb + (size_t)m * D) + F.lane;
#pragma unroll
        for (int j = 0; j < 8; ++j) { const f32x4 v = s4[64 * j]; d4[64 * j] = v; v2u o; o.x = pk2(v.x, v.y); o.y = pk2(v.z, v.w); b4[64 * j] = o; }
        if (F.lane == 0) { stats[2 * m] = 0.f; stats[2 * m + 1] = 1.f; }
    }
    const int gt = F.vcu * (NWAVES * 64) + F.tid;
    if (gt < 8192) ((float*)(F.ws + WS_IDG))[gt] = 1.f;
    if (gt < 32768) ((float*)(F.ws + WS_IDB))[gt] = 0.f;
}

struct ConvJob { const float* W; int K, N; bf16* WT; const float* gk; const float* bk; float* cvec; float* dvec; const float* ebias; int mode; };
__device__ __forceinline__ void conv_item(const float* W, int K, int N, bf16* WT, const float* gk, const float* bk, float* cvec, float* dvec, const float* ebias, int mode, int nb, LAS float* scr, int lane) {
    const int n0 = 32 * nb, n = lane & 31, kh = lane >> 5;
    const float colscale = (mode == 2 && n0 < 6144) ? QSCALE : 1.0f;
    int rbase = n0;
    if (mode == 1) { rbase = (n0 < FF) ? (n0 / 128) * 256 + (n0 % 128) : ((n0 - FF) / 128) * 256 + 128 + ((n0 - FF) % 128); }
    float csum = 0.f, dsum = 0.f;
    for (int k0 = 0; k0 < K; k0 += 64) {
#pragma unroll 8
        for (int i = 0; i < 32; ++i) { const int kk = 2 * i + kh; const float w = W[(size_t)(k0 + kk) * N + n0 + n] * colscale;
            const float v = bfround(w * gk[k0 + kk]); scr[kk * 33 + n] = v; csum += v; dsum += bk[k0 + kk] * w; }
        LDS_WAIT(); asm volatile("" ::: "memory");
        const int c = lane & 7;
#pragma unroll
        for (int j = 0; j < 4; ++j) { const int nn = (lane >> 3) + 8 * j; const LAS float* s = scr + (8 * c) * 33 + nn;
            v4u o; o.x = pk2(s[0 * 33], s[1 * 33]); o.y = pk2(s[2 * 33], s[3 * 33]); o.z = pk2(s[4 * 33], s[5 * 33]); o.w = pk2(s[6 * 33], s[7 * 33]);
            *(GAS v4u*)(WT + (size_t)(rbase + nn) * K + k0 + 8 * c) = o; }
        LDS_WAIT(); asm volatile("" ::: "memory");
    }
    csum = pg8::xor32_sum(csum); dsum = pg8::xor32_sum(dsum);
    if (lane < 32) { cvec[rbase + n] = csum; dvec[rbase + n] = dsum + ebias[n0 + n]; }
}
__device__ __forceinline__ void filt_pos(Frame& F, int jl, int var, int t) {
    const int L = var ? 2048 : 8192, lane = F.lane;
    const float* w1 = inp(F, 12) + (size_t)jl * 33 * 64; const float* b1 = inp(F, 13) + jl * 64; const float* w2 = inp(F, 14) + (size_t)jl * 64 * 64; const float* b2 = inp(F, 15) + jl * 64; const float* fr = inp(F, 16) + jl * 64;
    float feat = 0.f;
    if (lane == 0) feat = (float)t / (float)(L - 1);
    else if (lane < 33) { const int bi = (lane - 1) & 15; const float band = 1e-4f + (float)bi * ((15.0f - 1e-4f) / 15.0f); const float rev = band * ((float)t / (float)L);
        feat = (lane < 17) ? cos_rev(rev) : -sin_rev(rev); }
    float acc = b1[lane];
    for (int k = 0; k < 33; ++k) acc += __builtin_bit_cast(float, __builtin_amdgcn_readlane(__builtin_bit_cast(int, feat), k)) * w1[k * 64 + lane];
    const float fq = fr[lane];
    const float h1 = sin_acc(fq * acc);
    float acc2 = b2[lane];
    for (int k = 0; k < 64; ++k) acc2 += __builtin_bit_cast(float, __builtin_amdgcn_readlane(__builtin_bit_cast(int, h1), k)) * w2[k * 64 + lane];
    const float h2 = sin_acc(fq * acc2);
    bf16* hrow = (bf16*)(F.ws + WS_H2B) + (size_t)((var ? 8192 : 0) + t) * 256;
    hrow[lane] = (bf16)f2bf(h2); hrow[64 + lane] = 0; hrow[128 + lane] = 0; hrow[192 + lane] = 0;
}
__device__ __forceinline__ void phase_convert(Frame& F, int layer) {
    LAS float* scr = (LAS float*)(F.lds + RING_OFF + F.wave * 16384);
    const int gw = F.vcu * NWAVES + F.wave, NGW = F.G * NWAVES;
    const int jl = layer >> 1; const bool hy = (layer & 1) != 0;
    const float* ln_g = inp(F, 2); const float* ln_b = inp(F, 3);
    const float* ones = (const float*)(F.ws + WS_IDG); const float* zeros = (const float*)(F.ws + WS_IDB); float* dump = (float*)(F.ws + WS_DUMP);
    float* cd = (float*)(F.ws + WS_CD);
    float* c1 = cd, *d1 = cd + NFF2, *cm = cd + 2 * NFF2, *dm = cm + NQKV, *c2 = dm + NQKV, *d2 = c2 + NFF2;
    const int nb1 = D / 32, nb0 = NFF2 / 32, nb4 = (hy ? NHY : NQKV) / 32, nb5 = D / 32;
    const int total = 2 * nb1 + 2 * nb0 + nb4 + nb5;
    for (int it = gw; it < total; it += NGW) {
        int r = it;
        if (r < 2 * nb1) { const int f = r / nb1; r -= f * nb1;
            conv_item(inp(F, 5) + (size_t)(layer * 2 + f) * FF * D, FF, D, (bf16*)(F.ws + (f ? W_OUT2 : W_OUT1)), ones, zeros, dump, dump + NQKV, zeros, 0, r, scr, F.lane); continue; }
        r -= 2 * nb1;
        if (r < 2 * nb0) { const int f = r / nb0; r -= f * nb0;
            const float* gk = f ? ln_g + (size_t)(layer * 3 + 1) * D : (layer ? ln_g + (size_t)((layer - 1) * 3 + 2) * D : ones);
            const float* bk = f ? ln_b + (size_t)(layer * 3 + 1) * D : (layer ? ln_b + (size_t)((layer - 1) * 3 + 2) * D : zeros);
            conv_item(inp(F, 4) + (size_t)(layer * 2 + f) * D * NFF2, D, NFF2, (bf16*)(F.ws + (f ? W_IN2 : W_IN1)), gk, bk, f ? c2 : c1, f ? d2 : d1, zeros, 1, r, scr, F.lane); continue; }
        r -= 2 * nb0;
        if (r < nb4) {
            const float* gk = ln_g + (size_t)(layer * 3) * D; const float* bk = ln_b + (size_t)(layer * 3) * D;
            if (hy) conv_item(inp(F, 8) + (size_t)jl * D * NHY, D, NHY, (bf16*)(F.ws + W_MIN), gk, bk, cm, dm, inp(F, 9) + (size_t)jl * NHY, 0, r, scr, F.lane);
            else conv_item(inp(F, 6) + (size_t)jl * D * NQKV, D, NQKV, (bf16*)(F.ws + W_MIN), gk, bk, cm, dm, zeros, 2, r, scr, F.lane);
            continue; }
        r -= nb4;
        conv_item((hy ? inp(F, 19) : inp(F, 7)) + (size_t)jl * D * D, D, D, (bf16*)(F.ws + W_MOUT), ones, zeros, dump, dump + NQKV, zeros, 0, r, scr, F.lane);
    }
    if (hy) {
        for (int p = gw; p < 8192 + 2048; p += NGW) { if (p < 8192) filt_pos(F, jl, 0, p); else filt_pos(F, jl, 1, p - 8192); }
        const float* w3 = inp(F, 17) + (size_t)jl * 64 * 8192; bf16* w3T = (bf16*)(F.ws + WS_W3T);
        for (int n = gw; n < 8192; n += NGW) { bf16* r = w3T + (size_t)n * 256; r[F.lane] = (bf16)f2bf(w3[(size_t)F.lane * 8192 + n]); r[64 + F.lane] = 0; r[128 + F.lane] = 0; r[192 + F.lane] = 0; }
    }
}

__device__ __forceinline__ void phase_finalize(Frame& F) {
    const float* part = (const float*)(F.ws + WS_PART); float* stats = (float*)(F.ws + WS_STATS);
    for (int row = F.vcu * (NWAVES * 64) + F.tid; row < T; row += F.G * NWAVES * 64) {
        const GAS f32x4* p = (const GAS f32x4*)(part + (size_t)row * 128);
        float s = 0.f, q = 0.f;
#pragma unroll 8
        for (int j = 0; j < 32; ++j) { const f32x4 v = p[j]; s += v.x + v.z; q += v.y + v.w; }
        const float mean = s * (1.0f / D); const float var = fmaxf(q * (1.0f / D) - mean * mean, 0.f);
        *(GAS f32x2*)(stats + 2 * (size_t)row) = (f32x2){mean, 1.0f / sqrtf(var + LN_EPS)};
    }
}

#ifdef DBG_CHECK
__device__ __forceinline__ void phase_check_qkv(Frame& F) {
    const int gw = F.vcu * NWAVES + F.wave, NGW = F.G * NWAVES;
    const float* W = inp(F, 6); const float* g = inp(F, 2); const float* b = inp(F, 3);
    const float* stats = (const float*)(F.ws + WS_STATS); const bf16* QKV = (const bf16*)(F.ws + WS_BIG + BIG_QKV);
#ifndef DBG_ROW0
#define DBG_ROW0 0
#define DBG_ROW1 T
#endif
#ifndef DBG_COL0
#define DBG_COL0 0
#define DBG_COL1 NQKV
#endif
    float worst = 0.f; unsigned nbad = 0;
#ifdef CHK_ROWS
    {
        const bf16* zbp = (const bf16*)(F.ws + WS_ZB);
        for (int s = gw; s < 8192; s += NGW) {
            const unsigned hsh = (unsigned)s * 2654435761u; const int row = (int)(hsh % (unsigned)T);
            float sm = 0.f, sq = 0.f, dz = 0.f;
            for (int k = F.lane; k < D; k += 64) { const float v = F.z[(size_t)row * D + k]; sm += v; sq += v * v; dz = fmaxf(dz, fabsf(bf2f(zbp[(size_t)row * D + k]) - v)); }
            sm = wave_sum(sm); sq = wave_sum(sq); dz = fmaxf(dz, pg8::xor32_max(dz)); dz = fmaxf(dz, pg8::swz_xor<16>(dz)); dz = fmaxf(dz, pg8::swz_xor<8>(dz)); dz = fmaxf(dz, pg8::swz_xor<4>(dz)); dz = fmaxf(dz, pg8::swz_xor<2>(dz)); dz = fmaxf(dz, pg8::swz_xor<1>(dz));
            const float mean = sm * (1.0f / D), var = sq * (1.0f / D) - mean * mean, rstd = 1.0f / sqrtf(var + LN_EPS);
            const bool bad = (CHK_ROWS == 1) ? (fabsf(mean - stats[2 * row]) > CHK_MTOL || fabsf(rstd - stats[2 * row + 1]) > CHK_RTOL * rstd) : (dz > 0.05f);
            nbad += bad ? 1u : 0u;
        }
        if (F.lane == 0 && nbad) atomicAdd((unsigned*)(F.ws + WS_CTL) + 15000, nbad);
        return;
    }
#endif
    for (int s = gw; s < 8192; s += NGW) {
        const unsigned hsh = (unsigned)s * 2654435761u; const int row = DBG_ROW0 + (int)(hsh % (unsigned)(DBG_ROW1 - DBG_ROW0)), col = DBG_COL0 + (int)((hsh >> 7) % (unsigned)(DBG_COL1 - DBG_COL0));
#ifdef CHK_HYP
        const float mean = 0.f, rstd = 1.f;
#else
        const float mean = stats[2 * row], rstd = stats[2 * row + 1];
#endif
        float acc = 0.f;
        for (int k = F.lane; k < D; k += 64) acc += ((F.z[(size_t)row * D + k] - mean) * rstd * g[k] + b[k]) * W[(size_t)k * NQKV + col];
        acc = wave_sum(acc) * (col < 6144 ? QSCALE : 1.0f);
        const float got = bf2f(QKV[(size_t)row * NQKV + col]);
        worst = fmaxf(worst, fabsf(got - acc)); nbad += (fabsf(got - acc) > DBG_THR) ? 1u : 0u;
    }
#ifdef DBG_COUNT
    if (F.lane == 0 && nbad) atomicAdd((unsigned*)(F.ws + WS_CTL) + 15000, nbad);
#else
    if (F.lane == 0) atomicMax((unsigned*)(F.ws + WS_CTL) + 15000, __builtin_bit_cast(unsigned, worst));
#endif
}
#endif
__device__ __forceinline__ void phase_final_ln(Frame& F) {
    const int gw = F.vcu * NWAVES + F.wave, NGW = F.G * NWAVES;
    const float* stats = (const float*)(F.ws + WS_STATS);
    const float* g = inp(F, 2) + (size_t)(3 * 3 + 2) * D; const float* b = inp(F, 3) + (size_t)(3 * 3 + 2) * D;
    for (int m = gw; m < T; m += NGW) {
        const float mean = stats[2 * m], rstd = stats[2 * m + 1];
        GAS f32x4* d4 = (GAS f32x4*)(F.z + (size_t)m * D) + F.lane; const GAS f32x4* g4 = (const GAS f32x4*)g + F.lane; const GAS f32x4* b4 = (const GAS f32x4*)b + F.lane;
        float dbg = 0.f;
#ifdef DBG_CHECK
        #ifdef DBG_COUNT
        const float dbgval = (float)((const unsigned*)(F.ws + WS_CTL))[15000] * DBG_CHECK_SCALE;
#else
        const float dbgval = __builtin_bit_cast(float, ((const unsigned*)(F.ws + WS_CTL))[15000]) * DBG_CHECK_SCALE;
#endif
#endif
#ifdef DBG_BUF
        {
            const bf16* bp = (const bf16*)(F.ws + WS_BIG + DBG_OFF) + (size_t)m * DBG_PITCH; float s = 0.f;
            for (int c = F.lane; c < DBG_COLS; c += 64) s += bf2f(bp[c]) * (float)(1 + (c & 7));
            dbg = wave_sum(s) * 0.01f;
        }
#endif
#pragma unroll
        for (int j = 0; j < 8; ++j) { const f32x4 v = d4[64 * j] + dbg; d4[64 * j] = (v - mean) * rstd * g4[64 * j] + b4[64 * j];
#ifdef DBG_CHECK
            d4[64 * j] = (f32x4){dbgval, dbgval, dbgval, dbgval};
#endif
        }
    }
}

__device__ __forceinline__ void transpose_tile(const bf16* src, size_t sp, bf16* dst, size_t dp, int r0, int c0, LAS unsigned char* scr, int lane) {
#pragma unroll
    for (int i = 0; i < 8; ++i) { const int row = (lane >> 3) + 8 * i, ch = lane & 7;
        const v4u v = *(const GAS v4u*)(src + (size_t)(r0 + row) * sp + c0 + 8 * ch);
        LAS unsigned* w = (LAS unsigned*)(scr + row * 132 + ch * 16); w[0] = v.x; w[1] = v.y; w[2] = v.z; w[3] = v.w; }
    LDS_WAIT(); asm volatile("" ::: "memory");
    const LAS unsigned short* rd = (const LAS unsigned short*)(scr + lane * 132);
#pragma unroll 8
    for (int c = 0; c < 64; ++c) dst[(size_t)(c0 + c) * dp + r0 + lane] = rd[c];
    LDS_WAIT(); asm volatile("" ::: "memory");
}
__device__ __forceinline__ void phase_transpose(Frame& F, const bf16* src, int R, int C, bf16* dst) {
    LAS unsigned char* scr = F.lds + RING_OFF + F.wave * 16384;
    const int gw = F.vcu * NWAVES + F.wave, NGW = F.G * NWAVES, tr = R / 64, tc = C / 64;
    for (int it = gw; it < tr * tc; it += NGW) { const int a = it / tc, b = it % tc; transpose_tile(src, (size_t)C, dst, (size_t)R, 64 * a, 64 * b, scr, F.lane); }
}
__device__ __forceinline__ void fft_forward(LAS cpx* X, int tid, int logN) {
    int logM = logN;
    for (; logM >= 4; logM -= 4) { fft_pass<16, false>(X, tid, NWAVES * 64, logM); __syncthreads(); }
    if (logM == 2) { fft_pass<4, false>(X, tid, NWAVES * 64, 2); __syncthreads(); }
}
__device__ __forceinline__ void fft_inverse(LAS cpx* X, int tid, int logN) {
    const int rem = logN & 3;
    if (rem == 2) { fft_pass<4, true>(X, tid, NWAVES * 64, 2); __syncthreads(); }
    for (int logM = 4 + rem; logM <= logN; logM += 4) { fft_pass<16, true>(X, tid, NWAVES * 64, logM); __syncthreads(); }
}
template <int VAR> __device__ __forceinline__ void spec_unit(Frame& F, int jl, int c) {
    constexpr int L = VAR ? 2048 : 8192, N = 2 * L, LOGN = VAR ? 12 : 14, NP = L / 512;
    LAS cpx* X = (LAS cpx*)(F.lds + RING_OFF);
    int tid = F.tid; asm volatile("" : "+v"(tid));
    const float* taps = (const float*)(F.ws + WS_TAPS) + (size_t)c * 10240 + (VAR ? 8192 : 0);
    float acc[NP][4];
    float n0 = 0.f, n1 = 0.f;
#pragma unroll
    for (int k = 0; k < NP; ++k) {
#pragma unroll
        for (int f = 0; f < 4; ++f) acc[k][f] = taps[(size_t)f * 2048 * 10240 + tid + 512 * k];
        n0 += fabsf(acc[k][0]) + fabsf(acc[k][1]); n1 += fabsf(acc[k][2]) + fabsf(acc[k][3]); }
    block_sum2(F, n0, n1);
    const float i0 = 1.0f / n0, i1 = 1.0f / n1;
#pragma unroll
    for (int k = 0; k < NP; ++k) { acc[k][0] *= i0; acc[k][1] *= i0; acc[k][2] *= i1; acc[k][3] *= i1; }
    cpx* spec = (cpx*)(F.ws + WS_BIG + (VAR ? BIG_SPEC1 : BIG_SPEC0));
    if (VAR == 0) {
        float* tmp = (float*)(spec + ((size_t)1 * D + c) * N);
#pragma unroll
        for (int k = 0; k < NP; ++k) *(GAS f32x2*)(tmp + 2 * (tid + 512 * k)) = (f32x2){acc[k][2], acc[k][3]};
        __syncthreads();
#pragma unroll
        for (int k = 0; k < NP; ++k) { const int t = tid + 512 * k; const float hf = acc[k][0], hb = acc[k][1];
            if (t == 0) { X[pidx(0)] = cpx{hf + hb, 0.f}; X[pidx(L)] = cpx{0.f, 0.f}; }
            else { X[pidx(t)] = cpx{hf, 0.f}; X[pidx(N - t)] = cpx{hb, 0.f}; } }
        __syncthreads();
        fft_forward(X, tid, LOGN);
        { cpx* dst = spec + ((size_t)0 * D + c) * N; for (int p = tid; p < N; p += 512) dst[p] = X[pidx(p)]; }
        float h1[NP][2];
#pragma unroll
        for (int k = 0; k < NP; ++k) { const f32x2 v = *(const GAS f32x2*)(tmp + 2 * (tid + 512 * k)); h1[k][0] = v.x; h1[k][1] = v.y; }
        __syncthreads();
#pragma unroll
        for (int k = 0; k < NP; ++k) { const int t = tid + 512 * k; const float hf = h1[k][0], hb = h1[k][1];
            if (t == 0) { X[pidx(0)] = cpx{hf + hb, 0.f}; X[pidx(L)] = cpx{0.f, 0.f}; }
            else { X[pidx(t)] = cpx{hf, 0.f}; X[pidx(N - t)] = cpx{hb, 0.f}; } }
        __syncthreads();
        fft_forward(X, tid, LOGN);
        { cpx* dst = spec + ((size_t)1 * D + c) * N; for (int p = tid; p < N; p += 512) dst[p] = X[pidx(p)]; }
    } else {
        __syncthreads();
#pragma unroll
        for (int k = 0; k < NP; ++k) { const int t = tid + 512 * k;
#pragma unroll
            for (int o = 0; o < 2; ++o) { const float hf = acc[k][2 * o], hb = acc[k][2 * o + 1];
                if (t == 0) { X[pidx(o * N)] = cpx{hf + hb, 0.f}; X[pidx(o * N + L)] = cpx{0.f, 0.f}; }
                else { X[pidx(o * N + t)] = cpx{hf, 0.f}; X[pidx(o * N + N - t)] = cpx{hb, 0.f}; } } }
        for (int p = 2 * N + tid; p < 16384; p += 512) X[pidx(p)] = cpx{0.f, 0.f};
        __syncthreads();
        fft_forward(X, tid, LOGN);
#pragma unroll
        for (int o = 0; o < 2; ++o) { cpx* dst = spec + ((size_t)o * D + c) * N; for (int p = tid; p < N; p += 512) dst[p] = X[pidx(o * N + p)]; }
    }
}
__device__ __forceinline__ void phase_spectra(Frame& F, int jl) {
    for (int u = F.vcu; u < 2 * D; u += F.G) { if (u < D) spec_unit<0>(F, jl, u); else spec_unit<1>(F, jl, u - D); }
    __syncthreads();
}
__device__ __forceinline__ void load_conv16(const bf16* seq, int t0, int L, float w0, float w1, float w2, float cb, float (&out)[16]) {
    const v4u a = *(const GAS v4u*)(seq + t0), b = *(const GAS v4u*)(seq + t0 + 8);
    float u[18];
    u[0] = (t0 > 0) ? bf2f(seq[t0 - 1]) : 0.f; u[17] = (t0 + 16 < L) ? bf2f(seq[t0 + 16]) : 0.f;
    u[1] = bf2f(a.x & 0xffffu); u[2] = bf2f(a.x >> 16); u[3] = bf2f(a.y & 0xffffu); u[4] = bf2f(a.y >> 16); u[5] = bf2f(a.z & 0xffffu); u[6] = bf2f(a.z >> 16); u[7] = bf2f(a.w & 0xffffu); u[8] = bf2f(a.w >> 16);
    u[9] = bf2f(b.x & 0xffffu); u[10] = bf2f(b.x >> 16); u[11] = bf2f(b.y & 0xffffu); u[12] = bf2f(b.y >> 16); u[13] = bf2f(b.z & 0xffffu); u[14] = bf2f(b.z >> 16); u[15] = bf2f(b.w & 0xffffu); u[16] = bf2f(b.w >> 16);
#pragma unroll
    for (int i = 0; i < 16; ++i) out[i] = w0 * u[i] + w1 * u[i + 1] + w2 * u[i + 2] + cb;
}
template <int VAR> __device__ __forceinline__ void conv_unit(Frame& F, int jl, int c, int pair) {
    constexpr int L = VAR ? 2048 : 8192, N = 2 * L, LOGN = VAR ? 12 : 14, TPS = VAR ? 128 : 512;
    LAS cpx* X = (LAS cpx*)(F.lds + RING_OFF);
    int tid = F.tid; asm volatile("" : "+v"(tid));
    const int seg = tid / TPS, t0 = (tid % TPS) * 16;
    const int rowA = VAR ? T_PROMPT + (2 * seg) * L : (2 * pair) * L, rowB = rowA + L;
    const bf16* UT = (const bf16*)(F.ws + WS_BIG + BIG_UT); bf16* Z2T = (bf16*)(F.ws + WS_BIG + BIG_Z2T);
    const float* cw = inp(F, 10) + (size_t)jl * 3 * NHY; const float* cbv = inp(F, 11) + (size_t)jl * NHY; const float* skip = inp(F, 18) + (size_t)jl * 2 * D;
    const cpx* spec = (const cpx*)(F.ws + WS_BIG + (VAR ? BIG_SPEC1 : BIG_SPEC0));
#ifndef CONV_SCALE
#define CONV_SCALE 1.0f
#endif
    const float invN = CONV_SCALE / (float)N;
    float va[16], vb[16];
    { const int ch = c; const float w0 = cw[ch], w1 = cw[NHY + ch], w2 = cw[2 * NHY + ch], cb = cbv[ch];
      load_conv16(UT + (size_t)ch * T + rowA, t0, L, w0, w1, w2, cb, va); load_conv16(UT + (size_t)ch * T + rowB, t0, L, w0, w1, w2, cb, vb); }
    __syncthreads();
#pragma unroll
    for (int i = 0; i < 16; ++i) { X[pidx(seg * N + t0 + i)] = cpx{va[i], vb[i]}; X[pidx(seg * N + L + t0 + i)] = cpx{0.f, 0.f}; }
    __syncthreads();
    fft_forward(X, tid, LOGN);
    { const cpx* H = spec + ((size_t)0 * D + c) * N; for (int p = tid; p < 16384; p += 512) X[pidx(p)] = cmul(X[pidx(p)], H[p & (N - 1)]); }
    __syncthreads();
    fft_inverse(X, tid, LOGN);
    {   float ga[16], gb[16];
        const int ch = D + c; const float w0 = cw[ch], w1 = cw[NHY + ch], w2 = cw[2 * NHY + ch], cb = cbv[ch];
        load_conv16(UT + (size_t)ch * T + rowA, t0, L, w0, w1, w2, cb, ga); load_conv16(UT + (size_t)ch * T + rowB, t0, L, w0, w1, w2, cb, gb);
        const float sk = skip[c];
#pragma unroll
        for (int i = 0; i < 16; ++i) { const cpx y = X[pidx(seg * N + t0 + i)]; va[i] = ga[i] * (y.x * invN + sk * va[i]); vb[i] = gb[i] * (y.y * invN + sk * vb[i]); }
#pragma unroll
        for (int i = 0; i < 16; ++i) { X[pidx(seg * N + t0 + i)] = cpx{va[i], vb[i]}; X[pidx(seg * N + L + t0 + i)] = cpx{0.f, 0.f}; }
    }
    __syncthreads();
    fft_forward(X, tid, LOGN);
    { const cpx* H = spec + ((size_t)1 * D + c) * N; for (int p = tid; p < 16384; p += 512) X[pidx(p)] = cmul(X[pidx(p)], H[p & (N - 1)]); }
    __syncthreads();
    fft_inverse(X, tid, LOGN);
    {   float ga[16], gb[16];
        const int ch = 2 * D + c; const float w0 = cw[ch], w1 = cw[NHY + ch], w2 = cw[2 * NHY + ch], cb = cbv[ch];
        load_conv16(UT + (size_t)ch * T + rowA, t0, L, w0, w1, w2, cb, ga); load_conv16(UT + (size_t)ch * T + rowB, t0, L, w0, w1, w2, cb, gb);
        const float sk = skip[D + c];
        float ra[16], rb[16];
#pragma unroll
        for (int i = 0; i < 16; ++i) { const cpx y = X[pidx(seg * N + t0 + i)]; ra[i] = ga[i] * (y.x * invN + sk * va[i]); rb[i] = gb[i] * (y.y * invN + sk * vb[i]); }
        v4u o0, o1;
        o0.x = pk2(ra[0], ra[1]); o0.y = pk2(ra[2], ra[3]); o0.z = pk2(ra[4], ra[5]); o0.w = pk2(ra[6], ra[7]); o1.x = pk2(ra[8], ra[9]); o1.y = pk2(ra[10], ra[11]); o1.z = pk2(ra[12], ra[13]); o1.w = pk2(ra[14], ra[15]);
        GAS v4u* da = (GAS v4u*)(Z2T + (size_t)c * T + rowA + t0); da[0] = o0; da[1] = o1;
        o0.x = pk2(rb[0], rb[1]); o0.y = pk2(rb[2], rb[3]); o0.z = pk2(rb[4], rb[5]); o0.w = pk2(rb[6], rb[7]); o1.x = pk2(rb[8], rb[9]); o1.y = pk2(rb[10], rb[11]); o1.z = pk2(rb[12], rb[13]); o1.w = pk2(rb[14], rb[15]);
        GAS v4u* db = (GAS v4u*)(Z2T + (size_t)c * T + rowB + t0); db[0] = o0; db[1] = o1;
    }
}
__device__ __forceinline__ void phase_conv(Frame& F, int jl) {
    for (int u = F.vcu; u < 3 * D; u += F.G) { if (u < 2 * D) conv_unit<0>(F, jl, u >> 1, u & 1); else conv_unit<1>(F, jl, u - 2 * D, 0); }
    __syncthreads();
}
__device__ __forceinline__ unsigned voff_b(unsigned row, unsigned ch) { return 256u * row + 16u * (ch ^ (((row & 3u) << 2) | ((row >> 2) & 3u))); }
__device__ __forceinline__ s16x4 vtr(const LAS unsigned char* p) { typedef short v4i16_t __attribute__((ext_vector_type(4))); return __builtin_bit_cast(s16x4, __builtin_amdgcn_ds_read_tr16_b64_v4i16((LAS v4i16_t*)p)); }
__device__ __forceinline__ unsigned cvtpk(float lo, float hi) { typedef __bf16 bf16x2_t __attribute__((ext_vector_type(2))); f32x2 v = {lo, hi}; bf16x2_t b = __builtin_convertvector(v, bf16x2_t); return __builtin_bit_cast(unsigned, b); }
struct TileDesc { int g, kt0; };
__device__ __forceinline__ TileDesc attn_tile(int it, int T0w) {
    TileDesc t;
    if (it < 8) { t.g = 0; t.kt0 = T0w - 64 + 32 * it; }
    else if (it < 13) { t.g = 1; t.kt0 = T0w - 256 + 128 * (it - 8); }
    else { const int e = it - 13, ch = e / 5, tl = e % 5; t.g = 2; t.kt0 = T0w + 4 * ch - 1024 + 512 * tl; }
    return t;
}
__device__ __forceinline__ void attn_wave_task(const bf16* QKV, bf16* AO, LAS unsigned char* vimg, int blk, int h, int w, int lane) {
    const int r = lane & 31, hh = lane >> 5;
    const int T0 = blk * 128;
    int seq_start, seq_len;
    if (T0 < T_PROMPT) { seq_start = T0 & ~8191; seq_len = 8192; } else { seq_start = T_PROMPT + ((T0 - T_PROMPT) & ~2047); seq_len = 2048; }
    const int seq_end = seq_start + seq_len;
    const int T0w = T0 + w, qt = T0w + 4 * r;
    const float slope2 = __builtin_amdgcn_exp2f(-0.5f * (float)(h + 1)) * LOG2E;
    f32x16 o[4];
#pragma unroll
    for (int dt = 0; dt < 4; ++dt)
#pragma unroll
        for (int i = 0; i < 16; ++i) o[dt][i] = 0.f;
    float m_run = -1e30f, l_run = 0.f;
    bf16x8 qf[8], kf[8];
    const bf16* hb = QKV + h * 128;
    auto issue_tile = [&](const TileDesc& td, LAS unsigned char* img_dst) {
        const int d = 1 << (2 * td.g);
        const bf16* Kb = hb + 6144 + td.g * 2048; const bf16* Vb = hb + 12288 + td.g * 2048;
#pragma unroll
        for (int i = 0; i < 8; ++i) { const int row = 4 * i + (lane >> 4); int vt = td.kt0 + row * d; vt = vt < seq_start ? seq_start : (vt >= seq_end ? seq_end - 1 : vt);
            const int lch = (lane & 15) ^ (((row & 3) << 2) | ((row >> 2) & 3));
            __builtin_amdgcn_global_load_lds((const unsigned*)(Vb + (size_t)vt * NQKV + 8 * lch), (LAS unsigned*)(img_dst + i * 1024), 16, 0, 0); }
        int kt = td.kt0 + r * d; kt = kt < seq_start ? seq_start : (kt >= seq_end ? seq_end - 1 : kt);
        const bf16* kp = Kb + (size_t)kt * NQKV + 8 * hh;
#pragma unroll
        for (int s = 0; s < 8; ++s) kf[s] = *(const GAS bf16x8*)(kp + 16 * s);
    };
    auto load_q = [&](int g) { const bf16* qp = hb + g * 2048 + (size_t)qt * NQKV + 8 * hh;
#pragma unroll
        for (int s = 0; s < 8; ++s) qf[s] = *(const GAS bf16x8*)(qp + 16 * s); };
    TileDesc cur = attn_tile(0, T0w);
    load_q(0);
    issue_tile(cur, vimg);
    for (int it = 0; it < 33; ++it) {
        LAS unsigned char* img = vimg + (it & 1) * 8192;
        const int d = 1 << (2 * cur.g), win = 64 * d, kt0 = cur.kt0;
        f32x16 st;
#pragma unroll
        for (int i = 0; i < 16; ++i) st[i] = 0.f;
#pragma unroll
        for (int s = 0; s < 8; ++s) st = __builtin_amdgcn_mfma_f32_32x32x16_bf16(kf[s], qf[s], st, 0, 0, 0);
        if (it + 1 < 33) { const TileDesc nx = attn_tile(it + 1, T0w); if (nx.g != cur.g) load_q(nx.g); issue_tile(nx, vimg + ((it + 1) & 1) * 8192); cur = nx; }
        float mloc = -1e30f;
#pragma unroll
        for (int i = 0; i < 16; ++i) { const int kk = (i & 3) + 8 * (i >> 2) + 4 * hh; const int kt = kt0 + kk * d; const int dl = kt - qt; const int ad = dl < 0 ? -dl : dl;
            const bool ok = ((dl & (d - 1)) == 0) && (ad <= win) && (kt >= seq_start) && (kt < seq_end);
            const float s = ok ? st[i] - slope2 * (float)ad : -1e30f; st[i] = s; mloc = fmaxf(mloc, s); }
        mloc = pg8::xor32_max(mloc);
        const float m_new = fmaxf(m_run, mloc);
        const float alpha = __builtin_amdgcn_exp2f(m_run - m_new);
        float ls = 0.f;
#pragma unroll
        for (int i = 0; i < 16; ++i) { const float pv = (st[i] > -1e29f) ? __builtin_amdgcn_exp2f(st[i] - m_new) : 0.f; st[i] = pv; ls += pv; }
        ls = pg8::xor32_sum(ls);
        l_run = l_run * alpha + ls; m_run = m_new;
#pragma unroll
        for (int dt = 0; dt < 4; ++dt)
#pragma unroll
            for (int i = 0; i < 16; ++i) o[dt][i] *= alpha;
        bf16x8 pb[2];
#pragma unroll
        for (int s2 = 0; s2 < 2; ++s2) { v4u w; w.x = cvtpk(st[8 * s2 + 0], st[8 * s2 + 1]); w.y = cvtpk(st[8 * s2 + 2], st[8 * s2 + 3]); w.z = cvtpk(st[8 * s2 + 4], st[8 * s2 + 5]); w.w = cvtpk(st[8 * s2 + 6], st[8 * s2 + 7]); pb[s2] = __builtin_bit_cast(bf16x8, w); }
        const int q4 = (lane & 15) >> 2, p4 = lane & 3, blk16 = (lane >> 4) & 1;
#pragma unroll
        for (int dt = 0; dt < 4; ++dt)
#pragma unroll
            for (int s2 = 0; s2 < 2; ++s2) {
                const unsigned chn = 4 * dt + 2 * blk16 + (p4 >> 1);
                const s16x4 lo = vtr(img + voff_b(16 * s2 + 4 * hh + q4, chn) + 8 * (p4 & 1));
                const s16x4 hi = vtr(img + voff_b(16 * s2 + 8 + 4 * hh + q4, chn) + 8 * (p4 & 1));
                const bf16x8 va = __builtin_shufflevector(lo, hi, 0, 1, 2, 3, 4, 5, 6, 7);
                o[dt] = __builtin_amdgcn_mfma_f32_32x32x16_bf16(va, pb[s2], o[dt], 0, 0, 0);
            }
    }
    const float inv = 1.0f / l_run;
    bf16* op = AO + (size_t)qt * D + h * 128 + 4 * hh;
#pragma unroll
    for (int dt = 0; dt < 4; ++dt)
#pragma unroll
        for (int i4 = 0; i4 < 4; ++i4) { v2u w; w.x = cvtpk(o[dt][4 * i4] * inv, o[dt][4 * i4 + 1] * inv); w.y = cvtpk(o[dt][4 * i4 + 2] * inv, o[dt][4 * i4 + 3] * inv);
            *(GAS v2u*)(op + 32 * dt + 8 * i4) = w; }
}
__device__ __forceinline__ void phase_attention(Frame& F) {
    const bf16* QKV = (const bf16*)(F.ws + WS_BIG + BIG_QKV); bf16* AO = (bf16*)(F.ws + WS_BIG + BIG_AO);
    LAS unsigned char* vimg = F.lds + RING_OFF + F.wave * 16384;
    for (int j = F.vcu; j < (T / 128) * 16 * 4 / NWAVES; j += F.G) {
        const int wt = j * NWAVES + F.wave, w = wt & 3, h = (wt >> 2) & 15, blk = wt >> 6;
        attn_wave_task(QKV, AO, vimg, blk, h, w, F.lane);
    }
}

#ifdef ATTN_NAIVE
__device__ __forceinline__ void phase_attention_naive(Frame& F) {
    const bf16* QKV = (const bf16*)(F.ws + WS_BIG + BIG_QKV); bf16* AO = (bf16*)(F.ws + WS_BIG + BIG_AO);
    const int gw = F.vcu * NWAVES + F.wave, NGW = F.G * NWAVES, lane = F.lane;
    for (int p = gw; p < T * 16; p += NGW) {
        const int tok = p >> 4, h = p & 15;
        int seq_start, seq_len;
        if (tok < T_PROMPT) { seq_start = tok & ~8191; seq_len = 8192; } else { seq_start = T_PROMPT + ((tok - T_PROMPT) & ~2047); seq_len = 2048; }
        const int seq_end = seq_start + seq_len;
        const float slope2 = __builtin_amdgcn_exp2f(-0.5f * (float)(h + 1)) * LOG2E;
        float m = -1e30f, l = 0.f, o0 = 0.f, o1 = 0.f;
        for (int g = 0; g < 3; ++g) {
            const int d = 1 << (2 * g);
            const unsigned qw = *(const GAS unsigned*)(QKV + (size_t)tok * NQKV + g * 2048 + h * 128 + 2 * lane);
            const float q0 = bf2f(qw & 0xffffu), q1 = bf2f(qw >> 16);
            for (int j = -64; j <= 64; ++j) {
                const int kt = tok + j * d;
                if (kt < seq_start || kt >= seq_end) continue;
                const unsigned kw = *(const GAS unsigned*)(QKV + (size_t)kt * NQKV + 6144 + g * 2048 + h * 128 + 2 * lane);
                const unsigned vw = *(const GAS unsigned*)(QKV + (size_t)kt * NQKV + 12288 + g * 2048 + h * 128 + 2 * lane);
                const float s = wave_sum(q0 * bf2f(kw & 0xffffu) + q1 * bf2f(kw >> 16)) - slope2 * (float)((j < 0 ? -j : j) * d);
                const float mn = fmaxf(m, s), al = __builtin_amdgcn_exp2f(m - mn), pv = __builtin_amdgcn_exp2f(s - mn);
                l = l * al + pv; o0 = o0 * al + pv * bf2f(vw & 0xffffu); o1 = o1 * al + pv * bf2f(vw >> 16); m = mn;
            }
        }
        const float inv = 1.0f / l;
        *(GAS unsigned*)(AO + (size_t)tok * D + h * 128 + 2 * lane) = pk2(o0 * inv, o1 * inv);
    }
}
#endif
constexpr int NPHASE = 54;
#ifndef DUP_PHASE
#define DUP_PHASE (-1)
#define DUP_N 0
#endif
#define REPS(id) for (int rep_ = 0; rep_ < ((DUP_PHASE) == (id) ? 1 + (DUP_N) : 1); ++rep_)
#ifndef ZERO_HY
#define ZERO_HY 0
#endif
#ifndef ZERO_AT
#define ZERO_AT 0
#endif
#ifndef AT_SCALE
#define AT_SCALE 1.0f
#endif
#ifndef HY_SCALE
#define HY_SCALE 1.0f
#endif
#define MIXSCALE(hy) ((hy) ? (ZERO_HY ? 0.0f : HY_SCALE) : (ZERO_AT ? 0.0f : AT_SCALE))
struct Args { const float* in[21]; float* out; unsigned char* ws; int ph_lo, ph_hi; };
static_assert(sizeof(Args) == 21 * 8 + 8 + 8 + 8, "Args has no padding");
__global__ void __launch_bounds__(NWAVES * 64, 2) fwd_kernel(Args args) {
    extern __shared__ __attribute__((aligned(16))) unsigned char lds[];
    unsigned char* const ws0 = args.ws;
    const int wave0 = __builtin_amdgcn_readfirstlane(threadIdx.x >> 6);
    volatile LAS unsigned* MISC = (volatile LAS unsigned*)((LAS unsigned char*)lds + MISC_OFF);
    if (threadIdx.x < 64) MISC[threadIdx.x] = 0u;
    if (threadIdx.x == 64) {
#pragma unroll
        for (int i = 0; i < 21; ++i) ((LAS unsigned long long*)((LAS unsigned char*)lds + PTR_OFF))[i] = (unsigned long long)args.in[i];
    }
    __syncthreads();
    XcdBarrier bar = xcd_barrier_post((unsigned*)(ws0 + WS_CTL), MISC);
#define FRAME() Frame F = make_frame(lds, args.ws, args.out, wave0)
    const int lo = args.ph_lo, hi = args.ph_hi;
#define RUN(id) (lo <= (id) && (id) < hi)
#define SEAM(id) do { if ((id) + 1 < hi) xcd_barrier(bar); } while (0)

#define ZB ((bf16*)(F.ws + WS_ZB))
#define STATS ((float*)(F.ws + WS_STATS))
#define PART ((float*)(F.ws + WS_PART))
#define CDV(off) ((float*)(F.ws + WS_CD) + (off))
#define HID ((bf16*)(F.ws + WS_BIG + BIG_HID))
    constexpr int O_C1 = 0, O_D1 = NFF2, O_CM = 2 * NFF2, O_DM = 2 * NFF2 + NQKV, O_C2 = 2 * NFF2 + 2 * NQKV, O_D2 = 3 * NFF2 + 2 * NQKV;

    if (RUN(0)) { FRAME(); phase_init(F); SEAM(0); }

#pragma unroll
    for (int layer = 0; layer < DEPTH; ++layer) {
        const int pb = 1 + 13 * layer; const bool hy = (layer & 1) != 0; const int jl = layer >> 1;
        if (RUN(pb + 0)) { FRAME(); REPS(0) phase_convert(F, layer); SEAM(pb + 0); }

        if (RUN(pb + 1)) {
            if (hy) {
                FRAME();
                pg8::Gemm gt{(const bf16*)(F.ws + WS_W3T), (const bf16*)(F.ws + WS_H2B), 8192, 10240, 256}; pg8::StaticOrder St; St.init(8192, 10240, F.G, F.bx);
                pg8::EpiTaps Et{(float*)(F.ws + WS_TAPS), MIN_DECAY, (MAX_DECAY - MIN_DECAY) / 2047.0f};
                pg8::gemm_phase<pg8::EpiTaps, pg8::StaticOrder, PG8_ALIGN, PG8_SP2>(F.lds + RING_OFF, gt, St, Et, F.tid);
            }
            FRAME();
            pg8::Gemm g{ZB, (const bf16*)(F.ws + W_IN1), T, NFF2, D}; pg8::StaticOrder S; S.init(T, NFF2, F.G, F.bx);
            pg8::EpiSwiglu E{HID, FF, STATS, CDV(O_C1), CDV(O_D1)};
            REPS(1) pg8::gemm_phase<pg8::EpiSwiglu, pg8::StaticOrder, PG8_ALIGN, PG8_SP2>(F.lds + RING_OFF, g, S, E, F.tid);
            SEAM(pb + 1);
        }
        if (RUN(pb + 2)) {
            FRAME();
            pg8::Gemm g{HID, (const bf16*)(F.ws + W_OUT1), T, D, FF}; pg8::StaticOrder S; S.init(T, D, F.G, F.bx);
            const float* g0 = layer ? inp(F, 2) + (size_t)((layer - 1) * 3 + 2) * D : (const float*)(F.ws + WS_IDG); const float* b0 = layer ? inp(F, 3) + (size_t)((layer - 1) * 3 + 2) * D : (const float*)(F.ws + WS_IDB);
            pg8::EpiResid E{F.z, ZB, STATS, g0, b0, (const float*)(F.ws + WS_IDB), PART, 0.5f, 0};
            pg8::gemm_phase<pg8::EpiResid, pg8::StaticOrder, PG8_ALIGN, PG8_SP2>(F.lds + RING_OFF, g, S, E, F.tid);
            SEAM(pb + 2);
        }
        if (RUN(pb + 3)) { FRAME(); REPS(3) phase_finalize(F); SEAM(pb + 3); }

        if (RUN(pb + 4)) {
            FRAME(); const int N = hy ? NHY : NQKV;
            pg8::Gemm g{ZB, (const bf16*)(F.ws + W_MIN), T, N, D}; pg8::StaticOrder S; S.init(T, N, F.G, F.bx);
            pg8::EpiLnBf16 E{(bf16*)(F.ws + WS_BIG), N, STATS, CDV(O_CM), CDV(O_DM)};
            REPS(4) pg8::gemm_phase<pg8::EpiLnBf16, pg8::StaticOrder, PG8_ALIGN, PG8_SP2>(F.lds + RING_OFF, g, S, E, F.tid);
            SEAM(pb + 4);
        }
        if (RUN(pb + 5)) {
            FRAME();
#ifdef ATTN_NAIVE
            if (!hy) phase_attention_naive(F);
#else
            if (!hy) { REPS(5) phase_attention(F); }
#endif
            else { REPS(15) phase_spectra(F, jl); REPS(25) phase_transpose(F, (const bf16*)(F.ws + WS_BIG + BIG_U), T, NHY, (bf16*)(F.ws + WS_BIG + BIG_UT)); }
            SEAM(pb + 5);
        }
        if (hy) {
            if (RUN(pb + 6)) { FRAME(); REPS(6) phase_conv(F, jl); SEAM(pb + 6); }
            if (RUN(pb + 7)) { FRAME(); REPS(7) phase_transpose(F, (const bf16*)(F.ws + WS_BIG + BIG_Z2T), D, T, (bf16*)(F.ws + WS_BIG + BIG_Z2)); SEAM(pb + 7); }
        }
        if (RUN(pb + 8)) {
            FRAME();
            const bf16* A = hy ? (const bf16*)(F.ws + WS_BIG + BIG_Z2) : (const bf16*)(F.ws + WS_BIG + BIG_AO);
            pg8::Gemm g{A, (const bf16*)(F.ws + W_MOUT), T, D, D}; pg8::StaticOrder S; S.init(T, D, F.G, F.bx);
            pg8::EpiResid E{F.z, ZB, STATS, inp(F, 2) + (size_t)(layer * 3) * D, inp(F, 3) + (size_t)(layer * 3) * D, hy ? inp(F, 20) + (size_t)jl * D : (const float*)(F.ws + WS_IDB), PART, MIXSCALE(hy), 0};
            pg8::gemm_phase<pg8::EpiResid, pg8::StaticOrder, PG8_ALIGN, PG8_SP2>(F.lds + RING_OFF, g, S, E, F.tid);
            SEAM(pb + 8);
        }
        if (RUN(pb + 9)) { FRAME(); phase_finalize(F); SEAM(pb + 9); }

        if (RUN(pb + 10)) {
            FRAME();
            pg8::Gemm g{ZB, (const bf16*)(F.ws + W_IN2), T, NFF2, D}; pg8::StaticOrder S; S.init(T, NFF2, F.G, F.bx);
            pg8::EpiSwiglu E{HID, FF, STATS, CDV(O_C2), CDV(O_D2)};
            pg8::gemm_phase<pg8::EpiSwiglu, pg8::StaticOrder, PG8_ALIGN, PG8_SP2>(F.lds + RING_OFF, g, S, E, F.tid);
            SEAM(pb + 10);
        }
        if (RUN(pb + 11)) {
            FRAME();
            pg8::Gemm g{HID, (const bf16*)(F.ws + W_OUT2), T, D, FF}; pg8::StaticOrder S; S.init(T, D, F.G, F.bx);
            pg8::EpiResid E{F.z, ZB, STATS, inp(F, 2) + (size_t)(layer * 3 + 1) * D, inp(F, 3) + (size_t)(layer * 3 + 1) * D, (const float*)(F.ws + WS_IDB), PART, 0.5f, 0};
            pg8::gemm_phase<pg8::EpiResid, pg8::StaticOrder, PG8_ALIGN, PG8_SP2>(F.lds + RING_OFF, g, S, E, F.tid);
            SEAM(pb + 11);
        }
        if (RUN(pb + 12)) { FRAME(); phase_finalize(F); SEAM(pb + 12); }
    }
#ifdef DBG_CHECK
    if (RUN(NPHASE - 2)) { FRAME(); phase_check_qkv(F); SEAM(NPHASE - 2); }
#endif
    if (RUN(NPHASE - 1)) { FRAME(); phase_final_ln(F); }
#undef RUN
#undef SEAM
#undef FRAME
}


#ifdef PHASE_PROBE
#define PROBE_FRAME() extern __shared__ __attribute__((aligned(16))) unsigned char lds[]; Frame F = make_frame(lds, args.ws, args.out, __builtin_amdgcn_readfirstlane(threadIdx.x >> 6));
__global__ void __launch_bounds__(NWAVES * 64, 2) probe_init(Args args) { PROBE_FRAME(); phase_init(F); }
__global__ void __launch_bounds__(NWAVES * 64, 2) probe_convert(Args args) { PROBE_FRAME(); phase_convert(F, args.ph_lo); }
__global__ void __launch_bounds__(NWAVES * 64, 2) probe_finalize(Args args) { PROBE_FRAME(); phase_finalize(F); phase_final_ln(F); }
__global__ void __launch_bounds__(NWAVES * 64, 2) probe_transpose(Args args) { PROBE_FRAME(); phase_transpose(F, (const bf16*)(F.ws + WS_BIG + BIG_U), T, NHY, (bf16*)(F.ws + WS_BIG + BIG_UT)); }
__global__ void __launch_bounds__(NWAVES * 64, 2) probe_spectra(Args args) { PROBE_FRAME(); phase_spectra(F, args.ph_lo); }
__global__ void __launch_bounds__(NWAVES * 64, 2) probe_conv(Args args) { PROBE_FRAME(); phase_conv(F, args.ph_lo); }
__global__ void __launch_bounds__(NWAVES * 64, 2) probe_attn(Args args) { PROBE_FRAME(); phase_attention(F); }
__global__ void __launch_bounds__(NWAVES * 64, 2) probe_gemm_swiglu(Args args) { PROBE_FRAME(); pg8::Gemm g{(const bf16*)F.ws, (const bf16*)(F.ws + W_IN1), T, NFF2, D}; pg8::StaticOrder S; S.init(T, NFF2, F.G, F.bx); pg8::EpiSwiglu E{(bf16*)(F.ws + WS_BIG), FF, (float*)(F.ws + WS_STATS), (float*)(F.ws + WS_CD), (float*)(F.ws + WS_CD)}; pg8::gemm_phase<pg8::EpiSwiglu, pg8::StaticOrder, PG8_ALIGN, PG8_SP2>(F.lds + RING_OFF, g, S, E, F.tid); }
__global__ void __launch_bounds__(NWAVES * 64, 2) probe_gemm_resid(Args args) { PROBE_FRAME(); pg8::Gemm g{(const bf16*)F.ws, (const bf16*)(F.ws + W_IN1), T, D, FF}; pg8::StaticOrder S; S.init(T, D, F.G, F.bx); pg8::EpiResid E{F.z, (bf16*)(F.ws + WS_ZB), (float*)(F.ws + WS_STATS), inp(F, 2), inp(F, 3), args.ph_lo ? inp(F, 20) : (const float*)(F.ws + WS_IDB), (float*)(F.ws + WS_PART), 0.5f, 0}; pg8::gemm_phase<pg8::EpiResid, pg8::StaticOrder, PG8_ALIGN, PG8_SP2>(F.lds + RING_OFF, g, S, E, F.tid); }
__global__ void __launch_bounds__(NWAVES * 64, 2) probe_gemm_ln(Args args) { PROBE_FRAME(); pg8::Gemm g{(const bf16*)F.ws, (const bf16*)(F.ws + W_IN1), T, NQKV, D}; pg8::StaticOrder S; S.init(T, NQKV, F.G, F.bx); pg8::EpiLnBf16 E{(bf16*)(F.ws + WS_BIG), NQKV, (float*)(F.ws + WS_STATS), (float*)(F.ws + WS_CD), (float*)(F.ws + WS_CD)}; pg8::gemm_phase<pg8::EpiLnBf16, pg8::StaticOrder, PG8_ALIGN, PG8_SP2>(F.lds + RING_OFF, g, S, E, F.tid); }
#endif
#ifndef MK_MULTI
#define MK_MULTI 0
#endif
extern "C" void kernel_launch(void* const* d_in, const int* in_sizes, int n_in, void* d_out, int out_size, void* d_ws, size_t ws_size, hipStream_t stream) {
    static int grid = 0;
    if (grid == 0) {
        if (n_in != 21 || out_size != T * D || ws_size < WS_END) { fprintf(stderr, "kernel_launch: unexpected shapes (n_in %d, out %d, ws %zu, need %zu)\n", n_in, out_size, ws_size, (size_t)WS_END); grid = -1; return; }
        int dev = 0, cus = 0, per_cu = 0;
        if (hipGetDevice(&dev) != hipSuccess || hipDeviceGetAttribute(&cus, hipDeviceAttributeMultiprocessorCount, dev) != hipSuccess) { grid = -1; return; }
        if (hipFuncSetAttribute((const void*)fwd_kernel, hipFuncAttributeMaxDynamicSharedMemorySize, LDS_BYTES) != hipSuccess) { fprintf(stderr, "kernel_launch: hipFuncSetAttribute failed\n"); grid = -1; return; }
        if (hipOccupancyMaxActiveBlocksPerMultiprocessor(&per_cu, (const void*)fwd_kernel, NWAVES * 64, LDS_BYTES) != hipSuccess || per_cu < 1) fprintf(stderr, "kernel_launch: occupancy query reports %d\n", per_cu);
        (void)hipGetLastError();
        grid = cus;
    }
    if (grid < 0) return;
    if (hipMemsetAsync((char*)d_ws + WS_CTL, 0, CTL_ZERO_BYTES, stream) != hipSuccess) return;
    Args a{};
    for (int i = 0; i < 21; ++i) a.in[i] = (const float*)d_in[i];
    a.out = (float*)d_out; a.ws = (unsigned char*)d_ws;
#ifndef STOP_AFTER
#define STOP_AFTER (NPHASE - 1)
#endif
#ifdef DBG_CHECK
#define DBGCHK_ON 1
#else
#define DBGCHK_ON 0
#endif
#if MK_MULTI
    for (int p = 0; p < NPHASE; ++p) { if (p >= STOP_AFTER && p != NPHASE - 1 && !(DBGCHK_ON && p == NPHASE - 2)) continue; a.ph_lo = p; a.ph_hi = p + 1; hipLaunchKernelGGL(fwd_kernel, dim3(grid), dim3(NWAVES * 64), LDS_BYTES, stream, a); }
#else
    a.ph_lo = 0; a.ph_hi = NPHASE;
    hipLaunchKernelGGL(fwd_kernel, dim3(grid), dim3(NWAVES * 64), LDS_BYTES, stream, a);
#endif
}
```

```cpp
#include <hip/hip_runtime.h>
#include <cstdio>
#include <cstdint>
namespace pg8 {
#define PG8_LAS __attribute__((address_space(3)))
typedef unsigned short bf16_t;
typedef short bf16x8 __attribute__((ext_vector_type(8)));
typedef float f32x4 __attribute__((ext_vector_type(4)));
typedef unsigned u32x4 __attribute__((ext_vector_type(4)));
constexpr int BM = 256, BK = 64, HALF = 128, HTB = HALF * BK * 2  , STAGE_BYTES = 8 * HTB, NXCD = 8, WGM = 8;

__host__ __device__ __forceinline__ int lds_byte(int r, int c) { const int st = (r >> 4) * 2 + (c >> 5), rr = r & 15, cc = c & 31, ob = rr * 64 + cc * 2; return st * 1024 + (ob ^ (((ob >> 9) & 1) << 5)); }
__host__ __device__ __forceinline__ void stage_rc(int b, int& R, int& C) { const int st = b / 1024, sb = b % 1024, swz = sb ^ (((sb >> 9) & 1) << 5); R = (st >> 1) * 16 + swz / 64; C = (st & 1) * 32 + (swz % 64) / 2; }
__host__ __device__ __forceinline__ int perm32(int rho) { const int n = rho >> 4, i = rho & 15; return 8 * (i >> 2) + 4 * n + (i & 3); }

struct Unit { int pm, pn; };
struct Gemm { const bf16_t* A; const bf16_t* Bt; int M, N, K; };

struct StaticOrder {
    int nM, nN, nwg, G, c;
    __host__ __device__ void init(int M, int N, int G_, int c_) { nM = M / BM; nN = N / BM; nwg = nM * nN; G = G_; c = c_; }
    __host__ __device__ bool next(int i, Unit& u) const {
        const long L = (long)i * G + c; if (L >= nwg) return false;
        int wgid = (int)L; { const int q = nwg / NXCD, r = nwg % NXCD, xcd = wgid % NXCD, off = wgid / NXCD; wgid = (xcd < r ? xcd * (q + 1) : r * (q + 1) + (xcd - r) * q) + off; }
        const int nig = WGM * nN, gid = wgid / nig, fm = gid * WGM, gsz = (nM - fm) < WGM ? (nM - fm) : WGM;
        u.pm = fm + ((wgid % nig) % gsz); u.pn = (wgid % nig) / gsz; return true;
    }
    __device__ __forceinline__ void a_ready(const Unit&) const {}
    __device__ __forceinline__ void done(const Unit&) const {}
};

__device__ __forceinline__ unsigned cvt_pk_bf16(float lo, float hi) { unsigned r; asm volatile("v_cvt_pk_bf16_f32 %0, %1, %2" : "=v"(r) : "v"(lo), "v"(hi)); return r; }
typedef float f32x2 __attribute__((ext_vector_type(2)));
typedef float f32x2v __attribute__((ext_vector_type(2)));
typedef unsigned u32x2v __attribute__((ext_vector_type(2)));
constexpr float DN_ALPHA_F = 1.6817928305074292f;

__device__ __forceinline__ unsigned cvt2(float lo, float hi) { typedef __bf16 bf16x2_t __attribute__((ext_vector_type(2))); const f32x2v v = {lo, hi}; return __builtin_bit_cast(unsigned, __builtin_convertvector(v, bf16x2_t)); }
__device__ __forceinline__ float xor32_sum(float x) { const auto r = __builtin_amdgcn_permlane32_swap(__float_as_uint(x), __float_as_uint(x), false, false); const unsigned r0 = r[0], r1 = r[1]; return __uint_as_float(r0) + __uint_as_float(r1); }
__device__ __forceinline__ float xor32_max(float x) { const auto r = __builtin_amdgcn_permlane32_swap(__float_as_uint(x), __float_as_uint(x), false, false); const unsigned r0 = r[0], r1 = r[1]; return fmaxf(__uint_as_float(r0), __uint_as_float(r1)); }
template <int MASK> __device__ __forceinline__ float swz_xor(float x) { return __builtin_bit_cast(float, __builtin_amdgcn_ds_swizzle(__builtin_bit_cast(int, x), (MASK << 10) | 0x1F)); }
__device__ __forceinline__ float wave_sum64(float v) { v += swz_xor<1>(v); v += swz_xor<2>(v); v += swz_xor<4>(v); v += swz_xor<8>(v); v += swz_xor<16>(v); return xor32_sum(v); }

struct EpiLnBf16 {
    static constexpr bool PERM = true, AFTER_DRAIN = false;
    bf16_t* O; int ldc; const float* stats; const float* cvec; const float* dvec;
    __device__ __forceinline__ void operator()(const f32x4 (&acc)[2][2][4][2], const Unit& u, int wr, int wc, int fr, int fq) const {
        const int row0 = u.pm * BM + wr * 64 + fr, col0 = u.pn * BM + wc * 32 + 8 * fq;
        f32x4 cv[2][2], dv[2][2];
#pragma unroll
        for (int bj = 0; bj < 2; ++bj)
#pragma unroll
            for (int n = 0; n < 2; ++n) { cv[bj][n] = *(const f32x4*)(cvec + col0 + bj * HALF + 4 * n); dv[bj][n] = *(const f32x4*)(dvec + col0 + bj * HALF + 4 * n); }
        f32x2v sts[2][4];
#pragma unroll
        for (int ai = 0; ai < 2; ++ai)
#pragma unroll
            for (int m = 0; m < 4; ++m) sts[ai][m] = *(const f32x2v*)(stats + 2 * (size_t)(row0 + ai * HALF + m * 16));
#pragma unroll
        for (int ai = 0; ai < 2; ++ai)
#pragma unroll
            for (int m = 0; m < 4; ++m) { const int row = row0 + ai * HALF + m * 16; const f32x2v st = sts[ai][m];
                bf16_t* rowp = O + (size_t)row * ldc + col0;
#pragma unroll
                for (int bj = 0; bj < 2; ++bj) { const f32x4 v0 = (acc[ai][bj][m][0] - st.x * cv[bj][0]) * st.y + dv[bj][0], v1 = (acc[ai][bj][m][1] - st.x * cv[bj][1]) * st.y + dv[bj][1];
                    u32x4 w; w.x = cvt2(v0[0], v0[1]); w.y = cvt2(v0[2], v0[3]); w.z = cvt2(v1[0], v1[1]); w.w = cvt2(v1[2], v1[3]);
                    *(u32x4*)(rowp + bj * HALF) = w; } }
    }
};
__device__ __forceinline__ float silu_mul(float g, float up) { const float e = __builtin_amdgcn_exp2f(-1.4426950408889634f * g); return g * __builtin_amdgcn_rcpf(1.0f + e) * up; }
struct EpiSwiglu {
    static constexpr bool PERM = true, AFTER_DRAIN = false;
    bf16_t* O; int ldc; const float* stats; const float* cvec; const float* dvec;
    __device__ __forceinline__ void operator()(const f32x4 (&acc)[2][2][4][2], const Unit& u, int wr, int wc, int fr, int fq) const {
        const int row0 = u.pm * BM + wr * 64 + fr, col0 = u.pn * BM + wc * 32 + 8 * fq, ocol = u.pn * HALF + wc * 32 + 8 * fq;
        f32x4 cv[2][2], dv[2][2];
#pragma unroll
        for (int bj = 0; bj < 2; ++bj)
#pragma unroll
            for (int n = 0; n < 2; ++n) { cv[bj][n] = *(const f32x4*)(cvec + col0 + bj * HALF + 4 * n); dv[bj][n] = *(const f32x4*)(dvec + col0 + bj * HALF + 4 * n); }
        f32x2v sts[2][4];
#pragma unroll
        for (int ai = 0; ai < 2; ++ai)
#pragma unroll
            for (int m = 0; m < 4; ++m) sts[ai][m] = *(const f32x2v*)(stats + 2 * (size_t)(row0 + ai * HALF + m * 16));
#pragma unroll
        for (int ai = 0; ai < 2; ++ai)
#pragma unroll
            for (int m = 0; m < 4; ++m) { const int row = row0 + ai * HALF + m * 16; const f32x2v st = sts[ai][m];
                f32x4 h[2];
#pragma unroll
                for (int n = 0; n < 2; ++n) { const f32x4 g = (acc[ai][0][m][n] - st.x * cv[0][n]) * st.y + dv[0][n], up = (acc[ai][1][m][n] - st.x * cv[1][n]) * st.y + dv[1][n];
                    h[n] = (f32x4){silu_mul(g[0], up[0]), silu_mul(g[1], up[1]), silu_mul(g[2], up[2]), silu_mul(g[3], up[3])}; }
                u32x4 w; w.x = cvt2(h[0][0], h[0][1]); w.y = cvt2(h[0][2], h[0][3]); w.z = cvt2(h[1][0], h[1][1]); w.w = cvt2(h[1][2], h[1][3]);
                *(u32x4*)(O + (size_t)row * ldc + ocol) = w; }
    }
};
struct EpiResid {
    static constexpr bool PERM = true, AFTER_DRAIN = false;
    float* Z; bf16_t* ZB; const float* stats; const float* gprev; const float* bprev; const float* bias; float* part; float scale; int pad;
    __device__ __forceinline__ void operator()(const f32x4 (&acc)[2][2][4][2], const Unit& u, int wr, int wc, int fr, int fq) const {
        const int row0 = u.pm * BM + wr * 64 + fr, col0 = u.pn * BM + wc * 32 + 8 * fq;
#pragma unroll
        for (int bj = 0; bj < 2; ++bj) {
            f32x4 gv[2], bv[2];
#pragma unroll
            for (int n = 0; n < 2; ++n) { const int c = col0 + bj * HALF + 4 * n; gv[n] = DN_ALPHA_F * *(const f32x4*)(gprev + c); bv[n] = DN_ALPHA_F * *(const f32x4*)(bprev + c) + scale * *(const f32x4*)(bias + c); }
#pragma unroll
            for (int ai = 0; ai < 2; ++ai)
#pragma unroll
                for (int mp = 0; mp < 2; ++mp) {
                    f32x4 zin[2][2]; f32x2v sts[2];
#pragma unroll
                    for (int mm = 0; mm < 2; ++mm) { const int row = row0 + ai * HALF + (2 * mp + mm) * 16; const float* zp = Z + (size_t)row * 2048 + col0 + bj * HALF;
                        zin[mm][0] = *(const f32x4*)zp; zin[mm][1] = *(const f32x4*)(zp + 4); sts[mm] = *(const f32x2v*)(stats + 2 * (size_t)row); }
#pragma unroll
                    for (int mm = 0; mm < 2; ++mm) { const int m = 2 * mp + mm; const int row = row0 + ai * HALF + m * 16; const f32x2v st = sts[mm];
                        float* zp = Z + (size_t)row * 2048 + col0 + bj * HALF;
                        const f32x4 n0 = (zin[mm][0] - st.x) * st.y * gv[0] + bv[0] + scale * acc[ai][bj][m][0];
                        const f32x4 n1 = (zin[mm][1] - st.x) * st.y * gv[1] + bv[1] + scale * acc[ai][bj][m][1];
                        *(f32x4*)zp = n0; *(f32x4*)(zp + 4) = n1;
                        u32x4 w; w.x = cvt2(n0[0], n0[1]); w.y = cvt2(n0[2], n0[3]); w.z = cvt2(n1[0], n1[1]); w.w = cvt2(n1[2], n1[3]);
                        *(u32x4*)(ZB + (size_t)row * 2048 + col0 + bj * HALF) = w;
                        float s = ((n0[0] + n0[1]) + (n0[2] + n0[3])) + ((n1[0] + n1[1]) + (n1[2] + n1[3]));
                        float q = ((n0[0] * n0[0] + n0[1] * n0[1]) + (n0[2] * n0[2] + n0[3] * n0[3])) + ((n1[0] * n1[0] + n1[1] * n1[1]) + (n1[2] * n1[2] + n1[3] * n1[3]));
                        s += swz_xor<16>(s); s = xor32_sum(s); q += swz_xor<16>(q); q = xor32_sum(q);
                        if (fq == 0) *(f32x2v*)(part + ((size_t)row * 64 + u.pn * 8 + wc * 2 + bj) * 2) = (f32x2v){s, q}; }
                }
        }
    }
};

struct EpiTaps {
    static constexpr bool PERM = false, AFTER_DRAIN = false;
    float* O; float min_decay, dstep;
    __device__ __forceinline__ void operator()(const f32x4 (&acc)[2][2][4][2], const Unit& u, int wr, int wc, int fr, int fq) const {
        int stride = 10240; float i0 = 1.0f / 8191.0f, i1 = 1.0f / 2047.0f; asm volatile("" : "+s"(stride), "+s"(i0), "+s"(i1));
        const int row0 = u.pm * BM + wr * 64 + fr, col0 = u.pn * BM + wc * 32 + 4 * fq;
        const int tbase = (u.pn < 32) ? 0 : 8192; const float ilm1 = (u.pn < 32) ? i0 : i1;
        const float t0 = (float)(col0 - tbase);
#pragma unroll
        for (int ai = 0; ai < 2; ++ai)
#pragma unroll
            for (int m = 0; m < 4; ++m) { const int row = row0 + ai * HALF + m * 16;
                const float a = -1.4426950408889634f * __builtin_fabsf(min_decay + (float)(row & 2047) * dstep) * ilm1;
                const float e0 = __builtin_amdgcn_exp2f(a * t0), s1 = __builtin_amdgcn_exp2f(a), s16 = __builtin_amdgcn_exp2f(16.0f * a), s128 = __builtin_amdgcn_exp2f(128.0f * a);
                float* rowp = O + (size_t)row * stride + col0;
#pragma unroll
                for (int bj = 0; bj < 2; ++bj) { const float eb = bj ? e0 * s128 : e0;
#pragma unroll
                    for (int n = 0; n < 2; ++n) { const float en = n ? eb * s16 : eb, en1 = en * s1, en2 = en1 * s1, en3 = en2 * s1; const f32x4 v = acc[ai][bj][m][n];
                        *(f32x4*)(rowp + bj * HALF + n * 16) = (f32x4){v[0] * en, v[1] * en1, v[2] * en2, v[3] * en3}; } } }
    }
};

template <class Epi, class Sched, bool ALIGN_EPI = false, bool SP2 = false>
__device__ __forceinline__ void gemm_phase(PG8_LAS unsigned char* lds, const Gemm g, const Sched& S, const Epi& E, const int tid_in) {
    int tid_ = tid_in; asm volatile("" : "+v"(tid_));
    const int tid = tid_, wid = __builtin_amdgcn_readfirstlane(tid >> 6), lane = tid & 63, wr = wid >> 2, wc = wid & 3, fr = lane & 15, fq = lane >> 4;
    const int K = g.K, nt = K / BK;
    unsigned voffA[2], voffB[2];
#pragma unroll
    for (int i = 0; i < 2; ++i) { int R, C; stage_rc(tid * 16 + i * 8192, R, C); const int Rb = Epi::PERM ? ((R & ~31) + perm32(R & 31)) : R;
        voffA[i] = (unsigned)(R * K + C) * 2u; voffB[i] = (unsigned)(Rb * K + C) * 2u; }
    const size_t kstep = (size_t)(BK * 2);
    const size_t hstep = (size_t)HALF * K * 2;
    const size_t tstep = 2 * hstep;
    const unsigned ldsw = (unsigned)wid * 1024u;
    const int aoff = lds_byte(wr * 64 + fr, fq * 8), boff = lds_byte(wc * 32 + fr, fq * 8);
#define PG8_SA(b, h) (((b) * 2 + (h)) * HTB)
#define PG8_SB(b, h) ((4 + (b) * 2 + (h)) * HTB)
#define PG8_STAGE(bufoff, gbase, voff) do { _Pragma("unroll") for (int _i = 0; _i < 2; ++_i) \
        __builtin_amdgcn_global_load_lds((const unsigned*)((const char*)(gbase) + (voff)[_i]), (PG8_LAS unsigned*)(lds + (bufoff) + ldsw + _i * 8192), 16, 0, 0); } while (0)
#define PG8_LDA(dst, b, h) do { _Pragma("unroll") for (int m = 0; m < 4; ++m) _Pragma("unroll") for (int k = 0; k < 2; ++k) dst[m][k] = *(const PG8_LAS bf16x8*)(lds + PG8_SA(b, h) + aoff + m * 2048 + k * 1024); } while (0)
#define PG8_LDB(dst, b, h) do { _Pragma("unroll") for (int n = 0; n < 2; ++n) _Pragma("unroll") for (int k = 0; k < 2; ++k) dst[n][k] = *(const PG8_LAS bf16x8*)(lds + PG8_SB(b, h) + boff + n * 2048 + k * 1024); } while (0)
#define PG8_MMA(ai, bj, At, Bt) do { __builtin_amdgcn_s_setprio(1); _Pragma("unroll") for (int m = 0; m < 4; ++m) _Pragma("unroll") for (int n = 0; n < 2; ++n) _Pragma("unroll") for (int k = 0; k < 2; ++k) \
        acc[ai][bj][m][n] = __builtin_amdgcn_mfma_f32_16x16x32_bf16(Bt[n][k], At[m][k], acc[ai][bj][m][n], 0, 0, 0); __builtin_amdgcn_s_setprio(0); } while (0)
#define PG8_WAIT_V(n) asm volatile("s_waitcnt vmcnt(" #n ")" ::: "memory")
#define PG8_WAIT_L(n) asm volatile("s_waitcnt lgkmcnt(" #n ")" ::: "memory")
#define PG8_BAR __builtin_amdgcn_s_barrier()
#define PG8_SCHED __builtin_amdgcn_sched_barrier(0)
    Unit cur, nxt; int ui = 0;
    if (!S.next(0, cur)) return;
    f32x4 acc[2][2][4][2];
    float zero_; asm volatile("v_mov_b32 %0, 0" : "=v"(zero_));
#pragma unroll
    for (int a = 0; a < 2; ++a)
#pragma unroll
        for (int b = 0; b < 2; ++b)
#pragma unroll
            for (int m = 0; m < 4; ++m)
#pragma unroll
                for (int n = 0; n < 2; ++n) acc[a][b][m][n] = (f32x4){zero_, zero_, zero_, zero_};
    bf16x8 At[4][2], B0[2][2], B1[2][2];
    const char* cA = (const char*)g.A + (size_t)cur.pm * tstep; const char* cB = (const char*)g.Bt + (size_t)cur.pn * tstep;
    S.a_ready(cur);
    if constexpr (SP2) {
        PG8_STAGE(PG8_SB(0, 0), cB, voffB); PG8_STAGE(PG8_SB(0, 1), cB + hstep, voffB); PG8_STAGE(PG8_SA(0, 0), cA, voffA); PG8_STAGE(PG8_SA(0, 1), cA + hstep, voffA);
        if (wr == 1) PG8_BAR;
        PG8_WAIT_V(2); PG8_BAR;
        PG8_STAGE(PG8_SB(1, 0), cB + kstep, voffB); PG8_STAGE(PG8_SA(1, 0), cA + kstep, voffA); PG8_STAGE(PG8_SB(1, 1), cB + hstep + kstep, voffB);
        PG8_WAIT_V(6); PG8_BAR;
    } else {
        PG8_STAGE(PG8_SB(0, 0), cB, voffB); PG8_STAGE(PG8_SA(0, 0), cA, voffA); PG8_STAGE(PG8_SB(0, 1), cB + hstep, voffB); PG8_STAGE(PG8_SA(0, 1), cA + hstep, voffA);
        if (wr == 1) PG8_BAR;
        PG8_WAIT_V(4); PG8_BAR;
        PG8_STAGE(PG8_SB(1, 0), cB + kstep, voffB); PG8_STAGE(PG8_SA(1, 0), cA + kstep, voffA); PG8_STAGE(PG8_SB(1, 1), cB + hstep + kstep, voffB);
        PG8_WAIT_V(6); PG8_BAR;
    }
    for (;;) {
        const bool has_next = S.next(ui + 1, nxt);
        const char* nA = has_next ? (const char*)g.A + (size_t)nxt.pm * tstep : cA; const char* nB = has_next ? (const char*)g.Bt + (size_t)nxt.pn * tstep : cB;
        for (int t = 0; t < nt; t += 2) {
            const bool last = (t == nt - 2);
            const char* a1 = cA + (size_t)(t + 1) * kstep;
            const char* a2 = last ? nA : cA + (size_t)(t + 2) * kstep; const char* b2 = last ? nB : cB + (size_t)(t + 2) * kstep;
            const char* a3 = a2 + kstep; const char* b3 = b2 + kstep;
            if (last && has_next) S.a_ready(nxt);
            if constexpr (SP2) {
            PG8_LDB(B0, 0, 0); PG8_LDB(B1, 0, 1); PG8_SCHED; PG8_LDA(At, 0, 0); PG8_STAGE(PG8_SA(1, 1), a1 + hstep, voffA);
            PG8_WAIT_V(8); PG8_WAIT_L(0); PG8_BAR; PG8_MMA(0, 0, At, B0); PG8_MMA(0, 1, At, B1); PG8_BAR; PG8_SCHED;
            PG8_LDA(At, 0, 1); PG8_STAGE(PG8_SB(0, 0), b2, voffB); PG8_STAGE(PG8_SB(0, 1), b2 + hstep, voffB); PG8_STAGE(PG8_SA(0, 0), a2, voffA);
            PG8_WAIT_V(8); PG8_WAIT_L(0); PG8_BAR; PG8_MMA(1, 0, At, B0); PG8_MMA(1, 1, At, B1); PG8_BAR; PG8_SCHED;
            PG8_LDB(B0, 1, 0); PG8_LDB(B1, 1, 1); PG8_SCHED; PG8_LDA(At, 1, 0); PG8_STAGE(PG8_SA(0, 1), a2 + hstep, voffA);
            PG8_WAIT_V(8); PG8_WAIT_L(0); PG8_BAR; PG8_MMA(0, 0, At, B0); PG8_MMA(0, 1, At, B1); PG8_BAR; PG8_SCHED;
            PG8_LDA(At, 1, 1); PG8_STAGE(PG8_SB(1, 0), b3, voffB); PG8_STAGE(PG8_SB(1, 1), b3 + hstep, voffB); PG8_STAGE(PG8_SA(1, 0), a3, voffA);
            PG8_WAIT_V(8); PG8_WAIT_L(0); PG8_BAR; PG8_MMA(1, 0, At, B0); PG8_MMA(1, 1, At, B1); PG8_BAR; PG8_SCHED;
            } else {
            PG8_LDB(B0, 0, 0); PG8_SCHED; PG8_LDA(At, 0, 0); PG8_STAGE(PG8_SA(1, 1), a1 + hstep, voffA);
            PG8_WAIT_L(8); PG8_BAR; PG8_WAIT_L(0); PG8_MMA(0, 0, At, B0); PG8_BAR; PG8_SCHED;
            PG8_LDB(B1, 0, 1); PG8_STAGE(PG8_SB(0, 0), b2, voffB);
            PG8_BAR; PG8_WAIT_L(0); PG8_MMA(0, 1, At, B1); PG8_BAR;
            PG8_LDA(At, 0, 1); PG8_STAGE(PG8_SA(0, 0), a2, voffA);
            PG8_BAR; PG8_WAIT_L(0); PG8_MMA(1, 0, At, B0); PG8_BAR; PG8_SCHED;
            PG8_STAGE(PG8_SB(0, 1), b2 + hstep, voffB);
            PG8_WAIT_V(6); PG8_BAR; PG8_MMA(1, 1, At, B1); PG8_BAR;
            PG8_LDB(B0, 1, 0); PG8_SCHED; PG8_LDA(At, 1, 0); PG8_STAGE(PG8_SA(0, 1), a2 + hstep, voffA);
            PG8_WAIT_L(8); PG8_BAR; PG8_WAIT_L(0); PG8_MMA(0, 0, At, B0); PG8_BAR; PG8_SCHED;
            PG8_LDB(B1, 1, 1); PG8_STAGE(PG8_SB(1, 0), b3, voffB);
            PG8_BAR; PG8_WAIT_L(0); PG8_MMA(0, 1, At, B1); PG8_BAR;
            PG8_LDA(At, 1, 1); PG8_STAGE(PG8_SA(1, 0), a3, voffA);
            PG8_BAR; PG8_WAIT_L(0); PG8_MMA(1, 0, At, B0); PG8_BAR; PG8_SCHED;
            PG8_STAGE(PG8_SB(1, 1), b3 + hstep, voffB);
            PG8_WAIT_V(6); PG8_BAR; PG8_MMA(1, 1, At, B1); PG8_BAR;
            }
        }
        if constexpr (ALIGN_EPI) { if (wr == 0) PG8_BAR; }
        if constexpr (!Epi::AFTER_DRAIN) { E(acc, cur, wr, wc, fr, fq); S.done(cur); }
        if (!has_next) break;
        asm volatile("v_mov_b32 %0, 0" : "=v"(zero_));
#pragma unroll
        for (int a = 0; a < 2; ++a)
#pragma unroll
            for (int b = 0; b < 2; ++b)
#pragma unroll
                for (int m = 0; m < 4; ++m)
#pragma unroll
                    for (int n = 0; n < 2; ++n) acc[a][b][m][n] = (f32x4){zero_, zero_, zero_, zero_};
        cur = nxt; cA = nA; cB = nB; ++ui;
        if constexpr (ALIGN_EPI) { if (wr == 1) PG8_BAR; }
    }
    PG8_WAIT_V(0);
    if constexpr (!ALIGN_EPI) { if (wr == 0) PG8_BAR; }
    PG8_BAR;
    if constexpr (Epi::AFTER_DRAIN) { E.fused(acc, cur, wr, wc, fr, fq, lds, wid, lane); S.done(cur); }
#undef PG8_SA
#undef PG8_SB
#undef PG8_STAGE
#undef PG8_LDA
#undef PG8_LDB
#undef PG8_MMA
#undef PG8_WAIT_V
#undef PG8_WAIT_L
#undef PG8_BAR
#undef PG8_SCHED
}
}

#ifndef PG8_SP2
#define PG8_SP2 true
#endif
#ifndef PG8_ALIGN
#define PG8_ALIGN true
#endif
#define XB_TMO      128
#define XB_XCNT(j)  (256  + 64 * (j))
#define XB_XSUB(j)  (1280 + 64 * (j))
#define XB_XGEN(j)  (2304 + 64 * (j))
#define XB_TOP      3328
#define XB_TOPGEN   3392
#define XCD_BAR_WORDS 3456
#define XB_SPIN_CAP (1u << 18)
#define LAS __attribute__((address_space(3)))

__device__ __forceinline__ unsigned xb_ld(unsigned* p)              { return __hip_atomic_load(p, __ATOMIC_RELAXED, __HIP_MEMORY_SCOPE_AGENT); }
__device__ __forceinline__ unsigned xb_add(unsigned* p, unsigned v) { return __hip_atomic_fetch_add(p, v, __ATOMIC_RELAXED, __HIP_MEMORY_SCOPE_AGENT); }
__device__ __forceinline__ unsigned xb_xcc_id() { return (unsigned)__builtin_amdgcn_s_getreg((3 << 11) | 20) & 0xFu; }
#define XB_SPIN(cond, bar) do { unsigned _sp = 0; while (cond) { __builtin_amdgcn_s_sleep(1); \
    if ((++_sp & 255u) == 0u) { if (xb_ld(&(bar)[XB_TMO])) break; if (_sp > XB_SPIN_CAP) { atomicAdd(&(bar)[XB_TMO], 1u); break; } } } } while (0)

struct XcdBarrier {
    unsigned* bar; unsigned x;
    unsigned w0;
    volatile LAS unsigned* st;
};

__device__ __forceinline__ XcdBarrier xcd_barrier_post(unsigned* bar, volatile LAS unsigned* st) {
    XcdBarrier b; b.bar = bar; b.x = xb_xcc_id(); b.st = st; b.w0 = (unsigned)__builtin_amdgcn_readfirstlane(threadIdx.x >> 6);
    if (threadIdx.x == 0) (void)xb_add(&bar[XB_XCNT(b.x)], 1u);
    return b;
}
__device__ __forceinline__ void xcd_barrier_complete(unsigned* bar, unsigned x, unsigned& nloc, unsigned& nx) {
    const unsigned G = gridDim.x * gridDim.y * gridDim.z;
    unsigned sum, cnt, mine, sp = 0u;
    for (;;) {
        sum = 0u; cnt = 0u; mine = 0u;
#pragma unroll
        for (unsigned j = 0; j < 16; ++j) { const unsigned c = xb_ld(&bar[XB_XCNT(j)]); sum += c; cnt += (c > 0u) ? 1u : 0u; mine = (j == x) ? c : mine; }
        if (sum == G) break;
        __builtin_amdgcn_s_sleep(1);
        if ((++sp & 255u) == 0u) { if (xb_ld(&bar[XB_TMO])) break; if (sp > XB_SPIN_CAP) { atomicAdd(&bar[XB_TMO], 1u); break; } }
    }
    nloc = mine > 0u ? mine : 1u; nx = cnt > 0u ? cnt : 1u;
}

__device__ __forceinline__ void xcd_barrier(const XcdBarrier& b) {
    asm volatile("s_waitcnt vmcnt(0)" ::: "memory");
    __syncthreads();
    unsigned xb_lane; asm volatile("v_mbcnt_lo_u32_b32 %0, -1, 0\n\tv_mbcnt_hi_u32_b32 %0, -1, %0" : "=v"(xb_lane));
    if (b.w0 == 0u && xb_lane == 0u) {
        unsigned* bar = b.bar;
        __builtin_amdgcn_s_waitcnt(0);
        unsigned nloc = b.st[0], nx = b.st[1];
        if (nloc == 0u) { xcd_barrier_complete(bar, b.x, nloc, nx); b.st[0] = nloc; b.st[1] = nx; }
        const unsigned old = xb_add(&bar[XB_XSUB(b.x)], 1u);
        const unsigned gen = old / nloc;
        if (old + 1u == (gen + 1u) * nloc) {
            __builtin_amdgcn_fence(__ATOMIC_RELEASE, "agent");
            asm volatile("s_waitcnt vmcnt(0)" ::: "memory");
            const unsigned og = xb_add(&bar[XB_TOP], 1u);
            const unsigned tg = og / nx;
            if (og + 1u == (tg + 1u) * nx) xb_add(&bar[XB_TOPGEN], 1u);
            else XB_SPIN(xb_ld(&bar[XB_TOPGEN]) == tg, bar);
            __builtin_amdgcn_fence(__ATOMIC_ACQUIRE, "agent");
            xb_add(&bar[XB_XGEN(b.x)], 1u);
            asm volatile("s_waitcnt vmcnt(0)" ::: "memory");
        } else {
            XB_SPIN(xb_ld(&bar[XB_XGEN(b.x)]) == gen, bar);
            __builtin_amdgcn_fence(__ATOMIC_ACQUIRE, "agent");
            asm volatile("s_waitcnt vmcnt(0)" ::: "memory");
        }
    }
    __syncthreads();
}
constexpr int NWAVES = 8;
constexpr int D = 2048, FF = 5632, NFF2 = 2 * FF, NQKV = 18432, NHY = 6144, DEPTH = 4;
constexpr int T_PROMPT = 4 * 8192, T = 49152;
constexpr float LN_EPS = 1e-5f;
constexpr float QSCALE = 0.12751743082459868f;
constexpr float LOG2E = 1.4426950408889634f;
constexpr float MIN_DECAY = -3.0701134573253946f, MAX_DECAY = -15.350567286626973f;

constexpr size_t MiB = 1u << 20;
constexpr size_t WS_CTL = 0, CTL_ZERO_BYTES = 64 * 1024;
constexpr size_t WS_IDG = 1 * MiB, WS_IDB = 1 * MiB + 32768, WS_DUMP = 1 * MiB + 32768 + 131072;
constexpr size_t WS_CD = 2 * MiB;
constexpr size_t WS_STATS = 3 * MiB;
constexpr size_t WS_H2T = 4 * MiB;
constexpr size_t WS_PART = 8 * MiB;
constexpr size_t WS_W = 32 * MiB;
constexpr size_t W_IN1 = WS_W, W_OUT1 = W_IN1 + 44 * MiB, W_IN2 = W_OUT1 + 22 * MiB, W_OUT2 = W_IN2 + 44 * MiB, W_MIN = W_OUT2 + 22 * MiB, W_MOUT = W_MIN + 72 * MiB;
constexpr size_t WS_ZB = W_MOUT + 8 * MiB;
constexpr size_t WS_BIG = WS_ZB + 192 * MiB;
constexpr size_t BIG_HID = 0;
constexpr size_t BIG_QKV = 0, BIG_AO = 1728 * MiB;
constexpr size_t BIG_U = 0, BIG_Z2T = 0, BIG_Z2 = 192 * MiB, BIG_UT = 576 * MiB, BIG_SPEC0 = 1152 * MiB, BIG_SPEC1 = 1664 * MiB;
constexpr size_t WS_TAPS = WS_BIG + 1920 * MiB;
constexpr size_t WS_H2B = WS_TAPS + 320 * MiB, WS_W3T = WS_H2B + 6 * MiB;
constexpr size_t WS_END = WS_W3T + 4 * MiB;
static_assert(WS_ZB == 244 * MiB && WS_BIG == 436 * MiB && (size_t)T * 64 * 8 <= 24 * MiB && WS_END <= 2816 * MiB && (size_t)8192 * 10240 * 4 <= 320 * MiB, "ws map");
static_assert((size_t)T * FF * 2 <= 528 * MiB && (size_t)T * NQKV * 2 <= 1728 * MiB && (size_t)T * NHY * 2 <= 576 * MiB && BIG_SPEC1 + 128 * MiB <= 1920 * MiB, "ws map");

constexpr int RING_OFF = 0;
constexpr int FFT_BYTES = (16384 + 512) * 8;
constexpr int SCR_OFF = FFT_BYTES;
constexpr int MISC_OFF = SCR_OFF + 1024;
constexpr int PTR_OFF = MISC_OFF + 256;
constexpr int LDS_BYTES = PTR_OFF + 256;

#define GAS __attribute__((address_space(1)))
#define LAS __attribute__((address_space(3)))
typedef unsigned short bf16;
typedef unsigned v4u __attribute__((ext_vector_type(4)));
typedef unsigned v2u __attribute__((ext_vector_type(2)));
typedef float f32x4 __attribute__((ext_vector_type(4)));
typedef float f32x2 __attribute__((ext_vector_type(2)));
typedef float f32x16 __attribute__((ext_vector_type(16)));
typedef short bf16x8 __attribute__((ext_vector_type(8)));
typedef short s16x4 __attribute__((ext_vector_type(4)));
#define LDS_WAIT() asm volatile("s_waitcnt lgkmcnt(0)" ::: "memory")
#define VM_WAIT() asm volatile("s_waitcnt vmcnt(0)" ::: "memory")
__device__ __forceinline__ unsigned f2bf(float f) { unsigned u = __builtin_bit_cast(unsigned, f); return (u + 0x7fffu + ((u >> 16) & 1u)) >> 16; }
__device__ __forceinline__ unsigned pk2(float lo, float hi) { return f2bf(lo) | (f2bf(hi) << 16); }
__device__ __forceinline__ float bf2f(unsigned b) { return __builtin_bit_cast(float, b << 16); }
__device__ __forceinline__ float bfround(float f) { return bf2f(f2bf(f)); }

#ifndef FFT_HD
#define FFT_HD __host__ __device__ __forceinline__
#endif
#if defined(__clang__)
typedef float cpx __attribute__((ext_vector_type(2)));
#else
struct cpx { float x, y; };
#endif
FFT_HD cpx cmul(cpx a, cpx b) { return cpx{a.x * b.x - a.y * b.y, a.x * b.y + a.y * b.x}; }
FFT_HD cpx cmulc(cpx a, cpx b) { return cpx{a.x * b.x + a.y * b.y, a.y * b.x - a.x * b.y}; }
FFT_HD cpx cadd(cpx a, cpx b) { return cpx{a.x + b.x, a.y + b.y}; }
FFT_HD cpx csub(cpx a, cpx b) { return cpx{a.x - b.x, a.y - b.y}; }
FFT_HD int pidx(int i) { return i + (i >> 5); }
FFT_HD cpx cis_neg_rev(float rev) {
    const float x8 = rev * 8.0f; int oct = (int)x8; oct = oct > 7 ? 7 : oct; const float f = x8 - (float)oct;
    const float a = (oct & 1) ? (1.0f - f) : f, phi = a * 0.78539816339744831f, p2 = phi * phi;
    const float s = phi * (1.0f + p2 * (-1.6666666666666666e-1f + p2 * (8.3333333333333332e-3f + p2 * (-1.9841269841269841e-4f + p2 * 2.7557319223985893e-6f))));
    const float c = 1.0f + p2 * (-0.5f + p2 * (4.1666666666666664e-2f + p2 * (-1.3888888888888889e-3f + p2 * (2.4801587301587302e-5f + p2 * -2.7557319223985888e-7f))));
    const bool sw = ((oct + 1) & 2) != 0;
    float cc = sw ? s : c, ss = sw ? c : s;
    if (oct >= 2 && oct <= 5) cc = -cc;
    if (oct >= 4) ss = -ss;
    return cpx{cc, -ss};
}
FFT_HD float sin_acc(float x) { float rev = x * 0.15915494309189535f; rev -= floorf(rev); const cpx e = cis_neg_rev(rev); return -e.y; }
FFT_HD float cos_rev(float rev) { rev -= floorf(rev); return cis_neg_rev(rev).x; }
FFT_HD float sin_rev(float rev) { rev -= floorf(rev); return -cis_neg_rev(rev).y; }
FFT_HD cpx w16(int k) {
    constexpr float C1 = 0.92387953251128674f, S1 = 0.38268343236508977f, R2 = 0.70710678118654752f;
    switch (k) { case 0: return cpx{1.f, 0.f}; case 1: return cpx{C1, -S1}; case 2: return cpx{R2, -R2}; case 3: return cpx{S1, -C1};
                 case 4: return cpx{0.f, -1.f}; case 5: return cpx{-S1, -C1}; case 6: return cpx{-R2, -R2}; default: return cpx{-C1, -S1}; }
}
template <int R> FFT_HD constexpr int bitrev(int i) { int r = 0; for (int b = 1, c = R >> 1; b < R; b <<= 1, c >>= 1) if (i & b) r |= c; return r; }
template <int R> FFT_HD void dif_regs(cpx (&a)[R]) {
#pragma unroll
    for (int len = R; len >= 2; len >>= 1) { const int half = len >> 1;
#pragma unroll
        for (int b0 = 0; b0 < R; b0 += len)
#pragma unroll
            for (int j = 0; j < half; ++j) { const cpx u = a[b0 + j], v = a[b0 + j + half]; a[b0 + j] = cadd(u, v); const cpx d = csub(u, v); a[b0 + j + half] = (j == 0) ? d : cmul(d, w16(j * (16 / len))); } }
}
template <int R> FFT_HD void dit_regs(cpx (&a)[R]) {
#pragma unroll
    for (int len = 2; len <= R; len <<= 1) { const int half = len >> 1;
#pragma unroll
        for (int b0 = 0; b0 < R; b0 += len)
#pragma unroll
            for (int j = 0; j < half; ++j) { const cpx u = a[b0 + j]; const cpx v = (j == 0) ? a[b0 + j + half] : cmulc(a[b0 + j + half], w16(j * (16 / len))); a[b0 + j] = cadd(u, v); a[b0 + j + half] = csub(u, v); } }
}
template <int R> FFT_HD void twiddle_powers(cpx w1, cpx (&pw)[R]) {
    pw[0] = cpx{1.f, 0.f}; pw[1] = w1; pw[2] = cmul(w1, w1); pw[3] = cmul(pw[2], w1);
    if constexpr (R > 4) { pw[4] = cmul(pw[2], pw[2]); pw[5] = cmul(pw[4], pw[1]); pw[6] = cmul(pw[4], pw[2]); pw[7] = cmul(pw[4], pw[3]); }
    if constexpr (R > 8) { pw[8] = cmul(pw[4], pw[4]);
#pragma unroll
        for (int k = 1; k < 8; ++k) pw[8 + k] = cmul(pw[8], pw[k]); }
}
template <int R, bool INV, class P> FFT_HD void fft_pass(P X, int tid, int nthr, int logM) {
    constexpr int LOGR = (R == 16) ? 4 : 2;
    const int logs = logM - LOGR, s = 1 << logs;
#pragma unroll 1
    for (int blk = tid; blk < 16384 / R; blk += nthr) {
        const int base = blk & (s - 1), idx0 = ((blk >> logs) << logM) + base;
        cpx a[R], pw[R];
        if (logs > 0) twiddle_powers<R>(cis_neg_rev((float)base / (float)(1 << logM)), pw);
        if (!INV) {
#pragma unroll
            for (int j = 0; j < R; ++j) a[j] = X[pidx(idx0 + (j << logs))];
            dif_regs<R>(a);
#pragma unroll
            for (int i = 0; i < R; ++i) { const int k1 = bitrev<R>(i); cpx v = a[i]; if (logs > 0 && k1 != 0) v = cmul(v, pw[k1]); X[pidx(idx0 + (k1 << logs))] = v; }
        } else {
#pragma unroll
            for (int i = 0; i < R; ++i) { const int k1 = bitrev<R>(i); cpx v = X[pidx(idx0 + (k1 << logs))]; if (logs > 0 && k1 != 0) v = cmulc(v, pw[k1]); a[i] = v; }
            dit_regs<R>(a);
#pragma unroll
            for (int j = 0; j < R; ++j) X[pidx(idx0 + (j << logs))] = a[j];
        }
    }
}
struct Frame {
    LAS unsigned char* lds;
    int tid, lane, wave;
    int vcu, G, bx;
    unsigned char* ws; float* z;
};
__device__ __forceinline__ Frame make_frame(unsigned char* lds_generic, unsigned char* ws, float* out, int wave0) {
    Frame F;
    int lane; asm volatile("v_mbcnt_lo_u32_b32 %0, -1, 0\n\tv_mbcnt_hi_u32_b32 %0, -1, %0" : "=v"(lane));
    int bx = blockIdx.x, G = gridDim.x;
    asm volatile("" : "+v"(lane)); asm volatile("" : "+s"(bx)); asm volatile("" : "+s"(G)); asm volatile("" : "+s"(wave0));
    const int tid = wave0 * 64 + lane;
    unsigned long long w = (unsigned long long)ws, o = (unsigned long long)out; asm volatile("" : "+s"(w)); asm volatile("" : "+s"(o));
    F.lds = (LAS unsigned char*)lds_generic;
    F.tid = tid; F.lane = lane; F.wave = wave0;
    F.G = G; F.bx = bx; F.vcu = (G % 8 == 0) ? (bx % 8) * (G / 8) + bx / 8 : bx;
    F.ws = (unsigned char*)(GAS unsigned char*)w; F.z = (float*)(GAS float*)o;
    return F;
}
__device__ __forceinline__ const float* inp(const Frame& F, int i) {
    const LAS unsigned* t = (const LAS unsigned*)(F.lds + PTR_OFF) + 2 * i;
    const unsigned lo = __builtin_amdgcn_readfirstlane(t[0]), hi = __builtin_amdgcn_readfirstlane(t[1]);
    return (const float*)(const GAS float*)(((unsigned long long)hi << 32) | lo);
}
__device__ __forceinline__ float wave_sum(float v) { return pg8::wave_sum64(v); }
__device__ __forceinline__ void block_sum2(Frame& F, float& a, float& b) {
    LAS float* scr = (LAS float*)(F.lds + SCR_OFF);
    a = wave_sum(a); b = wave_sum(b);
    __syncthreads();
    if (F.lane == 0) { scr[F.wave * 2] = a; scr[F.wave * 2 + 1] = b; }
    __syncthreads();
    float sa = 0.f, sb = 0.f;
#pragma unroll
    for (int w = 0; w < NWAVES; ++w) { sa += scr[w * 2]; sb += scr[w * 2 + 1]; }
    a = sa; b = sb;
}

__device__ __forceinline__ void phase_init(Frame& F) {
    const int gw = F.vcu * NWAVES + F.wave, NGW = F.G * NWAVES;
    bf16* zb = (bf16*)(F.ws + WS_ZB); float* stats = (float*)(F.ws + WS_STATS);
    const float* x0 = inp(F, 0); const float* x1 = inp(F, 1);
    for (int m = gw; m < T; m += NGW) {
        const float* src = (m < T_PROMPT) ? x0 + (size_t)m * D : x1 + (size_t)(m - T_PROMPT) * D;
        const GAS f32x4* s4 = (const GAS f32x4*)src + F.lane; GAS f32x4* d4 = (GAS f32x4*)(F.z + (size_t)m * D) + F.lane; GAS v2u* b4 = (GAS v2u*)(zb + (size_t)m * D) + F.lane;
#pragma unroll
        for (int j = 0; j < 8; ++j) { const f32x4 v = s4[64 * j]; d4[64 * j] = v; v2u o; o.x = pk2(v.x, v.y); o.y = pk2(v.z, v.w); b4[64 * j] = o; }
        if (F.lane == 0) { stats[2 * m] = 0.f; stats[2 * m + 1] = 1.f; }
    }
    const int gt = F.vcu * (NWAVES * 64) + F.tid;
    if (gt < 8192) ((float*)(F.ws + WS_IDG))[gt] = 1.f;
    if (gt < 32768) ((float*)(F.ws + WS_IDB))[gt] = 0.f;
}

struct ConvJob { const float* W; int K, N; bf16* WT; const float* gk; const float* bk; float* cvec; float* dvec; const float* ebias; int mode; };
__device__ __forceinline__ void conv_item(const float* W, int K, int N, bf16* WT, const float* gk, const float* bk, float* cvec, float* dvec, const float* ebias, int mode, int nb, LAS float* scr, int lane) {
    const int n0 = 32 * nb, n = lane & 31, kh = lane >> 5;
    const float colscale = (mode == 2 && n0 < 6144) ? QSCALE : 1.0f;
    int rbase = n0;
    if (mode == 1) { rbase = (n0 < FF) ? (n0 / 128) * 256 + (n0 % 128) : ((n0 - FF) / 128) * 256 + 128 + ((n0 - FF) % 128); }
    float csum = 0.f, dsum = 0.f;
    for (int k0 = 0; k0 < K; k0 += 64) {
#pragma unroll 8
        for (int i = 0; i < 32; ++i) { const int kk = 2 * i + kh; const float w = W[(size_t)(k0 + kk) * N + n0 + n] * colscale;
            const float v = bfround(w * gk[k0 + kk]); scr[kk * 33 + n] = v; csum += v; dsum += bk[k0 + kk] * w; }
        LDS_WAIT(); asm volatile("" ::: "memory");
        const int c = lane & 7;
#pragma unroll
        for (int j = 0; j < 4; ++j) { const int nn = (lane >> 3) + 8 * j; const LAS float* s = scr + (8 * c) * 33 + nn;
            v4u o; o.x = pk2(s[0 * 33], s[1 * 33]); o.y = pk2(s[2 * 33], s[3 * 33]); o.z = pk2(s[4 * 33], s[5 * 33]); o.w = pk2(s[6 * 33], s[7 * 33]);
            *(GAS v4u*)(WT + (size_t)(rbase + nn) * K + k0 + 8 * c) = o; }
        LDS_WAIT(); asm volatile("" ::: "memory");
    }
    csum = pg8::xor32_sum(csum); dsum = pg8::xor32_sum(dsum);
    if (lane < 32) { cvec[rbase + n] = csum; dvec[rbase + n] = dsum + ebias[n0 + n]; }
}
__device__ __forceinline__ void filt_pos(Frame& F, int jl, int var, int t) {
    const int L = var ? 2048 : 8192, lane = F.lane;
    const float* w1 = inp(F, 12) + (size_t)jl * 33 * 64; const float* b1 = inp(F, 13) + jl * 64; const float* w2 = inp(F, 14) + (size_t)jl * 64 * 64; const float* b2 = inp(F, 15) + jl * 64; const float* fr = inp(F, 16) + jl * 64;
    float feat = 0.f;
    if (lane == 0) feat = (float)t / (float)(L - 1);
    else if (lane < 33) { const int bi = (lane - 1) & 15; const float band = 1e-4f + (float)bi * ((15.0f - 1e-4f) / 15.0f); const float rev = band * ((float)t / (float)L);
        feat = (lane < 17) ? cos_rev(rev) : -sin_rev(rev); }
    float acc = b1[lane];
    for (int k = 0; k < 33; ++k) acc += __builtin_bit_cast(float, __builtin_amdgcn_readlane(__builtin_bit_cast(int, feat), k)) * w1[k * 64 + lane];
    const float fq = fr[lane];
    const float h1 = sin_acc(fq * acc);
    float acc2 = b2[lane];
    for (int k = 0; k < 64; ++k) acc2 += __builtin_bit_cast(float, __builtin_amdgcn_readlane(__builtin_bit_cast(int, h1), k)) * w2[k * 64 + lane];
    const float h2 = sin_acc(fq * acc2);
    bf16* hrow = (bf16*)(F.ws + WS_H2B) + (size_t)((var ? 8192 : 0) + t) * 256;
    hrow[lane] = (bf16)f2bf(h2); hrow[64 + lane] = 0; hrow[128 + lane] = 0; hrow[192 + lane] = 0;
}
__device__ __forceinline__ void phase_convert(Frame& F, int layer) {
    LAS float* scr = (LAS float*)(F.lds + RING_OFF + F.wave * 16384);
    const int gw = F.vcu * NWAVES + F.wave, NGW = F.G * NWAVES;
    const int jl = layer >> 1; const bool hy = (layer & 1) != 0;
    const float* ln_g = inp(F, 2); const float* ln_b = inp(F, 3);
    const float* ones = (const float*)(F.ws + WS_IDG); const float* zeros = (const float*)(F.ws + WS_IDB); float* dump = (float*)(F.ws + WS_DUMP);
    float* cd = (float*)(F.ws + WS_CD);
    float* c1 = cd, *d1 = cd + NFF2, *cm = cd + 2 * NFF2, *dm = cm + NQKV, *c2 = dm + NQKV, *d2 = c2 + NFF2;
    const int nb1 = D / 32, nb0 = NFF2 / 32, nb4 = (hy ? NHY : NQKV) / 32, nb5 = D / 32;
    const int total = 2 * nb1 + 2 * nb0 + nb4 + nb5;
    for (int it = gw; it < total; it += NGW) {
        int r = it;
        if (r < 2 * nb1) { const int f = r / nb1; r -= f * nb1;
            conv_item(inp(F, 5) + (size_t)(layer * 2 + f) * FF * D, FF, D, (bf16*)(F.ws + (f ? W_OUT2 : W_OUT1)), ones, zeros, dump, dump + NQKV, zeros, 0, r, scr, F.lane); continue; }
        r -= 2 * nb1;
        if (r < 2 * nb0) { const int f = r / nb0; r -= f * nb0;
            const float* gk = f ? ln_g + (size_t)(layer * 3 + 1) * D : (layer ? ln_g + (size_t)((layer - 1) * 3 + 2) * D : ones);
            const float* bk = f ? ln_b + (size_t)(layer * 3 + 1) * D : (layer ? ln_b + (size_t)((layer - 1) * 3 + 2) * D : zeros);
            conv_item(inp(F, 4) + (size_t)(layer * 2 + f) * D * NFF2, D, NFF2, (bf16*)(F.ws + (f ? W_IN2 : W_IN1)), gk, bk, f ? c2 : c1, f ? d2 : d1, zeros, 1, r, scr, F.lane); continue; }
        r -= 2 * nb0;
        if (r < nb4) {
            const float* gk = ln_g + (size_t)(layer * 3) * D; const float* bk = ln_b + (size_t)(layer * 3) * D;
            if (hy) conv_item(inp(F, 8) + (size_t)jl * D * NHY, D, NHY, (bf16*)(F.ws + W_MIN), gk, bk, cm, dm, inp(F, 9) + (size_t)jl * NHY, 0, r, scr, F.lane);
            else conv_item(inp(F, 6) + (size_t)jl * D * NQKV, D, NQKV, (bf16*)(F.ws + W_MIN), gk, bk, cm, dm, zeros, 2, r, scr, F.lane);
            continue; }
        r -= nb4;
        conv_item((hy ? inp(F, 19) : inp(F, 7)) + (size_t)jl * D * D, D, D, (bf16*)(F.ws + W_MOUT), ones, zeros, dump, dump + NQKV, zeros, 0, r, scr, F.lane);
    }
    if (hy) {
        for (int p = gw; p < 8192 + 2048; p += NGW) { if (p < 8192) filt_pos(F, jl, 0, p); else filt_pos(F, jl, 1, p - 8192); }
        const float* w3 = inp(F, 17) + (size_t)jl * 64 * 8192; bf16* w3T = (bf16*)(F.ws + WS_W3T);
        for (int n = gw; n < 8192; n += NGW) { bf16* r = w3T + (size_t)n * 256; r[F.lane] = (bf16)f2bf(w3[(size_t)F.lane * 8192 + n]); r[64 + F.lane] = 0; r[128 + F.lane] = 0; r[192 + F.lane] = 0; }
    }
}

__device__ __forceinline__ void phase_finalize(Frame& F) {
    const float* part = (const float*)(F.ws + WS_PART); float* stats = (float*)(F.ws + WS_STATS);
    for (int row = F.vcu * (NWAVES * 64) + F.tid; row < T; row += F.G * NWAVES * 64) {
        const GAS f32x4* p = (const GAS f32x4*)(part + (size_t)row * 128);
        float s = 0.f, q = 0.f;
#pragma unroll 8
        for (int j = 0; j < 32; ++j) { const f32x4 v = p[j]; s += v.x + v.z; q += v.y + v.w; }
        const float mean = s * (1.0f / D); const float var = fmaxf(q * (1.0f / D) - mean * mean, 0.f);
        *(GAS f32x2*)(stats + 2 * (size_t)row) = (f32x2){mean, 1.0f / sqrtf(var + LN_EPS)};
    }
}

#ifdef DBG_CHECK
__device__ __forceinline__ void phase_check_qkv(Frame& F) {
    const int gw = F.vcu * NWAVES + F.wave, NGW = F.G * NWAVES;
    const float* W = inp(F, 6); const float* g = inp(F, 2); const float* b = inp(F, 3);
    const float* stats = (const float*)(F.ws + WS_STATS); const bf16* QKV = (const bf16*)(F.ws + WS_BIG + BIG_QKV);
#ifndef DBG_ROW0
#define DBG_ROW0 0
#define DBG_ROW1 T
#endif
#ifndef DBG_COL0
#define DBG_COL0 0
#define DBG_COL1 NQKV
#endif
    float worst = 0.f; unsigned nbad = 0;
#ifdef CHK_ROWS
    {
        const bf16* zbp = (const bf16*)(F.ws + WS_ZB);
        for (int s = gw; s < 8192; s += NGW) {
            const unsigned hsh = (unsigned)s * 2654435761u; const int row = (int)(hsh % (unsigned)T);
            float sm = 0.f, sq = 0.f, dz = 0.f;
            for (int k = F.lane; k < D; k += 64) { const float v = F.z[(size_t)row * D + k]; sm += v; sq += v * v; dz = fmaxf(dz, fabsf(bf2f(zbp[(size_t)row * D + k]) - v)); }
            sm = wave_sum(sm); sq = wave_sum(sq); dz = fmaxf(dz, pg8::xor32_max(dz)); dz = fmaxf(dz, pg8::swz_xor<16>(dz)); dz = fmaxf(dz, pg8::swz_xor<8>(dz)); dz = fmaxf(dz, pg8::swz_xor<4>(dz)); dz = fmaxf(dz, pg8::swz_xor<2>(dz)); dz = fmaxf(dz, pg8::swz_xor<1>(dz));
            const float mean = sm * (1.0f / D), var = sq * (1.0f / D) - mean * mean, rstd = 1.0f / sqrtf(var + LN_EPS);
            const bool bad = (CHK_ROWS == 1) ? (fabsf(mean - stats[2 * row]) > CHK_MTOL || fabsf(rstd - stats[2 * row + 1]) > CHK_RTOL * rstd) : (dz > 0.05f);
            nbad += bad ? 1u : 0u;
        }
        if (F.lane == 0 && nbad) atomicAdd((unsigned*)(F.ws + WS_CTL) + 15000, nbad);
        return;
    }
#endif
    for (int s = gw; s < 8192; s += NGW) {
        const unsigned hsh = (unsigned)s * 2654435761u; const int row = DBG_ROW0 + (int)(hsh % (unsigned)(DBG_ROW1 - DBG_ROW0)), col = DBG_COL0 + (int)((hsh >> 7) % (unsigned)(DBG_COL1 - DBG_COL0));
#ifdef CHK_HYP
        const float mean = 0.f, rstd = 1.f;
#else
        const float mean = stats[2 * row], rstd = stats[2 * row + 1];
#endif
        float acc = 0.f;
        for (int k = F.lane; k < D; k += 64) acc += ((F.z[(size_t)row * D + k] - mean) * rstd * g[k] + b[k]) * W[(size_t)k * NQKV + col];
        acc = wave_sum(acc) * (col < 6144 ? QSCALE : 1.0f);
        const float got = bf2f(QKV[(size_t)row * NQKV + col]);
        worst = fmaxf(worst, fabsf(got - acc)); nbad += (fabsf(got - acc) > DBG_THR) ? 1u : 0u;
    }
#ifdef DBG_COUNT
    if (F.lane == 0 && nbad) atomicAdd((unsigned*)(F.ws + WS_CTL) + 15000, nbad);
#else
    if (F.lane == 0) atomicMax((unsigned*)(F.ws + WS_CTL) + 15000, __builtin_bit_cast(unsigned, worst));
#endif
}
#endif
__device__ __forceinline__ void phase_final_ln(Frame& F) {
    const int gw = F.vcu * NWAVES + F.wave, NGW = F.G * NWAVES;
    const float* stats = (const float*)(F.ws + WS_STATS);
    const float* g = inp(F, 2) + (size_t)(3 * 3 + 2) * D; const float* b = inp(F, 3) + (size_t)(3 * 3 + 2) * D;
    for (int m = gw; m < T; m += NGW) {
        const float mean = stats[2 * m], rstd = stats[2 * m + 1];
        GAS f32x4* d4 = (GAS f32x4*)(F.z + (size_t)m * D) + F.lane; const GAS f32x4* g4 = (const GAS f32x4*)g + F.lane; const GAS f32x4* b4 = (const GAS f32x4*)b + F.lane;
        float dbg = 0.f;
#ifdef DBG_CHECK
        #ifdef DBG_COUNT
        const float dbgval = (float)((const unsigned*)(F.ws + WS_CTL))[15000] * DBG_CHECK_SCALE;
#else
        const float dbgval = __builtin_bit_cast(float, ((const unsigned*)(F.ws + WS_CTL))[15000]) * DBG_CHECK_SCALE;
#endif
#endif
#ifdef DBG_BUF
        {
            const bf16* bp = (const bf16*)(F.ws + WS_BIG + DBG_OFF) + (size_t)m * DBG_PITCH; float s = 0.f;
            for (int c = F.lane; c < DBG_COLS; c += 64) s += bf2f(bp[c]) * (float)(1 + (c & 7));
            dbg = wave_sum(s) * 0.01f;
        }
#endif
#pragma unroll
        for (int j = 0; j < 8; ++j) { const f32x4 v = d4[64 * j] + dbg; d4[64 * j] = (v - mean) * rstd * g4[64 * j] + b4[64 * j];
#ifdef DBG_CHECK
            d4[64 * j] = (f32x4){dbgval, dbgval, dbgval, dbgval};
#endif
        }
    }
}

__device__ __forceinline__ void transpose_tile(const bf16* src, size_t sp, bf16* dst, size_t dp, int r0, int c0, LAS unsigned char* scr, int lane) {
#pragma unroll
    for (int i = 0; i < 8; ++i) { const int row = (lane >> 3) + 8 * i, ch = lane & 7;
        const v4u v = *(const GAS v4u*)(src + (size_t)(r0 + row) * sp + c0 + 8 * ch);
        LAS unsigned* w = (LAS unsigned*)(scr + row * 132 + ch * 16); w[0] = v.x; w[1] = v.y; w[2] = v.z; w[3] = v.w; }
    LDS_WAIT(); asm volatile("" ::: "memory");
    const LAS unsigned short* rd = (const LAS unsigned short*)(scr + lane * 132);
#pragma unroll 8
    for (int c = 0; c < 64; ++c) dst[(size_t)(c0 + c) * dp + r0 + lane] = rd[c];
    LDS_WAIT(); asm volatile("" ::: "memory");
}
__device__ __forceinline__ void phase_transpose(Frame& F, const bf16* src, int R, int C, bf16* dst) {
    LAS unsigned char* scr = F.lds + RING_OFF + F.wave * 16384;
    const int gw = F.vcu * NWAVES + F.wave, NGW = F.G * NWAVES, tr = R / 64, tc = C / 64;
    for (int it = gw; it < tr * tc; it += NGW) { const int a = it / tc, b = it % tc; transpose_tile(src, (size_t)C, dst, (size_t)R, 64 * a, 64 * b, scr, F.lane); }
}
__device__ __forceinline__ void fft_forward(LAS cpx* X, int tid, int logN) {
    int logM = logN;
    for (; logM >= 4; logM -= 4) { fft_pass<16, false>(X, tid, NWAVES * 64, logM); __syncthreads(); }
    if (logM == 2) { fft_pass<4, false>(X, tid, NWAVES * 64, 2); __syncthreads(); }
}
__device__ __forceinline__ void fft_inverse(LAS cpx* X, int tid, int logN) {
    const int rem = logN & 3;
    if (rem == 2) { fft_pass<4, true>(X, tid, NWAVES * 64, 2); __syncthreads(); }
    for (int logM = 4 + rem; logM <= logN; logM += 4) { fft_pass<16, true>(X, tid, NWAVES * 64, logM); __syncthreads(); }
}
template <int VAR> __device__ __forceinline__ void spec_unit(Frame& F, int jl, int c) {
    constexpr int L = VAR ? 2048 : 8192, N = 2 * L, LOGN = VAR ? 12 : 14, NP = L / 512;
    LAS cpx* X = (LAS cpx*)(F.lds + RING_OFF);
    int tid = F.tid; asm volatile("" : "+v"(tid));
    const float* taps = (const float*)(F.ws + WS_TAPS) + (size_t)c * 10240 + (VAR ? 8192 : 0);
    float acc[NP][4];
    float n0 = 0.f, n1 = 0.f;
#pragma unroll
    for (int k = 0; k < NP; ++k) {
#pragma unroll
        for (int f = 0; f < 4; ++f) acc[k][f] = taps[(size_t)f * 2048 * 10240 + tid + 512 * k];
        n0 += fabsf(acc[k][0]) + fabsf(acc[k][1]); n1 += fabsf(acc[k][2]) + fabsf(acc[k][3]); }
    block_sum2(F, n0, n1);
    const float i0 = 1.0f / n0, i1 = 1.0f / n1;
#pragma unroll
    for (int k = 0; k < NP; ++k) { acc[k][0] *= i0; acc[k][1] *= i0; acc[k][2] *= i1; acc[k][3] *= i1; }
    cpx* spec = (cpx*)(F.ws + WS_BIG + (VAR ? BIG_SPEC1 : BIG_SPEC0));
    if (VAR == 0) {
        float* tmp = (float*)(spec + ((size_t)1 * D + c) * N);
#pragma unroll
        for (int k = 0; k < NP; ++k) *(GAS f32x2*)(tmp + 2 * (tid + 512 * k)) = (f32x2){acc[k][2], acc[k][3]};
        __syncthreads();
#pragma unroll
        for (int k = 0; k < NP; ++k) { const int t = tid + 512 * k; const float hf = acc[k][0], hb = acc[k][1];
            if (t == 0) { X[pidx(0)] = cpx{hf + hb, 0.f}; X[pidx(L)] = cpx{0.f, 0.f}; }
            else { X[pidx(t)] = cpx{hf, 0.f}; X[pidx(N - t)] = cpx{hb, 0.f}; } }
        __syncthreads();
        fft_forward(X, tid, LOGN);
        { cpx* dst = spec + ((size_t)0 * D + c) * N; for (int p = tid; p < N; p += 512) dst[p] = X[pidx(p)]; }
        float h1[NP][2];
#pragma unroll
        for (int k = 0; k < NP; ++k) { const f32x2 v = *(const GAS f32x2*)(tmp + 2 * (tid + 512 * k)); h1[k][0] = v.x; h1[k][1] = v.y; }
        __syncthreads();
#pragma unroll
        for (int k = 0; k < NP; ++k) { const int t = tid + 512 * k; const float hf = h1[k][0], hb = h1[k][1];
            if (t == 0) { X[pidx(0)] = cpx{hf + hb, 0.f}; X[pidx(L)] = cpx{0.f, 0.f}; }
            else { X[pidx(t)] = cpx{hf, 0.f}; X[pidx(N - t)] = cpx{hb, 0.f}; } }
        __syncthreads();
        fft_forward(X, tid, LOGN);
        { cpx* dst = spec + ((size_t)1 * D + c) * N; for (int p = tid; p < N; p += 512) dst[p] = X[pidx(p)]; }
    } else {
        __syncthreads();
#pragma unroll
        for (int k = 0; k < NP; ++k) { const int t = tid + 512 * k;
#pragma unroll
            for (int o = 0; o < 2; ++o) { const float hf = acc[k][2 * o], hb = acc[k][2 * o + 1];
                if (t == 0) { X[pidx(o * N)] = cpx{hf + hb, 0.f}; X[pidx(o * N + L)] = cpx{0.f, 0.f}; }
                else { X[pidx(o * N + t)] = cpx{hf, 0.f}; X[pidx(o * N + N - t)] = cpx{hb, 0.f}; } } }
        for (int p = 2 * N + tid; p < 16384; p += 512) X[pidx(p)] = cpx{0.f, 0.f};
        __syncthreads();
        fft_forward(X, tid, LOGN);
#pragma unroll
        for (int o = 0; o < 2; ++o) { cpx* dst = spec + ((size_t)o * D + c) * N; for (int p = tid; p < N; p += 512) dst[p] = X[pidx(o * N + p)]; }
    }
}
__device__ __forceinline__ void phase_spectra(Frame& F, int jl) {
    for (int u = F.vcu; u < 2 * D; u += F.G) { if (u < D) spec_unit<0>(F, jl, u); else spec_unit<1>(F, jl, u - D); }
    __syncthreads();
}
__device__ __forceinline__ void load_conv16(const bf16* seq, int t0, int L, float w0, float w1, float w2, float cb, float (&out)[16]) {
    const v4u a = *(const GAS v4u*)(seq + t0), b = *(const GAS v4u*)(seq + t0 + 8);
    float u[18];
    u[0] = (t0 > 0) ? bf2f(seq[t0 - 1]) : 0.f; u[17] = (t0 + 16 < L) ? bf2f(seq[t0 + 16]) : 0.f;
    u[1] = bf2f(a.x & 0xffffu); u[2] = bf2f(a.x >> 16); u[3] = bf2f(a.y & 0xffffu); u[4] = bf2f(a.y >> 16); u[5] = bf2f(a.z & 0xffffu); u[6] = bf2f(a.z >> 16); u[7] = bf2f(a.w & 0xffffu); u[8] = bf2f(a.w >> 16);
    u[9] = bf2f(b.x & 0xffffu); u[10] = bf2f(b.x >> 16); u[11] = bf2f(b.y & 0xffffu); u[12] = bf2f(b.y >> 16); u[13] = bf2f(b.z & 0xffffu); u[14] = bf2f(b.z >> 16); u[15] = bf2f(b.w & 0xffffu); u[16] = bf2f(b.w >> 16);
#pragma unroll
    for (int i = 0; i < 16; ++i) out[i] = w0 * u[i] + w1 * u[i + 1] + w2 * u[i + 2] + cb;
}
template <int VAR> __device__ __forceinline__ void conv_unit(Frame& F, int jl, int c, int pair) {
    constexpr int L = VAR ? 2048 : 8192, N = 2 * L, LOGN = VAR ? 12 : 14, TPS = VAR ? 128 : 512;
    LAS cpx* X = (LAS cpx*)(F.lds + RING_OFF);
    int tid = F.tid; asm volatile("" : "+v"(tid));
    const int seg = tid / TPS, t0 = (tid % TPS) * 16;
    const int rowA = VAR ? T_PROMPT + (2 * seg) * L : (2 * pair) * L, rowB = rowA + L;
    const bf16* UT = (const bf16*)(F.ws + WS_BIG + BIG_UT); bf16* Z2T = (bf16*)(F.ws + WS_BIG + BIG_Z2T);
    const float* cw = inp(F, 10) + (size_t)jl * 3 * NHY; const float* cbv = inp(F, 11) + (size_t)jl * NHY; const float* skip = inp(F, 18) + (size_t)jl * 2 * D;
    const cpx* spec = (const cpx*)(F.ws + WS_BIG + (VAR ? BIG_SPEC1 : BIG_SPEC0));
#ifndef CONV_SCALE
#define CONV_SCALE 1.0f
#endif
    const float invN = CONV_SCALE / (float)N;
    float va[16], vb[16];
    { const int ch = c; const float w0 = cw[ch], w1 = cw[NHY + ch], w2 = cw[2 * NHY + ch], cb = cbv[ch];
      load_conv16(UT + (size_t)ch * T + rowA, t0, L, w0, w1, w2, cb, va); load_conv16(UT + (size_t)ch * T + rowB, t0, L, w0, w1, w2, cb, vb); }
    __syncthreads();
#pragma unroll
    for (int i = 0; i < 16; ++i) { X[pidx(seg * N + t0 + i)] = cpx{va[i], vb[i]}; X[pidx(seg * N + L + t0 + i)] = cpx{0.f, 0.f}; }
    __syncthreads();
    fft_forward(X, tid, LOGN);
    { const cpx* H = spec + ((size_t)0 * D + c) * N; for (int p = tid; p < 16384; p += 512) X[pidx(p)] = cmul(X[pidx(p)], H[p & (N - 1)]); }
    __syncthreads();
    fft_inverse(X, tid, LOGN);
    {   float ga[16], gb[16];
        const int ch = D + c; const float w0 = cw[ch], w1 = cw[NHY + ch], w2 = cw[2 * NHY + ch], cb = cbv[ch];
        load_conv16(UT + (size_t)ch * T + rowA, t0, L, w0, w1, w2, cb, ga); load_conv16(UT + (size_t)ch * T + rowB, t0, L, w0, w1, w2, cb, gb);
        const float sk = skip[c];
#pragma unroll
        for (int i = 0; i < 16; ++i) { const cpx y = X[pidx(seg * N + t0 + i)]; va[i] = ga[i] * (y.x * invN + sk * va[i]); vb[i] = gb[i] * (y.y * invN + sk * vb[i]); }
#pragma unroll
        for (int i = 0; i < 16; ++i) { X[pidx(seg * N + t0 + i)] = cpx{va[i], vb[i]}; X[pidx(seg * N + L + t0 + i)] = cpx{0.f, 0.f}; }
    }
    __syncthreads();
    fft_forward(X, tid, LOGN);
    { const cpx* H = spec + ((size_t)1 * D + c) * N; for (int p = tid; p < 16384; p += 512) X[pidx(p)] = cmul(X[pidx(p)], H[p & (N - 1)]); }
    __syncthreads();
    fft_inverse(X, tid, LOGN);
    {   float ga[16], gb[16];
        const int ch = 2 * D + c; const float w0 = cw[ch], w1 = cw[NHY + ch], w2 = cw[2 * NHY + ch], cb = cbv[ch];
        load_conv16(UT + (size_t)ch * T + rowA, t0, L, w0, w1, w2, cb, ga); load_conv16(UT + (size_t)ch * T + rowB, t0, L, w0, w1, w2, cb, gb);
        const float sk = skip[D + c];
        float ra[16], rb[16];
#pragma unroll
        for (int i = 0; i < 16; ++i) { const cpx y = X[pidx(seg * N + t0 + i)]; ra[i] = ga[i] * (y.x * invN + sk * va[i]); rb[i] = gb[i] * (y.y * invN + sk * vb[i]); }
        v4u o0, o1;
        o0.x = pk2(ra[0], ra[1]); o0.y = pk2(ra[2], ra[3]); o0.z = pk2(ra[4], ra[5]); o0.w = pk2(ra[6], ra[7]); o1.x = pk2(ra[8], ra[9]); o1.y = pk2(ra[10], ra[11]); o1.z = pk2(ra[12], ra[13]); o1.w = pk2(ra[14], ra[15]);
        GAS v4u* da = (GAS v4u*)(Z2T + (size_t)c * T + rowA + t0); da[0] = o0; da[1] = o1;
        o0.x = pk2(rb[0], rb[1]); o0.y = pk2(rb[2], rb[3]); o0.z = pk2(rb[4], rb[5]); o0.w = pk2(rb[6], rb[7]); o1.x = pk2(rb[8], rb[9]); o1.y = pk2(rb[10], rb[11]); o1.z = pk2(rb[12], rb[13]); o1.w = pk2(rb[14], rb[15]);
        GAS v4u* db = (GAS v4u*)(Z2T + (size_t)c * T + rowB + t0); db[0] = o0; db[1] = o1;
    }
}
__device__ __forceinline__ void phase_conv(Frame& F, int jl) {
    for (int u = F.vcu; u < 3 * D; u += F.G) { if (u < 2 * D) conv_unit<0>(F, jl, u >> 1, u & 1); else conv_unit<1>(F, jl, u - 2 * D, 0); }
    __syncthreads();
}
__device__ __forceinline__ unsigned voff_b(unsigned row, unsigned ch) { return 256u * row + 16u * (ch ^ (((row & 3u) << 2) | ((row >> 2) & 3u))); }
__device__ __forceinline__ s16x4 vtr(const LAS unsigned char* p) { typedef short v4i16_t __attribute__((ext_vector_type(4))); return __builtin_bit_cast(s16x4, __builtin_amdgcn_ds_read_tr16_b64_v4i16((LAS v4i16_t*)p)); }
__device__ __forceinline__ unsigned cvtpk(float lo, float hi) { typedef __bf16 bf16x2_t __attribute__((ext_vector_type(2))); f32x2 v = {lo, hi}; bf16x2_t b = __builtin_convertvector(v, bf16x2_t); return __builtin_bit_cast(unsigned, b); }
__device__ __forceinline__ void dma16(const void* gsrc, LAS unsigned char* lds_dst) {
    unsigned keep; const unsigned dst = __builtin_amdgcn_readfirstlane((unsigned)(unsigned long long)lds_dst);
    asm volatile("s_mov_b32 %0, m0\n\ts_mov_b32 m0, %2\n\ts_nop 0\n\tglobal_load_lds_dwordx4 %1, off\n\ts_mov_b32 m0, %0" : "=&s"(keep) : "v"(gsrc), "s"(dst) : "memory");
}
struct TileDesc { int g, kt0; };
__device__ __forceinline__ TileDesc attn_tile(int it, int T0w) {
    TileDesc t;
    if (it < 8) { t.g = 0; t.kt0 = T0w - 64 + 32 * it; }
    else if (it < 13) { t.g = 1; t.kt0 = T0w - 256 + 128 * (it - 8); }
    else { const int e = it - 13, ch = e / 5, tl = e % 5; t.g = 2; t.kt0 = T0w + 4 * ch - 1024 + 512 * tl; }
    return t;
}
__device__ __forceinline__ void attn_wave_task(const bf16* QKV, bf16* AO, LAS unsigned char* vimg, int blk, int h, int w, int lane) {
    const int r = lane & 31, hh = lane >> 5;
    const int T0 = blk * 128;
    int seq_start, seq_len;
    if (T0 < T_PROMPT) { seq_start = T0 & ~8191; seq_len = 8192; } else { seq_start = T_PROMPT + ((T0 - T_PROMPT) & ~2047); seq_len = 2048; }
    const int seq_end = seq_start + seq_len;
    const int T0w = T0 + w, qt = T0w + 4 * r;
    const float slope2 = __builtin_amdgcn_exp2f(-0.5f * (float)(h + 1)) * LOG2E;
    f32x16 o[4];
#pragma unroll
    for (int dt = 0; dt < 4; ++dt)
#pragma unroll
        for (int i = 0; i < 16; ++i) o[dt][i] = 0.f;
    float m_run = -1e30f, l_run = 0.f;
    bf16x8 qf[8], kf[8];
    const bf16* hb = QKV + h * 128;
    auto issue_tile = [&](const TileDesc& td, LAS unsigned char* img_dst) {
        const int d = 1 << (2 * td.g);
        const bf16* Kb = hb + 6144 + td.g * 2048; const bf16* Vb = hb + 12288 + td.g * 2048;
#pragma unroll
        for (int i = 0; i < 8; ++i) { const int row = 4 * i + (lane >> 4); int vt = td.kt0 + row * d; vt = vt < seq_start ? seq_start : (vt >= seq_end ? seq_end - 1 : vt);
            const int lch = (lane & 15) ^ (((row & 3) << 2) | ((row >> 2) & 3));
            dma16(Vb + (size_t)vt * NQKV + 8 * lch, img_dst + i * 1024); }
        int kt = td.kt0 + r * d; kt = kt < seq_start ? seq_start : (kt >= seq_end ? seq_end - 1 : kt);
        const bf16* kp = Kb + (size_t)kt * NQKV + 8 * hh;
#pragma unroll
        for (int s = 0; s < 8; ++s) kf[s] = *(const GAS bf16x8*)(kp + 16 * s);
    };
    auto load_q = [&](int g) { const bf16* qp = hb + g * 2048 + (size_t)qt * NQKV + 8 * hh;
#pragma unroll
        for (int s = 0; s < 8; ++s) qf[s] = *(const GAS bf16x8*)(qp + 16 * s); };
    TileDesc cur = attn_tile(0, T0w);
    load_q(0);
    issue_tile(cur, vimg);
    for (int it = 0; it < 33; ++it) {
        LAS unsigned char* img = vimg + (it & 1) * 8192;
        const int d = 1 << (2 * cur.g), win = 64 * d, kt0 = cur.kt0;
        f32x16 st;
#pragma unroll
        for (int i = 0; i < 16; ++i) st[i] = 0.f;
#pragma unroll
        for (int s = 0; s < 8; ++s) st = __builtin_amdgcn_mfma_f32_32x32x16_bf16(kf[s], qf[s], st, 0, 0, 0);
        if (it + 1 < 33) { const TileDesc nx = attn_tile(it + 1, T0w); if (nx.g != cur.g) load_q(nx.g); issue_tile(nx, vimg + ((it + 1) & 1) * 8192); cur = nx; }
        const int dl0 = kt0 + 4 * hh * d - qt;
        const bool res_ok = (dl0 & (d - 1)) == 0;
        const int lo_i = max(-win, seq_start - qt), hi_i = min(win, seq_end - 1 - qt);
        const float flo = res_ok ? (float)lo_i : 1e30f, fhi = (float)hi_i, fdl0 = (float)dl0, fd = (float)d;
        float mloc = -1e30f;
#pragma unroll
        for (int i = 0; i < 16; ++i) { const float fdl = fdl0 + (float)((i & 3) + 8 * (i >> 2)) * fd;
            const float s = st[i] - slope2 * __builtin_fabsf(fdl);
            const bool ok = (fdl >= flo) && (fdl <= fhi);
            const float sm = ok ? s : -1e30f; st[i] = sm; mloc = fmaxf(mloc, sm); }
        mloc = pg8::xor32_max(mloc);
        const float m_new = fmaxf(m_run, mloc);
        const float m_use = fmaxf(m_new, -1e20f);
        float ls = 0.f;
#pragma unroll
        for (int i = 0; i < 16; ++i) { const float pv = __builtin_amdgcn_exp2f(st[i] - m_use); st[i] = pv; ls += pv; }
        ls = pg8::xor32_sum(ls);
        if (__any(m_new != m_run)) {
            const float alpha = __builtin_amdgcn_exp2f(m_run - m_new);
            l_run *= alpha;
#pragma unroll
            for (int dt = 0; dt < 4; ++dt)
#pragma unroll
                for (int i = 0; i < 16; ++i) o[dt][i] *= alpha;
        }
        l_run += ls; m_run = m_new;
        bf16x8 pb[2];
#pragma unroll
        for (int s2 = 0; s2 < 2; ++s2) { v4u w; w.x = cvtpk(st[8 * s2 + 0], st[8 * s2 + 1]); w.y = cvtpk(st[8 * s2 + 2], st[8 * s2 + 3]); w.z = cvtpk(st[8 * s2 + 4], st[8 * s2 + 5]); w.w = cvtpk(st[8 * s2 + 6], st[8 * s2 + 7]); pb[s2] = __builtin_bit_cast(bf16x8, w); }
        const int q4 = (lane & 15) >> 2, p4 = lane & 3, blk16 = (lane >> 4) & 1;
#pragma unroll
        for (int dt = 0; dt < 4; ++dt)
#pragma unroll
            for (int s2 = 0; s2 < 2; ++s2) {
                const unsigned chn = 4 * dt + 2 * blk16 + (p4 >> 1);
                const s16x4 lo = vtr(img + voff_b(16 * s2 + 4 * hh + q4, chn) + 8 * (p4 & 1));
                const s16x4 hi = vtr(img + voff_b(16 * s2 + 8 + 4 * hh + q4, chn) + 8 * (p4 & 1));
                const bf16x8 va = __builtin_shufflevector(lo, hi, 0, 1, 2, 3, 4, 5, 6, 7);
                o[dt] = __builtin_amdgcn_mfma_f32_32x32x16_bf16(va, pb[s2], o[dt], 0, 0, 0);
            }
    }
    const float inv = 1.0f / l_run;
    bf16* op = AO + (size_t)qt * D + h * 128 + 4 * hh;
#pragma unroll
    for (int dt = 0; dt < 4; ++dt)
#pragma unroll
        for (int i4 = 0; i4 < 4; ++i4) { v2u w; w.x = cvtpk(o[dt][4 * i4] * inv, o[dt][4 * i4 + 1] * inv); w.y = cvtpk(o[dt][4 * i4 + 2] * inv, o[dt][4 * i4 + 3] * inv);
            *(GAS v2u*)(op + 32 * dt + 8 * i4) = w; }
}
__device__ __forceinline__ void phase_attention(Frame& F) {
    const bf16* QKV = (const bf16*)(F.ws + WS_BIG + BIG_QKV); bf16* AO = (bf16*)(F.ws + WS_BIG + BIG_AO);
    LAS unsigned char* vimg = F.lds + RING_OFF + F.wave * 16384;
    for (int j = F.vcu; j < (T / 128) * 16 * 4 / NWAVES; j += F.G) {
        const int wt = j * NWAVES + F.wave, w = wt & 3, h = (wt >> 2) & 15, blk = wt >> 6;
        attn_wave_task(QKV, AO, vimg, blk, h, w, F.lane);
    }
}

#ifdef ATTN_NAIVE
__device__ __forceinline__ void phase_attention_naive(Frame& F) {
    const bf16* QKV = (const bf16*)(F.ws + WS_BIG + BIG_QKV); bf16* AO = (bf16*)(F.ws + WS_BIG + BIG_AO);
    const int gw = F.vcu * NWAVES + F.wave, NGW = F.G * NWAVES, lane = F.lane;
    for (int p = gw; p < T * 16; p += NGW) {
        const int tok = p >> 4, h = p & 15;
        int seq_start, seq_len;
        if (tok < T_PROMPT) { seq_start = tok & ~8191; seq_len = 8192; } else { seq_start = T_PROMPT + ((tok - T_PROMPT) & ~2047); seq_len = 2048; }
        const int seq_end = seq_start + seq_len;
        const float slope2 = __builtin_amdgcn_exp2f(-0.5f * (float)(h + 1)) * LOG2E;
        float m = -1e30f, l = 0.f, o0 = 0.f, o1 = 0.f;
        for (int g = 0; g < 3; ++g) {
            const int d = 1 << (2 * g);
            const unsigned qw = *(const GAS unsigned*)(QKV + (size_t)tok * NQKV + g * 2048 + h * 128 + 2 * lane);
            const float q0 = bf2f(qw & 0xffffu), q1 = bf2f(qw >> 16);
            for (int j = -64; j <= 64; ++j) {
                const int kt = tok + j * d;
                if (kt < seq_start || kt >= seq_end) continue;
                const unsigned kw = *(const GAS unsigned*)(QKV + (size_t)kt * NQKV + 6144 + g * 2048 + h * 128 + 2 * lane);
                const unsigned vw = *(const GAS unsigned*)(QKV + (size_t)kt * NQKV + 12288 + g * 2048 + h * 128 + 2 * lane);
                const float s = wave_sum(q0 * bf2f(kw & 0xffffu) + q1 * bf2f(kw >> 16)) - slope2 * (float)((j < 0 ? -j : j) * d);
                const float mn = fmaxf(m, s), al = __builtin_amdgcn_exp2f(m - mn), pv = __builtin_amdgcn_exp2f(s - mn);
                l = l * al + pv; o0 = o0 * al + pv * bf2f(vw & 0xffffu); o1 = o1 * al + pv * bf2f(vw >> 16); m = mn;
            }
        }
        const float inv = 1.0f / l;
        *(GAS unsigned*)(AO + (size_t)tok * D + h * 128 + 2 * lane) = pk2(o0 * inv, o1 * inv);
    }
}
#endif
constexpr int NPHASE = 54;
#ifndef DUP_PHASE
#define DUP_PHASE (-1)
#define DUP_N 0
#endif
#define REPS(id) for (int rep_ = 0; rep_ < ((DUP_PHASE) == (id) ? 1 + (DUP_N) : 1); ++rep_)
#ifndef ZERO_HY
#define ZERO_HY 0
#endif
#ifndef ZERO_AT
#define ZERO_AT 0
#endif
#ifndef AT_SCALE
#define AT_SCALE 1.0f
#endif
#ifndef HY_SCALE
#define HY_SCALE 1.0f
#endif
#define MIXSCALE(hy) ((hy) ? (ZERO_HY ? 0.0f : HY_SCALE) : (ZERO_AT ? 0.0f : AT_SCALE))
struct Args { const float* in[21]; float* out; unsigned char* ws; int ph_lo, ph_hi; };
static_assert(sizeof(Args) == 21 * 8 + 8 + 8 + 8, "Args has no padding");
__global__ void __launch_bounds__(NWAVES * 64, 2) fwd_kernel(Args args) {
    extern __shared__ __attribute__((aligned(16))) unsigned char lds[];
    unsigned char* const ws0 = args.ws;
    const int wave0 = __builtin_amdgcn_readfirstlane(threadIdx.x >> 6);
    volatile LAS unsigned* MISC = (volatile LAS unsigned*)((LAS unsigned char*)lds + MISC_OFF);
    if (threadIdx.x < 64) MISC[threadIdx.x] = 0u;
    if (threadIdx.x == 64) {
#pragma unroll
        for (int i = 0; i < 21; ++i) ((LAS unsigned long long*)((LAS unsigned char*)lds + PTR_OFF))[i] = (unsigned long long)args.in[i];
    }
    __syncthreads();
    XcdBarrier bar = xcd_barrier_post((unsigned*)(ws0 + WS_CTL), MISC);
#define FRAME() Frame F = make_frame(lds, args.ws, args.out, wave0)
    const int lo = args.ph_lo, hi = args.ph_hi;
#define RUN(id) (lo <= (id) && (id) < hi)
#define SEAM(id) do { if ((id) + 1 < hi) xcd_barrier(bar); } while (0)

#define ZB ((bf16*)(F.ws + WS_ZB))
#define STATS ((float*)(F.ws + WS_STATS))
#define PART ((float*)(F.ws + WS_PART))
#define CDV(off) ((float*)(F.ws + WS_CD) + (off))
#define HID ((bf16*)(F.ws + WS_BIG + BIG_HID))
    constexpr int O_C1 = 0, O_D1 = NFF2, O_CM = 2 * NFF2, O_DM = 2 * NFF2 + NQKV, O_C2 = 2 * NFF2 + 2 * NQKV, O_D2 = 3 * NFF2 + 2 * NQKV;

    if (RUN(0)) { FRAME(); phase_init(F); SEAM(0); }

#pragma unroll
    for (int layer = 0; layer < DEPTH; ++layer) {
        const int pb = 1 + 13 * layer; const bool hy = (layer & 1) != 0; const int jl = layer >> 1;
        if (RUN(pb + 0)) { FRAME(); REPS(0) phase_convert(F, layer); SEAM(pb + 0); }

        if (RUN(pb + 1)) {
            if (hy) {
                FRAME();
                pg8::Gemm gt{(const bf16*)(F.ws + WS_W3T), (const bf16*)(F.ws + WS_H2B), 8192, 10240, 256}; pg8::StaticOrder St; St.init(8192, 10240, F.G, F.bx);
                pg8::EpiTaps Et{(float*)(F.ws + WS_TAPS), MIN_DECAY, (MAX_DECAY - MIN_DECAY) / 2047.0f};
                pg8::gemm_phase<pg8::EpiTaps, pg8::StaticOrder, PG8_ALIGN, PG8_SP2>(F.lds + RING_OFF, gt, St, Et, F.tid);
            }
            FRAME();
            pg8::Gemm g{ZB, (const bf16*)(F.ws + W_IN1), T, NFF2, D}; pg8::StaticOrder S; S.init(T, NFF2, F.G, F.bx);
            pg8::EpiSwiglu E{HID, FF, STATS, CDV(O_C1), CDV(O_D1)};
            REPS(1) pg8::gemm_phase<pg8::EpiSwiglu, pg8::StaticOrder, PG8_ALIGN, PG8_SP2>(F.lds + RING_OFF, g, S, E, F.tid);
            SEAM(pb + 1);
        }
        if (RUN(pb + 2)) {
            FRAME();
            pg8::Gemm g{HID, (const bf16*)(F.ws + W_OUT1), T, D, FF}; pg8::StaticOrder S; S.init(T, D, F.G, F.bx);
            const float* g0 = layer ? inp(F, 2) + (size_t)((layer - 1) * 3 + 2) * D : (const float*)(F.ws + WS_IDG); const float* b0 = layer ? inp(F, 3) + (size_t)((layer - 1) * 3 + 2) * D : (const float*)(F.ws + WS_IDB);
            pg8::EpiResid E{F.z, ZB, STATS, g0, b0, (const float*)(F.ws + WS_IDB), PART, 0.5f, 0};
            pg8::gemm_phase<pg8::EpiResid, pg8::StaticOrder, PG8_ALIGN, PG8_SP2>(F.lds + RING_OFF, g, S, E, F.tid);
            SEAM(pb + 2);
        }
        if (RUN(pb + 3)) { FRAME(); REPS(3) phase_finalize(F); SEAM(pb + 3); }

        if (RUN(pb + 4)) {
            FRAME(); const int N = hy ? NHY : NQKV;
            pg8::Gemm g{ZB, (const bf16*)(F.ws + W_MIN), T, N, D}; pg8::StaticOrder S; S.init(T, N, F.G, F.bx);
            pg8::EpiLnBf16 E{(bf16*)(F.ws + WS_BIG), N, STATS, CDV(O_CM), CDV(O_DM)};
            REPS(4) pg8::gemm_phase<pg8::EpiLnBf16, pg8::StaticOrder, PG8_ALIGN, PG8_SP2>(F.lds + RING_OFF, g, S, E, F.tid);
            SEAM(pb + 4);
        }
        if (RUN(pb + 5)) {
            FRAME();
#ifdef ATTN_NAIVE
            if (!hy) phase_attention_naive(F);
#else
            if (!hy) { REPS(5) phase_attention(F); }
#endif
            else { REPS(15) phase_spectra(F, jl); REPS(25) phase_transpose(F, (const bf16*)(F.ws + WS_BIG + BIG_U), T, NHY, (bf16*)(F.ws + WS_BIG + BIG_UT)); }
            SEAM(pb + 5);
        }
        if (hy) {
            if (RUN(pb + 6)) { FRAME(); REPS(6) phase_conv(F, jl); SEAM(pb + 6); }
            if (RUN(pb + 7)) { FRAME(); REPS(7) phase_transpose(F, (const bf16*)(F.ws + WS_BIG + BIG_Z2T), D, T, (bf16*)(F.ws + WS_BIG + BIG_Z2)); SEAM(pb + 7); }
        }
        if (RUN(pb + 8)) {
            FRAME();
            const bf16* A = hy ? (const bf16*)(F.ws + WS_BIG + BIG_Z2) : (const bf16*)(F.ws + WS_BIG + BIG_AO);
            pg8::Gemm g{A, (const bf16*)(F.ws + W_MOUT), T, D, D}; pg8::StaticOrder S; S.init(T, D, F.G, F.bx);
            pg8::EpiResid E{F.z, ZB, STATS, inp(F, 2) + (size_t)(layer * 3) * D, inp(F, 3) + (size_t)(layer * 3) * D, hy ? inp(F, 20) + (size_t)jl * D : (const float*)(F.ws + WS_IDB), PART, MIXSCALE(hy), 0};
            pg8::gemm_phase<pg8::EpiResid, pg8::StaticOrder, PG8_ALIGN, PG8_SP2>(F.lds + RING_OFF, g, S, E, F.tid);
            SEAM(pb + 8);
        }
        if (RUN(pb + 9)) { FRAME(); phase_finalize(F); SEAM(pb + 9); }

        if (RUN(pb + 10)) {
            FRAME();
            pg8::Gemm g{ZB, (const bf16*)(F.ws + W_IN2), T, NFF2, D}; pg8::StaticOrder S; S.init(T, NFF2, F.G, F.bx);
            pg8::EpiSwiglu E{HID, FF, STATS, CDV(O_C2), CDV(O_D2)};
            pg8::gemm_phase<pg8::EpiSwiglu, pg8::StaticOrder, PG8_ALIGN, PG8_SP2>(F.lds + RING_OFF, g, S, E, F.tid);
            SEAM(pb + 10);
        }
        if (RUN(pb + 11)) {
            FRAME();
            pg8::Gemm g{HID, (const bf16*)(F.ws + W_OUT2), T, D, FF}; pg8::StaticOrder S; S.init(T, D, F.G, F.bx);
            pg8::EpiResid E{F.z, ZB, STATS, inp(F, 2) + (size_t)(layer * 3 + 1) * D, inp(F, 3) + (size_t)(layer * 3 + 1) * D, (const float*)(F.ws + WS_IDB), PART, 0.5f, 0};
            pg8::gemm_phase<pg8::EpiResid, pg8::StaticOrder, PG8_ALIGN, PG8_SP2>(F.lds + RING_OFF, g, S, E, F.tid);
            SEAM(pb + 11);
        }
        if (RUN(pb + 12)) { FRAME(); phase_finalize(F); SEAM(pb + 12); }
    }
#ifdef DBG_CHECK
    if (RUN(NPHASE - 2)) { FRAME(); phase_check_qkv(F); SEAM(NPHASE - 2); }
#endif
    if (RUN(NPHASE - 1)) { FRAME(); phase_final_ln(F); }
#undef RUN
#undef SEAM
#undef FRAME
}


#ifdef PHASE_PROBE
#define PROBE_FRAME() extern __shared__ __attribute__((aligned(16))) unsigned char lds[]; Frame F = make_frame(lds, args.ws, args.out, __builtin_amdgcn_readfirstlane(threadIdx.x >> 6));
__global__ void __launch_bounds__(NWAVES * 64, 2) probe_init(Args args) { PROBE_FRAME(); phase_init(F); }
__global__ void __launch_bounds__(NWAVES * 64, 2) probe_convert(Args args) { PROBE_FRAME(); phase_convert(F, args.ph_lo); }
__global__ void __launch_bounds__(NWAVES * 64, 2) probe_finalize(Args args) { PROBE_FRAME(); phase_finalize(F); phase_final_ln(F); }
__global__ void __launch_bounds__(NWAVES * 64, 2) probe_transpose(Args args) { PROBE_FRAME(); phase_transpose(F, (const bf16*)(F.ws + WS_BIG + BIG_U), T, NHY, (bf16*)(F.ws + WS_BIG + BIG_UT)); }
__global__ void __launch_bounds__(NWAVES * 64, 2) probe_spectra(Args args) { PROBE_FRAME(); phase_spectra(F, args.ph_lo); }
__global__ void __launch_bounds__(NWAVES * 64, 2) probe_conv(Args args) { PROBE_FRAME(); phase_conv(F, args.ph_lo); }
__global__ void __launch_bounds__(NWAVES * 64, 2) probe_attn(Args args) { PROBE_FRAME(); phase_attention(F); }
__global__ void __launch_bounds__(NWAVES * 64, 2) probe_gemm_swiglu(Args args) { PROBE_FRAME(); pg8::Gemm g{(const bf16*)F.ws, (const bf16*)(F.ws + W_IN1), T, NFF2, D}; pg8::StaticOrder S; S.init(T, NFF2, F.G, F.bx); pg8::EpiSwiglu E{(bf16*)(F.ws + WS_BIG), FF, (float*)(F.ws + WS_STATS), (float*)(F.ws + WS_CD), (float*)(F.ws + WS_CD)}; pg8::gemm_phase<pg8::EpiSwiglu, pg8::StaticOrder, PG8_ALIGN, PG8_SP2>(F.lds + RING_OFF, g, S, E, F.tid); }
__global__ void __launch_bounds__(NWAVES * 64, 2) probe_gemm_resid(Args args) { PROBE_FRAME(); pg8::Gemm g{(const bf16*)F.ws, (const bf16*)(F.ws + W_IN1), T, D, FF}; pg8::StaticOrder S; S.init(T, D, F.G, F.bx); pg8::EpiResid E{F.z, (bf16*)(F.ws + WS_ZB), (float*)(F.ws + WS_STATS), inp(F, 2), inp(F, 3), args.ph_lo ? inp(F, 20) : (const float*)(F.ws + WS_IDB), (float*)(F.ws + WS_PART), 0.5f, 0}; pg8::gemm_phase<pg8::EpiResid, pg8::StaticOrder, PG8_ALIGN, PG8_SP2>(F.lds + RING_OFF, g, S, E, F.tid); }
__global__ void __launch_bounds__(NWAVES * 64, 2) probe_gemm_ln(Args args) { PROBE_FRAME(); pg8::Gemm g{(const bf16*)F.ws, (const bf16*)(F.ws + W_IN1), T, NQKV, D}; pg8::StaticOrder S; S.init(T, NQKV, F.G, F.bx); pg8::EpiLnBf16 E{(bf16*)(F.ws + WS_BIG), NQKV, (float*)(F.ws + WS_STATS), (float*)(F.ws + WS_CD), (float*)(F.ws + WS_CD)}; pg8::gemm_phase<pg8::EpiLnBf16, pg8::StaticOrder, PG8_ALIGN, PG8_SP2>(F.lds + RING_OFF, g, S, E, F.tid); }
#endif
#ifndef MK_MULTI
#define MK_MULTI 0
#endif
extern "C" void kernel_launch(void* const* d_in, const int* in_sizes, int n_in, void* d_out, int out_size, void* d_ws, size_t ws_size, hipStream_t stream) {
    static int grid = 0;
    if (grid == 0) {
        if (n_in != 21 || out_size != T * D || ws_size < WS_END) { fprintf(stderr, "kernel_launch: unexpected shapes (n_in %d, out %d, ws %zu, need %zu)\n", n_in, out_size, ws_size, (size_t)WS_END); grid = -1; return; }
        int dev = 0, cus = 0, per_cu = 0;
        if (hipGetDevice(&dev) != hipSuccess || hipDeviceGetAttribute(&cus, hipDeviceAttributeMultiprocessorCount, dev) != hipSuccess) { grid = -1; return; }
        if (hipFuncSetAttribute((const void*)fwd_kernel, hipFuncAttributeMaxDynamicSharedMemorySize, LDS_BYTES) != hipSuccess) { fprintf(stderr, "kernel_launch: hipFuncSetAttribute failed\n"); grid = -1; return; }
        if (hipOccupancyMaxActiveBlocksPerMultiprocessor(&per_cu, (const void*)fwd_kernel, NWAVES * 64, LDS_BYTES) != hipSuccess || per_cu < 1) fprintf(stderr, "kernel_launch: occupancy query reports %d\n", per_cu);
        (void)hipGetLastError();
        grid = cus;
    }
    if (grid < 0) return;
    if (hipMemsetAsync((char*)d_ws + WS_CTL, 0, CTL_ZERO_BYTES, stream) != hipSuccess) return;
    Args a{};
    for (int i = 0; i < 21; ++i) a.in[i] = (const float*)d_in[i];
    a.out = (float*)d_out; a.ws = (unsigned char*)d_ws;
#ifndef STOP_AFTER
#define STOP_AFTER (NPHASE - 1)
#endif
#ifdef DBG_CHECK
#define DBGCHK_ON 1
#else
#define DBGCHK_ON 0
#endif
#if MK_MULTI
    for (int p = 0; p < NPHASE; ++p) { if (p >= STOP_AFTER && p != NPHASE - 1 && !(DBGCHK_ON && p == NPHASE - 2)) continue; a.ph_lo = p; a.ph_hi = p + 1; hipLaunchKernelGGL(fwd_kernel, dim3(grid), dim3(NWAVES * 64), LDS_BYTES, stream, a); }
#else
    a.ph_lo = 0; a.ph_hi = NPHASE;
    hipLaunchKernelGGL(fwd_kernel, dim3(grid), dim3(NWAVES * 64), LDS_BYTES, stream, a);
#endif
}
```

```cpp
#include <hip/hip_runtime.h>
#include <cstdio>
#include <cstdint>
namespace pg8 {
#define PG8_LAS __attribute__((address_space(3)))
typedef unsigned short bf16_t;
typedef short bf16x8 __attribute__((ext_vector_type(8)));
typedef float f32x4 __attribute__((ext_vector_type(4)));
typedef unsigned u32x4 __attribute__((ext_vector_type(4)));
constexpr int BM = 256, BK = 64, HALF = 128, HTB = HALF * BK * 2  , STAGE_BYTES = 8 * HTB, NXCD = 8, WGM = 8;

__host__ __device__ __forceinline__ int lds_byte(int r, int c) { const int st = (r >> 4) * 2 + (c >> 5), rr = r & 15, cc = c & 31, ob = rr * 64 + cc * 2; return st * 1024 + (ob ^ (((ob >> 9) & 1) << 5)); }
__host__ __device__ __forceinline__ void stage_rc(int b, int& R, int& C) { const int st = b / 1024, sb = b % 1024, swz = sb ^ (((sb >> 9) & 1) << 5); R = (st >> 1) * 16 + swz / 64; C = (st & 1) * 32 + (swz % 64) / 2; }
__host__ __device__ __forceinline__ int perm32(int rho) { const int n = rho >> 4, i = rho & 15; return 8 * (i >> 2) + 4 * n + (i & 3); }

struct Unit { int pm, pn; };
struct Gemm { const bf16_t* A; const bf16_t* Bt; int M, N, K; };

struct StaticOrder {
    int nM, nN, nwg, G, c;
    __host__ __device__ void init(int M, int N, int G_, int c_) { nM = M / BM; nN = N / BM; nwg = nM * nN; G = G_; c = c_; }
    __host__ __device__ bool next(int i, Unit& u) const {
        const long L = (long)i * G + c; if (L >= nwg) return false;
        int wgid = (int)L; { const int q = nwg / NXCD, r = nwg % NXCD, xcd = wgid % NXCD, off = wgid / NXCD; wgid = (xcd < r ? xcd * (q + 1) : r * (q + 1) + (xcd - r) * q) + off; }
        const int nig = WGM * nN, gid = wgid / nig, fm = gid * WGM, gsz = (nM - fm) < WGM ? (nM - fm) : WGM;
        u.pm = fm + ((wgid % nig) % gsz); u.pn = (wgid % nig) / gsz; return true;
    }
    __device__ __forceinline__ void a_ready(const Unit&) const {}
    __device__ __forceinline__ void done(const Unit&) const {}
};

__device__ __forceinline__ unsigned cvt_pk_bf16(float lo, float hi) { unsigned r; asm volatile("v_cvt_pk_bf16_f32 %0, %1, %2" : "=v"(r) : "v"(lo), "v"(hi)); return r; }
typedef float f32x2 __attribute__((ext_vector_type(2)));
typedef float f32x2v __attribute__((ext_vector_type(2)));
typedef unsigned u32x2v __attribute__((ext_vector_type(2)));
constexpr float DN_ALPHA_F = 1.6817928305074292f;

__device__ __forceinline__ unsigned cvt2(float lo, float hi) { typedef __bf16 bf16x2_t __attribute__((ext_vector_type(2))); const f32x2v v = {lo, hi}; return __builtin_bit_cast(unsigned, __builtin_convertvector(v, bf16x2_t)); }
__device__ __forceinline__ float xor32_sum(float x) { const auto r = __builtin_amdgcn_permlane32_swap(__float_as_uint(x), __float_as_uint(x), false, false); const unsigned r0 = r[0], r1 = r[1]; return __uint_as_float(r0) + __uint_as_float(r1); }
__device__ __forceinline__ float xor32_max(float x) { const auto r = __builtin_amdgcn_permlane32_swap(__float_as_uint(x), __float_as_uint(x), false, false); const unsigned r0 = r[0], r1 = r[1]; return fmaxf(__uint_as_float(r0), __uint_as_float(r1)); }
template <int MASK> __device__ __forceinline__ float swz_xor(float x) { return __builtin_bit_cast(float, __builtin_amdgcn_ds_swizzle(__builtin_bit_cast(int, x), (MASK << 10) | 0x1F)); }
__device__ __forceinline__ float wave_sum64(float v) { v += swz_xor<1>(v); v += swz_xor<2>(v); v += swz_xor<4>(v); v += swz_xor<8>(v); v += swz_xor<16>(v); return xor32_sum(v); }

struct EpiLnBf16 {
    static constexpr bool PERM = true, AFTER_DRAIN = false;
    bf16_t* O; int ldc; const float* stats; const float* cvec; const float* dvec;
    __device__ __forceinline__ void operator()(const f32x4 (&acc)[2][2][4][2], const Unit& u, int wr, int wc, int fr, int fq) const {
        const int row0 = u.pm * BM + wr * 64 + fr, col0 = u.pn * BM + wc * 32 + 8 * fq;
        f32x4 cv[2][2], dv[2][2];
#pragma unroll
        for (int bj = 0; bj < 2; ++bj)
#pragma unroll
            for (int n = 0; n < 2; ++n) { cv[bj][n] = *(const f32x4*)(cvec + col0 + bj * HALF + 4 * n); dv[bj][n] = *(const f32x4*)(dvec + col0 + bj * HALF + 4 * n); }
        f32x2v sts[2][4];
#pragma unroll
        for (int ai = 0; ai < 2; ++ai)
#pragma unroll
            for (int m = 0; m < 4; ++m) sts[ai][m] = *(const f32x2v*)(stats + 2 * (size_t)(row0 + ai * HALF + m * 16));
#pragma unroll
        for (int ai = 0; ai < 2; ++ai)
#pragma unroll
            for (int m = 0; m < 4; ++m) { const int row = row0 + ai * HALF + m * 16; const f32x2v st = sts[ai][m];
                bf16_t* rowp = O + (size_t)row * ldc + col0;
#pragma unroll
                for (int bj = 0; bj < 2; ++bj) { const f32x4 v0 = (acc[ai][bj][m][0] - st.x * cv[bj][0]) * st.y + dv[bj][0], v1 = (acc[ai][bj][m][1] - st.x * cv[bj][1]) * st.y + dv[bj][1];
                    u32x4 w; w.x = cvt2(v0[0], v0[1]); w.y = cvt2(v0[2], v0[3]); w.z = cvt2(v1[0], v1[1]); w.w = cvt2(v1[2], v1[3]);
                    *(u32x4*)(rowp + bj * HALF) = w; } }
    }
};
__device__ __forceinline__ float silu_mul(float g, float up) { const float e = __builtin_amdgcn_exp2f(-1.4426950408889634f * g); return g * __builtin_amdgcn_rcpf(1.0f + e) * up; }
struct EpiSwiglu {
    static constexpr bool PERM = true, AFTER_DRAIN = false;
    bf16_t* O; int ldc; const float* stats; const float* cvec; const float* dvec;
    __device__ __forceinline__ void operator()(const f32x4 (&acc)[2][2][4][2], const Unit& u, int wr, int wc, int fr, int fq) const {
        const int row0 = u.pm * BM + wr * 64 + fr, col0 = u.pn * BM + wc * 32 + 8 * fq, ocol = u.pn * HALF + wc * 32 + 8 * fq;
        f32x4 cv[2][2], dv[2][2];
#pragma unroll
        for (int bj = 0; bj < 2; ++bj)
#pragma unroll
            for (int n = 0; n < 2; ++n) { cv[bj][n] = *(const f32x4*)(cvec + col0 + bj * HALF + 4 * n); dv[bj][n] = *(const f32x4*)(dvec + col0 + bj * HALF + 4 * n); }
        f32x2v sts[2][4];
#pragma unroll
        for (int ai = 0; ai < 2; ++ai)
#pragma unroll
            for (int m = 0; m < 4; ++m) sts[ai][m] = *(const f32x2v*)(stats + 2 * (size_t)(row0 + ai * HALF + m * 16));
#pragma unroll
        for (int ai = 0; ai < 2; ++ai)
#pragma unroll
            for (int m = 0; m < 4; ++m) { const int row = row0 + ai * HALF + m * 16; const f32x2v st = sts[ai][m];
                f32x4 h[2];
#pragma unroll
                for (int n = 0; n < 2; ++n) { const f32x4 g = (acc[ai][0][m][n] - st.x * cv[0][n]) * st.y + dv[0][n], up = (acc[ai][1][m][n] - st.x * cv[1][n]) * st.y + dv[1][n];
                    h[n] = (f32x4){silu_mul(g[0], up[0]), silu_mul(g[1], up[1]), silu_mul(g[2], up[2]), silu_mul(g[3], up[3])}; }
                u32x4 w; w.x = cvt2(h[0][0], h[0][1]); w.y = cvt2(h[0][2], h[0][3]); w.z = cvt2(h[1][0], h[1][1]); w.w = cvt2(h[1][2], h[1][3]);
                *(u32x4*)(O + (size_t)row * ldc + ocol) = w; }
    }
};
struct EpiResid {
    static constexpr bool PERM = true, AFTER_DRAIN = false;
    float* Z; bf16_t* ZB; const float* stats; const float* gprev; const float* bprev; const float* bias; float* part; float scale; int pad;
    __device__ __forceinline__ void operator()(const f32x4 (&acc)[2][2][4][2], const Unit& u, int wr, int wc, int fr, int fq) const {
        const int row0 = u.pm * BM + wr * 64 + fr, col0 = u.pn * BM + wc * 32 + 8 * fq;
#pragma unroll
        for (int bj = 0; bj < 2; ++bj) {
            f32x4 gv[2], bv[2];
#pragma unroll
            for (int n = 0; n < 2; ++n) { const int c = col0 + bj * HALF + 4 * n; gv[n] = DN_ALPHA_F * *(const f32x4*)(gprev + c); bv[n] = DN_ALPHA_F * *(const f32x4*)(bprev + c) + scale * *(const f32x4*)(bias + c); }
#pragma unroll
            for (int ai = 0; ai < 2; ++ai)
#pragma unroll
                for (int mp = 0; mp < 2; ++mp) {
                    f32x4 zin[2][2]; f32x2v sts[2];
#pragma unroll
                    for (int mm = 0; mm < 2; ++mm) { const int row = row0 + ai * HALF + (2 * mp + mm) * 16; const float* zp = Z + (size_t)row * 2048 + col0 + bj * HALF;
                        zin[mm][0] = *(const f32x4*)zp; zin[mm][1] = *(const f32x4*)(zp + 4); sts[mm] = *(const f32x2v*)(stats + 2 * (size_t)row); }
#pragma unroll
                    for (int mm = 0; mm < 2; ++mm) { const int m = 2 * mp + mm; const int row = row0 + ai * HALF + m * 16; const f32x2v st = sts[mm];
                        float* zp = Z + (size_t)row * 2048 + col0 + bj * HALF;
                        const f32x4 n0 = (zin[mm][0] - st.x) * st.y * gv[0] + bv[0] + scale * acc[ai][bj][m][0];
                        const f32x4 n1 = (zin[mm][1] - st.x) * st.y * gv[1] + bv[1] + scale * acc[ai][bj][m][1];
                        *(f32x4*)zp = n0; *(f32x4*)(zp + 4) = n1;
                        u32x4 w; w.x = cvt2(n0[0], n0[1]); w.y = cvt2(n0[2], n0[3]); w.z = cvt2(n1[0], n1[1]); w.w = cvt2(n1[2], n1[3]);
                        *(u32x4*)(ZB + (size_t)row * 2048 + col0 + bj * HALF) = w;
                        float s = ((n0[0] + n0[1]) + (n0[2] + n0[3])) + ((n1[0] + n1[1]) + (n1[2] + n1[3]));
                        float q = ((n0[0] * n0[0] + n0[1] * n0[1]) + (n0[2] * n0[2] + n0[3] * n0[3])) + ((n1[0] * n1[0] + n1[1] * n1[1]) + (n1[2] * n1[2] + n1[3] * n1[3]));
                        s += swz_xor<16>(s); s = xor32_sum(s); q += swz_xor<16>(q); q = xor32_sum(q);
                        if (fq == 0) *(f32x2v*)(part + ((size_t)row * 64 + u.pn * 8 + wc * 2 + bj) * 2) = (f32x2v){s, q}; }
                }
        }
    }
};

struct EpiTaps {
    static constexpr bool PERM = false, AFTER_DRAIN = false;
    float* O; float min_decay, dstep;
    __device__ __forceinline__ void operator()(const f32x4 (&acc)[2][2][4][2], const Unit& u, int wr, int wc, int fr, int fq) const {
        int stride = 10240; float i0 = 1.0f / 8191.0f, i1 = 1.0f / 2047.0f; asm volatile("" : "+s"(stride), "+s"(i0), "+s"(i1));
        const int row0 = u.pm * BM + wr * 64 + fr, col0 = u.pn * BM + wc * 32 + 4 * fq;
        const int tbase = (u.pn < 32) ? 0 : 8192; const float ilm1 = (u.pn < 32) ? i0 : i1;
        const float t0 = (float)(col0 - tbase);
#pragma unroll
        for (int ai = 0; ai < 2; ++ai)
#pragma unroll
            for (int m = 0; m < 4; ++m) { const int row = row0 + ai * HALF + m * 16;
                const float a = -1.4426950408889634f * __builtin_fabsf(min_decay + (float)(row & 2047) * dstep) * ilm1;
                const float e0 = __builtin_amdgcn_exp2f(a * t0), s1 = __builtin_amdgcn_exp2f(a), s16 = __builtin_amdgcn_exp2f(16.0f * a), s128 = __builtin_amdgcn_exp2f(128.0f * a);
                float* rowp = O + (size_t)row * stride + col0;
#pragma unroll
                for (int bj = 0; bj < 2; ++bj) { const float eb = bj ? e0 * s128 : e0;
#pragma unroll
                    for (int n = 0; n < 2; ++n) { const float en = n ? eb * s16 : eb, en1 = en * s1, en2 = en1 * s1, en3 = en2 * s1; const f32x4 v = acc[ai][bj][m][n];
                        *(f32x4*)(rowp + bj * HALF + n * 16) = (f32x4){v[0] * en, v[1] * en1, v[2] * en2, v[3] * en3}; } } }
    }
};

template <class Epi, class Sched, bool ALIGN_EPI = false, bool SP2 = false>
__device__ __forceinline__ void gemm_phase(PG8_LAS unsigned char* lds, const Gemm g, const Sched& S, const Epi& E, const int tid_in) {
    int tid_ = tid_in; asm volatile("" : "+v"(tid_));
    const int tid = tid_, wid = __builtin_amdgcn_readfirstlane(tid >> 6), lane = tid & 63, wr = wid >> 2, wc = wid & 3, fr = lane & 15, fq = lane >> 4;
    const int K = g.K, nt = K / BK;
    unsigned voffA[2], voffB[2];
#pragma unroll
    for (int i = 0; i < 2; ++i) { int R, C; stage_rc(tid * 16 + i * 8192, R, C); const int Rb = Epi::PERM ? ((R & ~31) + perm32(R & 31)) : R;
        voffA[i] = (unsigned)(R * K + C) * 2u; voffB[i] = (unsigned)(Rb * K + C) * 2u; }
    const size_t kstep = (size_t)(BK * 2);
    const size_t hstep = (size_t)HALF * K * 2;
    const size_t tstep = 2 * hstep;
    const unsigned ldsw = (unsigned)wid * 1024u;
    const int aoff = lds_byte(wr * 64 + fr, fq * 8), boff = lds_byte(wc * 32 + fr, fq * 8);
#define PG8_SA(b, h) (((b) * 2 + (h)) * HTB)
#define PG8_SB(b, h) ((4 + (b) * 2 + (h)) * HTB)
#define PG8_STAGE(bufoff, gbase, voff) do { _Pragma("unroll") for (int _i = 0; _i < 2; ++_i) \
        __builtin_amdgcn_global_load_lds((const unsigned*)((const char*)(gbase) + (voff)[_i]), (PG8_LAS unsigned*)(lds + (bufoff) + ldsw + _i * 8192), 16, 0, 0); } while (0)
#define PG8_LDA(dst, b, h) do { _Pragma("unroll") for (int m = 0; m < 4; ++m) _Pragma("unroll") for (int k = 0; k < 2; ++k) dst[m][k] = *(const PG8_LAS bf16x8*)(lds + PG8_SA(b, h) + aoff + m * 2048 + k * 1024); } while (0)
#define PG8_LDB(dst, b, h) do { _Pragma("unroll") for (int n = 0; n < 2; ++n) _Pragma("unroll") for (int k = 0; k < 2; ++k) dst[n][k] = *(const PG8_LAS bf16x8*)(lds + PG8_SB(b, h) + boff + n * 2048 + k * 1024); } while (0)
#define PG8_MMA(ai, bj, At, Bt) do { __builtin_amdgcn_s_setprio(1); _Pragma("unroll") for (int m = 0; m < 4; ++m) _Pragma("unroll") for (int n = 0; n < 2; ++n) _Pragma("unroll") for (int k = 0; k < 2; ++k) \
        acc[ai][bj][m][n] = __builtin_amdgcn_mfma_f32_16x16x32_bf16(Bt[n][k], At[m][k], acc[ai][bj][m][n], 0, 0, 0); __builtin_amdgcn_s_setprio(0); } while (0)
#define PG8_WAIT_V(n) asm volatile("s_waitcnt vmcnt(" #n ")" ::: "memory")
#define PG8_WAIT_L(n) asm volatile("s_waitcnt lgkmcnt(" #n ")" ::: "memory")
#define PG8_BAR __builtin_amdgcn_s_barrier()
#define PG8_SCHED __builtin_amdgcn_sched_barrier(0)
    Unit cur, nxt; int ui = 0;
    if (!S.next(0, cur)) return;
    f32x4 acc[2][2][4][2];
    float zero_; asm volatile("v_mov_b32 %0, 0" : "=v"(zero_));
#pragma unroll
    for (int a = 0; a < 2; ++a)
#pragma unroll
        for (int b = 0; b < 2; ++b)
#pragma unroll
            for (int m = 0; m < 4; ++m)
#pragma unroll
                for (int n = 0; n < 2; ++n) acc[a][b][m][n] = (f32x4){zero_, zero_, zero_, zero_};
    bf16x8 At[4][2], B0[2][2], B1[2][2];
    const char* cA = (const char*)g.A + (size_t)cur.pm * tstep; const char* cB = (const char*)g.Bt + (size_t)cur.pn * tstep;
    S.a_ready(cur);
    if constexpr (SP2) {
        PG8_STAGE(PG8_SB(0, 0), cB, voffB); PG8_STAGE(PG8_SB(0, 1), cB + hstep, voffB); PG8_STAGE(PG8_SA(0, 0), cA, voffA); PG8_STAGE(PG8_SA(0, 1), cA + hstep, voffA);
        if (wr == 1) PG8_BAR;
        PG8_WAIT_V(2); PG8_BAR;
        PG8_STAGE(PG8_SB(1, 0), cB + kstep, voffB); PG8_STAGE(PG8_SA(1, 0), cA + kstep, voffA); PG8_STAGE(PG8_SB(1, 1), cB + hstep + kstep, voffB);
        PG8_WAIT_V(6); PG8_BAR;
    } else {
        PG8_STAGE(PG8_SB(0, 0), cB, voffB); PG8_STAGE(PG8_SA(0, 0), cA, voffA); PG8_STAGE(PG8_SB(0, 1), cB + hstep, voffB); PG8_STAGE(PG8_SA(0, 1), cA + hstep, voffA);
        if (wr == 1) PG8_BAR;
        PG8_WAIT_V(4); PG8_BAR;
        PG8_STAGE(PG8_SB(1, 0), cB + kstep, voffB); PG8_STAGE(PG8_SA(1, 0), cA + kstep, voffA); PG8_STAGE(PG8_SB(1, 1), cB + hstep + kstep, voffB);
        PG8_WAIT_V(6); PG8_BAR;
    }
    for (;;) {
        const bool has_next = S.next(ui + 1, nxt);
        const char* nA = has_next ? (const char*)g.A + (size_t)nxt.pm * tstep : cA; const char* nB = has_next ? (const char*)g.Bt + (size_t)nxt.pn * tstep : cB;
        for (int t = 0; t < nt; t += 2) {
            const bool last = (t == nt - 2);
            const char* a1 = cA + (size_t)(t + 1) * kstep;
            const char* a2 = last ? nA : cA + (size_t)(t + 2) * kstep; const char* b2 = last ? nB : cB + (size_t)(t + 2) * kstep;
            const char* a3 = a2 + kstep; const char* b3 = b2 + kstep;
            if (last && has_next) S.a_ready(nxt);
            if constexpr (SP2) {
            PG8_LDB(B0, 0, 0); PG8_LDB(B1, 0, 1); PG8_SCHED; PG8_LDA(At, 0, 0); PG8_STAGE(PG8_SA(1, 1), a1 + hstep, voffA);
            PG8_WAIT_V(8); PG8_WAIT_L(0); PG8_BAR; PG8_MMA(0, 0, At, B0); PG8_MMA(0, 1, At, B1); PG8_BAR; PG8_SCHED;
            PG8_LDA(At, 0, 1); PG8_STAGE(PG8_SB(0, 0), b2, voffB); PG8_STAGE(PG8_SB(0, 1), b2 + hstep, voffB); PG8_STAGE(PG8_SA(0, 0), a2, voffA);
            PG8_WAIT_V(8); PG8_WAIT_L(0); PG8_BAR; PG8_MMA(1, 0, At, B0); PG8_MMA(1, 1, At, B1); PG8_BAR; PG8_SCHED;
            PG8_LDB(B0, 1, 0); PG8_LDB(B1, 1, 1); PG8_SCHED; PG8_LDA(At, 1, 0); PG8_STAGE(PG8_SA(0, 1), a2 + hstep, voffA);
            PG8_WAIT_V(8); PG8_WAIT_L(0); PG8_BAR; PG8_MMA(0, 0, At, B0); PG8_MMA(0, 1, At, B1); PG8_BAR; PG8_SCHED;
            PG8_LDA(At, 1, 1); PG8_STAGE(PG8_SB(1, 0), b3, voffB); PG8_STAGE(PG8_SB(1, 1), b3 + hstep, voffB); PG8_STAGE(PG8_SA(1, 0), a3, voffA);
            PG8_WAIT_V(8); PG8_WAIT_L(0); PG8_BAR; PG8_MMA(1, 0, At, B0); PG8_MMA(1, 1, At, B1); PG8_BAR; PG8_SCHED;
            } else {
            PG8_LDB(B0, 0, 0); PG8_SCHED; PG8_LDA(At, 0, 0); PG8_STAGE(PG8_SA(1, 1), a1 + hstep, voffA);
            PG8_WAIT_L(8); PG8_BAR; PG8_WAIT_L(0); PG8_MMA(0, 0, At, B0); PG8_BAR; PG8_SCHED;
            PG8_LDB(B1, 0, 1); PG8_STAGE(PG8_SB(0, 0), b2, voffB);
            PG8_BAR; PG8_WAIT_L(0); PG8_MMA(0, 1, At, B1); PG8_BAR;
            PG8_LDA(At, 0, 1); PG8_STAGE(PG8_SA(0, 0), a2, voffA);
            PG8_BAR; PG8_WAIT_L(0); PG8_MMA(1, 0, At, B0); PG8_BAR; PG8_SCHED;
            PG8_STAGE(PG8_SB(0, 1), b2 + hstep, voffB);
            PG8_WAIT_V(6); PG8_BAR; PG8_MMA(1, 1, At, B1); PG8_BAR;
            PG8_LDB(B0, 1, 0); PG8_SCHED; PG8_LDA(At, 1, 0); PG8_STAGE(PG8_SA(0, 1), a2 + hstep, voffA);
            PG8_WAIT_L(8); PG8_BAR; PG8_WAIT_L(0); PG8_MMA(0, 0, At, B0); PG8_BAR; PG8_SCHED;
            PG8_LDB(B1, 1, 1); PG8_STAGE(PG8_SB(1, 0), b3, voffB);
            PG8_BAR; PG8_WAIT_L(0); PG8_MMA(0, 1, At, B1); PG8_BAR;
            PG8_LDA(At, 1, 1); PG8_STAGE(PG8_SA(1, 0), a3, voffA);
            PG8_BAR; PG8_WAIT_L(0); PG8_MMA(1, 0, At, B0); PG8_BAR; PG8_SCHED;
            PG8_STAGE(PG8_SB(1, 1), b3 + hstep, voffB);
            PG8_WAIT_V(6); PG8_BAR; PG8_MMA(1, 1, At, B1); PG8_BAR;
            }
        }
        if constexpr (ALIGN_EPI) { if (wr == 0) PG8_BAR; }
        if constexpr (!Epi::AFTER_DRAIN) { E(acc, cur, wr, wc, fr, fq); S.done(cur); }
        if (!has_next) break;
        asm volatile("v_mov_b32 %0, 0" : "=v"(zero_));
#pragma unroll
        for (int a = 0; a < 2; ++a)
#pragma unroll
            for (int b = 0; b < 2; ++b)
#pragma unroll
                for (int m = 0; m < 4; ++m)
#pragma unroll
                    for (int n = 0; n < 2; ++n) acc[a][b][m][n] = (f32x4){zero_, zero_, zero_, zero_};
        cur = nxt; cA = nA; cB = nB; ++ui;
        if constexpr (ALIGN_EPI) { if (wr == 1) PG8_BAR; }
    }
    PG8_WAIT_V(0);
    if constexpr (!ALIGN_EPI) { if (wr == 0) PG8_BAR; }
    PG8_BAR;
    if constexpr (Epi::AFTER_DRAIN) { E.fused(acc, cur, wr, wc, fr, fq, lds, wid, lane); S.done(cur); }
#undef PG8_SA
#undef PG8_SB
#undef PG8_STAGE
#undef PG8_LDA
#undef PG8_LDB
#undef PG8_MMA
#undef PG8_WAIT_V
#undef PG8_WAIT_L
#undef PG8_BAR
#undef PG8_SCHED
}
}

#ifndef PG8_SP2
#define PG8_SP2 true
#endif
#ifndef PG8_ALIGN
#define PG8_ALIGN true
#endif
#define XB_TMO      128
#define XB_XCNT(j)  (256  + 64 * (j))
#define XB_XSUB(j)  (1280 + 64 * (j))
#define XB_XGEN(j)  (2304 + 64 * (j))
#define XB_TOP      3328
#define XB_TOPGEN   3392
#define XCD_BAR_WORDS 3456
#define XB_SPIN_CAP (1u << 18)
#define LAS __attribute__((address_space(3)))

__device__ __forceinline__ unsigned xb_ld(unsigned* p)              { return __hip_atomic_load(p, __ATOMIC_RELAXED, __HIP_MEMORY_SCOPE_AGENT); }
__device__ __forceinline__ unsigned xb_add(unsigned* p, unsigned v) { return __hip_atomic_fetch_add(p, v, __ATOMIC_RELAXED, __HIP_MEMORY_SCOPE_AGENT); }
__device__ __forceinline__ unsigned xb_xcc_id() { return (unsigned)__builtin_amdgcn_s_getreg((3 << 11) | 20) & 0xFu; }
#define XB_SPIN(cond, bar) do { unsigned _sp = 0; while (cond) { __builtin_amdgcn_s_sleep(1); \
    if ((++_sp & 255u) == 0u) { if (xb_ld(&(bar)[XB_TMO])) break; if (_sp > XB_SPIN_CAP) { atomicAdd(&(bar)[XB_TMO], 1u); break; } } } } while (0)

struct XcdBarrier {
    unsigned* bar; unsigned x;
    unsigned w0;
    volatile LAS unsigned* st;
};

__device__ __forceinline__ XcdBarrier xcd_barrier_post(unsigned* bar, volatile LAS unsigned* st) {
    XcdBarrier b; b.bar = bar; b.x = xb_xcc_id(); b.st = st; b.w0 = (unsigned)__builtin_amdgcn_readfirstlane(threadIdx.x >> 6);
    if (threadIdx.x == 0) (void)xb_add(&bar[XB_XCNT(b.x)], 1u);
    return b;
}
__device__ __forceinline__ void xcd_barrier_complete(unsigned* bar, unsigned x, unsigned& nloc, unsigned& nx) {
    const unsigned G = gridDim.x * gridDim.y * gridDim.z;
    unsigned sum, cnt, mine, sp = 0u;
    for (;;) {
        sum = 0u; cnt = 0u; mine = 0u;
#pragma unroll
        for (unsigned j = 0; j < 16; ++j) { const unsigned c = xb_ld(&bar[XB_XCNT(j)]); sum += c; cnt += (c > 0u) ? 1u : 0u; mine = (j == x) ? c : mine; }
        if (sum == G) break;
        __builtin_amdgcn_s_sleep(1);
        if ((++sp & 255u) == 0u) { if (xb_ld(&bar[XB_TMO])) break; if (sp > XB_SPIN_CAP) { atomicAdd(&bar[XB_TMO], 1u); break; } }
    }
    nloc = mine > 0u ? mine : 1u; nx = cnt > 0u ? cnt : 1u;
}

__device__ __forceinline__ void xcd_barrier(const XcdBarrier& b) {
    asm volatile("s_waitcnt vmcnt(0)" ::: "memory");
    __syncthreads();
    unsigned xb_lane; asm volatile("v_mbcnt_lo_u32_b32 %0, -1, 0\n\tv_mbcnt_hi_u32_b32 %0, -1, %0" : "=v"(xb_lane));
    if (b.w0 == 0u && xb_lane == 0u) {
        unsigned* bar = b.bar;
        __builtin_amdgcn_s_waitcnt(0);
        unsigned nloc = b.st[0], nx = b.st[1];
        if (nloc == 0u) { xcd_barrier_complete(bar, b.x, nloc, nx); b.st[0] = nloc; b.st[1] = nx; }
        const unsigned old = xb_add(&bar[XB_XSUB(b.x)], 1u);
        const unsigned gen = old / nloc;
        if (old + 1u == (gen + 1u) * nloc) {
            __builtin_amdgcn_fence(__ATOMIC_RELEASE, "agent");
            asm volatile("s_waitcnt vmcnt(0)" ::: "memory");
            const unsigned og = xb_add(&bar[XB_TOP], 1u);
            const unsigned tg = og / nx;
            if (og + 1u == (tg + 1u) * nx) xb_add(&bar[XB_TOPGEN], 1u);
            else XB_SPIN(xb_ld(&bar[XB_TOPGEN]) == tg, bar);
            __builtin_amdgcn_fence(__ATOMIC_ACQUIRE, "agent");
            xb_add(&bar[XB_XGEN(b.x)], 1u);
            asm volatile("s_waitcnt vmcnt(0)" ::: "memory");
        } else {
            XB_SPIN(xb_ld(&bar[XB_XGEN(b.x)]) == gen, bar);
            __builtin_amdgcn_fence(__ATOMIC_ACQUIRE, "agent");
            asm volatile("s_waitcnt vmcnt(0)" ::: "memory");
        }
    }
    __syncthreads();
}
constexpr int NWAVES = 8;
constexpr int D = 2048, FF = 5632, NFF2 = 2 * FF, NQKV = 18432, NHY = 6144, DEPTH = 4;
constexpr int T_PROMPT = 4 * 8192, T = 49152;
constexpr float LN_EPS = 1e-5f;
constexpr float QSCALE = 0.12751743082459868f;
constexpr float LOG2E = 1.4426950408889634f;
constexpr float MIN_DECAY = -3.0701134573253946f, MAX_DECAY = -15.350567286626973f;

constexpr size_t MiB = 1u << 20;
constexpr size_t WS_CTL = 0, CTL_ZERO_BYTES = 64 * 1024;
constexpr size_t WS_IDG = 1 * MiB, WS_IDB = 1 * MiB + 32768, WS_DUMP = 1 * MiB + 32768 + 131072;
constexpr size_t WS_CD = 2 * MiB;
constexpr size_t WS_STATS = 3 * MiB;
constexpr size_t WS_H2T = 4 * MiB;
constexpr size_t WS_PART = 8 * MiB;
constexpr size_t WS_W = 32 * MiB;
constexpr size_t W_IN1 = WS_W, W_OUT1 = W_IN1 + 44 * MiB, W_IN2 = W_OUT1 + 22 * MiB, W_OUT2 = W_IN2 + 44 * MiB, W_MIN = W_OUT2 + 22 * MiB, W_MOUT = W_MIN + 72 * MiB;
constexpr size_t WS_ZB = W_MOUT + 8 * MiB;
constexpr size_t WS_BIG = WS_ZB + 192 * MiB;
constexpr size_t BIG_HID = 0;
constexpr size_t BIG_QKV = 0, BIG_AO = 1728 * MiB;
constexpr size_t BIG_U = 0, BIG_Z2T = 0, BIG_Z2 = 192 * MiB, BIG_UT = 576 * MiB, BIG_SPEC0 = 1152 * MiB, BIG_SPEC1 = 1664 * MiB;
constexpr size_t WS_TAPS = WS_BIG + 1920 * MiB;
constexpr size_t WS_H2B = WS_TAPS + 320 * MiB, WS_W3T = WS_H2B + 6 * MiB;
constexpr size_t WS_END = WS_W3T + 4 * MiB;
static_assert(WS_ZB == 244 * MiB && WS_BIG == 436 * MiB && (size_t)T * 64 * 8 <= 24 * MiB && WS_END <= 2816 * MiB && (size_t)8192 * 10240 * 4 <= 320 * MiB, "ws map");
static_assert((size_t)T * FF * 2 <= 528 * MiB && (size_t)T * NQKV * 2 <= 1728 * MiB && (size_t)T * NHY * 2 <= 576 * MiB && BIG_SPEC1 + 128 * MiB <= 1920 * MiB, "ws map");

constexpr int RING_OFF = 0;
constexpr int FFT_BYTES = (16384 + 512) * 8;
constexpr int SCR_OFF = FFT_BYTES;
constexpr int MISC_OFF = SCR_OFF + 1024;
constexpr int PTR_OFF = MISC_OFF + 256;
constexpr int LDS_BYTES = PTR_OFF + 256;

#define GAS __attribute__((address_space(1)))
#define LAS __attribute__((address_space(3)))
typedef unsigned short bf16;
typedef unsigned v4u __attribute__((ext_vector_type(4)));
typedef unsigned v2u __attribute__((ext_vector_type(2)));
typedef float f32x4 __attribute__((ext_vector_type(4)));
typedef float f32x2 __attribute__((ext_vector_type(2)));
typedef float f32x16 __attribute__((ext_vector_type(16)));
typedef short bf16x8 __attribute__((ext_vector_type(8)));
typedef short s16x4 __attribute__((ext_vector_type(4)));
#define LDS_WAIT() asm volatile("s_waitcnt lgkmcnt(0)" ::: "memory")
#define VM_WAIT() asm volatile("s_waitcnt vmcnt(0)" ::: "memory")
__device__ __forceinline__ unsigned f2bf(float f) { unsigned u = __builtin_bit_cast(unsigned, f); return (u + 0x7fffu + ((u >> 16) & 1u)) >> 16; }
__device__ __forceinline__ unsigned pk2(float lo, float hi) { return f2bf(lo) | (f2bf(hi) << 16); }
__device__ __forceinline__ float bf2f(unsigned b) { return __builtin_bit_cast(float, b << 16); }
__device__ __forceinline__ float bfround(float f) { return bf2f(f2bf(f)); }

#ifndef FFT_HD
#define FFT_HD __host__ __device__ __forceinline__
#endif
#if defined(__clang__)
typedef float cpx __attribute__((ext_vector_type(2)));
#else
struct cpx { float x, y; };
#endif
FFT_HD cpx cmul(cpx a, cpx b) { return cpx{a.x * b.x - a.y * b.y, a.x * b.y + a.y * b.x}; }
FFT_HD cpx cmulc(cpx a, cpx b) { return cpx{a.x * b.x + a.y * b.y, a.y * b.x - a.x * b.y}; }
FFT_HD cpx cadd(cpx a, cpx b) { return cpx{a.x + b.x, a.y + b.y}; }
FFT_HD cpx csub(cpx a, cpx b) { return cpx{a.x - b.x, a.y - b.y}; }
FFT_HD int pidx(int i) { return i + (i >> 5); }
FFT_HD cpx cis_neg_rev(float rev) {
    const float x8 = rev * 8.0f; int oct = (int)x8; oct = oct > 7 ? 7 : oct; const float f = x8 - (float)oct;
    const float a = (oct & 1) ? (1.0f - f) : f, phi = a * 0.78539816339744831f, p2 = phi * phi;
    const float s = phi * (1.0f + p2 * (-1.6666666666666666e-1f + p2 * (8.3333333333333332e-3f + p2 * (-1.9841269841269841e-4f + p2 * 2.7557319223985893e-6f))));
    const float c = 1.0f + p2 * (-0.5f + p2 * (4.1666666666666664e-2f + p2 * (-1.3888888888888889e-3f + p2 * (2.4801587301587302e-5f + p2 * -2.7557319223985888e-7f))));
    const bool sw = ((oct + 1) & 2) != 0;
    float cc = sw ? s : c, ss = sw ? c : s;
    if (oct >= 2 && oct <= 5) cc = -cc;
    if (oct >= 4) ss = -ss;
    return cpx{cc, -ss};
}
FFT_HD float sin_acc(float x) { float rev = x * 0.15915494309189535f; rev -= floorf(rev); const cpx e = cis_neg_rev(rev); return -e.y; }
FFT_HD float cos_rev(float rev) { rev -= floorf(rev); return cis_neg_rev(rev).x; }
FFT_HD float sin_rev(float rev) { rev -= floorf(rev); return -cis_neg_rev(rev).y; }
FFT_HD cpx w16(int k) {
    constexpr float C1 = 0.92387953251128674f, S1 = 0.38268343236508977f, R2 = 0.70710678118654752f;
    switch (k) { case 0: return cpx{1.f, 0.f}; case 1: return cpx{C1, -S1}; case 2: return cpx{R2, -R2}; case 3: return cpx{S1, -C1};
                 case 4: return cpx{0.f, -1.f}; case 5: return cpx{-S1, -C1}; case 6: return cpx{-R2, -R2}; default: return cpx{-C1, -S1}; }
}
template <int R> FFT_HD constexpr int bitrev(int i) { int r = 0; for (int b = 1, c = R >> 1; b < R; b <<= 1, c >>= 1) if (i & b) r |= c; return r; }
template <int R> FFT_HD void dif_regs(cpx (&a)[R]) {
#pragma unroll
    for (int len = R; len >= 2; len >>= 1) { const int half = len >> 1;
#pragma unroll
        for (int b0 = 0; b0 < R; b0 += len)
#pragma unroll
            for (int j = 0; j < half; ++j) { const cpx u = a[b0 + j], v = a[b0 + j + half]; a[b0 + j] = cadd(u, v); const cpx d = csub(u, v); a[b0 + j + half] = (j == 0) ? d : cmul(d, w16(j * (16 / len))); } }
}
template <int R> FFT_HD void dit_regs(cpx (&a)[R]) {
#pragma unroll
    for (int len = 2; len <= R; len <<= 1) { const int half = len >> 1;
#pragma unroll
        for (int b0 = 0; b0 < R; b0 += len)
#pragma unroll
            for (int j = 0; j < half; ++j) { const cpx u = a[b0 + j]; const cpx v = (j == 0) ? a[b0 + j + half] : cmulc(a[b0 + j + half], w16(j * (16 / len))); a[b0 + j] = cadd(u, v); a[b0 + j + half] = csub(u, v); } }
}
template <int R> FFT_HD void twiddle_powers(cpx w1, cpx (&pw)[R]) {
    pw[0] = cpx{1.f, 0.f}; pw[1] = w1; pw[2] = cmul(w1, w1); pw[3] = cmul(pw[2], w1);
    if constexpr (R > 4) { pw[4] = cmul(pw[2], pw[2]); pw[5] = cmul(pw[4], pw[1]); pw[6] = cmul(pw[4], pw[2]); pw[7] = cmul(pw[4], pw[3]); }
    if constexpr (R > 8) { pw[8] = cmul(pw[4], pw[4]);
#pragma unroll
        for (int k = 1; k < 8; ++k) pw[8 + k] = cmul(pw[8], pw[k]); }
}
template <int R, bool INV, class P> FFT_HD void fft_pass(P X, int tid, int nthr, int logM) {
    constexpr int LOGR = (R == 16) ? 4 : 2;
    const int logs = logM - LOGR, s = 1 << logs;
#pragma unroll 1
    for (int blk = tid; blk < 16384 / R; blk += nthr) {
        const int base = blk & (s - 1), idx0 = ((blk >> logs) << logM) + base;
        cpx a[R], pw[R];
        if (logs > 0) twiddle_powers<R>(cis_neg_rev((float)base / (float)(1 << logM)), pw);
        if (!INV) {
#pragma unroll
            for (int j = 0; j < R; ++j) a[j] = X[pidx(idx0 + (j << logs))];
            dif_regs<R>(a);
#pragma unroll
            for (int i = 0; i < R; ++i) { const int k1 = bitrev<R>(i); cpx v = a[i]; if (logs > 0 && k1 != 0) v = cmul(v, pw[k1]); X[pidx(idx0 + (k1 << logs))] = v; }
        } else {
#pragma unroll
            for (int i = 0; i < R; ++i) { const int k1 = bitrev<R>(i); cpx v = X[pidx(idx0 + (k1 << logs))]; if (logs > 0 && k1 != 0) v = cmulc(v, pw[k1]); a[i] = v; }
            dit_regs<R>(a);
#pragma unroll
            for (int j = 0; j < R; ++j) X[pidx(idx0 + (j << logs))] = a[j];
        }
    }
}
struct Frame {
    LAS unsigned char* lds;
    int tid, lane, wave;
    int vcu, G, bx;
    unsigned char* ws; float* z;
};
__device__ __forceinline__ Frame make_frame(unsigned char* lds_generic, unsigned char* ws, float* out, int wave0) {
    Frame F;
    int lane; asm volatile("v_mbcnt_lo_u32_b32 %0, -1, 0\n\tv_mbcnt_hi_u32_b32 %0, -1, %0" : "=v"(lane));
    int bx = blockIdx.x, G = gridDim.x;
    asm volatile("" : "+v"(lane)); asm volatile("" : "+s"(bx)); asm volatile("" : "+s"(G)); asm volatile("" : "+s"(wave0));
    const int tid = wave0 * 64 + lane;
    unsigned long long w = (unsigned long long)ws, o = (unsigned long long)out; asm volatile("" : "+s"(w)); asm volatile("" : "+s"(o));
    F.lds = (LAS unsigned char*)lds_generic;
    F.tid = tid; F.lane = lane; F.wave = wave0;
    F.G = G; F.bx = bx; F.vcu = (G % 8 == 0) ? (bx % 8) * (G / 8) + bx / 8 : bx;
    F.ws = (unsigned char*)(GAS unsigned char*)w; F.z = (float*)(GAS float*)o;
    return F;
}
__device__ __forceinline__ const float* inp(const Frame& F, int i) {
    const LAS unsigned* t = (const LAS unsigned*)(F.lds + PTR_OFF) + 2 * i;
    const unsigned lo = __builtin_amdgcn_readfirstlane(t[0]), hi = __builtin_amdgcn_readfirstlane(t[1]);
    return (const float*)(const GAS float*)(((unsigned long long)hi << 32) | lo);
}
__device__ __forceinline__ float wave_sum(float v) { return pg8::wave_sum64(v); }
__device__ __forceinline__ void block_sum2(Frame& F, float& a, float& b) {
    LAS float* scr = (LAS float*)(F.lds + SCR_OFF);
    a = wave_sum(a); b = wave_sum(b);
    __syncthreads();
    if (F.lane == 0) { scr[F.wave * 2] = a; scr[F.wave * 2 + 1] = b; }
    __syncthreads();
    float sa = 0.f, sb = 0.f;
#pragma unroll
    for (int w = 0; w < NWAVES; ++w) { sa += scr[w * 2]; sb += scr[w * 2 + 1]; }
    a = sa; b = sb;
}

__device__ __forceinline__ void phase_init(Frame& F) {
    const int gw = F.vcu * NWAVES + F.wave, NGW = F.G * NWAVES;
    bf16* zb = (bf16*)(F.ws + WS_ZB); float* stats = (float*)(F.ws + WS_STATS);
    const float* x0 = inp(F, 0); const float* x1 = inp(F, 1);
    for (int m = gw; m < T; m += NGW) {
        const float* src = (m < T_PROMPT) ? x0 + (size_t)m * D : x1 + (size_t)(m - T_PROMPT) * D;
        const GAS f32x4* s4 = (const GAS f32x4*)src + F.lane; GAS f32x4* d4 = (GAS f32x4*)(F.z + (size_t)m * D) + F.lane; GAS v2u* b4 = (GAS v2u*)(zb + (size_t)m * D) + F.lane;
#pragma unroll
        for (int j = 0; j < 8; ++j) { const f32x4 v = s4[64 * j]; d4[64 * j] = v; v2u o; o.x = pk2(v.x, v.y); o.y = pk2(v.z, v.w); b4[64 * j] = o; }
        if (F.lane == 0) { stats[2 * m] = 0.f; stats[2 * m + 1] = 1.f; }
    }
    const int gt = F.vcu * (NWAVES * 64) + F.tid;
    if (gt < 8192) ((float*)(F.ws + WS_IDG))[gt] = 1.f;
    if (gt < 32768) ((float*)(F.ws + WS_IDB))[gt] = 0.f;
}

struct ConvJob { const float* W; int K, N; bf16* WT; const float* gk; const float* bk; float* cvec; float* dvec; const float* ebias; int mode; };
__device__ __forceinline__ void conv_item(const float* W, int K, int N, bf16* WT, const float* gk, const float* bk, float* cvec, float* dvec, const float* ebias, int mode, int nb, LAS float* scr, int lane) {
    const int n0 = 32 * nb, n = lane & 31, kh = lane >> 5;
    const float colscale = (mode == 2 && n0 < 6144) ? QSCALE : 1.0f;
    int rbase = n0;
    if (mode == 1) { rbase = (n0 < FF) ? (n0 / 128) * 256 + (n0 % 128) : ((n0 - FF) / 128) * 256 + 128 + ((n0 - FF) % 128); }
    float csum = 0.f, dsum = 0.f;
    for (int k0 = 0; k0 < K; k0 += 64) {
        float wv[32];
#pragma unroll
        for (int i = 0; i < 32; ++i) wv[i] = W[(size_t)(k0 + 2 * i + kh) * N + n0 + n];
#pragma unroll
        for (int i = 0; i < 32; ++i) { const int kk = 2 * i + kh; const float w = wv[i] * colscale;
            const float v = bfround(w * gk[k0 + kk]); scr[kk * 33 + n] = v; csum += v; dsum += bk[k0 + kk] * w; }
        LDS_WAIT(); asm volatile("" ::: "memory");
        const int c = lane & 7;
#pragma unroll
        for (int j = 0; j < 4; ++j) { const int nn = (lane >> 3) + 8 * j; const LAS float* s = scr + (8 * c) * 33 + nn;
            v4u o; o.x = pk2(s[0 * 33], s[1 * 33]); o.y = pk2(s[2 * 33], s[3 * 33]); o.z = pk2(s[4 * 33], s[5 * 33]); o.w = pk2(s[6 * 33], s[7 * 33]);
            *(GAS v4u*)(WT + (size_t)(rbase + nn) * K + k0 + 8 * c) = o; }
        LDS_WAIT(); asm volatile("" ::: "memory");
    }
    csum = pg8::xor32_sum(csum); dsum = pg8::xor32_sum(dsum);
    if (lane < 32) { cvec[rbase + n] = csum; dvec[rbase + n] = dsum + ebias[n0 + n]; }
}
__device__ __forceinline__ void filt_pos(Frame& F, int jl, int var, int t) {
    const int L = var ? 2048 : 8192, lane = F.lane;
    const float* w1 = inp(F, 12) + (size_t)jl * 33 * 64; const float* b1 = inp(F, 13) + jl * 64; const float* w2 = inp(F, 14) + (size_t)jl * 64 * 64; const float* b2 = inp(F, 15) + jl * 64; const float* fr = inp(F, 16) + jl * 64;
    float feat = 0.f;
    if (lane == 0) feat = (float)t / (float)(L - 1);
    else if (lane < 33) { const int bi = (lane - 1) & 15; const float band = 1e-4f + (float)bi * ((15.0f - 1e-4f) / 15.0f); const float rev = band * ((float)t / (float)L);
        feat = (lane < 17) ? cos_rev(rev) : -sin_rev(rev); }
    float acc = b1[lane];
    for (int k = 0; k < 33; ++k) acc += __builtin_bit_cast(float, __builtin_amdgcn_readlane(__builtin_bit_cast(int, feat), k)) * w1[k * 64 + lane];
    const float fq = fr[lane];
    const float h1 = sin_acc(fq * acc);
    float acc2 = b2[lane];
    for (int k = 0; k < 64; ++k) acc2 += __builtin_bit_cast(float, __builtin_amdgcn_readlane(__builtin_bit_cast(int, h1), k)) * w2[k * 64 + lane];
    const float h2 = sin_acc(fq * acc2);
    bf16* hrow = (bf16*)(F.ws + WS_H2B) + (size_t)((var ? 8192 : 0) + t) * 256;
    hrow[lane] = (bf16)f2bf(h2); hrow[64 + lane] = 0; hrow[128 + lane] = 0; hrow[192 + lane] = 0;
}
__device__ __forceinline__ void phase_convert(Frame& F, int layer) {
    LAS float* scr = (LAS float*)(F.lds + RING_OFF + F.wave * 16384);
    const int gw = F.vcu * NWAVES + F.wave, NGW = F.G * NWAVES;
    const int jl = layer >> 1; const bool hy = (layer & 1) != 0;
    const float* ln_g = inp(F, 2); const float* ln_b = inp(F, 3);
    const float* ones = (const float*)(F.ws + WS_IDG); const float* zeros = (const float*)(F.ws + WS_IDB); float* dump = (float*)(F.ws + WS_DUMP);
    float* cd = (float*)(F.ws + WS_CD);
    float* c1 = cd, *d1 = cd + NFF2, *cm = cd + 2 * NFF2, *dm = cm + NQKV, *c2 = dm + NQKV, *d2 = c2 + NFF2;
    const int nb1 = D / 32, nb0 = NFF2 / 32, nb4 = (hy ? NHY : NQKV) / 32, nb5 = D / 32;
    const int total = 2 * nb1 + 2 * nb0 + nb4 + nb5;
    for (int it = gw; it < total; it += NGW) {
        int r = it;
        if (r < 2 * nb1) { const int f = r / nb1; r -= f * nb1;
            conv_item(inp(F, 5) + (size_t)(layer * 2 + f) * FF * D, FF, D, (bf16*)(F.ws + (f ? W_OUT2 : W_OUT1)), ones, zeros, dump, dump + NQKV, zeros, 0, r, scr, F.lane); continue; }
        r -= 2 * nb1;
        if (r < 2 * nb0) { const int f = r / nb0; r -= f * nb0;
            const float* gk = f ? ln_g + (size_t)(layer * 3 + 1) * D : (layer ? ln_g + (size_t)((layer - 1) * 3 + 2) * D : ones);
            const float* bk = f ? ln_b + (size_t)(layer * 3 + 1) * D : (layer ? ln_b + (size_t)((layer - 1) * 3 + 2) * D : zeros);
            conv_item(inp(F, 4) + (size_t)(layer * 2 + f) * D * NFF2, D, NFF2, (bf16*)(F.ws + (f ? W_IN2 : W_IN1)), gk, bk, f ? c2 : c1, f ? d2 : d1, zeros, 1, r, scr, F.lane); continue; }
        r -= 2 * nb0;
        if (r < nb4) {
            const float* gk = ln_g + (size_t)(layer * 3) * D; const float* bk = ln_b + (size_t)(layer * 3) * D;
            if (hy) conv_item(inp(F, 8) + (size_t)jl * D * NHY, D, NHY, (bf16*)(F.ws + W_MIN), gk, bk, cm, dm, inp(F, 9) + (size_t)jl * NHY, 0, r, scr, F.lane);
            else conv_item(inp(F, 6) + (size_t)jl * D * NQKV, D, NQKV, (bf16*)(F.ws + W_MIN), gk, bk, cm, dm, zeros, 2, r, scr, F.lane);
            continue; }
        r -= nb4;
        conv_item((hy ? inp(F, 19) : inp(F, 7)) + (size_t)jl * D * D, D, D, (bf16*)(F.ws + W_MOUT), ones, zeros, dump, dump + NQKV, zeros, 0, r, scr, F.lane);
    }
    if (hy) {
        for (int p = gw; p < 8192 + 2048; p += NGW) { if (p < 8192) filt_pos(F, jl, 0, p); else filt_pos(F, jl, 1, p - 8192); }
        const float* w3 = inp(F, 17) + (size_t)jl * 64 * 8192; bf16* w3T = (bf16*)(F.ws + WS_W3T);
        for (int n = gw; n < 8192; n += NGW) { bf16* r = w3T + (size_t)n * 256; r[F.lane] = (bf16)f2bf(w3[(size_t)F.lane * 8192 + n]); r[64 + F.lane] = 0; r[128 + F.lane] = 0; r[192 + F.lane] = 0; }
    }
}

__device__ __forceinline__ void phase_finalize(Frame& F) {
    const float* part = (const float*)(F.ws + WS_PART); float* stats = (float*)(F.ws + WS_STATS);
    for (int row = F.vcu * (NWAVES * 64) + F.tid; row < T; row += F.G * NWAVES * 64) {
        const GAS f32x4* p = (const GAS f32x4*)(part + (size_t)row * 128);
        float s = 0.f, q = 0.f;
#pragma unroll 8
        for (int j = 0; j < 32; ++j) { const f32x4 v = p[j]; s += v.x + v.z; q += v.y + v.w; }
        const float mean = s * (1.0f / D); const float var = fmaxf(q * (1.0f / D) - mean * mean, 0.f);
        *(GAS f32x2*)(stats + 2 * (size_t)row) = (f32x2){mean, 1.0f / sqrtf(var + LN_EPS)};
    }
}

#ifdef DBG_CHECK
__device__ __forceinline__ void phase_check_qkv(Frame& F) {
    const int gw = F.vcu * NWAVES + F.wave, NGW = F.G * NWAVES;
    const float* W = inp(F, 6); const float* g = inp(F, 2); const float* b = inp(F, 3);
    const float* stats = (const float*)(F.ws + WS_STATS); const bf16* QKV = (const bf16*)(F.ws + WS_BIG + BIG_QKV);
#ifndef DBG_ROW0
#define DBG_ROW0 0
#define DBG_ROW1 T
#endif
#ifndef DBG_COL0
#define DBG_COL0 0
#define DBG_COL1 NQKV
#endif
    float worst = 0.f; unsigned nbad = 0;
#ifdef CHK_ROWS
    {
        const bf16* zbp = (const bf16*)(F.ws + WS_ZB);
        for (int s = gw; s < 8192; s += NGW) {
            const unsigned hsh = (unsigned)s * 2654435761u; const int row = (int)(hsh % (unsigned)T);
            float sm = 0.f, sq = 0.f, dz = 0.f;
            for (int k = F.lane; k < D; k += 64) { const float v = F.z[(size_t)row * D + k]; sm += v; sq += v * v; dz = fmaxf(dz, fabsf(bf2f(zbp[(size_t)row * D + k]) - v)); }
            sm = wave_sum(sm); sq = wave_sum(sq); dz = fmaxf(dz, pg8::xor32_max(dz)); dz = fmaxf(dz, pg8::swz_xor<16>(dz)); dz = fmaxf(dz, pg8::swz_xor<8>(dz)); dz = fmaxf(dz, pg8::swz_xor<4>(dz)); dz = fmaxf(dz, pg8::swz_xor<2>(dz)); dz = fmaxf(dz, pg8::swz_xor<1>(dz));
            const float mean = sm * (1.0f / D), var = sq * (1.0f / D) - mean * mean, rstd = 1.0f / sqrtf(var + LN_EPS);
            const bool bad = (CHK_ROWS == 1) ? (fabsf(mean - stats[2 * row]) > CHK_MTOL || fabsf(rstd - stats[2 * row + 1]) > CHK_RTOL * rstd) : (dz > 0.05f);
            nbad += bad ? 1u : 0u;
        }
        if (F.lane == 0 && nbad) atomicAdd((unsigned*)(F.ws + WS_CTL) + 15000, nbad);
        return;
    }
#endif
    for (int s = gw; s < 8192; s += NGW) {
        const unsigned hsh = (unsigned)s * 2654435761u; const int row = DBG_ROW0 + (int)(hsh % (unsigned)(DBG_ROW1 - DBG_ROW0)), col = DBG_COL0 + (int)((hsh >> 7) % (unsigned)(DBG_COL1 - DBG_COL0));
#ifdef CHK_HYP
        const float mean = 0.f, rstd = 1.f;
#else
        const float mean = stats[2 * row], rstd = stats[2 * row + 1];
#endif
        float acc = 0.f;
        for (int k = F.lane; k < D; k += 64) acc += ((F.z[(size_t)row * D + k] - mean) * rstd * g[k] + b[k]) * W[(size_t)k * NQKV + col];
        acc = wave_sum(acc) * (col < 6144 ? QSCALE : 1.0f);
        const float got = bf2f(QKV[(size_t)row * NQKV + col]);
        worst = fmaxf(worst, fabsf(got - acc)); nbad += (fabsf(got - acc) > DBG_THR) ? 1u : 0u;
    }
#ifdef DBG_COUNT
    if (F.lane == 0 && nbad) atomicAdd((unsigned*)(F.ws + WS_CTL) + 15000, nbad);
#else
    if (F.lane == 0) atomicMax((unsigned*)(F.ws + WS_CTL) + 15000, __builtin_bit_cast(unsigned, worst));
#endif
}
#endif
__device__ __forceinline__ void phase_final_ln(Frame& F) {
    const int gw = F.vcu * NWAVES + F.wave, NGW = F.G * NWAVES;
    const float* stats = (const float*)(F.ws + WS_STATS);
    const float* g = inp(F, 2) + (size_t)(3 * 3 + 2) * D; const float* b = inp(F, 3) + (size_t)(3 * 3 + 2) * D;
    for (int m = gw; m < T; m += NGW) {
        const float mean = stats[2 * m], rstd = stats[2 * m + 1];
        GAS f32x4* d4 = (GAS f32x4*)(F.z + (size_t)m * D) + F.lane; const GAS f32x4* g4 = (const GAS f32x4*)g + F.lane; const GAS f32x4* b4 = (const GAS f32x4*)b + F.lane;
        float dbg = 0.f;
#ifdef DBG_CHECK
        #ifdef DBG_COUNT
        const float dbgval = (float)((const unsigned*)(F.ws + WS_CTL))[15000] * DBG_CHECK_SCALE;
#else
        const float dbgval = __builtin_bit_cast(float, ((const unsigned*)(F.ws + WS_CTL))[15000]) * DBG_CHECK_SCALE;
#endif
#endif
#ifdef DBG_BUF
        {
            const bf16* bp = (const bf16*)(F.ws + WS_BIG + DBG_OFF) + (size_t)m * DBG_PITCH; float s = 0.f;
            for (int c = F.lane; c < DBG_COLS; c += 64) s += bf2f(bp[c]) * (float)(1 + (c & 7));
            dbg = wave_sum(s) * 0.01f;
        }
#endif
#pragma unroll
        for (int j = 0; j < 8; ++j) { const f32x4 v = d4[64 * j] + dbg; d4[64 * j] = (v - mean) * rstd * g4[64 * j] + b4[64 * j];
#ifdef DBG_CHECK
            d4[64 * j] = (f32x4){dbgval, dbgval, dbgval, dbgval};
#endif
        }
    }
}

__device__ __forceinline__ void transpose_tile(const bf16* src, size_t sp, bf16* dst, size_t dp, int r0, int c0, LAS unsigned char* scr, int lane) {
#pragma unroll
    for (int i = 0; i < 8; ++i) { const int row = (lane >> 3) + 8 * i, ch = lane & 7;
        const v4u v = *(const GAS v4u*)(src + (size_t)(r0 + row) * sp + c0 + 8 * ch);
        LAS unsigned* w = (LAS unsigned*)(scr + row * 132 + ch * 16); w[0] = v.x; w[1] = v.y; w[2] = v.z; w[3] = v.w; }
    LDS_WAIT(); asm volatile("" ::: "memory");
    const LAS unsigned short* rd = (const LAS unsigned short*)(scr + lane * 132);
#pragma unroll 8
    for (int c = 0; c < 64; ++c) dst[(size_t)(c0 + c) * dp + r0 + lane] = rd[c];
    LDS_WAIT(); asm volatile("" ::: "memory");
}
__device__ __forceinline__ void phase_transpose(Frame& F, const bf16* src, int R, int C, bf16* dst) {
    LAS unsigned char* scr = F.lds + RING_OFF + F.wave * 16384;
    const int gw = F.vcu * NWAVES + F.wave, NGW = F.G * NWAVES, tr = R / 64, tc = C / 64;
    for (int it = gw; it < tr * tc; it += NGW) { const int a = it / tc, b = it % tc; transpose_tile(src, (size_t)C, dst, (size_t)R, 64 * a, 64 * b, scr, F.lane); }
}
__device__ __forceinline__ void fft_forward(LAS cpx* X, int tid, int logN) {
    int logM = logN;
    for (; logM >= 4; logM -= 4) { fft_pass<16, false>(X, tid, NWAVES * 64, logM); __syncthreads(); }
    if (logM == 2) { fft_pass<4, false>(X, tid, NWAVES * 64, 2); __syncthreads(); }
}
__device__ __forceinline__ void fft_inverse(LAS cpx* X, int tid, int logN) {
    const int rem = logN & 3;
    if (rem == 2) { fft_pass<4, true>(X, tid, NWAVES * 64, 2); __syncthreads(); }
    for (int logM = 4 + rem; logM <= logN; logM += 4) { fft_pass<16, true>(X, tid, NWAVES * 64, logM); __syncthreads(); }
}
template <int VAR> __device__ __forceinline__ void spec_unit(Frame& F, int jl, int c) {
    constexpr int L = VAR ? 2048 : 8192, N = 2 * L, LOGN = VAR ? 12 : 14, NP = L / 512;
    LAS cpx* X = (LAS cpx*)(F.lds + RING_OFF);
    int tid = F.tid; asm volatile("" : "+v"(tid));
    const float* taps = (const float*)(F.ws + WS_TAPS) + (size_t)c * 10240 + (VAR ? 8192 : 0);
    float acc[NP][4];
    float n0 = 0.f, n1 = 0.f;
#pragma unroll
    for (int k = 0; k < NP; ++k) {
#pragma unroll
        for (int f = 0; f < 4; ++f) acc[k][f] = taps[(size_t)f * 2048 * 10240 + tid + 512 * k];
        n0 += fabsf(acc[k][0]) + fabsf(acc[k][1]); n1 += fabsf(acc[k][2]) + fabsf(acc[k][3]); }
    block_sum2(F, n0, n1);
    const float i0 = 1.0f / n0, i1 = 1.0f / n1;
#pragma unroll
    for (int k = 0; k < NP; ++k) { acc[k][0] *= i0; acc[k][1] *= i0; acc[k][2] *= i1; acc[k][3] *= i1; }
    cpx* spec = (cpx*)(F.ws + WS_BIG + (VAR ? BIG_SPEC1 : BIG_SPEC0));
    if (VAR == 0) {
        float* tmp = (float*)(spec + ((size_t)1 * D + c) * N);
#pragma unroll
        for (int k = 0; k < NP; ++k) *(GAS f32x2*)(tmp + 2 * (tid + 512 * k)) = (f32x2){acc[k][2], acc[k][3]};
        __syncthreads();
#pragma unroll
        for (int k = 0; k < NP; ++k) { const int t = tid + 512 * k; const float hf = acc[k][0], hb = acc[k][1];
            if (t == 0) { X[pidx(0)] = cpx{hf + hb, 0.f}; X[pidx(L)] = cpx{0.f, 0.f}; }
            else { X[pidx(t)] = cpx{hf, 0.f}; X[pidx(N - t)] = cpx{hb, 0.f}; } }
        __syncthreads();
        fft_forward(X, tid, LOGN);
        { cpx* dst = spec + ((size_t)0 * D + c) * N; for (int p = tid; p < N; p += 512) dst[p] = X[pidx(p)]; }
        float h1[NP][2];
#pragma unroll
        for (int k = 0; k < NP; ++k) { const f32x2 v = *(const GAS f32x2*)(tmp + 2 * (tid + 512 * k)); h1[k][0] = v.x; h1[k][1] = v.y; }
        __syncthreads();
#pragma unroll
        for (int k = 0; k < NP; ++k) { const int t = tid + 512 * k; const float hf = h1[k][0], hb = h1[k][1];
            if (t == 0) { X[pidx(0)] = cpx{hf + hb, 0.f}; X[pidx(L)] = cpx{0.f, 0.f}; }
            else { X[pidx(t)] = cpx{hf, 0.f}; X[pidx(N - t)] = cpx{hb, 0.f}; } }
        __syncthreads();
        fft_forward(X, tid, LOGN);
        { cpx* dst = spec + ((size_t)1 * D + c) * N; for (int p = tid; p < N; p += 512) dst[p] = X[pidx(p)]; }
    } else {
        __syncthreads();
#pragma unroll
        for (int k = 0; k < NP; ++k) { const int t = tid + 512 * k;
#pragma unroll
            for (int o = 0; o < 2; ++o) { const float hf = acc[k][2 * o], hb = acc[k][2 * o + 1];
                if (t == 0) { X[pidx(o * N)] = cpx{hf + hb, 0.f}; X[pidx(o * N + L)] = cpx{0.f, 0.f}; }
                else { X[pidx(o * N + t)] = cpx{hf, 0.f}; X[pidx(o * N + N - t)] = cpx{hb, 0.f}; } } }
        for (int p = 2 * N + tid; p < 16384; p += 512) X[pidx(p)] = cpx{0.f, 0.f};
        __syncthreads();
        fft_forward(X, tid, LOGN);
#pragma unroll
        for (int o = 0; o < 2; ++o) { cpx* dst = spec + ((size_t)o * D + c) * N; for (int p = tid; p < N; p += 512) dst[p] = X[pidx(o * N + p)]; }
    }
}
__device__ __forceinline__ void phase_spectra(Frame& F, int jl) {
    for (int u = F.vcu; u < 2 * D; u += F.G) { if (u < D) spec_unit<0>(F, jl, u); else spec_unit<1>(F, jl, u - D); }
    __syncthreads();
}
__device__ __forceinline__ void load_conv16(const bf16* seq, int t0, int L, float w0, float w1, float w2, float cb, float (&out)[16]) {
    const v4u a = *(const GAS v4u*)(seq + t0), b = *(const GAS v4u*)(seq + t0 + 8);
    float u[18];
    u[0] = (t0 > 0) ? bf2f(seq[t0 - 1]) : 0.f; u[17] = (t0 + 16 < L) ? bf2f(seq[t0 + 16]) : 0.f;
    u[1] = bf2f(a.x & 0xffffu); u[2] = bf2f(a.x >> 16); u[3] = bf2f(a.y & 0xffffu); u[4] = bf2f(a.y >> 16); u[5] = bf2f(a.z & 0xffffu); u[6] = bf2f(a.z >> 16); u[7] = bf2f(a.w & 0xffffu); u[8] = bf2f(a.w >> 16);
    u[9] = bf2f(b.x & 0xffffu); u[10] = bf2f(b.x >> 16); u[11] = bf2f(b.y & 0xffffu); u[12] = bf2f(b.y >> 16); u[13] = bf2f(b.z & 0xffffu); u[14] = bf2f(b.z >> 16); u[15] = bf2f(b.w & 0xffffu); u[16] = bf2f(b.w >> 16);
#pragma unroll
    for (int i = 0; i < 16; ++i) out[i] = w0 * u[i] + w1 * u[i + 1] + w2 * u[i + 2] + cb;
}
template <int VAR> __device__ __forceinline__ void conv_unit(Frame& F, int jl, int c, int pair) {
    constexpr int L = VAR ? 2048 : 8192, N = 2 * L, LOGN = VAR ? 12 : 14, TPS = VAR ? 128 : 512;
    LAS cpx* X = (LAS cpx*)(F.lds + RING_OFF);
    int tid = F.tid; asm volatile("" : "+v"(tid));
    const int seg = tid / TPS, t0 = (tid % TPS) * 16;
    const int rowA = VAR ? T_PROMPT + (2 * seg) * L : (2 * pair) * L, rowB = rowA + L;
    const bf16* UT = (const bf16*)(F.ws + WS_BIG + BIG_UT); bf16* Z2T = (bf16*)(F.ws + WS_BIG + BIG_Z2T);
    const float* cw = inp(F, 10) + (size_t)jl * 3 * NHY; const float* cbv = inp(F, 11) + (size_t)jl * NHY; const float* skip = inp(F, 18) + (size_t)jl * 2 * D;
    const cpx* spec = (const cpx*)(F.ws + WS_BIG + (VAR ? BIG_SPEC1 : BIG_SPEC0));
#ifndef CONV_SCALE
#define CONV_SCALE 1.0f
#endif
    const float invN = CONV_SCALE / (float)N;
    float va[16], vb[16];
    { const int ch = c; const float w0 = cw[ch], w1 = cw[NHY + ch], w2 = cw[2 * NHY + ch], cb = cbv[ch];
      load_conv16(UT + (size_t)ch * T + rowA, t0, L, w0, w1, w2, cb, va); load_conv16(UT + (size_t)ch * T + rowB, t0, L, w0, w1, w2, cb, vb); }
    __syncthreads();
#pragma unroll
    for (int i = 0; i < 16; ++i) { X[pidx(seg * N + t0 + i)] = cpx{va[i], vb[i]}; X[pidx(seg * N + L + t0 + i)] = cpx{0.f, 0.f}; }
    __syncthreads();
    fft_forward(X, tid, LOGN);
    { const cpx* H = spec + ((size_t)0 * D + c) * N; for (int p = tid; p < 16384; p += 512) X[pidx(p)] = cmul(X[pidx(p)], H[p & (N - 1)]); }
    __syncthreads();
    fft_inverse(X, tid, LOGN);
    {   float ga[16], gb[16];
        const int ch = D + c; const float w0 = cw[ch], w1 = cw[NHY + ch], w2 = cw[2 * NHY + ch], cb = cbv[ch];
        load_conv16(UT + (size_t)ch * T + rowA, t0, L, w0, w1, w2, cb, ga); load_conv16(UT + (size_t)ch * T + rowB, t0, L, w0, w1, w2, cb, gb);
        const float sk = skip[c];
#pragma unroll
        for (int i = 0; i < 16; ++i) { const cpx y = X[pidx(seg * N + t0 + i)]; va[i] = ga[i] * (y.x * invN + sk * va[i]); vb[i] = gb[i] * (y.y * invN + sk * vb[i]); }
#pragma unroll
        for (int i = 0; i < 16; ++i) { X[pidx(seg * N + t0 + i)] = cpx{va[i], vb[i]}; X[pidx(seg * N + L + t0 + i)] = cpx{0.f, 0.f}; }
    }
    __syncthreads();
    fft_forward(X, tid, LOGN);
    { const cpx* H = spec + ((size_t)1 * D + c) * N; for (int p = tid; p < 16384; p += 512) X[pidx(p)] = cmul(X[pidx(p)], H[p & (N - 1)]); }
    __syncthreads();
    fft_inverse(X, tid, LOGN);
    {   float ga[16], gb[16];
        const int ch = 2 * D + c; const float w0 = cw[ch], w1 = cw[NHY + ch], w2 = cw[2 * NHY + ch], cb = cbv[ch];
        load_conv16(UT + (size_t)ch * T + rowA, t0, L, w0, w1, w2, cb, ga); load_conv16(UT + (size_t)ch * T + rowB, t0, L, w0, w1, w2, cb, gb);
        const float sk = skip[D + c];
        float ra[16], rb[16];
#pragma unroll
        for (int i = 0; i < 16; ++i) { const cpx y = X[pidx(seg * N + t0 + i)]; ra[i] = ga[i] * (y.x * invN + sk * va[i]); rb[i] = gb[i] * (y.y * invN + sk * vb[i]); }
        v4u o0, o1;
        o0.x = pk2(ra[0], ra[1]); o0.y = pk2(ra[2], ra[3]); o0.z = pk2(ra[4], ra[5]); o0.w = pk2(ra[6], ra[7]); o1.x = pk2(ra[8], ra[9]); o1.y = pk2(ra[10], ra[11]); o1.z = pk2(ra[12], ra[13]); o1.w = pk2(ra[14], ra[15]);
        GAS v4u* da = (GAS v4u*)(Z2T + (size_t)c * T + rowA + t0); da[0] = o0; da[1] = o1;
        o0.x = pk2(rb[0], rb[1]); o0.y = pk2(rb[2], rb[3]); o0.z = pk2(rb[4], rb[5]); o0.w = pk2(rb[6], rb[7]); o1.x = pk2(rb[8], rb[9]); o1.y = pk2(rb[10], rb[11]); o1.z = pk2(rb[12], rb[13]); o1.w = pk2(rb[14], rb[15]);
        GAS v4u* db = (GAS v4u*)(Z2T + (size_t)c * T + rowB + t0); db[0] = o0; db[1] = o1;
    }
}
__device__ __forceinline__ void phase_conv(Frame& F, int jl) {
    for (int u = F.vcu; u < 3 * D; u += F.G) { if (u < 2 * D) conv_unit<0>(F, jl, u >> 1, u & 1); else conv_unit<1>(F, jl, u - 2 * D, 0); }
    __syncthreads();
}
__device__ __forceinline__ unsigned voff_b(unsigned row, unsigned ch) { return 256u * row + 16u * (ch ^ (((row & 3u) << 2) | ((row >> 2) & 3u))); }
__device__ __forceinline__ s16x4 vtr(const LAS unsigned char* p) { typedef short v4i16_t __attribute__((ext_vector_type(4))); return __builtin_bit_cast(s16x4, __builtin_amdgcn_ds_read_tr16_b64_v4i16((LAS v4i16_t*)p)); }
__device__ __forceinline__ unsigned cvtpk(float lo, float hi) { typedef __bf16 bf16x2_t __attribute__((ext_vector_type(2))); f32x2 v = {lo, hi}; bf16x2_t b = __builtin_convertvector(v, bf16x2_t); return __builtin_bit_cast(unsigned, b); }
__device__ __forceinline__ void dma16(const void* gsrc, LAS unsigned char* lds_dst) {
    unsigned keep; const unsigned dst = __builtin_amdgcn_readfirstlane((unsigned)(unsigned long long)lds_dst);
    asm volatile("s_mov_b32 %0, m0\n\ts_mov_b32 m0, %2\n\ts_nop 0\n\tglobal_load_lds_dwordx4 %1, off\n\ts_mov_b32 m0, %0" : "=&s"(keep) : "v"(gsrc), "s"(dst) : "memory");
}
struct TileDesc { int g, kt0; };
constexpr int ATT_NT = 28;
__device__ __forceinline__ TileDesc attn_tile(int it, int T0w) {
    TileDesc t;
    if (it < 12) { t.g = 0; t.kt0 = T0w - 64 + 32 * it; }
    else if (it < 18) { t.g = 1; t.kt0 = T0w - 256 + 128 * (it - 12); }
    else { const int e = it - 18, ch = e / 5, tl = e % 5; t.g = 2; t.kt0 = T0w + 8 * ch - 1024 + 512 * tl; }
    return t;
}
__device__ __forceinline__ void attn_wave_task(const bf16* QKV, bf16* AO, LAS unsigned char* vimg, int blk, int h, int w, int lane) {
    const int r = lane & 31, hh = lane >> 5;
    const int T0 = blk * 256;
    int seq_start, seq_len;
    if (T0 < T_PROMPT) { seq_start = T0 & ~8191; seq_len = 8192; } else { seq_start = T_PROMPT + ((T0 - T_PROMPT) & ~2047); seq_len = 2048; }
    const int seq_end = seq_start + seq_len;
    const int T0w = T0 + w, qt = T0w + 8 * r;
    const float slope2 = __builtin_amdgcn_exp2f(-0.5f * (float)(h + 1)) * LOG2E;
    f32x16 o[4];
#pragma unroll
    for (int dt = 0; dt < 4; ++dt)
#pragma unroll
        for (int i = 0; i < 16; ++i) o[dt][i] = 0.f;
    float m_run = -1e30f, l_run = 0.f;
    bf16x8 qf[8], kf[8];
    const bf16* hb = QKV + h * 128;
    auto issue_tile = [&](const TileDesc& td, LAS unsigned char* img_dst) {
        const int d = 1 << (2 * td.g);
        const bf16* Kb = hb + 6144 + td.g * 2048; const bf16* Vb = hb + 12288 + td.g * 2048;
#pragma unroll
        for (int i = 0; i < 8; ++i) { const int row = 4 * i + (lane >> 4); int vt = td.kt0 + row * d; vt = vt < seq_start ? seq_start : (vt >= seq_end ? seq_end - 1 : vt);
            const int lch = (lane & 15) ^ (((row & 3) << 2) | ((row >> 2) & 3));
            dma16(Vb + (size_t)vt * NQKV + 8 * lch, img_dst + i * 1024); }
        int kt = td.kt0 + r * d; kt = kt < seq_start ? seq_start : (kt >= seq_end ? seq_end - 1 : kt);
        const bf16* kp = Kb + (size_t)kt * NQKV + 8 * hh;
#pragma unroll
        for (int s = 0; s < 8; ++s) kf[s] = *(const GAS bf16x8*)(kp + 16 * s);
    };
    auto load_q = [&](int g) { const bf16* qp = hb + g * 2048 + (size_t)qt * NQKV + 8 * hh;
#pragma unroll
        for (int s = 0; s < 8; ++s) qf[s] = *(const GAS bf16x8*)(qp + 16 * s); };
    TileDesc cur = attn_tile(0, T0w);
    load_q(0);
    issue_tile(cur, vimg);
    for (int it = 0; it < ATT_NT; ++it) {
        LAS unsigned char* img = vimg + (it & 1) * 8192;
        const int d = 1 << (2 * cur.g), win = 64 * d, kt0 = cur.kt0;
        f32x16 st;
#pragma unroll
        for (int i = 0; i < 16; ++i) st[i] = 0.f;
#pragma unroll
        for (int s = 0; s < 8; ++s) st = __builtin_amdgcn_mfma_f32_32x32x16_bf16(kf[s], qf[s], st, 0, 0, 0);
        if (it + 1 < ATT_NT) { const TileDesc nx = attn_tile(it + 1, T0w); if (nx.g != cur.g) load_q(nx.g); issue_tile(nx, vimg + ((it + 1) & 1) * 8192); cur = nx; }
        const int dl0 = kt0 + 4 * hh * d - qt;
        const bool res_ok = (dl0 & (d - 1)) == 0;
        const int lo_i = max(-win, seq_start - qt), hi_i = min(win, seq_end - 1 - qt);
        const float flo = res_ok ? (float)lo_i : 1e30f, fhi = (float)hi_i, fdl0 = (float)dl0, fd = (float)d;
        float mloc = -1e30f;
#pragma unroll
        for (int i = 0; i < 16; ++i) { const float fdl = fdl0 + (float)((i & 3) + 8 * (i >> 2)) * fd;
            const float s = st[i] - slope2 * __builtin_fabsf(fdl);
            const bool ok = (fdl >= flo) && (fdl <= fhi);
            const float sm = ok ? s : -1e30f; st[i] = sm; mloc = fmaxf(mloc, sm); }
        mloc = pg8::xor32_max(mloc);
        const float m_new = fmaxf(m_run, mloc);
        const float m_use = fmaxf(m_new, -1e20f);
        float ls = 0.f;
#pragma unroll
        for (int i = 0; i < 16; ++i) { const float pv = __builtin_amdgcn_exp2f(st[i] - m_use); st[i] = pv; ls += pv; }
        ls = pg8::xor32_sum(ls);
        if (__any(m_new != m_run)) {
            const float alpha = __builtin_amdgcn_exp2f(m_run - m_new);
            l_run *= alpha;
#pragma unroll
            for (int dt = 0; dt < 4; ++dt)
#pragma unroll
                for (int i = 0; i < 16; ++i) o[dt][i] *= alpha;
        }
        l_run += ls; m_run = m_new;
        bf16x8 pb[2];
#pragma unroll
        for (int s2 = 0; s2 < 2; ++s2) { v4u w; w.x = cvtpk(st[8 * s2 + 0], st[8 * s2 + 1]); w.y = cvtpk(st[8 * s2 + 2], st[8 * s2 + 3]); w.z = cvtpk(st[8 * s2 + 4], st[8 * s2 + 5]); w.w = cvtpk(st[8 * s2 + 6], st[8 * s2 + 7]); pb[s2] = __builtin_bit_cast(bf16x8, w); }
        const int q4 = (lane & 15) >> 2, p4 = lane & 3, blk16 = (lane >> 4) & 1;
#pragma unroll
        for (int dt = 0; dt < 4; ++dt)
#pragma unroll
            for (int s2 = 0; s2 < 2; ++s2) {
                const unsigned chn = 4 * dt + 2 * blk16 + (p4 >> 1);
                const s16x4 lo = vtr(img + voff_b(16 * s2 + 4 * hh + q4, chn) + 8 * (p4 & 1));
                const s16x4 hi = vtr(img + voff_b(16 * s2 + 8 + 4 * hh + q4, chn) + 8 * (p4 & 1));
                const bf16x8 va = __builtin_shufflevector(lo, hi, 0, 1, 2, 3, 4, 5, 6, 7);
                o[dt] = __builtin_amdgcn_mfma_f32_32x32x16_bf16(va, pb[s2], o[dt], 0, 0, 0);
            }
    }
    const float inv = 1.0f / l_run;
    bf16* op = AO + (size_t)qt * D + h * 128 + 4 * hh;
#pragma unroll
    for (int dt = 0; dt < 4; ++dt)
#pragma unroll
        for (int i4 = 0; i4 < 4; ++i4) { v2u w; w.x = cvtpk(o[dt][4 * i4] * inv, o[dt][4 * i4 + 1] * inv); w.y = cvtpk(o[dt][4 * i4 + 2] * inv, o[dt][4 * i4 + 3] * inv);
            *(GAS v2u*)(op + 32 * dt + 8 * i4) = w; }
}
__device__ __forceinline__ void phase_attention(Frame& F) {
    const bf16* QKV = (const bf16*)(F.ws + WS_BIG + BIG_QKV); bf16* AO = (bf16*)(F.ws + WS_BIG + BIG_AO);
    LAS unsigned char* vimg = F.lds + RING_OFF + F.wave * 16384;
    for (int j = F.vcu; j < (T / 256) * 16; j += F.G) {
        const int h = j & 15, blk = j >> 4;
        attn_wave_task(QKV, AO, vimg, blk, h, F.wave, F.lane);
    }
}

#ifdef ATTN_NAIVE
__device__ __forceinline__ void phase_attention_naive(Frame& F) {
    const bf16* QKV = (const bf16*)(F.ws + WS_BIG + BIG_QKV); bf16* AO = (bf16*)(F.ws + WS_BIG + BIG_AO);
    const int gw = F.vcu * NWAVES + F.wave, NGW = F.G * NWAVES, lane = F.lane;
    for (int p = gw; p < T * 16; p += NGW) {
        const int tok = p >> 4, h = p & 15;
        int seq_start, seq_len;
        if (tok < T_PROMPT) { seq_start = tok & ~8191; seq_len = 8192; } else { seq_start = T_PROMPT + ((tok - T_PROMPT) & ~2047); seq_len = 2048; }
        const int seq_end = seq_start + seq_len;
        const float slope2 = __builtin_amdgcn_exp2f(-0.5f * (float)(h + 1)) * LOG2E;
        float m = -1e30f, l = 0.f, o0 = 0.f, o1 = 0.f;
        for (int g = 0; g < 3; ++g) {
            const int d = 1 << (2 * g);
            const unsigned qw = *(const GAS unsigned*)(QKV + (size_t)tok * NQKV + g * 2048 + h * 128 + 2 * lane);
            const float q0 = bf2f(qw & 0xffffu), q1 = bf2f(qw >> 16);
            for (int j = -64; j <= 64; ++j) {
                const int kt = tok + j * d;
                if (kt < seq_start || kt >= seq_end) continue;
                const unsigned kw = *(const GAS unsigned*)(QKV + (size_t)kt * NQKV + 6144 + g * 2048 + h * 128 + 2 * lane);
                const unsigned vw = *(const GAS unsigned*)(QKV + (size_t)kt * NQKV + 12288 + g * 2048 + h * 128 + 2 * lane);
                const float s = wave_sum(q0 * bf2f(kw & 0xffffu) + q1 * bf2f(kw >> 16)) - slope2 * (float)((j < 0 ? -j : j) * d);
                const float mn = fmaxf(m, s), al = __builtin_amdgcn_exp2f(m - mn), pv = __builtin_amdgcn_exp2f(s - mn);
                l = l * al + pv; o0 = o0 * al + pv * bf2f(vw & 0xffffu); o1 = o1 * al + pv * bf2f(vw >> 16); m = mn;
            }
        }
        const float inv = 1.0f / l;
        *(GAS unsigned*)(AO + (size_t)tok * D + h * 128 + 2 * lane) = pk2(o0 * inv, o1 * inv);
    }
}
#endif
constexpr int NPHASE = 54;
#ifndef DUP_PHASE
#define DUP_PHASE (-1)
#define DUP_N 0
#endif
#define REPS(id) for (int rep_ = 0; rep_ < ((DUP_PHASE) == (id) ? 1 + (DUP_N) : 1); ++rep_)
#ifndef ZERO_HY
#define ZERO_HY 0
#endif
#ifndef ZERO_AT
#define ZERO_AT 0
#endif
#ifndef AT_SCALE
#define AT_SCALE 1.0f
#endif
#ifndef HY_SCALE
#define HY_SCALE 1.0f
#endif
#define MIXSCALE(hy) ((hy) ? (ZERO_HY ? 0.0f : HY_SCALE) : (ZERO_AT ? 0.0f : AT_SCALE))
struct Args { const float* in[21]; float* out; unsigned char* ws; int ph_lo, ph_hi; };
static_assert(sizeof(Args) == 21 * 8 + 8 + 8 + 8, "Args has no padding");
__global__ void __launch_bounds__(NWAVES * 64, 2) fwd_kernel(Args args) {
    extern __shared__ __attribute__((aligned(16))) unsigned char lds[];
    unsigned char* const ws0 = args.ws;
    const int wave0 = __builtin_amdgcn_readfirstlane(threadIdx.x >> 6);
    volatile LAS unsigned* MISC = (volatile LAS unsigned*)((LAS unsigned char*)lds + MISC_OFF);
    if (threadIdx.x < 64) MISC[threadIdx.x] = 0u;
    if (threadIdx.x == 64) {
#pragma unroll
        for (int i = 0; i < 21; ++i) ((LAS unsigned long long*)((LAS unsigned char*)lds + PTR_OFF))[i] = (unsigned long long)args.in[i];
    }
    __syncthreads();
    XcdBarrier bar = xcd_barrier_post((unsigned*)(ws0 + WS_CTL), MISC);
#define FRAME() Frame F = make_frame(lds, args.ws, args.out, wave0)
    const int lo = args.ph_lo, hi = args.ph_hi;
#define RUN(id) (lo <= (id) && (id) < hi)
#define SEAM(id) do { if ((id) + 1 < hi) xcd_barrier(bar); } while (0)

#define ZB ((bf16*)(F.ws + WS_ZB))
#define STATS ((float*)(F.ws + WS_STATS))
#define PART ((float*)(F.ws + WS_PART))
#define CDV(off) ((float*)(F.ws + WS_CD) + (off))
#define HID ((bf16*)(F.ws + WS_BIG + BIG_HID))
    constexpr int O_C1 = 0, O_D1 = NFF2, O_CM = 2 * NFF2, O_DM = 2 * NFF2 + NQKV, O_C2 = 2 * NFF2 + 2 * NQKV, O_D2 = 3 * NFF2 + 2 * NQKV;

    if (RUN(0)) { FRAME(); phase_init(F); SEAM(0); }

#pragma unroll
    for (int layer = 0; layer < DEPTH; ++layer) {
        const int pb = 1 + 13 * layer; const bool hy = (layer & 1) != 0; const int jl = layer >> 1;
        if (RUN(pb + 0)) { FRAME(); REPS(0) phase_convert(F, layer); SEAM(pb + 0); }

        if (RUN(pb + 1)) {
            if (hy) {
                FRAME();
                pg8::Gemm gt{(const bf16*)(F.ws + WS_W3T), (const bf16*)(F.ws + WS_H2B), 8192, 10240, 256}; pg8::StaticOrder St; St.init(8192, 10240, F.G, F.bx);
                pg8::EpiTaps Et{(float*)(F.ws + WS_TAPS), MIN_DECAY, (MAX_DECAY - MIN_DECAY) / 2047.0f};
                pg8::gemm_phase<pg8::EpiTaps, pg8::StaticOrder, PG8_ALIGN, PG8_SP2>(F.lds + RING_OFF, gt, St, Et, F.tid);
            }
            FRAME();
            pg8::Gemm g{ZB, (const bf16*)(F.ws + W_IN1), T, NFF2, D}; pg8::StaticOrder S; S.init(T, NFF2, F.G, F.bx);
            pg8::EpiSwiglu E{HID, FF, STATS, CDV(O_C1), CDV(O_D1)};
            REPS(1) pg8::gemm_phase<pg8::EpiSwiglu, pg8::StaticOrder, PG8_ALIGN, PG8_SP2>(F.lds + RING_OFF, g, S, E, F.tid);
            SEAM(pb + 1);
        }
        if (RUN(pb + 2)) {
            FRAME();
            pg8::Gemm g{HID, (const bf16*)(F.ws + W_OUT1), T, D, FF}; pg8::StaticOrder S; S.init(T, D, F.G, F.bx);
            const float* g0 = layer ? inp(F, 2) + (size_t)((layer - 1) * 3 + 2) * D : (const float*)(F.ws + WS_IDG); const float* b0 = layer ? inp(F, 3) + (size_t)((layer - 1) * 3 + 2) * D : (const float*)(F.ws + WS_IDB);
            pg8::EpiResid E{F.z, ZB, STATS, g0, b0, (const float*)(F.ws + WS_IDB), PART, 0.5f, 0};
            pg8::gemm_phase<pg8::EpiResid, pg8::StaticOrder, PG8_ALIGN, PG8_SP2>(F.lds + RING_OFF, g, S, E, F.tid);
            SEAM(pb + 2);
        }
        if (RUN(pb + 3)) { FRAME(); REPS(3) phase_finalize(F); SEAM(pb + 3); }

        if (RUN(pb + 4)) {
            FRAME(); const int N = hy ? NHY : NQKV;
            pg8::Gemm g{ZB, (const bf16*)(F.ws + W_MIN), T, N, D}; pg8::StaticOrder S; S.init(T, N, F.G, F.bx);
            pg8::EpiLnBf16 E{(bf16*)(F.ws + WS_BIG), N, STATS, CDV(O_CM), CDV(O_DM)};
            REPS(4) pg8::gemm_phase<pg8::EpiLnBf16, pg8::StaticOrder, PG8_ALIGN, PG8_SP2>(F.lds + RING_OFF, g, S, E, F.tid);
            SEAM(pb + 4);
        }
        if (RUN(pb + 5)) {
            FRAME();
#ifdef ATTN_NAIVE
            if (!hy) phase_attention_naive(F);
#else
            if (!hy) { REPS(5) phase_attention(F); }
#endif
            else { REPS(15) phase_spectra(F, jl); REPS(25) phase_transpose(F, (const bf16*)(F.ws + WS_BIG + BIG_U), T, NHY, (bf16*)(F.ws + WS_BIG + BIG_UT)); }
            SEAM(pb + 5);
        }
        if (hy) {
            if (RUN(pb + 6)) { FRAME(); REPS(6) phase_conv(F, jl); SEAM(pb + 6); }
            if (RUN(pb + 7)) { FRAME(); REPS(7) phase_transpose(F, (const bf16*)(F.ws + WS_BIG + BIG_Z2T), D, T, (bf16*)(F.ws + WS_BIG + BIG_Z2)); SEAM(pb + 7); }
        }
        if (RUN(pb + 8)) {
            FRAME();
            const bf16* A = hy ? (const bf16*)(F.ws + WS_BIG + BIG_Z2) : (const bf16*)(F.ws + WS_BIG + BIG_AO);
            pg8::Gemm g{A, (const bf16*)(F.ws + W_MOUT), T, D, D}; pg8::StaticOrder S; S.init(T, D, F.G, F.bx);
            pg8::EpiResid E{F.z, ZB, STATS, inp(F, 2) + (size_t)(layer * 3) * D, inp(F, 3) + (size_t)(layer * 3) * D, hy ? inp(F, 20) + (size_t)jl * D : (const float*)(F.ws + WS_IDB), PART, MIXSCALE(hy), 0};
            pg8::gemm_phase<pg8::EpiResid, pg8::StaticOrder, PG8_ALIGN, PG8_SP2>(F.lds + RING_OFF, g, S, E, F.tid);
            SEAM(pb + 8);
        }
        if (RUN(pb + 9)) { FRAME(); phase_finalize(F); SEAM(pb + 9); }

        if (RUN(pb + 10)) {
            FRAME();
            pg8::Gemm g{ZB, (const bf16*)(F.ws + W_IN2), T, NFF2, D}; pg8::StaticOrder S; S.init(T, NFF2, F.G, F.bx);
            pg8::EpiSwiglu E{HID, FF, STATS, CDV(O_C2), CDV(O_D2)};
            pg8::gemm_phase<pg8::EpiSwiglu, pg8::StaticOrder, PG8_ALIGN, PG8_SP2>(F.lds + RING_OFF, g, S, E, F.tid);
            SEAM(pb + 10);
        }
        if (RUN(pb + 11)) {
            FRAME();
            pg8::Gemm g{HID, (const bf16*)(F.ws + W_OUT2), T, D, FF}; pg8::StaticOrder S; S.init(T, D, F.G, F.bx);
            pg8::EpiResid E{F.z, ZB, STATS, inp(F, 2) + (size_t)(layer * 3 + 1) * D, inp(F, 3) + (size_t)(layer * 3 + 1) * D, (const float*)(F.ws + WS_IDB), PART, 0.5f, 0};
            pg8::gemm_phase<pg8::EpiResid, pg8::StaticOrder, PG8_ALIGN, PG8_SP2>(F.lds + RING_OFF, g, S, E, F.tid);
            SEAM(pb + 11);
        }
        if (RUN(pb + 12)) { FRAME(); phase_finalize(F); SEAM(pb + 12); }
    }
#ifdef DBG_CHECK
    if (RUN(NPHASE - 2)) { FRAME(); phase_check_qkv(F); SEAM(NPHASE - 2); }
#endif
    if (RUN(NPHASE - 1)) { FRAME(); phase_final_ln(F); }
#undef RUN
#undef SEAM
#undef FRAME
}


#ifdef PHASE_PROBE
#define PROBE_FRAME() extern __shared__ __attribute__((aligned(16))) unsigned char lds[]; Frame F = make_frame(lds, args.ws, args.out, __builtin_amdgcn_readfirstlane(threadIdx.x >> 6));
__global__ void __launch_bounds__(NWAVES * 64, 2) probe_init(Args args) { PROBE_FRAME(); phase_init(F); }
__global__ void __launch_bounds__(NWAVES * 64, 2) probe_convert(Args args) { PROBE_FRAME(); phase_convert(F, args.ph_lo); }
__global__ void __launch_bounds__(NWAVES * 64, 2) probe_finalize(Args args) { PROBE_FRAME(); phase_finalize(F); phase_final_ln(F); }
__global__ void __launch_bounds__(NWAVES * 64, 2) probe_transpose(Args args) { PROBE_FRAME(); phase_transpose(F, (const bf16*)(F.ws + WS_BIG + BIG_U), T, NHY, (bf16*)(F.ws + WS_BIG + BIG_UT)); }
__global__ void __launch_bounds__(NWAVES * 64, 2) probe_spectra(Args args) { PROBE_FRAME(); phase_spectra(F, args.ph_lo); }
__global__ void __launch_bounds__(NWAVES * 64, 2) probe_conv(Args args) { PROBE_FRAME(); phase_conv(F, args.ph_lo); }
__global__ void __launch_bounds__(NWAVES * 64, 2) probe_attn(Args args) { PROBE_FRAME(); phase_attention(F); }
__global__ void __launch_bounds__(NWAVES * 64, 2) probe_gemm_swiglu(Args args) { PROBE_FRAME(); pg8::Gemm g{(const bf16*)F.ws, (const bf16*)(F.ws + W_IN1), T, NFF2, D}; pg8::StaticOrder S; S.init(T, NFF2, F.G, F.bx); pg8::EpiSwiglu E{(bf16*)(F.ws + WS_BIG), FF, (float*)(F.ws + WS_STATS), (float*)(F.ws + WS_CD), (float*)(F.ws + WS_CD)}; pg8::gemm_phase<pg8::EpiSwiglu, pg8::StaticOrder, PG8_ALIGN, PG8_SP2>(F.lds + RING_OFF, g, S, E, F.tid); }
__global__ void __launch_bounds__(NWAVES * 64, 2) probe_gemm_resid(Args args) { PROBE_FRAME(); pg8::Gemm g{(const bf16*)F.ws, (const bf16*)(F.ws + W_IN1), T, D, FF}; pg8::StaticOrder S; S.init(T, D, F.G, F.bx); pg8::EpiResid E{F.z, (bf16*)(F.ws + WS_ZB), (float*)(F.ws + WS_STATS), inp(F, 2), inp(F, 3), args.ph_lo ? inp(F, 20) : (const float*)(F.ws + WS_IDB), (float*)(F.ws + WS_PART), 0.5f, 0}; pg8::gemm_phase<pg8::EpiResid, pg8::StaticOrder, PG8_ALIGN, PG8_SP2>(F.lds + RING_OFF, g, S, E, F.tid); }
__global__ void __launch_bounds__(NWAVES * 64, 2) probe_gemm_ln(Args args) { PROBE_FRAME(); pg8::Gemm g{(const bf16*)F.ws, (const bf16*)(F.ws + W_IN1), T, NQKV, D}; pg8::StaticOrder S; S.init(T, NQKV, F.G, F.bx); pg8::EpiLnBf16 E{(bf16*)(F.ws + WS_BIG), NQKV, (float*)(F.ws + WS_STATS), (float*)(F.ws + WS_CD), (float*)(F.ws + WS_CD)}; pg8::gemm_phase<pg8::EpiLnBf16, pg8::StaticOrder, PG8_ALIGN, PG8_SP2>(F.lds + RING_OFF, g, S, E, F.tid); }
#endif
#ifndef MK_MULTI
#define MK_MULTI 0
#endif
extern "C" void kernel_launch(void* const* d_in, const int* in_sizes, int n_in, void* d_out, int out_size, void* d_ws, size_t ws_size, hipStream_t stream) {
    static int grid = 0;
    if (grid == 0) {
        if (n_in != 21 || out_size != T * D || ws_size < WS_END) { fprintf(stderr, "kernel_launch: unexpected shapes (n_in %d, out %d, ws %zu, need %zu)\n", n_in, out_size, ws_size, (size_t)WS_END); grid = -1; return; }
        int dev = 0, cus = 0, per_cu = 0;
        if (hipGetDevice(&dev) != hipSuccess || hipDeviceGetAttribute(&cus, hipDeviceAttributeMultiprocessorCount, dev) != hipSuccess) { grid = -1; return; }
        if (hipFuncSetAttribute((const void*)fwd_kernel, hipFuncAttributeMaxDynamicSharedMemorySize, LDS_BYTES) != hipSuccess) { fprintf(stderr, "kernel_launch: hipFuncSetAttribute failed\n"); grid = -1; return; }
        if (hipOccupancyMaxActiveBlocksPerMultiprocessor(&per_cu, (const void*)fwd_kernel, NWAVES * 64, LDS_BYTES) != hipSuccess || per_cu < 1) fprintf(stderr, "kernel_launch: occupancy query reports %d\n", per_cu);
        (void)hipGetLastError();
        grid = cus;
    }
    if (grid < 0) return;
    if (hipMemsetAsync((char*)d_ws + WS_CTL, 0, CTL_ZERO_BYTES, stream) != hipSuccess) return;
    Args a{};
    for (int i = 0; i < 21; ++i) a.in[i] = (const float*)d_in[i];
    a.out = (float*)d_out; a.ws = (unsigned char*)d_ws;
#ifndef STOP_AFTER
#define STOP_AFTER (NPHASE - 1)
#endif
#ifdef DBG_CHECK
#define DBGCHK_ON 1
#else
#define DBGCHK_ON 0
#endif
#if MK_MULTI
    for (int p = 0; p < NPHASE; ++p) { if (p >= STOP_AFTER && p != NPHASE - 1 && !(DBGCHK_ON && p == NPHASE - 2)) continue; a.ph_lo = p; a.ph_hi = p + 1; hipLaunchKernelGGL(fwd_kernel, dim3(grid), dim3(NWAVES * 64), LDS_BYTES, stream, a); }
#else
    a.ph_lo = 0; a.ph_hi = NPHASE;
    hipLaunchKernelGGL(fwd_kernel, dim3(grid), dim3(NWAVES * 64), LDS_BYTES, stream, a);
#endif
}
```

```cpp
#include <hip/hip_runtime.h>
#include <cstdio>
#include <cstdint>
namespace pg8 {
#define PG8_LAS __attribute__((address_space(3)))
typedef unsigned short bf16_t;
typedef short bf16x8 __attribute__((ext_vector_type(8)));
typedef float f32x4 __attribute__((ext_vector_type(4)));
typedef unsigned u32x4 __attribute__((ext_vector_type(4)));
constexpr int BM = 256, BK = 64, HALF = 128, HTB = HALF * BK * 2  , STAGE_BYTES = 8 * HTB, NXCD = 8, WGM = 8;

__host__ __device__ __forceinline__ int lds_byte(int r, int c) { const int st = (r >> 4) * 2 + (c >> 5), rr = r & 15, cc = c & 31, ob = rr * 64 + cc * 2; return st * 1024 + (ob ^ (((ob >> 9) & 1) << 5)); }
__host__ __device__ __forceinline__ void stage_rc(int b, int& R, int& C) { const int st = b / 1024, sb = b % 1024, swz = sb ^ (((sb >> 9) & 1) << 5); R = (st >> 1) * 16 + swz / 64; C = (st & 1) * 32 + (swz % 64) / 2; }
__host__ __device__ __forceinline__ int perm32(int rho) { const int n = rho >> 4, i = rho & 15; return 8 * (i >> 2) + 4 * n + (i & 3); }

struct Unit { int pm, pn; };
struct Gemm { const bf16_t* A; const bf16_t* Bt; int M, N, K; };

struct StaticOrder {
    int nM, nN, nwg, G, c;
    __host__ __device__ void init(int M, int N, int G_, int c_) { nM = M / BM; nN = N / BM; nwg = nM * nN; G = G_; c = c_; }
    __host__ __device__ bool next(int i, Unit& u) const {
        const long L = (long)i * G + c; if (L >= nwg) return false;
        int wgid = (int)L; { const int q = nwg / NXCD, r = nwg % NXCD, xcd = wgid % NXCD, off = wgid / NXCD; wgid = (xcd < r ? xcd * (q + 1) : r * (q + 1) + (xcd - r) * q) + off; }
        const int nig = WGM * nN, gid = wgid / nig, fm = gid * WGM, gsz = (nM - fm) < WGM ? (nM - fm) : WGM;
        u.pm = fm + ((wgid % nig) % gsz); u.pn = (wgid % nig) / gsz; return true;
    }
    __device__ __forceinline__ void a_ready(const Unit&) const {}
    __device__ __forceinline__ void done(const Unit&) const {}
};

__device__ __forceinline__ unsigned cvt_pk_bf16(float lo, float hi) { unsigned r; asm volatile("v_cvt_pk_bf16_f32 %0, %1, %2" : "=v"(r) : "v"(lo), "v"(hi)); return r; }
typedef float f32x2 __attribute__((ext_vector_type(2)));
typedef float f32x2v __attribute__((ext_vector_type(2)));
typedef unsigned u32x2v __attribute__((ext_vector_type(2)));
constexpr float DN_ALPHA_F = 1.6817928305074292f;

__device__ __forceinline__ unsigned cvt2(float lo, float hi) { typedef __bf16 bf16x2_t __attribute__((ext_vector_type(2))); const f32x2v v = {lo, hi}; return __builtin_bit_cast(unsigned, __builtin_convertvector(v, bf16x2_t)); }
__device__ __forceinline__ float xor32_sum(float x) { const auto r = __builtin_amdgcn_permlane32_swap(__float_as_uint(x), __float_as_uint(x), false, false); const unsigned r0 = r[0], r1 = r[1]; return __uint_as_float(r0) + __uint_as_float(r1); }
__device__ __forceinline__ float xor32_max(float x) { const auto r = __builtin_amdgcn_permlane32_swap(__float_as_uint(x), __float_as_uint(x), false, false); const unsigned r0 = r[0], r1 = r[1]; return fmaxf(__uint_as_float(r0), __uint_as_float(r1)); }
template <int MASK> __device__ __forceinline__ float swz_xor(float x) { return __builtin_bit_cast(float, __builtin_amdgcn_ds_swizzle(__builtin_bit_cast(int, x), (MASK << 10) | 0x1F)); }
__device__ __forceinline__ float wave_sum64(float v) { v += swz_xor<1>(v); v += swz_xor<2>(v); v += swz_xor<4>(v); v += swz_xor<8>(v); v += swz_xor<16>(v); return xor32_sum(v); }

struct EpiLnBf16 {
    static constexpr bool PERM = true, AFTER_DRAIN = false;
    bf16_t* O; int ldc; const float* stats; const float* cvec; const float* dvec;
    __device__ __forceinline__ void operator()(const f32x4 (&acc)[2][2][4][2], const Unit& u, int wr, int wc, int fr, int fq) const {
        const int row0 = u.pm * BM + wr * 64 + fr, col0 = u.pn * BM + wc * 32 + 8 * fq;
        f32x4 cv[2][2], dv[2][2];
#pragma unroll
        for (int bj = 0; bj < 2; ++bj)
#pragma unroll
            for (int n = 0; n < 2; ++n) { cv[bj][n] = *(const f32x4*)(cvec + col0 + bj * HALF + 4 * n); dv[bj][n] = *(const f32x4*)(dvec + col0 + bj * HALF + 4 * n); }
        f32x2v sts[2][4];
#pragma unroll
        for (int ai = 0; ai < 2; ++ai)
#pragma unroll
            for (int m = 0; m < 4; ++m) sts[ai][m] = *(const f32x2v*)(stats + 2 * (size_t)(row0 + ai * HALF + m * 16));
#pragma unroll
        for (int ai = 0; ai < 2; ++ai)
#pragma unroll
            for (int m = 0; m < 4; ++m) { const int row = row0 + ai * HALF + m * 16; const f32x2v st = sts[ai][m];
                bf16_t* rowp = O + (size_t)row * ldc + col0;
#pragma unroll
                for (int bj = 0; bj < 2; ++bj) { const f32x4 v0 = (acc[ai][bj][m][0] - st.x * cv[bj][0]) * st.y + dv[bj][0], v1 = (acc[ai][bj][m][1] - st.x * cv[bj][1]) * st.y + dv[bj][1];
                    u32x4 w; w.x = cvt2(v0[0], v0[1]); w.y = cvt2(v0[2], v0[3]); w.z = cvt2(v1[0], v1[1]); w.w = cvt2(v1[2], v1[3]);
                    *(u32x4*)(rowp + bj * HALF) = w; } }
    }
};
__device__ __forceinline__ float silu_mul(float g, float up) { const float e = __builtin_amdgcn_exp2f(-1.4426950408889634f * g); return g * __builtin_amdgcn_rcpf(1.0f + e) * up; }
struct EpiSwiglu {
    static constexpr bool PERM = true, AFTER_DRAIN = false;
    bf16_t* O; int ldc; const float* stats; const float* cvec; const float* dvec;
    __device__ __forceinline__ void operator()(const f32x4 (&acc)[2][2][4][2], const Unit& u, int wr, int wc, int fr, int fq) const {
        const int row0 = u.pm * BM + wr * 64 + fr, col0 = u.pn * BM + wc * 32 + 8 * fq, ocol = u.pn * HALF + wc * 32 + 8 * fq;
        f32x4 cv[2][2], dv[2][2];
#pragma unroll
        for (int bj = 0; bj < 2; ++bj)
#pragma unroll
            for (int n = 0; n < 2; ++n) { cv[bj][n] = *(const f32x4*)(cvec + col0 + bj * HALF + 4 * n); dv[bj][n] = *(const f32x4*)(dvec + col0 + bj * HALF + 4 * n); }
        f32x2v sts[2][4];
#pragma unroll
        for (int ai = 0; ai < 2; ++ai)
#pragma unroll
            for (int m = 0; m < 4; ++m) sts[ai][m] = *(const f32x2v*)(stats + 2 * (size_t)(row0 + ai * HALF + m * 16));
#pragma unroll
        for (int ai = 0; ai < 2; ++ai)
#pragma unroll
            for (int m = 0; m < 4; ++m) { const int row = row0 + ai * HALF + m * 16; const f32x2v st = sts[ai][m];
                f32x4 h[2];
#pragma unroll
                for (int n = 0; n < 2; ++n) { const f32x4 g = (acc[ai][0][m][n] - st.x * cv[0][n]) * st.y + dv[0][n], up = (acc[ai][1][m][n] - st.x * cv[1][n]) * st.y + dv[1][n];
                    h[n] = (f32x4){silu_mul(g[0], up[0]), silu_mul(g[1], up[1]), silu_mul(g[2], up[2]), silu_mul(g[3], up[3])}; }
                u32x4 w; w.x = cvt2(h[0][0], h[0][1]); w.y = cvt2(h[0][2], h[0][3]); w.z = cvt2(h[1][0], h[1][1]); w.w = cvt2(h[1][2], h[1][3]);
                *(u32x4*)(O + (size_t)row * ldc + ocol) = w; }
    }
};
struct EpiResid {
    static constexpr bool PERM = true, AFTER_DRAIN = false;
    float* Z; bf16_t* ZB; const float* stats; const float* gprev; const float* bprev; const float* bias; float* part; float scale; int pad;
    __device__ __forceinline__ void operator()(const f32x4 (&acc)[2][2][4][2], const Unit& u, int wr, int wc, int fr, int fq) const {
        const int row0 = u.pm * BM + wr * 64 + fr, col0 = u.pn * BM + wc * 32 + 8 * fq;
#pragma unroll
        for (int bj = 0; bj < 2; ++bj) {
            f32x4 gv[2], bv[2];
#pragma unroll
            for (int n = 0; n < 2; ++n) { const int c = col0 + bj * HALF + 4 * n; gv[n] = DN_ALPHA_F * *(const f32x4*)(gprev + c); bv[n] = DN_ALPHA_F * *(const f32x4*)(bprev + c) + scale * *(const f32x4*)(bias + c); }
#pragma unroll
            for (int ai = 0; ai < 2; ++ai)
#pragma unroll
                for (int mp = 0; mp < 2; ++mp) {
                    f32x4 zin[2][2]; f32x2v sts[2];
#pragma unroll
                    for (int mm = 0; mm < 2; ++mm) { const int row = row0 + ai * HALF + (2 * mp + mm) * 16; const float* zp = Z + (size_t)row * 2048 + col0 + bj * HALF;
                        zin[mm][0] = *(const f32x4*)zp; zin[mm][1] = *(const f32x4*)(zp + 4); sts[mm] = *(const f32x2v*)(stats + 2 * (size_t)row); }
#pragma unroll
                    for (int mm = 0; mm < 2; ++mm) { const int m = 2 * mp + mm; const int row = row0 + ai * HALF + m * 16; const f32x2v st = sts[mm];
                        float* zp = Z + (size_t)row * 2048 + col0 + bj * HALF;
                        const f32x4 n0 = (zin[mm][0] - st.x) * st.y * gv[0] + bv[0] + scale * acc[ai][bj][m][0];
                        const f32x4 n1 = (zin[mm][1] - st.x) * st.y * gv[1] + bv[1] + scale * acc[ai][bj][m][1];
                        *(f32x4*)zp = n0; *(f32x4*)(zp + 4) = n1;
                        u32x4 w; w.x = cvt2(n0[0], n0[1]); w.y = cvt2(n0[2], n0[3]); w.z = cvt2(n1[0], n1[1]); w.w = cvt2(n1[2], n1[3]);
                        *(u32x4*)(ZB + (size_t)row * 2048 + col0 + bj * HALF) = w;
                        float s = ((n0[0] + n0[1]) + (n0[2] + n0[3])) + ((n1[0] + n1[1]) + (n1[2] + n1[3]));
                        float q = ((n0[0] * n0[0] + n0[1] * n0[1]) + (n0[2] * n0[2] + n0[3] * n0[3])) + ((n1[0] * n1[0] + n1[1] * n1[1]) + (n1[2] * n1[2] + n1[3] * n1[3]));
                        s += swz_xor<16>(s); s = xor32_sum(s); q += swz_xor<16>(q); q = xor32_sum(q);
                        if (fq == 0) *(f32x2v*)(part + ((size_t)row * 64 + u.pn * 8 + wc * 2 + bj) * 2) = (f32x2v){s, q}; }
                }
        }
    }
};

struct EpiTaps {
    static constexpr bool PERM = false, AFTER_DRAIN = false;
    float* O; float min_decay, dstep;
    __device__ __forceinline__ void operator()(const f32x4 (&acc)[2][2][4][2], const Unit& u, int wr, int wc, int fr, int fq) const {
        int stride = 10240; float i0 = 1.0f / 8191.0f, i1 = 1.0f / 2047.0f; asm volatile("" : "+s"(stride), "+s"(i0), "+s"(i1));
        const int row0 = u.pm * BM + wr * 64 + fr, col0 = u.pn * BM + wc * 32 + 4 * fq;
        const int tbase = (u.pn < 32) ? 0 : 8192; const float ilm1 = (u.pn < 32) ? i0 : i1;
        const float t0 = (float)(col0 - tbase);
#pragma unroll
        for (int ai = 0; ai < 2; ++ai)
#pragma unroll
            for (int m = 0; m < 4; ++m) { const int row = row0 + ai * HALF + m * 16;
                const float a = -1.4426950408889634f * __builtin_fabsf(min_decay + (float)(row & 2047) * dstep) * ilm1;
                const float e0 = __builtin_amdgcn_exp2f(a * t0), s1 = __builtin_amdgcn_exp2f(a), s16 = __builtin_amdgcn_exp2f(16.0f * a), s128 = __builtin_amdgcn_exp2f(128.0f * a);
                float* rowp = O + (size_t)row * stride + col0;
#pragma unroll
                for (int bj = 0; bj < 2; ++bj) { const float eb = bj ? e0 * s128 : e0;
#pragma unroll
                    for (int n = 0; n < 2; ++n) { const float en = n ? eb * s16 : eb, en1 = en * s1, en2 = en1 * s1, en3 = en2 * s1; const f32x4 v = acc[ai][bj][m][n];
                        *(f32x4*)(rowp + bj * HALF + n * 16) = (f32x4){v[0] * en, v[1] * en1, v[2] * en2, v[3] * en3}; } } }
    }
};

template <class Epi, class Sched, bool ALIGN_EPI = false, bool SP2 = false>
__device__ __forceinline__ void gemm_phase(PG8_LAS unsigned char* lds, const Gemm g, const Sched& S, const Epi& E, const int tid_in) {
    int tid_ = tid_in; asm volatile("" : "+v"(tid_));
    const int tid = tid_, wid = __builtin_amdgcn_readfirstlane(tid >> 6), lane = tid & 63, wr = wid >> 2, wc = wid & 3, fr = lane & 15, fq = lane >> 4;
    const int K = g.K, nt = K / BK;
    unsigned voffA[2], voffB[2];
#pragma unroll
    for (int i = 0; i < 2; ++i) { int R, C; stage_rc(tid * 16 + i * 8192, R, C); const int Rb = Epi::PERM ? ((R & ~31) + perm32(R & 31)) : R;
        voffA[i] = (unsigned)(R * K + C) * 2u; voffB[i] = (unsigned)(Rb * K + C) * 2u; }
    const size_t kstep = (size_t)(BK * 2);
    const size_t hstep = (size_t)HALF * K * 2;
    const size_t tstep = 2 * hstep;
    const unsigned ldsw = (unsigned)wid * 1024u;
    const int aoff = lds_byte(wr * 64 + fr, fq * 8), boff = lds_byte(wc * 32 + fr, fq * 8);
#define PG8_SA(b, h) (((b) * 2 + (h)) * HTB)
#define PG8_SB(b, h) ((4 + (b) * 2 + (h)) * HTB)
#define PG8_STAGE(bufoff, gbase, voff) do { _Pragma("unroll") for (int _i = 0; _i < 2; ++_i) \
        __builtin_amdgcn_global_load_lds((const unsigned*)((const char*)(gbase) + (voff)[_i]), (PG8_LAS unsigned*)(lds + (bufoff) + ldsw + _i * 8192), 16, 0, 0); } while (0)
#define PG8_LDA(dst, b, h) do { _Pragma("unroll") for (int m = 0; m < 4; ++m) _Pragma("unroll") for (int k = 0; k < 2; ++k) dst[m][k] = *(const PG8_LAS bf16x8*)(lds + PG8_SA(b, h) + aoff + m * 2048 + k * 1024); } while (0)
#define PG8_LDB(dst, b, h) do { _Pragma("unroll") for (int n = 0; n < 2; ++n) _Pragma("unroll") for (int k = 0; k < 2; ++k) dst[n][k] = *(const PG8_LAS bf16x8*)(lds + PG8_SB(b, h) + boff + n * 2048 + k * 1024); } while (0)
#define PG8_MMA(ai, bj, At, Bt) do { __builtin_amdgcn_s_setprio(1); _Pragma("unroll") for (int m = 0; m < 4; ++m) _Pragma("unroll") for (int n = 0; n < 2; ++n) _Pragma("unroll") for (int k = 0; k < 2; ++k) \
        acc[ai][bj][m][n] = __builtin_amdgcn_mfma_f32_16x16x32_bf16(Bt[n][k], At[m][k], acc[ai][bj][m][n], 0, 0, 0); __builtin_amdgcn_s_setprio(0); } while (0)
#define PG8_WAIT_V(n) asm volatile("s_waitcnt vmcnt(" #n ")" ::: "memory")
#define PG8_WAIT_L(n) asm volatile("s_waitcnt lgkmcnt(" #n ")" ::: "memory")
#define PG8_BAR __builtin_amdgcn_s_barrier()
#define PG8_SCHED __builtin_amdgcn_sched_barrier(0)
    Unit cur, nxt; int ui = 0;
    if (!S.next(0, cur)) return;
    f32x4 acc[2][2][4][2];
    float zero_; asm volatile("v_mov_b32 %0, 0" : "=v"(zero_));
#pragma unroll
    for (int a = 0; a < 2; ++a)
#pragma unroll
        for (int b = 0; b < 2; ++b)
#pragma unroll
            for (int m = 0; m < 4; ++m)
#pragma unroll
                for (int n = 0; n < 2; ++n) acc[a][b][m][n] = (f32x4){zero_, zero_, zero_, zero_};
    bf16x8 At[4][2], B0[2][2], B1[2][2];
    const char* cA = (const char*)g.A + (size_t)cur.pm * tstep; const char* cB = (const char*)g.Bt + (size_t)cur.pn * tstep;
    S.a_ready(cur);
    if constexpr (SP2) {
        PG8_STAGE(PG8_SB(0, 0), cB, voffB); PG8_STAGE(PG8_SB(0, 1), cB + hstep, voffB); PG8_STAGE(PG8_SA(0, 0), cA, voffA); PG8_STAGE(PG8_SA(0, 1), cA + hstep, voffA);
        if (wr == 1) PG8_BAR;
        PG8_WAIT_V(2); PG8_BAR;
        PG8_STAGE(PG8_SB(1, 0), cB + kstep, voffB); PG8_STAGE(PG8_SA(1, 0), cA + kstep, voffA); PG8_STAGE(PG8_SB(1, 1), cB + hstep + kstep, voffB);
        PG8_WAIT_V(6); PG8_BAR;
    } else {
        PG8_STAGE(PG8_SB(0, 0), cB, voffB); PG8_STAGE(PG8_SA(0, 0), cA, voffA); PG8_STAGE(PG8_SB(0, 1), cB + hstep, voffB); PG8_STAGE(PG8_SA(0, 1), cA + hstep, voffA);
        if (wr == 1) PG8_BAR;
        PG8_WAIT_V(4); PG8_BAR;
        PG8_STAGE(PG8_SB(1, 0), cB + kstep, voffB); PG8_STAGE(PG8_SA(1, 0), cA + kstep, voffA); PG8_STAGE(PG8_SB(1, 1), cB + hstep + kstep, voffB);
        PG8_WAIT_V(6); PG8_BAR;
    }
    for (;;) {
        const bool has_next = S.next(ui + 1, nxt);
        const char* nA = has_next ? (const char*)g.A + (size_t)nxt.pm * tstep : cA; const char* nB = has_next ? (const char*)g.Bt + (size_t)nxt.pn * tstep : cB;
        for (int t = 0; t < nt; t += 2) {
            const bool last = (t == nt - 2);
            const char* a1 = cA + (size_t)(t + 1) * kstep;
            const char* a2 = last ? nA : cA + (size_t)(t + 2) * kstep; const char* b2 = last ? nB : cB + (size_t)(t + 2) * kstep;
            const char* a3 = a2 + kstep; const char* b3 = b2 + kstep;
            if (last && has_next) S.a_ready(nxt);
            if constexpr (SP2) {
            PG8_LDB(B0, 0, 0); PG8_LDB(B1, 0, 1); PG8_SCHED; PG8_LDA(At, 0, 0); PG8_STAGE(PG8_SA(1, 1), a1 + hstep, voffA);
            PG8_WAIT_V(8); PG8_WAIT_L(0); PG8_BAR; PG8_MMA(0, 0, At, B0); PG8_MMA(0, 1, At, B1); PG8_BAR; PG8_SCHED;
            PG8_LDA(At, 0, 1); PG8_STAGE(PG8_SB(0, 0), b2, voffB); PG8_STAGE(PG8_SB(0, 1), b2 + hstep, voffB); PG8_STAGE(PG8_SA(0, 0), a2, voffA);
            PG8_WAIT_V(8); PG8_WAIT_L(0); PG8_BAR; PG8_MMA(1, 0, At, B0); PG8_MMA(1, 1, At, B1); PG8_BAR; PG8_SCHED;
            PG8_LDB(B0, 1, 0); PG8_LDB(B1, 1, 1); PG8_SCHED; PG8_LDA(At, 1, 0); PG8_STAGE(PG8_SA(0, 1), a2 + hstep, voffA);
            PG8_WAIT_V(8); PG8_WAIT_L(0); PG8_BAR; PG8_MMA(0, 0, At, B0); PG8_MMA(0, 1, At, B1); PG8_BAR; PG8_SCHED;
            PG8_LDA(At, 1, 1); PG8_STAGE(PG8_SB(1, 0), b3, voffB); PG8_STAGE(PG8_SB(1, 1), b3 + hstep, voffB); PG8_STAGE(PG8_SA(1, 0), a3, voffA);
            PG8_WAIT_V(8); PG8_WAIT_L(0); PG8_BAR; PG8_MMA(1, 0, At, B0); PG8_MMA(1, 1, At, B1); PG8_BAR; PG8_SCHED;
            } else {
            PG8_LDB(B0, 0, 0); PG8_SCHED; PG8_LDA(At, 0, 0); PG8_STAGE(PG8_SA(1, 1), a1 + hstep, voffA);
            PG8_WAIT_L(8); PG8_BAR; PG8_WAIT_L(0); PG8_MMA(0, 0, At, B0); PG8_BAR; PG8_SCHED;
            PG8_LDB(B1, 0, 1); PG8_STAGE(PG8_SB(0, 0), b2, voffB);
            PG8_BAR; PG8_WAIT_L(0); PG8_MMA(0, 1, At, B1); PG8_BAR;
            PG8_LDA(At, 0, 1); PG8_STAGE(PG8_SA(0, 0), a2, voffA);
            PG8_BAR; PG8_WAIT_L(0); PG8_MMA(1, 0, At, B0); PG8_BAR; PG8_SCHED;
            PG8_STAGE(PG8_SB(0, 1), b2 + hstep, voffB);
            PG8_WAIT_V(6); PG8_BAR; PG8_MMA(1, 1, At, B1); PG8_BAR;
            PG8_LDB(B0, 1, 0); PG8_SCHED; PG8_LDA(At, 1, 0); PG8_STAGE(PG8_SA(0, 1), a2 + hstep, voffA);
            PG8_WAIT_L(8); PG8_BAR; PG8_WAIT_L(0); PG8_MMA(0, 0, At, B0); PG8_BAR; PG8_SCHED;
            PG8_LDB(B1, 1, 1); PG8_STAGE(PG8_SB(1, 0), b3, voffB);
            PG8_BAR; PG8_WAIT_L(0); PG8_MMA(0, 1, At, B1); PG8_BAR;
            PG8_LDA(At, 1, 1); PG8_STAGE(PG8_SA(1, 0), a3, voffA);
            PG8_BAR; PG8_WAIT_L(0); PG8_MMA(1, 0, At, B0); PG8_BAR; PG8_SCHED;
            PG8_STAGE(PG8_SB(1, 1), b3 + hstep, voffB);
            PG8_WAIT_V(6); PG8_BAR; PG8_MMA(1, 1, At, B1); PG8_BAR;
            }
        }
        if constexpr (ALIGN_EPI) { if (wr == 0) PG8_BAR; }
        if constexpr (!Epi::AFTER_DRAIN) { E(acc, cur, wr, wc, fr, fq); S.done(cur); }
        if (!has_next) break;
        asm volatile("v_mov_b32 %0, 0" : "=v"(zero_));
#pragma unroll
        for (int a = 0; a < 2; ++a)
#pragma unroll
            for (int b = 0; b < 2; ++b)
#pragma unroll
                for (int m = 0; m < 4; ++m)
#pragma unroll
                    for (int n = 0; n < 2; ++n) acc[a][b][m][n] = (f32x4){zero_, zero_, zero_, zero_};
        cur = nxt; cA = nA; cB = nB; ++ui;
        if constexpr (ALIGN_EPI) { if (wr == 1) PG8_BAR; }
    }
    PG8_WAIT_V(0);
    if constexpr (!ALIGN_EPI) { if (wr == 0) PG8_BAR; }
    PG8_BAR;
    if constexpr (Epi::AFTER_DRAIN) { E.fused(acc, cur, wr, wc, fr, fq, lds, wid, lane); S.done(cur); }
#undef PG8_SA
#undef PG8_SB
#undef PG8_STAGE
#undef PG8_LDA
#undef PG8_LDB
#undef PG8_MMA
#undef PG8_WAIT_V
#undef PG8_WAIT_L
#undef PG8_BAR
#undef PG8_SCHED
}
}

#ifndef PG8_SP2
#define PG8_SP2 true
#endif
#ifndef PG8_ALIGN
#define PG8_ALIGN true
#endif
#define XB_TMO      128
#define XB_XCNT(j)  (256  + 64 * (j))
#define XB_XSUB(j)  (1280 + 64 * (j))
#define XB_XGEN(j)  (2304 + 64 * (j))
#define XB_TOP      3328
#define XB_TOPGEN   3392
#define XCD_BAR_WORDS 3456
#define XB_SPIN_CAP (1u << 18)
#define LAS __attribute__((address_space(3)))

__device__ __forceinline__ unsigned xb_ld(unsigned* p)              { return __hip_atomic_load(p, __ATOMIC_RELAXED, __HIP_MEMORY_SCOPE_AGENT); }
__device__ __forceinline__ unsigned xb_add(unsigned* p, unsigned v) { return __hip_atomic_fetch_add(p, v, __ATOMIC_RELAXED, __HIP_MEMORY_SCOPE_AGENT); }
__device__ __forceinline__ unsigned xb_xcc_id() { return (unsigned)__builtin_amdgcn_s_getreg((3 << 11) | 20) & 0xFu; }
#define XB_SPIN(cond, bar) do { unsigned _sp = 0; while (cond) { __builtin_amdgcn_s_sleep(1); \
    if ((++_sp & 255u) == 0u) { if (xb_ld(&(bar)[XB_TMO])) break; if (_sp > XB_SPIN_CAP) { atomicAdd(&(bar)[XB_TMO], 1u); break; } } } } while (0)

struct XcdBarrier {
    unsigned* bar; unsigned x;
    unsigned w0;
    volatile LAS unsigned* st;
};

__device__ __forceinline__ XcdBarrier xcd_barrier_post(unsigned* bar, volatile LAS unsigned* st) {
    XcdBarrier b; b.bar = bar; b.x = xb_xcc_id(); b.st = st; b.w0 = (unsigned)__builtin_amdgcn_readfirstlane(threadIdx.x >> 6);
    if (threadIdx.x == 0) (void)xb_add(&bar[XB_XCNT(b.x)], 1u);
    return b;
}
__device__ __forceinline__ void xcd_barrier_complete(unsigned* bar, unsigned x, unsigned& nloc, unsigned& nx) {
    const unsigned G = gridDim.x * gridDim.y * gridDim.z;
    unsigned sum, cnt, mine, sp = 0u;
    for (;;) {
        sum = 0u; cnt = 0u; mine = 0u;
#pragma unroll
        for (unsigned j = 0; j < 16; ++j) { const unsigned c = xb_ld(&bar[XB_XCNT(j)]); sum += c; cnt += (c > 0u) ? 1u : 0u; mine = (j == x) ? c : mine; }
        if (sum == G) break;
        __builtin_amdgcn_s_sleep(1);
        if ((++sp & 255u) == 0u) { if (xb_ld(&bar[XB_TMO])) break; if (sp > XB_SPIN_CAP) { atomicAdd(&bar[XB_TMO], 1u); break; } }
    }
    nloc = mine > 0u ? mine : 1u; nx = cnt > 0u ? cnt : 1u;
}

__device__ __forceinline__ void xcd_barrier(const XcdBarrier& b) {
    asm volatile("s_waitcnt vmcnt(0)" ::: "memory");
    __syncthreads();
    unsigned xb_lane; asm volatile("v_mbcnt_lo_u32_b32 %0, -1, 0\n\tv_mbcnt_hi_u32_b32 %0, -1, %0" : "=v"(xb_lane));
    if (b.w0 == 0u && xb_lane == 0u) {
        unsigned* bar = b.bar;
        __builtin_amdgcn_s_waitcnt(0);
        unsigned nloc = b.st[0], nx = b.st[1];
        if (nloc == 0u) { xcd_barrier_complete(bar, b.x, nloc, nx); b.st[0] = nloc; b.st[1] = nx; }
        const unsigned old = xb_add(&bar[XB_XSUB(b.x)], 1u);
        const unsigned gen = old / nloc;
        if (old + 1u == (gen + 1u) * nloc) {
            __builtin_amdgcn_fence(__ATOMIC_RELEASE, "agent");
            asm volatile("s_waitcnt vmcnt(0)" ::: "memory");
            const unsigned og = xb_add(&bar[XB_TOP], 1u);
            const unsigned tg = og / nx;
            if (og + 1u == (tg + 1u) * nx) xb_add(&bar[XB_TOPGEN], 1u);
            else XB_SPIN(xb_ld(&bar[XB_TOPGEN]) == tg, bar);
            __builtin_amdgcn_fence(__ATOMIC_ACQUIRE, "agent");
            xb_add(&bar[XB_XGEN(b.x)], 1u);
            asm volatile("s_waitcnt vmcnt(0)" ::: "memory");
        } else {
            XB_SPIN(xb_ld(&bar[XB_XGEN(b.x)]) == gen, bar);
            __builtin_amdgcn_fence(__ATOMIC_ACQUIRE, "agent");
            asm volatile("s_waitcnt vmcnt(0)" ::: "memory");
        }
    }
    __syncthreads();
}
constexpr int NWAVES = 8;
constexpr int D = 2048, FF = 5632, NFF2 = 2 * FF, NQKV = 18432, NHY = 6144, DEPTH = 4;
constexpr int T_PROMPT = 4 * 8192, T = 49152;
constexpr float LN_EPS = 1e-5f;
constexpr float QSCALE = 0.12751743082459868f;
constexpr float LOG2E = 1.4426950408889634f;
constexpr float MIN_DECAY = -3.0701134573253946f, MAX_DECAY = -15.350567286626973f;

constexpr size_t MiB = 1u << 20;
constexpr size_t WS_CTL = 0, CTL_ZERO_BYTES = 64 * 1024;
constexpr size_t WS_IDG = 1 * MiB, WS_IDB = 1 * MiB + 32768, WS_DUMP = 1 * MiB + 32768 + 131072;
constexpr size_t WS_CD = 2 * MiB;
constexpr size_t WS_STATS = 3 * MiB;
constexpr size_t WS_H2T = 4 * MiB;
constexpr size_t WS_PART = 8 * MiB;
constexpr size_t WS_W = 32 * MiB;
constexpr size_t W_IN1 = WS_W, W_OUT1 = W_IN1 + 44 * MiB, W_IN2 = W_OUT1 + 22 * MiB, W_OUT2 = W_IN2 + 44 * MiB, W_MIN = W_OUT2 + 22 * MiB, W_MOUT = W_MIN + 72 * MiB;
constexpr size_t WS_ZB = W_MOUT + 8 * MiB;
constexpr size_t WS_BIG = WS_ZB + 192 * MiB;
constexpr size_t BIG_HID = 0;
constexpr size_t BIG_QKV = 0, BIG_AO = 1728 * MiB;
constexpr size_t BIG_U = 0, BIG_Z2T = 0, BIG_Z2 = 192 * MiB, BIG_UT = 576 * MiB, BIG_SPEC0 = 1152 * MiB, BIG_SPEC1 = 1664 * MiB;
constexpr size_t WS_TAPS = WS_BIG + 1920 * MiB;
constexpr size_t WS_H2B = WS_TAPS + 320 * MiB, WS_W3T = WS_H2B + 6 * MiB;
constexpr size_t WS_END = WS_W3T + 4 * MiB;
static_assert(WS_ZB == 244 * MiB && WS_BIG == 436 * MiB && (size_t)T * 64 * 8 <= 24 * MiB && WS_END <= 2816 * MiB && (size_t)8192 * 10240 * 4 <= 320 * MiB, "ws map");
static_assert((size_t)T * FF * 2 <= 528 * MiB && (size_t)T * NQKV * 2 <= 1728 * MiB && (size_t)T * NHY * 2 <= 576 * MiB && BIG_SPEC1 + 128 * MiB <= 1920 * MiB, "ws map");

constexpr int RING_OFF = 0;
constexpr int FFT_BYTES = (16384 + 512) * 8;
constexpr int SCR_OFF = FFT_BYTES;
constexpr int MISC_OFF = SCR_OFF + 1024;
constexpr int PTR_OFF = MISC_OFF + 256;
constexpr int LDS_BYTES = PTR_OFF + 256;

#define GAS __attribute__((address_space(1)))
#define LAS __attribute__((address_space(3)))
typedef unsigned short bf16;
typedef unsigned v4u __attribute__((ext_vector_type(4)));
typedef unsigned v2u __attribute__((ext_vector_type(2)));
typedef float f32x4 __attribute__((ext_vector_type(4)));
typedef float f32x2 __attribute__((ext_vector_type(2)));
typedef float f32x16 __attribute__((ext_vector_type(16)));
typedef short bf16x8 __attribute__((ext_vector_type(8)));
typedef short s16x4 __attribute__((ext_vector_type(4)));
#define LDS_WAIT() asm volatile("s_waitcnt lgkmcnt(0)" ::: "memory")
#define VM_WAIT() asm volatile("s_waitcnt vmcnt(0)" ::: "memory")
__device__ __forceinline__ unsigned f2bf(float f) { unsigned u = __builtin_bit_cast(unsigned, f); return (u + 0x7fffu + ((u >> 16) & 1u)) >> 16; }
__device__ __forceinline__ unsigned pk2(float lo, float hi) { return f2bf(lo) | (f2bf(hi) << 16); }
__device__ __forceinline__ float bf2f(unsigned b) { return __builtin_bit_cast(float, b << 16); }
__device__ __forceinline__ float bfround(float f) { return bf2f(f2bf(f)); }

#ifndef FFT_HD
#define FFT_HD __host__ __device__ __forceinline__
#endif
#if defined(__clang__)
typedef float cpx __attribute__((ext_vector_type(2)));
#else
struct cpx { float x, y; };
#endif
FFT_HD cpx cmul(cpx a, cpx b) { return cpx{a.x * b.x - a.y * b.y, a.x * b.y + a.y * b.x}; }
FFT_HD cpx cmulc(cpx a, cpx b) { return cpx{a.x * b.x + a.y * b.y, a.y * b.x - a.x * b.y}; }
FFT_HD cpx cadd(cpx a, cpx b) { return cpx{a.x + b.x, a.y + b.y}; }
FFT_HD cpx csub(cpx a, cpx b) { return cpx{a.x - b.x, a.y - b.y}; }
FFT_HD int pidx(int i) { return i + (i >> 5); }
FFT_HD cpx cis_neg_rev(float rev) {
    const float x8 = rev * 8.0f; int oct = (int)x8; oct = oct > 7 ? 7 : oct; const float f = x8 - (float)oct;
    const float a = (oct & 1) ? (1.0f - f) : f, phi = a * 0.78539816339744831f, p2 = phi * phi;
    const float s = phi * (1.0f + p2 * (-1.6666666666666666e-1f + p2 * (8.3333333333333332e-3f + p2 * (-1.9841269841269841e-4f + p2 * 2.7557319223985893e-6f))));
    const float c = 1.0f + p2 * (-0.5f + p2 * (4.1666666666666664e-2f + p2 * (-1.3888888888888889e-3f + p2 * (2.4801587301587302e-5f + p2 * -2.7557319223985888e-7f))));
    const bool sw = ((oct + 1) & 2) != 0;
    float cc = sw ? s : c, ss = sw ? c : s;
    if (oct >= 2 && oct <= 5) cc = -cc;
    if (oct >= 4) ss = -ss;
    return cpx{cc, -ss};
}
FFT_HD float sin_acc(float x) { float rev = x * 0.15915494309189535f; rev -= floorf(rev); const cpx e = cis_neg_rev(rev); return -e.y; }
FFT_HD float cos_rev(float rev) { rev -= floorf(rev); return cis_neg_rev(rev).x; }
FFT_HD float sin_rev(float rev) { rev -= floorf(rev); return -cis_neg_rev(rev).y; }
FFT_HD cpx w16(int k) {
    constexpr float C1 = 0.92387953251128674f, S1 = 0.38268343236508977f, R2 = 0.70710678118654752f;
    switch (k) { case 0: return cpx{1.f, 0.f}; case 1: return cpx{C1, -S1}; case 2: return cpx{R2, -R2}; case 3: return cpx{S1, -C1};
                 case 4: return cpx{0.f, -1.f}; case 5: return cpx{-S1, -C1}; case 6: return cpx{-R2, -R2}; default: return cpx{-C1, -S1}; }
}
template <int R> FFT_HD constexpr int bitrev(int i) { int r = 0; for (int b = 1, c = R >> 1; b < R; b <<= 1, c >>= 1) if (i & b) r |= c; return r; }
template <int R> FFT_HD void dif_regs(cpx (&a)[R]) {
#pragma unroll
    for (int len = R; len >= 2; len >>= 1) { const int half = len >> 1;
#pragma unroll
        for (int b0 = 0; b0 < R; b0 += len)
#pragma unroll
            for (int j = 0; j < half; ++j) { const cpx u = a[b0 + j], v = a[b0 + j + half]; a[b0 + j] = cadd(u, v); const cpx d = csub(u, v); a[b0 + j + half] = (j == 0) ? d : cmul(d, w16(j * (16 / len))); } }
}
template <int R> FFT_HD void dit_regs(cpx (&a)[R]) {
#pragma unroll
    for (int len = 2; len <= R; len <<= 1) { const int half = len >> 1;
#pragma unroll
        for (int b0 = 0; b0 < R; b0 += len)
#pragma unroll
            for (int j = 0; j < half; ++j) { const cpx u = a[b0 + j]; const cpx v = (j == 0) ? a[b0 + j + half] : cmulc(a[b0 + j + half], w16(j * (16 / len))); a[b0 + j] = cadd(u, v); a[b0 + j + half] = csub(u, v); } }
}
template <int R> FFT_HD void twiddle_powers(cpx w1, cpx (&pw)[R]) {
    pw[0] = cpx{1.f, 0.f}; pw[1] = w1; pw[2] = cmul(w1, w1); pw[3] = cmul(pw[2], w1);
    if constexpr (R > 4) { pw[4] = cmul(pw[2], pw[2]); pw[5] = cmul(pw[4], pw[1]); pw[6] = cmul(pw[4], pw[2]); pw[7] = cmul(pw[4], pw[3]); }
    if constexpr (R > 8) { pw[8] = cmul(pw[4], pw[4]);
#pragma unroll
        for (int k = 1; k < 8; ++k) pw[8 + k] = cmul(pw[8], pw[k]); }
}
template <int R, bool INV, class P> FFT_HD void fft_pass(P X, int tid, int nthr, int logM) {
    constexpr int LOGR = (R == 16) ? 4 : 2;
    const int logs = logM - LOGR, s = 1 << logs;
#pragma unroll 1
    for (int blk = tid; blk < 16384 / R; blk += nthr) {
        const int base = blk & (s - 1), idx0 = ((blk >> logs) << logM) + base;
        cpx a[R], pw[R];
        if (logs > 0) twiddle_powers<R>(cis_neg_rev((float)base / (float)(1 << logM)), pw);
        if (!INV) {
#pragma unroll
            for (int j = 0; j < R; ++j) a[j] = X[pidx(idx0 + (j << logs))];
            dif_regs<R>(a);
#pragma unroll
            for (int i = 0; i < R; ++i) { const int k1 = bitrev<R>(i); cpx v = a[i]; if (logs > 0 && k1 != 0) v = cmul(v, pw[k1]); X[pidx(idx0 + (k1 << logs))] = v; }
        } else {
#pragma unroll
            for (int i = 0; i < R; ++i) { const int k1 = bitrev<R>(i); cpx v = X[pidx(idx0 + (k1 << logs))]; if (logs > 0 && k1 != 0) v = cmulc(v, pw[k1]); a[i] = v; }
            dit_regs<R>(a);
#pragma unroll
            for (int j = 0; j < R; ++j) X[pidx(idx0 + (j << logs))] = a[j];
        }
    }
}
struct Frame {
    LAS unsigned char* lds;
    int tid, lane, wave;
    int vcu, G, bx;
    unsigned char* ws; float* z;
};
__device__ __forceinline__ Frame make_frame(unsigned char* lds_generic, unsigned char* ws, float* out, int wave0) {
    Frame F;
    int lane; asm volatile("v_mbcnt_lo_u32_b32 %0, -1, 0\n\tv_mbcnt_hi_u32_b32 %0, -1, %0" : "=v"(lane));
    int bx = blockIdx.x, G = gridDim.x;
    asm volatile("" : "+v"(lane)); asm volatile("" : "+s"(bx)); asm volatile("" : "+s"(G)); asm volatile("" : "+s"(wave0));
    const int tid = wave0 * 64 + lane;
    unsigned long long w = (unsigned long long)ws, o = (unsigned long long)out; asm volatile("" : "+s"(w)); asm volatile("" : "+s"(o));
    F.lds = (LAS unsigned char*)lds_generic;
    F.tid = tid; F.lane = lane; F.wave = wave0;
    F.G = G; F.bx = bx; F.vcu = (G % 8 == 0) ? (bx % 8) * (G / 8) + bx / 8 : bx;
    F.ws = (unsigned char*)(GAS unsigned char*)w; F.z = (float*)(GAS float*)o;
    return F;
}
__device__ __forceinline__ const float* inp(const Frame& F, int i) {
    const LAS unsigned* t = (const LAS unsigned*)(F.lds + PTR_OFF) + 2 * i;
    const unsigned lo = __builtin_amdgcn_readfirstlane(t[0]), hi = __builtin_amdgcn_readfirstlane(t[1]);
    return (const float*)(const GAS float*)(((unsigned long long)hi << 32) | lo);
}
__device__ __forceinline__ float wave_sum(float v) { return pg8::wave_sum64(v); }
__device__ __forceinline__ void block_sum2(Frame& F, float& a, float& b) {
    LAS float* scr = (LAS float*)(F.lds + SCR_OFF);
    a = wave_sum(a); b = wave_sum(b);
    __syncthreads();
    if (F.lane == 0) { scr[F.wave * 2] = a; scr[F.wave * 2 + 1] = b; }
    __syncthreads();
    float sa = 0.f, sb = 0.f;
#pragma unroll
    for (int w = 0; w < NWAVES; ++w) { sa += scr[w * 2]; sb += scr[w * 2 + 1]; }
    a = sa; b = sb;
}

__device__ __forceinline__ void phase_init(Frame& F) {
    const int gw = F.vcu * NWAVES + F.wave, NGW = F.G * NWAVES;
    bf16* zb = (bf16*)(F.ws + WS_ZB); float* stats = (float*)(F.ws + WS_STATS);
    const float* x0 = inp(F, 0); const float* x1 = inp(F, 1);
    for (int m = gw; m < T; m += NGW) {
        const float* src = (m < T_PROMPT) ? x0 + (size_t)m * D : x1 + (size_t)(m - T_PROMPT) * D;
        const GAS f32x4* s4 = (const GAS f32x4*)src + F.lane; GAS f32x4* d4 = (GAS f32x4*)(F.z + (size_t)m * D) + F.lane; GAS v2u* b4 = (GAS v2u*)(zb + (size_t)m * D) + F.lane;
#pragma unroll
        for (int j = 0; j < 8; ++j) { const f32x4 v = s4[64 * j]; d4[64 * j] = v; v2u o; o.x = pk2(v.x, v.y); o.y = pk2(v.z, v.w); b4[64 * j] = o; }
        if (F.lane == 0) { stats[2 * m] = 0.f; stats[2 * m + 1] = 1.f; }
    }
    const int gt = F.vcu * (NWAVES * 64) + F.tid;
    if (gt < 8192) ((float*)(F.ws + WS_IDG))[gt] = 1.f;
    if (gt < 32768) ((float*)(F.ws + WS_IDB))[gt] = 0.f;
}

struct ConvJob { const float* W; int K, N; bf16* WT; const float* gk; const float* bk; float* cvec; float* dvec; const float* ebias; int mode; };
__device__ __forceinline__ void conv_item(const float* W, int K, int N, bf16* WT, const float* gk, const float* bk, float* cvec, float* dvec, const float* ebias, int mode, int nb, int kbeg, int kend, LAS float* scr, int lane) {
    const int n0 = 32 * nb;
    const float colscale = (mode == 2 && n0 < 6144) ? QSCALE : 1.0f;
    int rbase = n0;
    if (mode == 1) { rbase = (n0 < FF) ? (n0 / 128) * 256 + (n0 % 128) : ((n0 - FF) / 128) * 256 + 128 + ((n0 - FF) % 128); }
    float cs[32], ds[32];
#pragma unroll
    for (int i = 0; i < 32; ++i) { cs[i] = 0.f; ds[i] = 0.f; }
    f32x4 wv[8], wn[8];
    const float* wp = W + (size_t)(kbeg + lane) * N + n0;
#pragma unroll
    for (int j = 0; j < 8; ++j) wv[j] = *(const GAS f32x4*)(wp + 4 * j);
    float g = gk[kbeg + lane], b = bk[kbeg + lane];
    bf16* op = WT + (size_t)rbase * K + lane;
    for (int k0 = kbeg; k0 < kend; k0 += 64) {
        const int k1 = (k0 + 64 < kend) ? k0 + 64 : k0;
        const float* wq = W + (size_t)(k1 + lane) * N + n0;
#pragma unroll
        for (int j = 0; j < 8; ++j) wn[j] = *(const GAS f32x4*)(wq + 4 * j);
        const float gnx = gk[k1 + lane], bnx = bk[k1 + lane];
#pragma unroll
        for (int j = 0; j < 8; ++j)
#pragma unroll
            for (int e = 0; e < 4; ++e) { const int i = 4 * j + e; const float w = wv[j][e] * colscale; const unsigned vb = f2bf(w * g); const float v = bf2f(vb);
                cs[i] += v; ds[i] += b * w; op[(size_t)i * K + k0] = (bf16)vb; }
#pragma unroll
        for (int j = 0; j < 8; ++j) wv[j] = wn[j];
        g = gnx; b = bnx;
    }
    float myc = 0.f, myd = 0.f;
#pragma unroll
    for (int i = 0; i < 32; ++i) { const float c = wave_sum(cs[i]), d = wave_sum(ds[i]); myc = (lane == i) ? c : myc; myd = (lane == i) ? d : myd; }
    if (lane < 32) { cvec[rbase + lane] = myc; dvec[rbase + lane] = myd + ebias[n0 + lane]; }
}
__device__ __forceinline__ void filt_pos(Frame& F, int jl, int var, int t) {
    const int L = var ? 2048 : 8192, lane = F.lane;
    const float* w1 = inp(F, 12) + (size_t)jl * 33 * 64; const float* b1 = inp(F, 13) + jl * 64; const float* w2 = inp(F, 14) + (size_t)jl * 64 * 64; const float* b2 = inp(F, 15) + jl * 64; const float* fr = inp(F, 16) + jl * 64;
    float feat = 0.f;
    if (lane == 0) feat = (float)t / (float)(L - 1);
    else if (lane < 33) { const int bi = (lane - 1) & 15; const float band = 1e-4f + (float)bi * ((15.0f - 1e-4f) / 15.0f); const float rev = band * ((float)t / (float)L);
        feat = (lane < 17) ? cos_rev(rev) : -sin_rev(rev); }
    float acc = b1[lane];
    for (int k = 0; k < 33; ++k) acc += __builtin_bit_cast(float, __builtin_amdgcn_readlane(__builtin_bit_cast(int, feat), k)) * w1[k * 64 + lane];
    const float fq = fr[lane];
    const float h1 = sin_acc(fq * acc);
    float acc2 = b2[lane];
    for (int k = 0; k < 64; ++k) acc2 += __builtin_bit_cast(float, __builtin_amdgcn_readlane(__builtin_bit_cast(int, h1), k)) * w2[k * 64 + lane];
    const float h2 = sin_acc(fq * acc2);
    bf16* hrow = (bf16*)(F.ws + WS_H2B) + (size_t)((var ? 8192 : 0) + t) * 256;
    hrow[lane] = (bf16)f2bf(h2); hrow[64 + lane] = 0; hrow[128 + lane] = 0; hrow[192 + lane] = 0;
}
__device__ __forceinline__ void phase_convert(Frame& F, int layer) {
    LAS float* scr = (LAS float*)(F.lds + RING_OFF + F.wave * 16384);
    const int gw = F.vcu * NWAVES + F.wave, NGW = F.G * NWAVES;
    const int jl = layer >> 1; const bool hy = (layer & 1) != 0;
    const float* ln_g = inp(F, 2); const float* ln_b = inp(F, 3);
    const float* ones = (const float*)(F.ws + WS_IDG); const float* zeros = (const float*)(F.ws + WS_IDB); float* dump = (float*)(F.ws + WS_DUMP);
    float* cd = (float*)(F.ws + WS_CD);
    float* c1 = cd, *d1 = cd + NFF2, *cm = cd + 2 * NFF2, *dm = cm + NQKV, *c2 = dm + NQKV, *d2 = c2 + NFF2;
    const int nb1 = (D / 32) * 4, nb0 = NFF2 / 32, nb4 = (hy ? NHY : NQKV) / 32, nb5 = D / 32;
    const int total = 2 * nb1 + 2 * nb0 + nb4 + nb5;
    for (int it = gw; it < total; it += NGW) {
        int r = it;
        if (r < 2 * nb1) { const int f = r / nb1; r -= f * nb1;
            conv_item(inp(F, 5) + (size_t)(layer * 2 + f) * FF * D, FF, D, (bf16*)(F.ws + (f ? W_OUT2 : W_OUT1)), ones, zeros, dump, dump + NQKV, zeros, 0, r >> 2, (r & 3) * 1408, (r & 3) * 1408 + 1408, scr, F.lane); continue; }
        r -= 2 * nb1;
        if (r < 2 * nb0) { const int f = r / nb0; r -= f * nb0;
            const float* gk = f ? ln_g + (size_t)(layer * 3 + 1) * D : (layer ? ln_g + (size_t)((layer - 1) * 3 + 2) * D : ones);
            const float* bk = f ? ln_b + (size_t)(layer * 3 + 1) * D : (layer ? ln_b + (size_t)((layer - 1) * 3 + 2) * D : zeros);
            conv_item(inp(F, 4) + (size_t)(layer * 2 + f) * D * NFF2, D, NFF2, (bf16*)(F.ws + (f ? W_IN2 : W_IN1)), gk, bk, f ? c2 : c1, f ? d2 : d1, zeros, 1, r, 0, D, scr, F.lane); continue; }
        r -= 2 * nb0;
        if (r < nb4) {
            const float* gk = ln_g + (size_t)(layer * 3) * D; const float* bk = ln_b + (size_t)(layer * 3) * D;
            if (hy) conv_item(inp(F, 8) + (size_t)jl * D * NHY, D, NHY, (bf16*)(F.ws + W_MIN), gk, bk, cm, dm, inp(F, 9) + (size_t)jl * NHY, 0, r, 0, D, scr, F.lane);
            else conv_item(inp(F, 6) + (size_t)jl * D * NQKV, D, NQKV, (bf16*)(F.ws + W_MIN), gk, bk, cm, dm, zeros, 2, r, 0, D, scr, F.lane);
            continue; }
        r -= nb4;
        conv_item((hy ? inp(F, 19) : inp(F, 7)) + (size_t)jl * D * D, D, D, (bf16*)(F.ws + W_MOUT), ones, zeros, dump, dump + NQKV, zeros, 0, r, 0, D, scr, F.lane);
    }
    if (hy) {
        for (int p = gw; p < 8192 + 2048; p += NGW) { if (p < 8192) filt_pos(F, jl, 0, p); else filt_pos(F, jl, 1, p - 8192); }
        const float* w3 = inp(F, 17) + (size_t)jl * 64 * 8192; bf16* w3T = (bf16*)(F.ws + WS_W3T);
        for (int n = gw; n < 8192; n += NGW) { bf16* r = w3T + (size_t)n * 256; r[F.lane] = (bf16)f2bf(w3[(size_t)F.lane * 8192 + n]); r[64 + F.lane] = 0; r[128 + F.lane] = 0; r[192 + F.lane] = 0; }
    }
}

__device__ __forceinline__ void phase_finalize(Frame& F) {
    const float* part = (const float*)(F.ws + WS_PART); float* stats = (float*)(F.ws + WS_STATS);
    for (int row = F.vcu * (NWAVES * 64) + F.tid; row < T; row += F.G * NWAVES * 64) {
        const GAS f32x4* p = (const GAS f32x4*)(part + (size_t)row * 128);
        float s = 0.f, q = 0.f;
#pragma unroll 8
        for (int j = 0; j < 32; ++j) { const f32x4 v = p[j]; s += v.x + v.z; q += v.y + v.w; }
        const float mean = s * (1.0f / D); const float var = fmaxf(q * (1.0f / D) - mean * mean, 0.f);
        *(GAS f32x2*)(stats + 2 * (size_t)row) = (f32x2){mean, 1.0f / sqrtf(var + LN_EPS)};
    }
}

#ifdef DBG_CHECK
__device__ __forceinline__ void phase_check_qkv(Frame& F) {
    const int gw = F.vcu * NWAVES + F.wave, NGW = F.G * NWAVES;
    const float* W = inp(F, 6); const float* g = inp(F, 2); const float* b = inp(F, 3);
    const float* stats = (const float*)(F.ws + WS_STATS); const bf16* QKV = (const bf16*)(F.ws + WS_BIG + BIG_QKV);
#ifndef DBG_ROW0
#define DBG_ROW0 0
#define DBG_ROW1 T
#endif
#ifndef DBG_COL0
#define DBG_COL0 0
#define DBG_COL1 NQKV
#endif
    float worst = 0.f; unsigned nbad = 0;
#ifdef CHK_ROWS
    {
        const bf16* zbp = (const bf16*)(F.ws + WS_ZB);
        for (int s = gw; s < 8192; s += NGW) {
            const unsigned hsh = (unsigned)s * 2654435761u; const int row = (int)(hsh % (unsigned)T);
            float sm = 0.f, sq = 0.f, dz = 0.f;
            for (int k = F.lane; k < D; k += 64) { const float v = F.z[(size_t)row * D + k]; sm += v; sq += v * v; dz = fmaxf(dz, fabsf(bf2f(zbp[(size_t)row * D + k]) - v)); }
            sm = wave_sum(sm); sq = wave_sum(sq); dz = fmaxf(dz, pg8::xor32_max(dz)); dz = fmaxf(dz, pg8::swz_xor<16>(dz)); dz = fmaxf(dz, pg8::swz_xor<8>(dz)); dz = fmaxf(dz, pg8::swz_xor<4>(dz)); dz = fmaxf(dz, pg8::swz_xor<2>(dz)); dz = fmaxf(dz, pg8::swz_xor<1>(dz));
            const float mean = sm * (1.0f / D), var = sq * (1.0f / D) - mean * mean, rstd = 1.0f / sqrtf(var + LN_EPS);
            const bool bad = (CHK_ROWS == 1) ? (fabsf(mean - stats[2 * row]) > CHK_MTOL || fabsf(rstd - stats[2 * row + 1]) > CHK_RTOL * rstd) : (dz > 0.05f);
            nbad += bad ? 1u : 0u;
        }
        if (F.lane == 0 && nbad) atomicAdd((unsigned*)(F.ws + WS_CTL) + 15000, nbad);
        return;
    }
#endif
    for (int s = gw; s < 8192; s += NGW) {
        const unsigned hsh = (unsigned)s * 2654435761u; const int row = DBG_ROW0 + (int)(hsh % (unsigned)(DBG_ROW1 - DBG_ROW0)), col = DBG_COL0 + (int)((hsh >> 7) % (unsigned)(DBG_COL1 - DBG_COL0));
#ifdef CHK_HYP
        const float mean = 0.f, rstd = 1.f;
#else
        const float mean = stats[2 * row], rstd = stats[2 * row + 1];
#endif
        float acc = 0.f;
        for (int k = F.lane; k < D; k += 64) acc += ((F.z[(size_t)row * D + k] - mean) * rstd * g[k] + b[k]) * W[(size_t)k * NQKV + col];
        acc = wave_sum(acc) * (col < 6144 ? QSCALE : 1.0f);
        const float got = bf2f(QKV[(size_t)row * NQKV + col]);
        worst = fmaxf(worst, fabsf(got - acc)); nbad += (fabsf(got - acc) > DBG_THR) ? 1u : 0u;
    }
#ifdef DBG_COUNT
    if (F.lane == 0 && nbad) atomicAdd((unsigned*)(F.ws + WS_CTL) + 15000, nbad);
#else
    if (F.lane == 0) atomicMax((unsigned*)(F.ws + WS_CTL) + 15000, __builtin_bit_cast(unsigned, worst));
#endif
}
#endif
__device__ __forceinline__ void phase_final_ln(Frame& F) {
    const int gw = F.vcu * NWAVES + F.wave, NGW = F.G * NWAVES;
    const float* stats = (const float*)(F.ws + WS_STATS);
    const float* g = inp(F, 2) + (size_t)(3 * 3 + 2) * D; const float* b = inp(F, 3) + (size_t)(3 * 3 + 2) * D;
    for (int m = gw; m < T; m += NGW) {
        const float mean = stats[2 * m], rstd = stats[2 * m + 1];
        GAS f32x4* d4 = (GAS f32x4*)(F.z + (size_t)m * D) + F.lane; const GAS f32x4* g4 = (const GAS f32x4*)g + F.lane; const GAS f32x4* b4 = (const GAS f32x4*)b + F.lane;
        float dbg = 0.f;
#ifdef DBG_CHECK
        #ifdef DBG_COUNT
        const float dbgval = (float)((const unsigned*)(F.ws + WS_CTL))[15000] * DBG_CHECK_SCALE;
#else
        const float dbgval = __builtin_bit_cast(float, ((const unsigned*)(F.ws + WS_CTL))[15000]) * DBG_CHECK_SCALE;
#endif
#endif
#ifdef DBG_BUF
        {
            const bf16* bp = (const bf16*)(F.ws + WS_BIG + DBG_OFF) + (size_t)m * DBG_PITCH; float s = 0.f;
            for (int c = F.lane; c < DBG_COLS; c += 64) s += bf2f(bp[c]) * (float)(1 + (c & 7));
            dbg = wave_sum(s) * 0.01f;
        }
#endif
#pragma unroll
        for (int j = 0; j < 8; ++j) { const f32x4 v = d4[64 * j] + dbg; d4[64 * j] = (v - mean) * rstd * g4[64 * j] + b4[64 * j];
#ifdef DBG_CHECK
            d4[64 * j] = (f32x4){dbgval, dbgval, dbgval, dbgval};
#endif
        }
    }
}

__device__ __forceinline__ void transpose_tile(const bf16* src, size_t sp, bf16* dst, size_t dp, int r0, int c0, LAS unsigned char* scr, int lane) {
#pragma unroll
    for (int i = 0; i < 8; ++i) { const int row = (lane >> 3) + 8 * i, ch = lane & 7;
        const v4u v = *(const GAS v4u*)(src + (size_t)(r0 + row) * sp + c0 + 8 * ch);
        LAS unsigned* w = (LAS unsigned*)(scr + row * 132 + ch * 16); w[0] = v.x; w[1] = v.y; w[2] = v.z; w[3] = v.w; }
    LDS_WAIT(); asm volatile("" ::: "memory");
    const LAS unsigned short* rd = (const LAS unsigned short*)(scr + lane * 132);
#pragma unroll 8
    for (int c = 0; c < 64; ++c) dst[(size_t)(c0 + c) * dp + r0 + lane] = rd[c];
    LDS_WAIT(); asm volatile("" ::: "memory");
}
__device__ __forceinline__ void phase_transpose(Frame& F, const bf16* src, int R, int C, bf16* dst) {
    LAS unsigned char* scr = F.lds + RING_OFF + F.wave * 16384;
    const int gw = F.vcu * NWAVES + F.wave, NGW = F.G * NWAVES, tr = R / 64, tc = C / 64;
    for (int it = gw; it < tr * tc; it += NGW) { const int a = it / tc, b = it % tc; transpose_tile(src, (size_t)C, dst, (size_t)R, 64 * a, 64 * b, scr, F.lane); }
}
__device__ __forceinline__ void fft_forward(LAS cpx* X, int tid, int logN) {
    int logM = logN;
    for (; logM >= 4; logM -= 4) { fft_pass<16, false>(X, tid, NWAVES * 64, logM); __syncthreads(); }
    if (logM == 2) { fft_pass<4, false>(X, tid, NWAVES * 64, 2); __syncthreads(); }
}
__device__ __forceinline__ void fft_inverse(LAS cpx* X, int tid, int logN) {
    const int rem = logN & 3;
    if (rem == 2) { fft_pass<4, true>(X, tid, NWAVES * 64, 2); __syncthreads(); }
    for (int logM = 4 + rem; logM <= logN; logM += 4) { fft_pass<16, true>(X, tid, NWAVES * 64, logM); __syncthreads(); }
}
template <int VAR> __device__ __forceinline__ void spec_unit(Frame& F, int jl, int c) {
    constexpr int L = VAR ? 2048 : 8192, N = 2 * L, LOGN = VAR ? 12 : 14, NP = L / 512;
    LAS cpx* X = (LAS cpx*)(F.lds + RING_OFF);
    int tid = F.tid; asm volatile("" : "+v"(tid));
    const float* taps = (const float*)(F.ws + WS_TAPS) + (size_t)c * 10240 + (VAR ? 8192 : 0);
    float acc[NP][4];
    float n0 = 0.f, n1 = 0.f;
#pragma unroll
    for (int k = 0; k < NP; ++k) {
#pragma unroll
        for (int f = 0; f < 4; ++f) acc[k][f] = taps[(size_t)f * 2048 * 10240 + tid + 512 * k];
        n0 += fabsf(acc[k][0]) + fabsf(acc[k][1]); n1 += fabsf(acc[k][2]) + fabsf(acc[k][3]); }
    block_sum2(F, n0, n1);
    const float i0 = 1.0f / n0, i1 = 1.0f / n1;
#pragma unroll
    for (int k = 0; k < NP; ++k) { acc[k][0] *= i0; acc[k][1] *= i0; acc[k][2] *= i1; acc[k][3] *= i1; }
    cpx* spec = (cpx*)(F.ws + WS_BIG + (VAR ? BIG_SPEC1 : BIG_SPEC0));
    if (VAR == 0) {
        float* tmp = (float*)(spec + ((size_t)1 * D + c) * N);
#pragma unroll
        for (int k = 0; k < NP; ++k) *(GAS f32x2*)(tmp + 2 * (tid + 512 * k)) = (f32x2){acc[k][2], acc[k][3]};
        __syncthreads();
#pragma unroll
        for (int k = 0; k < NP; ++k) { const int t = tid + 512 * k; const float hf = acc[k][0], hb = acc[k][1];
            if (t == 0) { X[pidx(0)] = cpx{hf + hb, 0.f}; X[pidx(L)] = cpx{0.f, 0.f}; }
            else { X[pidx(t)] = cpx{hf, 0.f}; X[pidx(N - t)] = cpx{hb, 0.f}; } }
        __syncthreads();
        fft_forward(X, tid, LOGN);
        { cpx* dst = spec + ((size_t)0 * D + c) * N; for (int p = tid; p < N; p += 512) dst[p] = X[pidx(p)]; }
        float h1[NP][2];
#pragma unroll
        for (int k = 0; k < NP; ++k) { const f32x2 v = *(const GAS f32x2*)(tmp + 2 * (tid + 512 * k)); h1[k][0] = v.x; h1[k][1] = v.y; }
        __syncthreads();
#pragma unroll
        for (int k = 0; k < NP; ++k) { const int t = tid + 512 * k; const float hf = h1[k][0], hb = h1[k][1];
            if (t == 0) { X[pidx(0)] = cpx{hf + hb, 0.f}; X[pidx(L)] = cpx{0.f, 0.f}; }
            else { X[pidx(t)] = cpx{hf, 0.f}; X[pidx(N - t)] = cpx{hb, 0.f}; } }
        __syncthreads();
        fft_forward(X, tid, LOGN);
        { cpx* dst = spec + ((size_t)1 * D + c) * N; for (int p = tid; p < N; p += 512) dst[p] = X[pidx(p)]; }
    } else {
        __syncthreads();
#pragma unroll
        for (int k = 0; k < NP; ++k) { const int t = tid + 512 * k;
#pragma unroll
            for (int o = 0; o < 2; ++o) { const float hf = acc[k][2 * o], hb = acc[k][2 * o + 1];
                if (t == 0) { X[pidx(o * N)] = cpx{hf + hb, 0.f}; X[pidx(o * N + L)] = cpx{0.f, 0.f}; }
                else { X[pidx(o * N + t)] = cpx{hf, 0.f}; X[pidx(o * N + N - t)] = cpx{hb, 0.f}; } } }
        for (int p = 2 * N + tid; p < 16384; p += 512) X[pidx(p)] = cpx{0.f, 0.f};
        __syncthreads();
        fft_forward(X, tid, LOGN);
#pragma unroll
        for (int o = 0; o < 2; ++o) { cpx* dst = spec + ((size_t)o * D + c) * N; for (int p = tid; p < N; p += 512) dst[p] = X[pidx(o * N + p)]; }
    }
}
__device__ __forceinline__ void phase_spectra(Frame& F, int jl) {
    for (int u = F.vcu; u < 2 * D; u += F.G) { if (u < D) spec_unit<0>(F, jl, u); else spec_unit<1>(F, jl, u - D); }
    __syncthreads();
}
__device__ __forceinline__ void load_conv16(const bf16* seq, int t0, int L, float w0, float w1, float w2, float cb, float (&out)[16]) {
    const v4u a = *(const GAS v4u*)(seq + t0), b = *(const GAS v4u*)(seq + t0 + 8);
    float u[18];
    u[0] = (t0 > 0) ? bf2f(seq[t0 - 1]) : 0.f; u[17] = (t0 + 16 < L) ? bf2f(seq[t0 + 16]) : 0.f;
    u[1] = bf2f(a.x & 0xffffu); u[2] = bf2f(a.x >> 16); u[3] = bf2f(a.y & 0xffffu); u[4] = bf2f(a.y >> 16); u[5] = bf2f(a.z & 0xffffu); u[6] = bf2f(a.z >> 16); u[7] = bf2f(a.w & 0xffffu); u[8] = bf2f(a.w >> 16);
    u[9] = bf2f(b.x & 0xffffu); u[10] = bf2f(b.x >> 16); u[11] = bf2f(b.y & 0xffffu); u[12] = bf2f(b.y >> 16); u[13] = bf2f(b.z & 0xffffu); u[14] = bf2f(b.z >> 16); u[15] = bf2f(b.w & 0xffffu); u[16] = bf2f(b.w >> 16);
#pragma unroll
    for (int i = 0; i < 16; ++i) out[i] = w0 * u[i] + w1 * u[i + 1] + w2 * u[i + 2] + cb;
}
template <int VAR> __device__ __forceinline__ void conv_unit(Frame& F, int jl, int c, int pair) {
    constexpr int L = VAR ? 2048 : 8192, N = 2 * L, LOGN = VAR ? 12 : 14, TPS = VAR ? 128 : 512;
    LAS cpx* X = (LAS cpx*)(F.lds + RING_OFF);
    int tid = F.tid; asm volatile("" : "+v"(tid));
    const int seg = tid / TPS, t0 = (tid % TPS) * 16;
    const int rowA = VAR ? T_PROMPT + (2 * seg) * L : (2 * pair) * L, rowB = rowA + L;
    const bf16* UT = (const bf16*)(F.ws + WS_BIG + BIG_UT); bf16* Z2T = (bf16*)(F.ws + WS_BIG + BIG_Z2T);
    const float* cw = inp(F, 10) + (size_t)jl * 3 * NHY; const float* cbv = inp(F, 11) + (size_t)jl * NHY; const float* skip = inp(F, 18) + (size_t)jl * 2 * D;
    const cpx* spec = (const cpx*)(F.ws + WS_BIG + (VAR ? BIG_SPEC1 : BIG_SPEC0));
#ifndef CONV_SCALE
#define CONV_SCALE 1.0f
#endif
    const float invN = CONV_SCALE / (float)N;
    float va[16], vb[16];
    { const int ch = c; const float w0 = cw[ch], w1 = cw[NHY + ch], w2 = cw[2 * NHY + ch], cb = cbv[ch];
      load_conv16(UT + (size_t)ch * T + rowA, t0, L, w0, w1, w2, cb, va); load_conv16(UT + (size_t)ch * T + rowB, t0, L, w0, w1, w2, cb, vb); }
    __syncthreads();
#pragma unroll
    for (int i = 0; i < 16; ++i) { X[pidx(seg * N + t0 + i)] = cpx{va[i], vb[i]}; X[pidx(seg * N + L + t0 + i)] = cpx{0.f, 0.f}; }
    __syncthreads();
    fft_forward(X, tid, LOGN);
    { const cpx* H = spec + ((size_t)0 * D + c) * N;
#pragma unroll
      for (int hb = 0; hb < 2; ++hb) { cpx hv[16];
#pragma unroll
        for (int k = 0; k < 16; ++k) hv[k] = H[(tid + 512 * (16 * hb + k)) & (N - 1)];
#pragma unroll
        for (int k = 0; k < 16; ++k) { const int p = tid + 512 * (16 * hb + k); X[pidx(p)] = cmul(X[pidx(p)], hv[k]); } } }
    __syncthreads();
    fft_inverse(X, tid, LOGN);
    {   float ga[16], gb[16];
        const int ch = D + c; const float w0 = cw[ch], w1 = cw[NHY + ch], w2 = cw[2 * NHY + ch], cb = cbv[ch];
        load_conv16(UT + (size_t)ch * T + rowA, t0, L, w0, w1, w2, cb, ga); load_conv16(UT + (size_t)ch * T + rowB, t0, L, w0, w1, w2, cb, gb);
        const float sk = skip[c];
#pragma unroll
        for (int i = 0; i < 16; ++i) { const cpx y = X[pidx(seg * N + t0 + i)]; va[i] = ga[i] * (y.x * invN + sk * va[i]); vb[i] = gb[i] * (y.y * invN + sk * vb[i]); }
#pragma unroll
        for (int i = 0; i < 16; ++i) { X[pidx(seg * N + t0 + i)] = cpx{va[i], vb[i]}; X[pidx(seg * N + L + t0 + i)] = cpx{0.f, 0.f}; }
    }
    __syncthreads();
    fft_forward(X, tid, LOGN);
    { const cpx* H = spec + ((size_t)1 * D + c) * N;
#pragma unroll
      for (int hb = 0; hb < 2; ++hb) { cpx hv[16];
#pragma unroll
        for (int k = 0; k < 16; ++k) hv[k] = H[(tid + 512 * (16 * hb + k)) & (N - 1)];
#pragma unroll
        for (int k = 0; k < 16; ++k) { const int p = tid + 512 * (16 * hb + k); X[pidx(p)] = cmul(X[pidx(p)], hv[k]); } } }
    __syncthreads();
    fft_inverse(X, tid, LOGN);
    {   float ga[16], gb[16];
        const int ch = 2 * D + c; const float w0 = cw[ch], w1 = cw[NHY + ch], w2 = cw[2 * NHY + ch], cb = cbv[ch];
        load_conv16(UT + (size_t)ch * T + rowA, t0, L, w0, w1, w2, cb, ga); load_conv16(UT + (size_t)ch * T + rowB, t0, L, w0, w1, w2, cb, gb);
        const float sk = skip[D + c];
        float ra[16], rb[16];
#pragma unroll
        for (int i = 0; i < 16; ++i) { const cpx y = X[pidx(seg * N + t0 + i)]; ra[i] = ga[i] * (y.x * invN + sk * va[i]); rb[i] = gb[i] * (y.y * invN + sk * vb[i]); }
        v4u o0, o1;
        o0.x = pk2(ra[0], ra[1]); o0.y = pk2(ra[2], ra[3]); o0.z = pk2(ra[4], ra[5]); o0.w = pk2(ra[6], ra[7]); o1.x = pk2(ra[8], ra[9]); o1.y = pk2(ra[10], ra[11]); o1.z = pk2(ra[12], ra[13]); o1.w = pk2(ra[14], ra[15]);
        GAS v4u* da = (GAS v4u*)(Z2T + (size_t)c * T + rowA + t0); da[0] = o0; da[1] = o1;
        o0.x = pk2(rb[0], rb[1]); o0.y = pk2(rb[2], rb[3]); o0.z = pk2(rb[4], rb[5]); o0.w = pk2(rb[6], rb[7]); o1.x = pk2(rb[8], rb[9]); o1.y = pk2(rb[10], rb[11]); o1.z = pk2(rb[12], rb[13]); o1.w = pk2(rb[14], rb[15]);
        GAS v4u* db = (GAS v4u*)(Z2T + (size_t)c * T + rowB + t0); db[0] = o0; db[1] = o1;
    }
}
__device__ __forceinline__ void phase_conv(Frame& F, int jl) {
    for (int u = F.vcu; u < 3 * D; u += F.G) { if (u < 2 * D) conv_unit<0>(F, jl, u >> 1, u & 1); else conv_unit<1>(F, jl, u - 2 * D, 0); }
    __syncthreads();
}
__device__ __forceinline__ unsigned voff_b(unsigned row, unsigned ch) { return 256u * row + 16u * (ch ^ (((row & 3u) << 2) | ((row >> 2) & 3u))); }
__device__ __forceinline__ s16x4 vtr(const LAS unsigned char* p) { typedef short v4i16_t __attribute__((ext_vector_type(4))); return __builtin_bit_cast(s16x4, __builtin_amdgcn_ds_read_tr16_b64_v4i16((LAS v4i16_t*)p)); }
__device__ __forceinline__ unsigned cvtpk(float lo, float hi) { typedef __bf16 bf16x2_t __attribute__((ext_vector_type(2))); f32x2 v = {lo, hi}; bf16x2_t b = __builtin_convertvector(v, bf16x2_t); return __builtin_bit_cast(unsigned, b); }
__device__ __forceinline__ void dma16(const void* gsrc, LAS unsigned char* lds_dst) {
    unsigned keep; const unsigned dst = __builtin_amdgcn_readfirstlane((unsigned)(unsigned long long)lds_dst);
    asm volatile("s_mov_b32 %0, m0\n\ts_mov_b32 m0, %2\n\ts_nop 0\n\tglobal_load_lds_dwordx4 %1, off\n\ts_mov_b32 m0, %0" : "=&s"(keep) : "v"(gsrc), "s"(dst) : "memory");
}
struct TileDesc { int g, kt0; };
constexpr int ATT_NT = 28;
__device__ __forceinline__ TileDesc attn_tile(int it, int T0w) {
    TileDesc t;
    if (it < 12) { t.g = 0; t.kt0 = T0w - 64 + 32 * it; }
    else if (it < 18) { t.g = 1; t.kt0 = T0w - 256 + 128 * (it - 12); }
    else { const int e = it - 18, ch = e / 5, tl = e % 5; t.g = 2; t.kt0 = T0w + 8 * ch - 1024 + 512 * tl; }
    return t;
}
__device__ __forceinline__ void attn_wave_task(const bf16* QKV, bf16* AO, LAS unsigned char* vimg, int blk, int h, int w, int lane) {
    const int r = lane & 31, hh = lane >> 5;
    const int T0 = blk * 256;
    int seq_start, seq_len;
    if (T0 < T_PROMPT) { seq_start = T0 & ~8191; seq_len = 8192; } else { seq_start = T_PROMPT + ((T0 - T_PROMPT) & ~2047); seq_len = 2048; }
    const int seq_end = seq_start + seq_len;
    const int T0w = T0 + w, qt = T0w + 8 * r;
    const float slope2 = __builtin_amdgcn_exp2f(-0.5f * (float)(h + 1)) * LOG2E;
    f32x16 o[4];
#pragma unroll
    for (int dt = 0; dt < 4; ++dt)
#pragma unroll
        for (int i = 0; i < 16; ++i) o[dt][i] = 0.f;
    float m_run = -1e30f, l_run = 0.f;
    bf16x8 qf[8], kf[8];
    const bf16* hb = QKV + h * 128;
    auto issue_tile = [&](const TileDesc& td, LAS unsigned char* img_dst) {
        const int d = 1 << (2 * td.g);
        const bf16* Kb = hb + 6144 + td.g * 2048; const bf16* Vb = hb + 12288 + td.g * 2048;
#pragma unroll
        for (int i = 0; i < 8; ++i) { const int row = 4 * i + (lane >> 4); int vt = td.kt0 + row * d; vt = vt < seq_start ? seq_start : (vt >= seq_end ? seq_end - 1 : vt);
            const int lch = (lane & 15) ^ (((row & 3) << 2) | ((row >> 2) & 3));
            dma16(Vb + (size_t)vt * NQKV + 8 * lch, img_dst + i * 1024); }
        int kt = td.kt0 + r * d; kt = kt < seq_start ? seq_start : (kt >= seq_end ? seq_end - 1 : kt);
        const bf16* kp = Kb + (size_t)kt * NQKV + 8 * hh;
#pragma unroll
        for (int s = 0; s < 8; ++s) kf[s] = *(const GAS bf16x8*)(kp + 16 * s);
    };
    auto load_q = [&](int g) { const bf16* qp = hb + g * 2048 + (size_t)qt * NQKV + 8 * hh;
#pragma unroll
        for (int s = 0; s < 8; ++s) qf[s] = *(const GAS bf16x8*)(qp + 16 * s); };
    TileDesc cur = attn_tile(0, T0w);
    load_q(0);
    issue_tile(cur, vimg);
    for (int it = 0; it < ATT_NT; ++it) {
        LAS unsigned char* img = vimg + (it & 1) * 8192;
        const int d = 1 << (2 * cur.g), win = 64 * d, kt0 = cur.kt0;
        f32x16 st;
#pragma unroll
        for (int i = 0; i < 16; ++i) st[i] = 0.f;
#pragma unroll
        for (int s = 0; s < 8; ++s) st = __builtin_amdgcn_mfma_f32_32x32x16_bf16(kf[s], qf[s], st, 0, 0, 0);
        if (it + 1 < ATT_NT) { const TileDesc nx = attn_tile(it + 1, T0w); if (nx.g != cur.g) load_q(nx.g); issue_tile(nx, vimg + ((it + 1) & 1) * 8192); cur = nx; }
        const int dl0 = kt0 + 4 * hh * d - qt;
        const bool res_ok = (dl0 & (d - 1)) == 0;
        const int lo_i = max(-win, seq_start - qt), hi_i = min(win, seq_end - 1 - qt);
        const float flo = res_ok ? (float)lo_i : 1e30f, fhi = (float)hi_i, fdl0 = (float)dl0, fd = (float)d;
        float mloc = -1e30f;
#pragma unroll
        for (int i = 0; i < 16; ++i) { const float fdl = fdl0 + (float)((i & 3) + 8 * (i >> 2)) * fd;
            const float s = st[i] - slope2 * __builtin_fabsf(fdl);
            const bool ok = (fdl >= flo) && (fdl <= fhi);
            const float sm = ok ? s : -1e30f; st[i] = sm; mloc = fmaxf(mloc, sm); }
        mloc = pg8::xor32_max(mloc);
        const float m_new = fmaxf(m_run, mloc);
        const float m_use = fmaxf(m_new, -1e20f);
        float ls = 0.f;
#pragma unroll
        for (int i = 0; i < 16; ++i) { const float pv = __builtin_amdgcn_exp2f(st[i] - m_use); st[i] = pv; ls += pv; }
        ls = pg8::xor32_sum(ls);
        if (__any(m_new != m_run)) {
            const float alpha = __builtin_amdgcn_exp2f(m_run - m_new);
            l_run *= alpha;
#pragma unroll
            for (int dt = 0; dt < 4; ++dt)
#pragma unroll
                for (int i = 0; i < 16; ++i) o[dt][i] *= alpha;
        }
        l_run += ls; m_run = m_new;
        bf16x8 pb[2];
#pragma unroll
        for (int s2 = 0; s2 < 2; ++s2) { v4u w; w.x = cvtpk(st[8 * s2 + 0], st[8 * s2 + 1]); w.y = cvtpk(st[8 * s2 + 2], st[8 * s2 + 3]); w.z = cvtpk(st[8 * s2 + 4], st[8 * s2 + 5]); w.w = cvtpk(st[8 * s2 + 6], st[8 * s2 + 7]); pb[s2] = __builtin_bit_cast(bf16x8, w); }
        const int q4 = (lane & 15) >> 2, p4 = lane & 3, blk16 = (lane >> 4) & 1;
#pragma unroll
        for (int dt = 0; dt < 4; ++dt)
#pragma unroll
            for (int s2 = 0; s2 < 2; ++s2) {
                const unsigned chn = 4 * dt + 2 * blk16 + (p4 >> 1);
                const s16x4 lo = vtr(img + voff_b(16 * s2 + 4 * hh + q4, chn) + 8 * (p4 & 1));
                const s16x4 hi = vtr(img + voff_b(16 * s2 + 8 + 4 * hh + q4, chn) + 8 * (p4 & 1));
                const bf16x8 va = __builtin_shufflevector(lo, hi, 0, 1, 2, 3, 4, 5, 6, 7);
                o[dt] = __builtin_amdgcn_mfma_f32_32x32x16_bf16(va, pb[s2], o[dt], 0, 0, 0);
            }
    }
    const float inv = 1.0f / l_run;
    bf16* op = AO + (size_t)qt * D + h * 128 + 4 * hh;
#pragma unroll
    for (int dt = 0; dt < 4; ++dt)
#pragma unroll
        for (int i4 = 0; i4 < 4; ++i4) { v2u w; w.x = cvtpk(o[dt][4 * i4] * inv, o[dt][4 * i4 + 1] * inv); w.y = cvtpk(o[dt][4 * i4 + 2] * inv, o[dt][4 * i4 + 3] * inv);
            *(GAS v2u*)(op + 32 * dt + 8 * i4) = w; }
}
__device__ __forceinline__ void phase_attention(Frame& F) {
    const bf16* QKV = (const bf16*)(F.ws + WS_BIG + BIG_QKV); bf16* AO = (bf16*)(F.ws + WS_BIG + BIG_AO);
    LAS unsigned char* vimg = F.lds + RING_OFF + F.wave * 16384;
    for (int j = F.vcu; j < (T / 256) * 16; j += F.G) {
        const int h = j & 15, blk = j >> 4;
        attn_wave_task(QKV, AO, vimg, blk, h, F.wave, F.lane);
    }
}

#ifdef ATTN_NAIVE
__device__ __forceinline__ void phase_attention_naive(Frame& F) {
    const bf16* QKV = (const bf16*)(F.ws + WS_BIG + BIG_QKV); bf16* AO = (bf16*)(F.ws + WS_BIG + BIG_AO);
    const int gw = F.vcu * NWAVES + F.wave, NGW = F.G * NWAVES, lane = F.lane;
    for (int p = gw; p < T * 16; p += NGW) {
        const int tok = p >> 4, h = p & 15;
        int seq_start, seq_len;
        if (tok < T_PROMPT) { seq_start = tok & ~8191; seq_len = 8192; } else { seq_start = T_PROMPT + ((tok - T_PROMPT) & ~2047); seq_len = 2048; }
        const int seq_end = seq_start + seq_len;
        const float slope2 = __builtin_amdgcn_exp2f(-0.5f * (float)(h + 1)) * LOG2E;
        float m = -1e30f, l = 0.f, o0 = 0.f, o1 = 0.f;
        for (int g = 0; g < 3; ++g) {
            const int d = 1 << (2 * g);
            const unsigned qw = *(const GAS unsigned*)(QKV + (size_t)tok * NQKV + g * 2048 + h * 128 + 2 * lane);
            const float q0 = bf2f(qw & 0xffffu), q1 = bf2f(qw >> 16);
            for (int j = -64; j <= 64; ++j) {
                const int kt = tok + j * d;
                if (kt < seq_start || kt >= seq_end) continue;
                const unsigned kw = *(const GAS unsigned*)(QKV + (size_t)kt * NQKV + 6144 + g * 2048 + h * 128 + 2 * lane);
                const unsigned vw = *(const GAS unsigned*)(QKV + (size_t)kt * NQKV + 12288 + g * 2048 + h * 128 + 2 * lane);
                const float s = wave_sum(q0 * bf2f(kw & 0xffffu) + q1 * bf2f(kw >> 16)) - slope2 * (float)((j < 0 ? -j : j) * d);
                const float mn = fmaxf(m, s), al = __builtin_amdgcn_exp2f(m - mn), pv = __builtin_amdgcn_exp2f(s - mn);
                l = l * al + pv; o0 = o0 * al + pv * bf2f(vw & 0xffffu); o1 = o1 * al + pv * bf2f(vw >> 16); m = mn;
            }
        }
        const float inv = 1.0f / l;
        *(GAS unsigned*)(AO + (size_t)tok * D + h * 128 + 2 * lane) = pk2(o0 * inv, o1 * inv);
    }
}
#endif
constexpr int NPHASE = 54;
#ifndef DUP_PHASE
#define DUP_PHASE (-1)
#define DUP_N 0
#endif
#define REPS(id) for (int rep_ = 0; rep_ < ((DUP_PHASE) == (id) ? 1 + (DUP_N) : 1); ++rep_)
#ifndef ZERO_HY
#define ZERO_HY 0
#endif
#ifndef ZERO_AT
#define ZERO_AT 0
#endif
#ifndef AT_SCALE
#define AT_SCALE 1.0f
#endif
#ifndef HY_SCALE
#define HY_SCALE 1.0f
#endif
#define MIXSCALE(hy) ((hy) ? (ZERO_HY ? 0.0f : HY_SCALE) : (ZERO_AT ? 0.0f : AT_SCALE))
struct Args { const float* in[21]; float* out; unsigned char* ws; int ph_lo, ph_hi; };
static_assert(sizeof(Args) == 21 * 8 + 8 + 8 + 8, "Args has no padding");
__global__ void __launch_bounds__(NWAVES * 64, 2) fwd_kernel(Args args) {
    extern __shared__ __attribute__((aligned(16))) unsigned char lds[];
    unsigned char* const ws0 = args.ws;
    const int wave0 = __builtin_amdgcn_readfirstlane(threadIdx.x >> 6);
    volatile LAS unsigned* MISC = (volatile LAS unsigned*)((LAS unsigned char*)lds + MISC_OFF);
    if (threadIdx.x < 64) MISC[threadIdx.x] = 0u;
    if (threadIdx.x == 64) {
#pragma unroll
        for (int i = 0; i < 21; ++i) ((LAS unsigned long long*)((LAS unsigned char*)lds + PTR_OFF))[i] = (unsigned long long)args.in[i];
    }
    __syncthreads();
    XcdBarrier bar = xcd_barrier_post((unsigned*)(ws0 + WS_CTL), MISC);
#define FRAME() Frame F = make_frame(lds, args.ws, args.out, wave0)
    const int lo = args.ph_lo, hi = args.ph_hi;
#define RUN(id) (lo <= (id) && (id) < hi)
#define SEAM(id) do { if ((id) + 1 < hi) xcd_barrier(bar); } while (0)

#define ZB ((bf16*)(F.ws + WS_ZB))
#define STATS ((float*)(F.ws + WS_STATS))
#define PART ((float*)(F.ws + WS_PART))
#define CDV(off) ((float*)(F.ws + WS_CD) + (off))
#define HID ((bf16*)(F.ws + WS_BIG + BIG_HID))
    constexpr int O_C1 = 0, O_D1 = NFF2, O_CM = 2 * NFF2, O_DM = 2 * NFF2 + NQKV, O_C2 = 2 * NFF2 + 2 * NQKV, O_D2 = 3 * NFF2 + 2 * NQKV;

    if (RUN(0)) { FRAME(); phase_init(F); SEAM(0); }

#pragma unroll
    for (int layer = 0; layer < DEPTH; ++layer) {
        const int pb = 1 + 13 * layer; const bool hy = (layer & 1) != 0; const int jl = layer >> 1;
        if (RUN(pb + 0)) { FRAME(); REPS(0) phase_convert(F, layer); SEAM(pb + 0); }

        if (RUN(pb + 1)) {
            if (hy) {
                FRAME();
                pg8::Gemm gt{(const bf16*)(F.ws + WS_W3T), (const bf16*)(F.ws + WS_H2B), 8192, 10240, 256}; pg8::StaticOrder St; St.init(8192, 10240, F.G, F.bx);
                pg8::EpiTaps Et{(float*)(F.ws + WS_TAPS), MIN_DECAY, (MAX_DECAY - MIN_DECAY) / 2047.0f};
                pg8::gemm_phase<pg8::EpiTaps, pg8::StaticOrder, PG8_ALIGN, PG8_SP2>(F.lds + RING_OFF, gt, St, Et, F.tid);
            }
            FRAME();
            pg8::Gemm g{ZB, (const bf16*)(F.ws + W_IN1), T, NFF2, D}; pg8::StaticOrder S; S.init(T, NFF2, F.G, F.bx);
            pg8::EpiSwiglu E{HID, FF, STATS, CDV(O_C1), CDV(O_D1)};
            REPS(1) pg8::gemm_phase<pg8::EpiSwiglu, pg8::StaticOrder, PG8_ALIGN, PG8_SP2>(F.lds + RING_OFF, g, S, E, F.tid);
            SEAM(pb + 1);
        }
        if (RUN(pb + 2)) {
            FRAME();
            pg8::Gemm g{HID, (const bf16*)(F.ws + W_OUT1), T, D, FF}; pg8::StaticOrder S; S.init(T, D, F.G, F.bx);
            const float* g0 = layer ? inp(F, 2) + (size_t)((layer - 1) * 3 + 2) * D : (const float*)(F.ws + WS_IDG); const float* b0 = layer ? inp(F, 3) + (size_t)((layer - 1) * 3 + 2) * D : (const float*)(F.ws + WS_IDB);
            pg8::EpiResid E{F.z, ZB, STATS, g0, b0, (const float*)(F.ws + WS_IDB), PART, 0.5f, 0};
            pg8::gemm_phase<pg8::EpiResid, pg8::StaticOrder, PG8_ALIGN, PG8_SP2>(F.lds + RING_OFF, g, S, E, F.tid);
            SEAM(pb + 2);
        }
        if (RUN(pb + 3)) { FRAME(); REPS(3) phase_finalize(F); SEAM(pb + 3); }

        if (RUN(pb + 4)) {
            FRAME(); const int N = hy ? NHY : NQKV;
            pg8::Gemm g{ZB, (const bf16*)(F.ws + W_MIN), T, N, D}; pg8::StaticOrder S; S.init(T, N, F.G, F.bx);
            pg8::EpiLnBf16 E{(bf16*)(F.ws + WS_BIG), N, STATS, CDV(O_CM), CDV(O_DM)};
            REPS(4) pg8::gemm_phase<pg8::EpiLnBf16, pg8::StaticOrder, PG8_ALIGN, PG8_SP2>(F.lds + RING_OFF, g, S, E, F.tid);
            SEAM(pb + 4);
        }
        if (RUN(pb + 5)) {
            FRAME();
#ifdef ATTN_NAIVE
            if (!hy) phase_attention_naive(F);
#else
            if (!hy) { REPS(5) phase_attention(F); }
#endif
            else { REPS(15) phase_spectra(F, jl); REPS(25) phase_transpose(F, (const bf16*)(F.ws + WS_BIG + BIG_U), T, NHY, (bf16*)(F.ws + WS_BIG + BIG_UT)); }
            SEAM(pb + 5);
        }
        if (hy) {
            if (RUN(pb + 6)) { FRAME(); REPS(6) phase_conv(F, jl); SEAM(pb + 6); }
            if (RUN(pb + 7)) { FRAME(); REPS(7) phase_transpose(F, (const bf16*)(F.ws + WS_BIG + BIG_Z2T), D, T, (bf16*)(F.ws + WS_BIG + BIG_Z2)); SEAM(pb + 7); }
        }
        if (RUN(pb + 8)) {
            FRAME();
            const bf16* A = hy ? (const bf16*)(F.ws + WS_BIG + BIG_Z2) : (const bf16*)(F.ws + WS_BIG + BIG_AO);
            pg8::Gemm g{A, (const bf16*)(F.ws + W_MOUT), T, D, D}; pg8::StaticOrder S; S.init(T, D, F.G, F.bx);
            pg8::EpiResid E{F.z, ZB, STATS, inp(F, 2) + (size_t)(layer * 3) * D, inp(F, 3) + (size_t)(layer * 3) * D, hy ? inp(F, 20) + (size_t)jl * D : (const float*)(F.ws + WS_IDB), PART, MIXSCALE(hy), 0};
            pg8::gemm_phase<pg8::EpiResid, pg8::StaticOrder, PG8_ALIGN, PG8_SP2>(F.lds + RING_OFF, g, S, E, F.tid);
            SEAM(pb + 8);
        }
        if (RUN(pb + 9)) { FRAME(); phase_finalize(F); SEAM(pb + 9); }

        if (RUN(pb + 10)) {
            FRAME();
            pg8::Gemm g{ZB, (const bf16*)(F.ws + W_IN2), T, NFF2, D}; pg8::StaticOrder S; S.init(T, NFF2, F.G, F.bx);
            pg8::EpiSwiglu E{HID, FF, STATS, CDV(O_C2), CDV(O_D2)};
            pg8::gemm_phase<pg8::EpiSwiglu, pg8::StaticOrder, PG8_ALIGN, PG8_SP2>(F.lds + RING_OFF, g, S, E, F.tid);
            SEAM(pb + 10);
        }
        if (RUN(pb + 11)) {
            FRAME();
            pg8::Gemm g{HID, (const bf16*)(F.ws + W_OUT2), T, D, FF}; pg8::StaticOrder S; S.init(T, D, F.G, F.bx);
            pg8::EpiResid E{F.z, ZB, STATS, inp(F, 2) + (size_t)(layer * 3 + 1) * D, inp(F, 3) + (size_t)(layer * 3 + 1) * D, (const float*)(F.ws + WS_IDB), PART, 0.5f, 0};
            pg8::gemm_phase<pg8::EpiResid, pg8::StaticOrder, PG8_ALIGN, PG8_SP2>(F.lds + RING_OFF, g, S, E, F.tid);
            SEAM(pb + 11);
        }
        if (RUN(pb + 12)) { FRAME(); phase_finalize(F); SEAM(pb + 12); }
    }
#ifdef DBG_CHECK
    if (RUN(NPHASE - 2)) { FRAME(); phase_check_qkv(F); SEAM(NPHASE - 2); }
#endif
    if (RUN(NPHASE - 1)) { FRAME(); phase_final_ln(F); }
#undef RUN
#undef SEAM
#undef FRAME
}


#ifdef PHASE_PROBE
#define PROBE_FRAME() extern __shared__ __attribute__((aligned(16))) unsigned char lds[]; Frame F = make_frame(lds, args.ws, args.out, __builtin_amdgcn_readfirstlane(threadIdx.x >> 6));
__global__ void __launch_bounds__(NWAVES * 64, 2) probe_init(Args args) { PROBE_FRAME(); phase_init(F); }
__global__ void __launch_bounds__(NWAVES * 64, 2) probe_convert(Args args) { PROBE_FRAME(); phase_convert(F, args.ph_lo); }
__global__ void __launch_bounds__(NWAVES * 64, 2) probe_finalize(Args args) { PROBE_FRAME(); phase_finalize(F); phase_final_ln(F); }
__global__ void __launch_bounds__(NWAVES * 64, 2) probe_transpose(Args args) { PROBE_FRAME(); phase_transpose(F, (const bf16*)(F.ws + WS_BIG + BIG_U), T, NHY, (bf16*)(F.ws + WS_BIG + BIG_UT)); }
__global__ void __launch_bounds__(NWAVES * 64, 2) probe_spectra(Args args) { PROBE_FRAME(); phase_spectra(F, args.ph_lo); }
__global__ void __launch_bounds__(NWAVES * 64, 2) probe_conv(Args args) { PROBE_FRAME(); phase_conv(F, args.ph_lo); }
__global__ void __launch_bounds__(NWAVES * 64, 2) probe_attn(Args args) { PROBE_FRAME(); phase_attention(F); }
__global__ void __launch_bounds__(NWAVES * 64, 2) probe_gemm_swiglu(Args args) { PROBE_FRAME(); pg8::Gemm g{(const bf16*)F.ws, (const bf16*)(F.ws + W_IN1), T, NFF2, D}; pg8::StaticOrder S; S.init(T, NFF2, F.G, F.bx); pg8::EpiSwiglu E{(bf16*)(F.ws + WS_BIG), FF, (float*)(F.ws + WS_STATS), (float*)(F.ws + WS_CD), (float*)(F.ws + WS_CD)}; pg8::gemm_phase<pg8::EpiSwiglu, pg8::StaticOrder, PG8_ALIGN, PG8_SP2>(F.lds + RING_OFF, g, S, E, F.tid); }
__global__ void __launch_bounds__(NWAVES * 64, 2) probe_gemm_resid(Args args) { PROBE_FRAME(); pg8::Gemm g{(const bf16*)F.ws, (const bf16*)(F.ws + W_IN1), T, D, FF}; pg8::StaticOrder S; S.init(T, D, F.G, F.bx); pg8::EpiResid E{F.z, (bf16*)(F.ws + WS_ZB), (float*)(F.ws + WS_STATS), inp(F, 2), inp(F, 3), args.ph_lo ? inp(F, 20) : (const float*)(F.ws + WS_IDB), (float*)(F.ws + WS_PART), 0.5f, 0}; pg8::gemm_phase<pg8::EpiResid, pg8::StaticOrder, PG8_ALIGN, PG8_SP2>(F.lds + RING_OFF, g, S, E, F.tid); }
__global__ void __launch_bounds__(NWAVES * 64, 2) probe_gemm_ln(Args args) { PROBE_FRAME(); pg8::Gemm g{(const bf16*)F.ws, (const bf16*)(F.ws + W_IN1), T, NQKV, D}; pg8::StaticOrder S; S.init(T, NQKV, F.G, F.bx); pg8::EpiLnBf16 E{(bf16*)(F.ws + WS_BIG), NQKV, (float*)(F.ws + WS_STATS), (float*)(F.ws + WS_CD), (float*)(F.ws + WS_CD)}; pg8::gemm_phase<pg8::EpiLnBf16, pg8::StaticOrder, PG8_ALIGN, PG8_SP2>(F.lds + RING_OFF, g, S, E, F.tid); }
#endif
#ifndef MK_MULTI
#define MK_MULTI 0
#endif
extern "C" void kernel_launch(void* const* d_in, const int* in_sizes, int n_in, void* d_out, int out_size, void* d_ws, size_t ws_size, hipStream_t stream) {
    static int grid = 0;
    if (grid == 0) {
        if (n_in != 21 || out_size != T * D || ws_size < WS_END) { fprintf(stderr, "kernel_launch: unexpected shapes (n_in %d, out %d, ws %zu, need %zu)\n", n_in, out_size, ws_size, (size_t)WS_END); grid = -1; return; }
        int dev = 0, cus = 0, per_cu = 0;
        if (hipGetDevice(&dev) != hipSuccess || hipDeviceGetAttribute(&cus, hipDeviceAttributeMultiprocessorCount, dev) != hipSuccess) { grid = -1; return; }
        if (hipFuncSetAttribute((const void*)fwd_kernel, hipFuncAttributeMaxDynamicSharedMemorySize, LDS_BYTES) != hipSuccess) { fprintf(stderr, "kernel_launch: hipFuncSetAttribute failed\n"); grid = -1; return; }
        if (hipOccupancyMaxActiveBlocksPerMultiprocessor(&per_cu, (const void*)fwd_kernel, NWAVES * 64, LDS_BYTES) != hipSuccess || per_cu < 1) fprintf(stderr, "kernel_launch: occupancy query reports %d\n", per_cu);
        (void)hipGetLastError();
        grid = cus;
    }
    if (grid < 0) return;
    if (hipMemsetAsync((char*)d_ws + WS_CTL, 0, CTL_ZERO_BYTES, stream) != hipSuccess) return;
    Args a{};
    for (int i = 0; i < 21; ++i) a.in[i] = (const float*)d_in[i];
    a.out = (float*)d_out; a.ws = (unsigned char*)d_ws;
#ifndef STOP_AFTER
#define STOP_AFTER (NPHASE - 1)
#endif
#ifdef DBG_CHECK
#define DBGCHK_ON 1
#else
#define DBGCHK_ON 0
#endif
#if MK_MULTI
    for (int p = 0; p < NPHASE; ++p) { if (p >= STOP_AFTER && p != NPHASE - 1 && !(DBGCHK_ON && p == NPHASE - 2)) continue; a.ph_lo = p; a.ph_hi = p + 1; hipLaunchKernelGGL(fwd_kernel, dim3(grid), dim3(NWAVES * 64), LDS_BYTES, stream, a); }
#else
    a.ph_lo = 0; a.ph_hi = NPHASE;
    hipLaunchKernelGGL(fwd_kernel, dim3(grid), dim3(NWAVES * 64), LDS_BYTES, stream, a);
#endif
}
```

```cpp
#include <hip/hip_runtime.h>
#include <cstdio>
#include <cstdint>
namespace pg8 {
#define PG8_LAS __attribute__((address_space(3)))
typedef unsigned short bf16_t;
typedef short bf16x8 __attribute__((ext_vector_type(8)));
typedef float f32x4 __attribute__((ext_vector_type(4)));
typedef unsigned u32x4 __attribute__((ext_vector_type(4)));
constexpr int BM = 256, BK = 64, HALF = 128, HTB = HALF * BK * 2  , STAGE_BYTES = 8 * HTB, NXCD = 8, WGM = 8;

__host__ __device__ __forceinline__ int lds_byte(int r, int c) { const int st = (r >> 4) * 2 + (c >> 5), rr = r & 15, cc = c & 31, ob = rr * 64 + cc * 2; return st * 1024 + (ob ^ (((ob >> 9) & 1) << 5)); }
__host__ __device__ __forceinline__ void stage_rc(int b, int& R, int& C) { const int st = b / 1024, sb = b % 1024, swz = sb ^ (((sb >> 9) & 1) << 5); R = (st >> 1) * 16 + swz / 64; C = (st & 1) * 32 + (swz % 64) / 2; }
__host__ __device__ __forceinline__ int perm32(int rho) { const int n = rho >> 4, i = rho & 15; return 8 * (i >> 2) + 4 * n + (i & 3); }

struct Unit { int pm, pn; };
struct Gemm { const bf16_t* A; const bf16_t* Bt; int M, N, K; };

struct StaticOrder {
    int nM, nN, nwg, G, c, rev;
    __host__ __device__ void init(int M, int N, int G_, int c_, int rev_ = 0) { nM = M / BM; nN = N / BM; nwg = nM * nN; G = G_; c = c_; rev = rev_; }
    __host__ __device__ bool next(int i, Unit& u) const {
        const int nr = (nwg + G - 1) / G; if (i >= nr) return false;
        const long L = (long)(rev ? nr - 1 - i : i) * G + c; if (L >= nwg) return false;
        int wgid = (int)L; { const int q = nwg / NXCD, r = nwg % NXCD, xcd = wgid % NXCD, off = wgid / NXCD; wgid = (xcd < r ? xcd * (q + 1) : r * (q + 1) + (xcd - r) * q) + off; }
        const int nig = WGM * nN, gid = wgid / nig, fm = gid * WGM, gsz = (nM - fm) < WGM ? (nM - fm) : WGM;
        u.pm = fm + ((wgid % nig) % gsz); u.pn = (wgid % nig) / gsz; return true;
    }
    __device__ __forceinline__ void a_ready(const Unit&) const {}
    __device__ __forceinline__ void done(const Unit&) const {}
};

__device__ __forceinline__ unsigned cvt_pk_bf16(float lo, float hi) { unsigned r; asm volatile("v_cvt_pk_bf16_f32 %0, %1, %2" : "=v"(r) : "v"(lo), "v"(hi)); return r; }
typedef float f32x2 __attribute__((ext_vector_type(2)));
typedef float f32x2v __attribute__((ext_vector_type(2)));
typedef unsigned u32x2v __attribute__((ext_vector_type(2)));
constexpr float DN_ALPHA_F = 1.6817928305074292f;

__device__ __forceinline__ unsigned cvt2(float lo, float hi) { typedef __bf16 bf16x2_t __attribute__((ext_vector_type(2))); const f32x2v v = {lo, hi}; return __builtin_bit_cast(unsigned, __builtin_convertvector(v, bf16x2_t)); }
__device__ __forceinline__ float xor32_sum(float x) { const auto r = __builtin_amdgcn_permlane32_swap(__float_as_uint(x), __float_as_uint(x), false, false); const unsigned r0 = r[0], r1 = r[1]; return __uint_as_float(r0) + __uint_as_float(r1); }
__device__ __forceinline__ float xor32_max(float x) { const auto r = __builtin_amdgcn_permlane32_swap(__float_as_uint(x), __float_as_uint(x), false, false); const unsigned r0 = r[0], r1 = r[1]; return fmaxf(__uint_as_float(r0), __uint_as_float(r1)); }
template <int MASK> __device__ __forceinline__ float swz_xor(float x) { return __builtin_bit_cast(float, __builtin_amdgcn_ds_swizzle(__builtin_bit_cast(int, x), (MASK << 10) | 0x1F)); }
__device__ __forceinline__ float wave_sum64(float v) { v += swz_xor<1>(v); v += swz_xor<2>(v); v += swz_xor<4>(v); v += swz_xor<8>(v); v += swz_xor<16>(v); return xor32_sum(v); }

struct EpiLnBf16 {
    static constexpr bool PERM = true, AFTER_DRAIN = false;
    bf16_t* O; int ldc; const float* stats; const float* cvec; const float* dvec;
    __device__ __forceinline__ void operator()(const f32x4 (&acc)[2][2][4][2], const Unit& u, int wr, int wc, int fr, int fq) const {
        const int row0 = u.pm * BM + wr * 64 + fr, col0 = u.pn * BM + wc * 32 + 8 * fq;
        f32x4 cv[2][2], dv[2][2];
#pragma unroll
        for (int bj = 0; bj < 2; ++bj)
#pragma unroll
            for (int n = 0; n < 2; ++n) { cv[bj][n] = *(const f32x4*)(cvec + col0 + bj * HALF + 4 * n); dv[bj][n] = *(const f32x4*)(dvec + col0 + bj * HALF + 4 * n); }
        f32x2v sts[2][4];
#pragma unroll
        for (int ai = 0; ai < 2; ++ai)
#pragma unroll
            for (int m = 0; m < 4; ++m) sts[ai][m] = *(const f32x2v*)(stats + 2 * (size_t)(row0 + ai * HALF + m * 16));
#pragma unroll
        for (int ai = 0; ai < 2; ++ai)
#pragma unroll
            for (int m = 0; m < 4; ++m) { const int row = row0 + ai * HALF + m * 16; const f32x2v st = sts[ai][m];
                bf16_t* rowp = O + (size_t)row * ldc + col0;
#pragma unroll
                for (int bj = 0; bj < 2; ++bj) { const f32x4 v0 = (acc[ai][bj][m][0] - st.x * cv[bj][0]) * st.y + dv[bj][0], v1 = (acc[ai][bj][m][1] - st.x * cv[bj][1]) * st.y + dv[bj][1];
                    u32x4 w; w.x = cvt2(v0[0], v0[1]); w.y = cvt2(v0[2], v0[3]); w.z = cvt2(v1[0], v1[1]); w.w = cvt2(v1[2], v1[3]);
                    *(u32x4*)(rowp + bj * HALF) = w; } }
    }
};
__device__ __forceinline__ float silu_mul(float g, float up) { const float e = __builtin_amdgcn_exp2f(-1.4426950408889634f * g); return g * __builtin_amdgcn_rcpf(1.0f + e) * up; }
struct EpiSwiglu {
    static constexpr bool PERM = true, AFTER_DRAIN = false;
    bf16_t* O; int ldc; const float* stats; const float* cvec; const float* dvec;
    __device__ __forceinline__ void operator()(const f32x4 (&acc)[2][2][4][2], const Unit& u, int wr, int wc, int fr, int fq) const {
        const int row0 = u.pm * BM + wr * 64 + fr, col0 = u.pn * BM + wc * 32 + 8 * fq, ocol = u.pn * HALF + wc * 32 + 8 * fq;
        f32x4 cv[2][2], dv[2][2];
#pragma unroll
        for (int bj = 0; bj < 2; ++bj)
#pragma unroll
            for (int n = 0; n < 2; ++n) { cv[bj][n] = *(const f32x4*)(cvec + col0 + bj * HALF + 4 * n); dv[bj][n] = *(const f32x4*)(dvec + col0 + bj * HALF + 4 * n); }
        f32x2v sts[2][4];
#pragma unroll
        for (int ai = 0; ai < 2; ++ai)
#pragma unroll
            for (int m = 0; m < 4; ++m) sts[ai][m] = *(const f32x2v*)(stats + 2 * (size_t)(row0 + ai * HALF + m * 16));
#pragma unroll
        for (int ai = 0; ai < 2; ++ai)
#pragma unroll
            for (int m = 0; m < 4; ++m) { const int row = row0 + ai * HALF + m * 16; const f32x2v st = sts[ai][m];
                f32x4 h[2];
#pragma unroll
                for (int n = 0; n < 2; ++n) { const f32x4 g = (acc[ai][0][m][n] - st.x * cv[0][n]) * st.y + dv[0][n], up = (acc[ai][1][m][n] - st.x * cv[1][n]) * st.y + dv[1][n];
                    h[n] = (f32x4){silu_mul(g[0], up[0]), silu_mul(g[1], up[1]), silu_mul(g[2], up[2]), silu_mul(g[3], up[3])}; }
                u32x4 w; w.x = cvt2(h[0][0], h[0][1]); w.y = cvt2(h[0][2], h[0][3]); w.z = cvt2(h[1][0], h[1][1]); w.w = cvt2(h[1][2], h[1][3]);
                *(u32x4*)(O + (size_t)row * ldc + ocol) = w; }
    }
};
struct EpiResid {
    static constexpr bool PERM = true, AFTER_DRAIN = false;
    float* Z; bf16_t* ZB; const float* stats; const float* gprev; const float* bprev; const float* bias; float* part; float scale; int pad;
    __device__ __forceinline__ void operator()(const f32x4 (&acc)[2][2][4][2], const Unit& u, int wr, int wc, int fr, int fq) const {
        const int row0 = u.pm * BM + wr * 64 + fr, col0 = u.pn * BM + wc * 32 + 8 * fq;
#pragma unroll
        for (int bj = 0; bj < 2; ++bj) {
            f32x4 gv[2], bv[2];
#pragma unroll
            for (int n = 0; n < 2; ++n) { const int c = col0 + bj * HALF + 4 * n; gv[n] = DN_ALPHA_F * *(const f32x4*)(gprev + c); bv[n] = DN_ALPHA_F * *(const f32x4*)(bprev + c) + scale * *(const f32x4*)(bias + c); }
#pragma unroll
            for (int ai = 0; ai < 2; ++ai)
#pragma unroll
                for (int mp = 0; mp < 2; ++mp) {
                    f32x4 zin[2][2]; f32x2v sts[2];
#pragma unroll
                    for (int mm = 0; mm < 2; ++mm) { const int row = row0 + ai * HALF + (2 * mp + mm) * 16; const float* zp = Z + (size_t)row * 2048 + col0 + bj * HALF;
                        zin[mm][0] = *(const f32x4*)zp; zin[mm][1] = *(const f32x4*)(zp + 4); sts[mm] = *(const f32x2v*)(stats + 2 * (size_t)row); }
#pragma unroll
                    for (int mm = 0; mm < 2; ++mm) { const int m = 2 * mp + mm; const int row = row0 + ai * HALF + m * 16; const f32x2v st = sts[mm];
                        float* zp = Z + (size_t)row * 2048 + col0 + bj * HALF;
                        const f32x4 n0 = (zin[mm][0] - st.x) * st.y * gv[0] + bv[0] + scale * acc[ai][bj][m][0];
                        const f32x4 n1 = (zin[mm][1] - st.x) * st.y * gv[1] + bv[1] + scale * acc[ai][bj][m][1];
                        *(f32x4*)zp = n0; *(f32x4*)(zp + 4) = n1;
                        u32x4 w; w.x = cvt2(n0[0], n0[1]); w.y = cvt2(n0[2], n0[3]); w.z = cvt2(n1[0], n1[1]); w.w = cvt2(n1[2], n1[3]);
                        *(u32x4*)(ZB + (size_t)row * 2048 + col0 + bj * HALF) = w;
                        float s = ((n0[0] + n0[1]) + (n0[2] + n0[3])) + ((n1[0] + n1[1]) + (n1[2] + n1[3]));
                        float q = ((n0[0] * n0[0] + n0[1] * n0[1]) + (n0[2] * n0[2] + n0[3] * n0[3])) + ((n1[0] * n1[0] + n1[1] * n1[1]) + (n1[2] * n1[2] + n1[3] * n1[3]));
                        s += swz_xor<16>(s); s = xor32_sum(s); q += swz_xor<16>(q); q = xor32_sum(q);
                        if (fq == 0) *(f32x2v*)(part + ((size_t)row * 64 + u.pn * 8 + wc * 2 + bj) * 2) = (f32x2v){s, q}; }
                }
        }
    }
};

struct EpiTaps {
    static constexpr bool PERM = false, AFTER_DRAIN = false;
    float* O; float min_decay, dstep;
    __device__ __forceinline__ void operator()(const f32x4 (&acc)[2][2][4][2], const Unit& u, int wr, int wc, int fr, int fq) const {
        int stride = 10240; float i0 = 1.0f / 8191.0f, i1 = 1.0f / 2047.0f; asm volatile("" : "+s"(stride), "+s"(i0), "+s"(i1));
        const int row0 = u.pm * BM + wr * 64 + fr, col0 = u.pn * BM + wc * 32 + 4 * fq;
        const int tbase = (u.pn < 32) ? 0 : 8192; const float ilm1 = (u.pn < 32) ? i0 : i1;
        const float t0 = (float)(col0 - tbase);
#pragma unroll
        for (int ai = 0; ai < 2; ++ai)
#pragma unroll
            for (int m = 0; m < 4; ++m) { const int row = row0 + ai * HALF + m * 16;
                const float a = -1.4426950408889634f * __builtin_fabsf(min_decay + (float)(row & 2047) * dstep) * ilm1;
                const float e0 = __builtin_amdgcn_exp2f(a * t0), s1 = __builtin_amdgcn_exp2f(a), s16 = __builtin_amdgcn_exp2f(16.0f * a), s128 = __builtin_amdgcn_exp2f(128.0f * a);
                float* rowp = O + (size_t)row * stride + col0;
#pragma unroll
                for (int bj = 0; bj < 2; ++bj) { const float eb = bj ? e0 * s128 : e0;
#pragma unroll
                    for (int n = 0; n < 2; ++n) { const float en = n ? eb * s16 : eb, en1 = en * s1, en2 = en1 * s1, en3 = en2 * s1; const f32x4 v = acc[ai][bj][m][n];
                        *(f32x4*)(rowp + bj * HALF + n * 16) = (f32x4){v[0] * en, v[1] * en1, v[2] * en2, v[3] * en3}; } } }
    }
};

template <class Epi, class Sched, bool ALIGN_EPI = false, bool SP2 = false>
__device__ __forceinline__ void gemm_phase(PG8_LAS unsigned char* lds, const Gemm g, const Sched& S, const Epi& E, const int tid_in) {
    int tid_ = tid_in; asm volatile("" : "+v"(tid_));
    const int tid = tid_, wid = __builtin_amdgcn_readfirstlane(tid >> 6), lane = tid & 63, wr = wid >> 2, wc = wid & 3, fr = lane & 15, fq = lane >> 4;
    const int K = g.K, nt = K / BK;
    unsigned voffA[2], voffB[2];
#pragma unroll
    for (int i = 0; i < 2; ++i) { int R, C; stage_rc(tid * 16 + i * 8192, R, C); const int Rb = Epi::PERM ? ((R & ~31) + perm32(R & 31)) : R;
        voffA[i] = (unsigned)(R * K + C) * 2u; voffB[i] = (unsigned)(Rb * K + C) * 2u; }
    const size_t kstep = (size_t)(BK * 2);
    const size_t hstep = (size_t)HALF * K * 2;
    const size_t tstep = 2 * hstep;
    const unsigned ldsw = (unsigned)wid * 1024u;
    const int aoff = lds_byte(wr * 64 + fr, fq * 8), boff = lds_byte(wc * 32 + fr, fq * 8);
#define PG8_SA(b, h) (((b) * 2 + (h)) * HTB)
#define PG8_SB(b, h) ((4 + (b) * 2 + (h)) * HTB)
#define PG8_STAGE(bufoff, gbase, voff) do { _Pragma("unroll") for (int _i = 0; _i < 2; ++_i) \
        __builtin_amdgcn_global_load_lds((const unsigned*)((const char*)(gbase) + (voff)[_i]), (PG8_LAS unsigned*)(lds + (bufoff) + ldsw + _i * 8192), 16, 0, 0); } while (0)
#define PG8_LDA(dst, b, h) do { _Pragma("unroll") for (int m = 0; m < 4; ++m) _Pragma("unroll") for (int k = 0; k < 2; ++k) dst[m][k] = *(const PG8_LAS bf16x8*)(lds + PG8_SA(b, h) + aoff + m * 2048 + k * 1024); } while (0)
#define PG8_LDB(dst, b, h) do { _Pragma("unroll") for (int n = 0; n < 2; ++n) _Pragma("unroll") for (int k = 0; k < 2; ++k) dst[n][k] = *(const PG8_LAS bf16x8*)(lds + PG8_SB(b, h) + boff + n * 2048 + k * 1024); } while (0)
#define PG8_MMA(ai, bj, At, Bt) do { __builtin_amdgcn_s_setprio(1); _Pragma("unroll") for (int m = 0; m < 4; ++m) _Pragma("unroll") for (int n = 0; n < 2; ++n) _Pragma("unroll") for (int k = 0; k < 2; ++k) \
        acc[ai][bj][m][n] = __builtin_amdgcn_mfma_f32_16x16x32_bf16(Bt[n][k], At[m][k], acc[ai][bj][m][n], 0, 0, 0); __builtin_amdgcn_s_setprio(0); } while (0)
#define PG8_WAIT_V(n) asm volatile("s_waitcnt vmcnt(" #n ")" ::: "memory")
#define PG8_WAIT_L(n) asm volatile("s_waitcnt lgkmcnt(" #n ")" ::: "memory")
#define PG8_BAR __builtin_amdgcn_s_barrier()
#define PG8_SCHED __builtin_amdgcn_sched_barrier(0)
    Unit cur, nxt; int ui = 0;
    if (!S.next(0, cur)) return;
    f32x4 acc[2][2][4][2];
    float zero_; asm volatile("v_mov_b32 %0, 0" : "=v"(zero_));
#pragma unroll
    for (int a = 0; a < 2; ++a)
#pragma unroll
        for (int b = 0; b < 2; ++b)
#pragma unroll
            for (int m = 0; m < 4; ++m)
#pragma unroll
                for (int n = 0; n < 2; ++n) acc[a][b][m][n] = (f32x4){zero_, zero_, zero_, zero_};
    bf16x8 At[4][2], B0[2][2], B1[2][2];
    const char* cA = (const char*)g.A + (size_t)cur.pm * tstep; const char* cB = (const char*)g.Bt + (size_t)cur.pn * tstep;
    S.a_ready(cur);
    if constexpr (SP2) {
        PG8_STAGE(PG8_SB(0, 0), cB, voffB); PG8_STAGE(PG8_SB(0, 1), cB + hstep, voffB); PG8_STAGE(PG8_SA(0, 0), cA, voffA); PG8_STAGE(PG8_SA(0, 1), cA + hstep, voffA);
        if (wr == 1) PG8_BAR;
        PG8_WAIT_V(2); PG8_BAR;
        PG8_STAGE(PG8_SB(1, 0), cB + kstep, voffB); PG8_STAGE(PG8_SA(1, 0), cA + kstep, voffA); PG8_STAGE(PG8_SB(1, 1), cB + hstep + kstep, voffB);
        PG8_WAIT_V(6); PG8_BAR;
    } else {
        PG8_STAGE(PG8_SB(0, 0), cB, voffB); PG8_STAGE(PG8_SA(0, 0), cA, voffA); PG8_STAGE(PG8_SB(0, 1), cB + hstep, voffB); PG8_STAGE(PG8_SA(0, 1), cA + hstep, voffA);
        if (wr == 1) PG8_BAR;
        PG8_WAIT_V(4); PG8_BAR;
        PG8_STAGE(PG8_SB(1, 0), cB + kstep, voffB); PG8_STAGE(PG8_SA(1, 0), cA + kstep, voffA); PG8_STAGE(PG8_SB(1, 1), cB + hstep + kstep, voffB);
        PG8_WAIT_V(6); PG8_BAR;
    }
    for (;;) {
        const bool has_next = S.next(ui + 1, nxt);
        const char* nA = has_next ? (const char*)g.A + (size_t)nxt.pm * tstep : cA; const char* nB = has_next ? (const char*)g.Bt + (size_t)nxt.pn * tstep : cB;
        for (int t = 0; t < nt; t += 2) {
            const bool last = (t == nt - 2);
            const char* a1 = cA + (size_t)(t + 1) * kstep;
            const char* a2 = last ? nA : cA + (size_t)(t + 2) * kstep; const char* b2 = last ? nB : cB + (size_t)(t + 2) * kstep;
            const char* a3 = a2 + kstep; const char* b3 = b2 + kstep;
            if (last && has_next) S.a_ready(nxt);
            if constexpr (SP2) {
            PG8_LDB(B0, 0, 0); PG8_LDB(B1, 0, 1); PG8_SCHED; PG8_LDA(At, 0, 0); PG8_STAGE(PG8_SA(1, 1), a1 + hstep, voffA);
            PG8_WAIT_V(8); PG8_WAIT_L(0); PG8_BAR; PG8_MMA(0, 0, At, B0); PG8_MMA(0, 1, At, B1); PG8_BAR; PG8_SCHED;
            PG8_LDA(At, 0, 1); PG8_STAGE(PG8_SB(0, 0), b2, voffB); PG8_STAGE(PG8_SB(0, 1), b2 + hstep, voffB); PG8_STAGE(PG8_SA(0, 0), a2, voffA);
            PG8_WAIT_V(8); PG8_WAIT_L(0); PG8_BAR; PG8_MMA(1, 0, At, B0); PG8_MMA(1, 1, At, B1); PG8_BAR; PG8_SCHED;
            PG8_LDB(B0, 1, 0); PG8_LDB(B1, 1, 1); PG8_SCHED; PG8_LDA(At, 1, 0); PG8_STAGE(PG8_SA(0, 1), a2 + hstep, voffA);
            PG8_WAIT_V(8); PG8_WAIT_L(0); PG8_BAR; PG8_MMA(0, 0, At, B0); PG8_MMA(0, 1, At, B1); PG8_BAR; PG8_SCHED;
            PG8_LDA(At, 1, 1); PG8_STAGE(PG8_SB(1, 0), b3, voffB); PG8_STAGE(PG8_SB(1, 1), b3 + hstep, voffB); PG8_STAGE(PG8_SA(1, 0), a3, voffA);
            PG8_WAIT_V(8); PG8_WAIT_L(0); PG8_BAR; PG8_MMA(1, 0, At, B0); PG8_MMA(1, 1, At, B1); PG8_BAR; PG8_SCHED;
            } else {
            PG8_LDB(B0, 0, 0); PG8_SCHED; PG8_LDA(At, 0, 0); PG8_STAGE(PG8_SA(1, 1), a1 + hstep, voffA);
            PG8_WAIT_L(8); PG8_BAR; PG8_WAIT_L(0); PG8_MMA(0, 0, At, B0); PG8_BAR; PG8_SCHED;
            PG8_LDB(B1, 0, 1); PG8_STAGE(PG8_SB(0, 0), b2, voffB);
            PG8_BAR; PG8_WAIT_L(0); PG8_MMA(0, 1, At, B1); PG8_BAR;
            PG8_LDA(At, 0, 1); PG8_STAGE(PG8_SA(0, 0), a2, voffA);
            PG8_BAR; PG8_WAIT_L(0); PG8_MMA(1, 0, At, B0); PG8_BAR; PG8_SCHED;
            PG8_STAGE(PG8_SB(0, 1), b2 + hstep, voffB);
            PG8_WAIT_V(6); PG8_BAR; PG8_MMA(1, 1, At, B1); PG8_BAR;
            PG8_LDB(B0, 1, 0); PG8_SCHED; PG8_LDA(At, 1, 0); PG8_STAGE(PG8_SA(0, 1), a2 + hstep, voffA);
            PG8_WAIT_L(8); PG8_BAR; PG8_WAIT_L(0); PG8_MMA(0, 0, At, B0); PG8_BAR; PG8_SCHED;
            PG8_LDB(B1, 1, 1); PG8_STAGE(PG8_SB(1, 0), b3, voffB);
            PG8_BAR; PG8_WAIT_L(0); PG8_MMA(0, 1, At, B1); PG8_BAR;
            PG8_LDA(At, 1, 1); PG8_STAGE(PG8_SA(1, 0), a3, voffA);
            PG8_BAR; PG8_WAIT_L(0); PG8_MMA(1, 0, At, B0); PG8_BAR; PG8_SCHED;
            PG8_STAGE(PG8_SB(1, 1), b3 + hstep, voffB);
            PG8_WAIT_V(6); PG8_BAR; PG8_MMA(1, 1, At, B1); PG8_BAR;
            }
        }
        if constexpr (ALIGN_EPI) { if (wr == 0) PG8_BAR; }
        if constexpr (!Epi::AFTER_DRAIN) { E(acc, cur, wr, wc, fr, fq); S.done(cur); }
        if (!has_next) break;
        asm volatile("v_mov_b32 %0, 0" : "=v"(zero_));
#pragma unroll
        for (int a = 0; a < 2; ++a)
#pragma unroll
            for (int b = 0; b < 2; ++b)
#pragma unroll
                for (int m = 0; m < 4; ++m)
#pragma unroll
                    for (int n = 0; n < 2; ++n) acc[a][b][m][n] = (f32x4){zero_, zero_, zero_, zero_};
        cur = nxt; cA = nA; cB = nB; ++ui;
        if constexpr (ALIGN_EPI) { if (wr == 1) PG8_BAR; }
    }
    PG8_WAIT_V(0);
    if constexpr (!ALIGN_EPI) { if (wr == 0) PG8_BAR; }
    PG8_BAR;
    if constexpr (Epi::AFTER_DRAIN) { E.fused(acc, cur, wr, wc, fr, fq, lds, wid, lane); S.done(cur); }
#undef PG8_SA
#undef PG8_SB
#undef PG8_STAGE
#undef PG8_LDA
#undef PG8_LDB
#undef PG8_MMA
#undef PG8_WAIT_V
#undef PG8_WAIT_L
#undef PG8_BAR
#undef PG8_SCHED
}
}

#ifndef PG8_SP2
#define PG8_SP2 true
#endif
#ifndef PG8_ALIGN
#define PG8_ALIGN true
#endif
#define XB_TMO      128
#define XB_XCNT(j)  (256  + 64 * (j))
#define XB_XSUB(j)  (1280 + 64 * (j))
#define XB_XGEN(j)  (2304 + 64 * (j))
#define XB_TOP      3328
#define XB_TOPGEN   3392
#define XCD_BAR_WORDS 3456
#define XB_SPIN_CAP (1u << 18)
#define LAS __attribute__((address_space(3)))

__device__ __forceinline__ unsigned xb_ld(unsigned* p)              { return __hip_atomic_load(p, __ATOMIC_RELAXED, __HIP_MEMORY_SCOPE_AGENT); }
__device__ __forceinline__ unsigned xb_add(unsigned* p, unsigned v) { return __hip_atomic_fetch_add(p, v, __ATOMIC_RELAXED, __HIP_MEMORY_SCOPE_AGENT); }
__device__ __forceinline__ unsigned xb_xcc_id() { return (unsigned)__builtin_amdgcn_s_getreg((3 << 11) | 20) & 0xFu; }
#define XB_SPIN(cond, bar) do { unsigned _sp = 0; while (cond) { __builtin_amdgcn_s_sleep(1); \
    if ((++_sp & 255u) == 0u) { if (xb_ld(&(bar)[XB_TMO])) break; if (_sp > XB_SPIN_CAP) { atomicAdd(&(bar)[XB_TMO], 1u); break; } } } } while (0)

struct XcdBarrier {
    unsigned* bar; unsigned x;
    unsigned w0;
    volatile LAS unsigned* st;
};

__device__ __forceinline__ XcdBarrier xcd_barrier_post(unsigned* bar, volatile LAS unsigned* st) {
    XcdBarrier b; b.bar = bar; b.x = xb_xcc_id(); b.st = st; b.w0 = (unsigned)__builtin_amdgcn_readfirstlane(threadIdx.x >> 6);
    if (threadIdx.x == 0) (void)xb_add(&bar[XB_XCNT(b.x)], 1u);
    return b;
}
__device__ __forceinline__ void xcd_barrier_complete(unsigned* bar, unsigned x, unsigned& nloc, unsigned& nx) {
    const unsigned G = gridDim.x * gridDim.y * gridDim.z;
    unsigned sum, cnt, mine, sp = 0u;
    for (;;) {
        sum = 0u; cnt = 0u; mine = 0u;
#pragma unroll
        for (unsigned j = 0; j < 16; ++j) { const unsigned c = xb_ld(&bar[XB_XCNT(j)]); sum += c; cnt += (c > 0u) ? 1u : 0u; mine = (j == x) ? c : mine; }
        if (sum == G) break;
        __builtin_amdgcn_s_sleep(1);
        if ((++sp & 255u) == 0u) { if (xb_ld(&bar[XB_TMO])) break; if (sp > XB_SPIN_CAP) { atomicAdd(&bar[XB_TMO], 1u); break; } }
    }
    nloc = mine > 0u ? mine : 1u; nx = cnt > 0u ? cnt : 1u;
}

__device__ __forceinline__ void xcd_barrier(const XcdBarrier& b) {
    asm volatile("s_waitcnt vmcnt(0)" ::: "memory");
    __syncthreads();
    unsigned xb_lane; asm volatile("v_mbcnt_lo_u32_b32 %0, -1, 0\n\tv_mbcnt_hi_u32_b32 %0, -1, %0" : "=v"(xb_lane));
    if (b.w0 == 0u && xb_lane == 0u) {
        unsigned* bar = b.bar;
        __builtin_amdgcn_s_waitcnt(0);
        unsigned nloc = b.st[0], nx = b.st[1];
        if (nloc == 0u) { xcd_barrier_complete(bar, b.x, nloc, nx); b.st[0] = nloc; b.st[1] = nx; }
        const unsigned old = xb_add(&bar[XB_XSUB(b.x)], 1u);
        const unsigned gen = old / nloc;
        if (old + 1u == (gen + 1u) * nloc) {
            __builtin_amdgcn_fence(__ATOMIC_RELEASE, "agent");
            asm volatile("s_waitcnt vmcnt(0)" ::: "memory");
            const unsigned og = xb_add(&bar[XB_TOP], 1u);
            const unsigned tg = og / nx;
            if (og + 1u == (tg + 1u) * nx) xb_add(&bar[XB_TOPGEN], 1u);
            else XB_SPIN(xb_ld(&bar[XB_TOPGEN]) == tg, bar);
            __builtin_amdgcn_fence(__ATOMIC_ACQUIRE, "agent");
            xb_add(&bar[XB_XGEN(b.x)], 1u);
            asm volatile("s_waitcnt vmcnt(0)" ::: "memory");
        } else {
            XB_SPIN(xb_ld(&bar[XB_XGEN(b.x)]) == gen, bar);
            __builtin_amdgcn_fence(__ATOMIC_ACQUIRE, "agent");
            asm volatile("s_waitcnt vmcnt(0)" ::: "memory");
        }
    }
    __syncthreads();
}
constexpr int NWAVES = 8;
constexpr int D = 2048, FF = 5632, NFF2 = 2 * FF, NQKV = 18432, NHY = 6144, DEPTH = 4;
constexpr int T_PROMPT = 4 * 8192, T = 49152;
constexpr float LN_EPS = 1e-5f;
constexpr float QSCALE = 0.12751743082459868f;
constexpr float LOG2E = 1.4426950408889634f;
constexpr float MIN_DECAY = -3.0701134573253946f, MAX_DECAY = -15.350567286626973f;

constexpr size_t MiB = 1u << 20;
constexpr size_t WS_CTL = 0, CTL_ZERO_BYTES = 64 * 1024;
constexpr size_t WS_IDG = 1 * MiB, WS_IDB = 1 * MiB + 32768, WS_DUMP = 1 * MiB + 32768 + 131072;
constexpr size_t WS_CD = 2 * MiB;
constexpr size_t WS_STATS = 3 * MiB;
constexpr size_t WS_H2T = 4 * MiB;
constexpr size_t WS_PART = 8 * MiB;
constexpr size_t WS_W = 32 * MiB;
constexpr size_t W_IN1 = WS_W, W_OUT1 = W_IN1 + 44 * MiB, W_IN2 = W_OUT1 + 22 * MiB, W_OUT2 = W_IN2 + 44 * MiB, W_MIN = W_OUT2 + 22 * MiB, W_MOUT = W_MIN + 72 * MiB;
constexpr size_t WS_ZB = W_MOUT + 8 * MiB;
constexpr size_t WS_BIG = WS_ZB + 192 * MiB;
constexpr size_t BIG_HID = 0;
constexpr size_t BIG_QKV = 0, BIG_AO = 1728 * MiB;
constexpr size_t BIG_U = 0, BIG_Z2T = 0, BIG_Z2 = 192 * MiB, BIG_UT = 576 * MiB, BIG_SPEC0 = 1152 * MiB, BIG_SPEC1 = 1664 * MiB;
constexpr size_t WS_TAPS = WS_BIG + 1920 * MiB;
constexpr size_t WS_H2B = WS_TAPS + 320 * MiB, WS_W3T = WS_H2B + 6 * MiB;
constexpr size_t WS_END = WS_W3T + 4 * MiB;
static_assert(WS_ZB == 244 * MiB && WS_BIG == 436 * MiB && (size_t)T * 64 * 8 <= 24 * MiB && WS_END <= 2816 * MiB && (size_t)8192 * 10240 * 4 <= 320 * MiB, "ws map");
static_assert((size_t)T * FF * 2 <= 528 * MiB && (size_t)T * NQKV * 2 <= 1728 * MiB && (size_t)T * NHY * 2 <= 576 * MiB && BIG_SPEC1 + 128 * MiB <= 1920 * MiB, "ws map");

constexpr int RING_OFF = 0;
constexpr int FFT_BYTES = (16384 + 512) * 8;
constexpr int SCR_OFF = FFT_BYTES;
constexpr int MISC_OFF = SCR_OFF + 1024;
constexpr int PTR_OFF = MISC_OFF + 256;
constexpr int LDS_BYTES = PTR_OFF + 256;

#define GAS __attribute__((address_space(1)))
#define LAS __attribute__((address_space(3)))
typedef unsigned short bf16;
typedef unsigned v4u __attribute__((ext_vector_type(4)));
typedef unsigned v2u __attribute__((ext_vector_type(2)));
typedef float f32x4 __attribute__((ext_vector_type(4)));
typedef float f32x2 __attribute__((ext_vector_type(2)));
typedef float f32x16 __attribute__((ext_vector_type(16)));
typedef short bf16x8 __attribute__((ext_vector_type(8)));
typedef short s16x4 __attribute__((ext_vector_type(4)));
#define LDS_WAIT() asm volatile("s_waitcnt lgkmcnt(0)" ::: "memory")
#define VM_WAIT() asm volatile("s_waitcnt vmcnt(0)" ::: "memory")
__device__ __forceinline__ unsigned f2bf(float f) { unsigned u = __builtin_bit_cast(unsigned, f); return (u + 0x7fffu + ((u >> 16) & 1u)) >> 16; }
__device__ __forceinline__ unsigned pk2(float lo, float hi) { return f2bf(lo) | (f2bf(hi) << 16); }
__device__ __forceinline__ float bf2f(unsigned b) { return __builtin_bit_cast(float, b << 16); }
__device__ __forceinline__ float bfround(float f) { return bf2f(f2bf(f)); }

#ifndef FFT_HD
#define FFT_HD __host__ __device__ __forceinline__
#endif
#if defined(__clang__)
typedef float cpx __attribute__((ext_vector_type(2)));
#else
struct cpx { float x, y; };
#endif
FFT_HD cpx cmul(cpx a, cpx b) { return cpx{a.x * b.x - a.y * b.y, a.x * b.y + a.y * b.x}; }
FFT_HD cpx cmulc(cpx a, cpx b) { return cpx{a.x * b.x + a.y * b.y, a.y * b.x - a.x * b.y}; }
FFT_HD cpx cadd(cpx a, cpx b) { return cpx{a.x + b.x, a.y + b.y}; }
FFT_HD cpx csub(cpx a, cpx b) { return cpx{a.x - b.x, a.y - b.y}; }
FFT_HD int pidx(int i) { return i + (i >> 5); }
FFT_HD cpx cis_neg_rev(float rev) {
    const float x8 = rev * 8.0f; int oct = (int)x8; oct = oct > 7 ? 7 : oct; const float f = x8 - (float)oct;
    const float a = (oct & 1) ? (1.0f - f) : f, phi = a * 0.78539816339744831f, p2 = phi * phi;
    const float s = phi * (1.0f + p2 * (-1.6666666666666666e-1f + p2 * (8.3333333333333332e-3f + p2 * (-1.9841269841269841e-4f + p2 * 2.7557319223985893e-6f))));
    const float c = 1.0f + p2 * (-0.5f + p2 * (4.1666666666666664e-2f + p2 * (-1.3888888888888889e-3f + p2 * (2.4801587301587302e-5f + p2 * -2.7557319223985888e-7f))));
    const bool sw = ((oct + 1) & 2) != 0;
    float cc = sw ? s : c, ss = sw ? c : s;
    if (oct >= 2 && oct <= 5) cc = -cc;
    if (oct >= 4) ss = -ss;
    return cpx{cc, -ss};
}
FFT_HD float sin_acc(float x) { float rev = x * 0.15915494309189535f; rev -= floorf(rev); const cpx e = cis_neg_rev(rev); return -e.y; }
FFT_HD float cos_rev(float rev) { rev -= floorf(rev); return cis_neg_rev(rev).x; }
FFT_HD float sin_rev(float rev) { rev -= floorf(rev); return -cis_neg_rev(rev).y; }
FFT_HD cpx w16(int k) {
    constexpr float C1 = 0.92387953251128674f, S1 = 0.38268343236508977f, R2 = 0.70710678118654752f;
    switch (k) { case 0: return cpx{1.f, 0.f}; case 1: return cpx{C1, -S1}; case 2: return cpx{R2, -R2}; case 3: return cpx{S1, -C1};
                 case 4: return cpx{0.f, -1.f}; case 5: return cpx{-S1, -C1}; case 6: return cpx{-R2, -R2}; default: return cpx{-C1, -S1}; }
}
template <int R> FFT_HD constexpr int bitrev(int i) { int r = 0; for (int b = 1, c = R >> 1; b < R; b <<= 1, c >>= 1) if (i & b) r |= c; return r; }
template <int R> FFT_HD void dif_regs(cpx (&a)[R]) {
#pragma unroll
    for (int len = R; len >= 2; len >>= 1) { const int half = len >> 1;
#pragma unroll
        for (int b0 = 0; b0 < R; b0 += len)
#pragma unroll
            for (int j = 0; j < half; ++j) { const cpx u = a[b0 + j], v = a[b0 + j + half]; a[b0 + j] = cadd(u, v); const cpx d = csub(u, v); a[b0 + j + half] = (j == 0) ? d : cmul(d, w16(j * (16 / len))); } }
}
template <int R> FFT_HD void dit_regs(cpx (&a)[R]) {
#pragma unroll
    for (int len = 2; len <= R; len <<= 1) { const int half = len >> 1;
#pragma unroll
        for (int b0 = 0; b0 < R; b0 += len)
#pragma unroll
            for (int j = 0; j < half; ++j) { const cpx u = a[b0 + j]; const cpx v = (j == 0) ? a[b0 + j + half] : cmulc(a[b0 + j + half], w16(j * (16 / len))); a[b0 + j] = cadd(u, v); a[b0 + j + half] = csub(u, v); } }
}
template <int R> FFT_HD void twiddle_powers(cpx w1, cpx (&pw)[R]) {
    pw[0] = cpx{1.f, 0.f}; pw[1] = w1; pw[2] = cmul(w1, w1); pw[3] = cmul(pw[2], w1);
    if constexpr (R > 4) { pw[4] = cmul(pw[2], pw[2]); pw[5] = cmul(pw[4], pw[1]); pw[6] = cmul(pw[4], pw[2]); pw[7] = cmul(pw[4], pw[3]); }
    if constexpr (R > 8) { pw[8] = cmul(pw[4], pw[4]);
#pragma unroll
        for (int k = 1; k < 8; ++k) pw[8 + k] = cmul(pw[8], pw[k]); }
}
template <int R, bool INV, class P> FFT_HD void fft_pass(P X, int tid, int nthr, int logM) {
    constexpr int LOGR = (R == 16) ? 4 : 2;
    const int logs = logM - LOGR, s = 1 << logs;
#pragma unroll 1
    for (int blk = tid; blk < 16384 / R; blk += nthr) {
        const int base = blk & (s - 1), idx0 = ((blk >> logs) << logM) + base;
        cpx a[R], pw[R];
        if (logs > 0) twiddle_powers<R>(cis_neg_rev((float)base / (float)(1 << logM)), pw);
        if (!INV) {
#pragma unroll
            for (int j = 0; j < R; ++j) a[j] = X[pidx(idx0 + (j << logs))];
            dif_regs<R>(a);
#pragma unroll
            for (int i = 0; i < R; ++i) { const int k1 = bitrev<R>(i); cpx v = a[i]; if (logs > 0 && k1 != 0) v = cmul(v, pw[k1]); X[pidx(idx0 + (k1 << logs))] = v; }
        } else {
#pragma unroll
            for (int i = 0; i < R; ++i) { const int k1 = bitrev<R>(i); cpx v = X[pidx(idx0 + (k1 << logs))]; if (logs > 0 && k1 != 0) v = cmulc(v, pw[k1]); a[i] = v; }
            dit_regs<R>(a);
#pragma unroll
            for (int j = 0; j < R; ++j) X[pidx(idx0 + (j << logs))] = a[j];
        }
    }
}
struct Frame {
    LAS unsigned char* lds;
    int tid, lane, wave;
    int vcu, G, bx;
    unsigned char* ws; float* z;
};
__device__ __forceinline__ Frame make_frame(unsigned char* lds_generic, unsigned char* ws, float* out, int wave0) {
    Frame F;
    int lane; asm volatile("v_mbcnt_lo_u32_b32 %0, -1, 0\n\tv_mbcnt_hi_u32_b32 %0, -1, %0" : "=v"(lane));
    int bx = blockIdx.x, G = gridDim.x;
    asm volatile("" : "+v"(lane)); asm volatile("" : "+s"(bx)); asm volatile("" : "+s"(G)); asm volatile("" : "+s"(wave0));
    const int tid = wave0 * 64 + lane;
    unsigned long long w = (unsigned long long)ws, o = (unsigned long long)out; asm volatile("" : "+s"(w)); asm volatile("" : "+s"(o));
    F.lds = (LAS unsigned char*)lds_generic;
    F.tid = tid; F.lane = lane; F.wave = wave0;
    F.G = G; F.bx = bx; F.vcu = (G % 8 == 0) ? (bx % 8) * (G / 8) + bx / 8 : bx;
    F.ws = (unsigned char*)(GAS unsigned char*)w; F.z = (float*)(GAS float*)o;
    return F;
}
__device__ __forceinline__ const float* inp(const Frame& F, int i) {
    const LAS unsigned* t = (const LAS unsigned*)(F.lds + PTR_OFF) + 2 * i;
    const unsigned lo = __builtin_amdgcn_readfirstlane(t[0]), hi = __builtin_amdgcn_readfirstlane(t[1]);
    return (const float*)(const GAS float*)(((unsigned long long)hi << 32) | lo);
}
__device__ __forceinline__ float wave_sum(float v) { return pg8::wave_sum64(v); }
__device__ __forceinline__ void block_sum2(Frame& F, float& a, float& b) {
    LAS float* scr = (LAS float*)(F.lds + SCR_OFF);
    a = wave_sum(a); b = wave_sum(b);
    __syncthreads();
    if (F.lane == 0) { scr[F.wave * 2] = a; scr[F.wave * 2 + 1] = b; }
    __syncthreads();
    float sa = 0.f, sb = 0.f;
#pragma unroll
    for (int w = 0; w < NWAVES; ++w) { sa += scr[w * 2]; sb += scr[w * 2 + 1]; }
    a = sa; b = sb;
}

__device__ __forceinline__ void phase_init(Frame& F) {
    const int gw = F.vcu * NWAVES + F.wave, NGW = F.G * NWAVES;
    bf16* zb = (bf16*)(F.ws + WS_ZB); float* stats = (float*)(F.ws + WS_STATS);
    const float* x0 = inp(F, 0); const float* x1 = inp(F, 1);
    for (int m = gw; m < T; m += NGW) {
        const float* src = (m < T_PROMPT) ? x0 + (size_t)m * D : x1 + (size_t)(m - T_PROMPT) * D;
        const GAS f32x4* s4 = (const GAS f32x4*)src + F.lane; GAS f32x4* d4 = (GAS f32x4*)(F.z + (size_t)m * D) + F.lane; GAS v2u* b4 = (GAS v2u*)(zb + (size_t)m * D) + F.lane;
#pragma unroll
        for (int j = 0; j < 8; ++j) { const f32x4 v = s4[64 * j]; d4[64 * j] = v; v2u o; o.x = pk2(v.x, v.y); o.y = pk2(v.z, v.w); b4[64 * j] = o; }
        if (F.lane == 0) { stats[2 * m] = 0.f; stats[2 * m + 1] = 1.f; }
    }
    const int gt = F.vcu * (NWAVES * 64) + F.tid;
    if (gt < 8192) ((float*)(F.ws + WS_IDG))[gt] = 1.f;
    if (gt < 32768) ((float*)(F.ws + WS_IDB))[gt] = 0.f;
}

struct ConvJob { const float* W; int K, N; bf16* WT; const float* gk; const float* bk; float* cvec; float* dvec; const float* ebias; int mode; };
__device__ __forceinline__ void conv_item(const float* W, int K, int N, bf16* WT, const float* gk, const float* bk, float* cvec, float* dvec, const float* ebias, int mode, int nb, int kbeg, int kend, LAS float* scr, int lane) {
    const int n0 = 32 * nb;
    const float colscale = (mode == 2 && n0 < 6144) ? QSCALE : 1.0f;
    int rbase = n0;
    if (mode == 1) { rbase = (n0 < FF) ? (n0 / 128) * 256 + (n0 % 128) : ((n0 - FF) / 128) * 256 + 128 + ((n0 - FF) % 128); }
    float cs[32], ds[32];
#pragma unroll
    for (int i = 0; i < 32; ++i) { cs[i] = 0.f; ds[i] = 0.f; }
    f32x4 wv[8], wn[8];
    const float* wp = W + (size_t)(kbeg + lane) * N + n0;
#pragma unroll
    for (int j = 0; j < 8; ++j) wv[j] = *(const GAS f32x4*)(wp + 4 * j);
    float g = gk[kbeg + lane], b = bk[kbeg + lane];
    bf16* op = WT + (size_t)rbase * K + lane;
    for (int k0 = kbeg; k0 < kend; k0 += 64) {
        const int k1 = (k0 + 64 < kend) ? k0 + 64 : k0;
        const float* wq = W + (size_t)(k1 + lane) * N + n0;
#pragma unroll
        for (int j = 0; j < 8; ++j) wn[j] = *(const GAS f32x4*)(wq + 4 * j);
        const float gnx = gk[k1 + lane], bnx = bk[k1 + lane];
#pragma unroll
        for (int j = 0; j < 8; ++j)
#pragma unroll
            for (int e = 0; e < 4; ++e) { const int i = 4 * j + e; const float w = wv[j][e] * colscale; const unsigned vb = f2bf(w * g); const float v = bf2f(vb);
                cs[i] += v; ds[i] += b * w; op[(size_t)i * K + k0] = (bf16)vb; }
#pragma unroll
        for (int j = 0; j < 8; ++j) wv[j] = wn[j];
        g = gnx; b = bnx;
    }
    float myc = 0.f, myd = 0.f;
#pragma unroll
    for (int i = 0; i < 32; ++i) { const float c = wave_sum(cs[i]), d = wave_sum(ds[i]); myc = (lane == i) ? c : myc; myd = (lane == i) ? d : myd; }
    if (lane < 32) { cvec[rbase + lane] = myc; dvec[rbase + lane] = myd + ebias[n0 + lane]; }
}
__device__ __forceinline__ void filt_pos(Frame& F, int jl, int var, int t) {
    const int L = var ? 2048 : 8192, lane = F.lane;
    const float* w1 = inp(F, 12) + (size_t)jl * 33 * 64; const float* b1 = inp(F, 13) + jl * 64; const float* w2 = inp(F, 14) + (size_t)jl * 64 * 64; const float* b2 = inp(F, 15) + jl * 64; const float* fr = inp(F, 16) + jl * 64;
    float feat = 0.f;
    if (lane == 0) feat = (float)t / (float)(L - 1);
    else if (lane < 33) { const int bi = (lane - 1) & 15; const float band = 1e-4f + (float)bi * ((15.0f - 1e-4f) / 15.0f); const float rev = band * ((float)t / (float)L);
        feat = (lane < 17) ? cos_rev(rev) : -sin_rev(rev); }
    float acc = b1[lane];
    for (int k = 0; k < 33; ++k) acc += __builtin_bit_cast(float, __builtin_amdgcn_readlane(__builtin_bit_cast(int, feat), k)) * w1[k * 64 + lane];
    const float fq = fr[lane];
    const float h1 = sin_acc(fq * acc);
    float acc2 = b2[lane];
    for (int k = 0; k < 64; ++k) acc2 += __builtin_bit_cast(float, __builtin_amdgcn_readlane(__builtin_bit_cast(int, h1), k)) * w2[k * 64 + lane];
    const float h2 = sin_acc(fq * acc2);
    bf16* hrow = (bf16*)(F.ws + WS_H2B) + (size_t)((var ? 8192 : 0) + t) * 256;
    hrow[lane] = (bf16)f2bf(h2); hrow[64 + lane] = 0; hrow[128 + lane] = 0; hrow[192 + lane] = 0;
}
__device__ __forceinline__ void phase_convert(Frame& F, int layer) {
    LAS float* scr = (LAS float*)(F.lds + RING_OFF + F.wave * 16384);
    const int gw = F.vcu * NWAVES + F.wave, NGW = F.G * NWAVES;
    const int jl = layer >> 1; const bool hy = (layer & 1) != 0;
    const float* ln_g = inp(F, 2); const float* ln_b = inp(F, 3);
    const float* ones = (const float*)(F.ws + WS_IDG); const float* zeros = (const float*)(F.ws + WS_IDB); float* dump = (float*)(F.ws + WS_DUMP);
    float* cd = (float*)(F.ws + WS_CD);
    float* c1 = cd, *d1 = cd + NFF2, *cm = cd + 2 * NFF2, *dm = cm + NQKV, *c2 = dm + NQKV, *d2 = c2 + NFF2;
    const int nb1 = (D / 32) * 4, nb0 = NFF2 / 32, nb4 = (hy ? NHY : NQKV) / 32, nb5 = D / 32;
    const int total = 2 * nb1 + 2 * nb0 + nb4 + nb5;
    for (int it = gw; it < total; it += NGW) {
        int r = it;
        if (r < 2 * nb1) { const int f = r / nb1; r -= f * nb1;
            conv_item(inp(F, 5) + (size_t)(layer * 2 + f) * FF * D, FF, D, (bf16*)(F.ws + (f ? W_OUT2 : W_OUT1)), ones, zeros, dump, dump + NQKV, zeros, 0, r >> 2, (r & 3) * 1408, (r & 3) * 1408 + 1408, scr, F.lane); continue; }
        r -= 2 * nb1;
        if (r < 2 * nb0) { const int f = r / nb0; r -= f * nb0;
            const float* gk = f ? ln_g + (size_t)(layer * 3 + 1) * D : (layer ? ln_g + (size_t)((layer - 1) * 3 + 2) * D : ones);
            const float* bk = f ? ln_b + (size_t)(layer * 3 + 1) * D : (layer ? ln_b + (size_t)((layer - 1) * 3 + 2) * D : zeros);
            conv_item(inp(F, 4) + (size_t)(layer * 2 + f) * D * NFF2, D, NFF2, (bf16*)(F.ws + (f ? W_IN2 : W_IN1)), gk, bk, f ? c2 : c1, f ? d2 : d1, zeros, 1, r, 0, D, scr, F.lane); continue; }
        r -= 2 * nb0;
        if (r < nb4) {
            const float* gk = ln_g + (size_t)(layer * 3) * D; const float* bk = ln_b + (size_t)(layer * 3) * D;
            if (hy) conv_item(inp(F, 8) + (size_t)jl * D * NHY, D, NHY, (bf16*)(F.ws + W_MIN), gk, bk, cm, dm, inp(F, 9) + (size_t)jl * NHY, 0, r, 0, D, scr, F.lane);
            else conv_item(inp(F, 6) + (size_t)jl * D * NQKV, D, NQKV, (bf16*)(F.ws + W_MIN), gk, bk, cm, dm, zeros, 2, r, 0, D, scr, F.lane);
            continue; }
        r -= nb4;
        conv_item((hy ? inp(F, 19) : inp(F, 7)) + (size_t)jl * D * D, D, D, (bf16*)(F.ws + W_MOUT), ones, zeros, dump, dump + NQKV, zeros, 0, r, 0, D, scr, F.lane);
    }
    if (hy) {
        for (int p = gw; p < 8192 + 2048; p += NGW) { if (p < 8192) filt_pos(F, jl, 0, p); else filt_pos(F, jl, 1, p - 8192); }
        const float* w3 = inp(F, 17) + (size_t)jl * 64 * 8192; bf16* w3T = (bf16*)(F.ws + WS_W3T);
        for (int n = gw; n < 8192; n += NGW) { bf16* r = w3T + (size_t)n * 256; r[F.lane] = (bf16)f2bf(w3[(size_t)F.lane * 8192 + n]); r[64 + F.lane] = 0; r[128 + F.lane] = 0; r[192 + F.lane] = 0; }
    }
}

__device__ __forceinline__ void phase_finalize(Frame& F) {
    const float* part = (const float*)(F.ws + WS_PART); float* stats = (float*)(F.ws + WS_STATS);
    for (int row = F.vcu * (NWAVES * 64) + F.tid; row < T; row += F.G * NWAVES * 64) {
        const GAS f32x4* p = (const GAS f32x4*)(part + (size_t)row * 128);
        float s = 0.f, q = 0.f;
#pragma unroll 8
        for (int j = 0; j < 32; ++j) { const f32x4 v = p[j]; s += v.x + v.z; q += v.y + v.w; }
        const float mean = s * (1.0f / D); const float var = fmaxf(q * (1.0f / D) - mean * mean, 0.f);
        *(GAS f32x2*)(stats + 2 * (size_t)row) = (f32x2){mean, 1.0f / sqrtf(var + LN_EPS)};
    }
}

#ifdef DBG_CHECK
__device__ __forceinline__ void phase_check_qkv(Frame& F) {
    const int gw = F.vcu * NWAVES + F.wave, NGW = F.G * NWAVES;
    const float* W = inp(F, 6); const float* g = inp(F, 2); const float* b = inp(F, 3);
    const float* stats = (const float*)(F.ws + WS_STATS); const bf16* QKV = (const bf16*)(F.ws + WS_BIG + BIG_QKV);
#ifndef DBG_ROW0
#define DBG_ROW0 0
#define DBG_ROW1 T
#endif
#ifndef DBG_COL0
#define DBG_COL0 0
#define DBG_COL1 NQKV
#endif
    float worst = 0.f; unsigned nbad = 0;
#ifdef CHK_ROWS
    {
        const bf16* zbp = (const bf16*)(F.ws + WS_ZB);
        for (int s = gw; s < 8192; s += NGW) {
            const unsigned hsh = (unsigned)s * 2654435761u; const int row = (int)(hsh % (unsigned)T);
            float sm = 0.f, sq = 0.f, dz = 0.f;
            for (int k = F.lane; k < D; k += 64) { const float v = F.z[(size_t)row * D + k]; sm += v; sq += v * v; dz = fmaxf(dz, fabsf(bf2f(zbp[(size_t)row * D + k]) - v)); }
            sm = wave_sum(sm); sq = wave_sum(sq); dz = fmaxf(dz, pg8::xor32_max(dz)); dz = fmaxf(dz, pg8::swz_xor<16>(dz)); dz = fmaxf(dz, pg8::swz_xor<8>(dz)); dz = fmaxf(dz, pg8::swz_xor<4>(dz)); dz = fmaxf(dz, pg8::swz_xor<2>(dz)); dz = fmaxf(dz, pg8::swz_xor<1>(dz));
            const float mean = sm * (1.0f / D), var = sq * (1.0f / D) - mean * mean, rstd = 1.0f / sqrtf(var + LN_EPS);
            const bool bad = (CHK_ROWS == 1) ? (fabsf(mean - stats[2 * row]) > CHK_MTOL || fabsf(rstd - stats[2 * row + 1]) > CHK_RTOL * rstd) : (dz > 0.05f);
            nbad += bad ? 1u : 0u;
        }
        if (F.lane == 0 && nbad) atomicAdd((unsigned*)(F.ws + WS_CTL) + 15000, nbad);
        return;
    }
#endif
    for (int s = gw; s < 8192; s += NGW) {
        const unsigned hsh = (unsigned)s * 2654435761u; const int row = DBG_ROW0 + (int)(hsh % (unsigned)(DBG_ROW1 - DBG_ROW0)), col = DBG_COL0 + (int)((hsh >> 7) % (unsigned)(DBG_COL1 - DBG_COL0));
#ifdef CHK_HYP
        const float mean = 0.f, rstd = 1.f;
#else
        const float mean = stats[2 * row], rstd = stats[2 * row + 1];
#endif
        float acc = 0.f;
        for (int k = F.lane; k < D; k += 64) acc += ((F.z[(size_t)row * D + k] - mean) * rstd * g[k] + b[k]) * W[(size_t)k * NQKV + col];
        acc = wave_sum(acc) * (col < 6144 ? QSCALE : 1.0f);
        const float got = bf2f(QKV[(size_t)row * NQKV + col]);
        worst = fmaxf(worst, fabsf(got - acc)); nbad += (fabsf(got - acc) > DBG_THR) ? 1u : 0u;
    }
#ifdef DBG_COUNT
    if (F.lane == 0 && nbad) atomicAdd((unsigned*)(F.ws + WS_CTL) + 15000, nbad);
#else
    if (F.lane == 0) atomicMax((unsigned*)(F.ws + WS_CTL) + 15000, __builtin_bit_cast(unsigned, worst));
#endif
}
#endif
__device__ __forceinline__ void phase_final_ln(Frame& F) {
    const int gw = F.vcu * NWAVES + F.wave, NGW = F.G * NWAVES;
    const float* stats = (const float*)(F.ws + WS_STATS);
    const float* g = inp(F, 2) + (size_t)(3 * 3 + 2) * D; const float* b = inp(F, 3) + (size_t)(3 * 3 + 2) * D;
    for (int m = gw; m < T; m += NGW) {
        const float mean = stats[2 * m], rstd = stats[2 * m + 1];
        GAS f32x4* d4 = (GAS f32x4*)(F.z + (size_t)m * D) + F.lane; const GAS f32x4* g4 = (const GAS f32x4*)g + F.lane; const GAS f32x4* b4 = (const GAS f32x4*)b + F.lane;
        float dbg = 0.f;
#ifdef DBG_CHECK
        #ifdef DBG_COUNT
        const float dbgval = (float)((const unsigned*)(F.ws + WS_CTL))[15000] * DBG_CHECK_SCALE;
#else
        const float dbgval = __builtin_bit_cast(float, ((const unsigned*)(F.ws + WS_CTL))[15000]) * DBG_CHECK_SCALE;
#endif
#endif
#ifdef DBG_BUF
        {
            const bf16* bp = (const bf16*)(F.ws + WS_BIG + DBG_OFF) + (size_t)m * DBG_PITCH; float s = 0.f;
            for (int c = F.lane; c < DBG_COLS; c += 64) s += bf2f(bp[c]) * (float)(1 + (c & 7));
            dbg = wave_sum(s) * 0.01f;
        }
#endif
#pragma unroll
        for (int j = 0; j < 8; ++j) { const f32x4 v = d4[64 * j] + dbg; d4[64 * j] = (v - mean) * rstd * g4[64 * j] + b4[64 * j];
#ifdef DBG_CHECK
            d4[64 * j] = (f32x4){dbgval, dbgval, dbgval, dbgval};
#endif
        }
    }
}

__device__ __forceinline__ void transpose_tile(const bf16* src, size_t sp, bf16* dst, size_t dp, int r0, int c0, LAS unsigned char* scr, int lane) {
#pragma unroll
    for (int i = 0; i < 8; ++i) { const int row = (lane >> 3) + 8 * i, ch = lane & 7;
        const v4u v = *(const GAS v4u*)(src + (size_t)(r0 + row) * sp + c0 + 8 * ch);
        LAS unsigned* w = (LAS unsigned*)(scr + row * 132 + ch * 16); w[0] = v.x; w[1] = v.y; w[2] = v.z; w[3] = v.w; }
    LDS_WAIT(); asm volatile("" ::: "memory");
    const LAS unsigned short* rd = (const LAS unsigned short*)(scr + lane * 132);
#pragma unroll 8
    for (int c = 0; c < 64; ++c) dst[(size_t)(c0 + c) * dp + r0 + lane] = rd[c];
    LDS_WAIT(); asm volatile("" ::: "memory");
}
__device__ __forceinline__ void phase_transpose(Frame& F, const bf16* src, int R, int C, bf16* dst) {
    LAS unsigned char* scr = F.lds + RING_OFF + F.wave * 16384;
    const int gw = F.vcu * NWAVES + F.wave, NGW = F.G * NWAVES, tr = R / 64, tc = C / 64;
    for (int it = gw; it < tr * tc; it += NGW) { const int a = it / tc, b = it % tc; transpose_tile(src, (size_t)C, dst, (size_t)R, 64 * a, 64 * b, scr, F.lane); }
}
__device__ __forceinline__ void fft_forward(LAS cpx* X, int tid, int logN) {
    int logM = logN;
    for (; logM >= 4; logM -= 4) { fft_pass<16, false>(X, tid, NWAVES * 64, logM); __syncthreads(); }
    if (logM == 2) { fft_pass<4, false>(X, tid, NWAVES * 64, 2); __syncthreads(); }
}
__device__ __forceinline__ void fft_inverse(LAS cpx* X, int tid, int logN) {
    const int rem = logN & 3;
    if (rem == 2) { fft_pass<4, true>(X, tid, NWAVES * 64, 2); __syncthreads(); }
    for (int logM = 4 + rem; logM <= logN; logM += 4) { fft_pass<16, true>(X, tid, NWAVES * 64, logM); __syncthreads(); }
}
template <int VAR> __device__ __forceinline__ void spec_unit(Frame& F, int jl, int c) {
    constexpr int L = VAR ? 2048 : 8192, N = 2 * L, LOGN = VAR ? 12 : 14, NP = L / 512;
    LAS cpx* X = (LAS cpx*)(F.lds + RING_OFF);
    int tid = F.tid; asm volatile("" : "+v"(tid));
    const float* taps = (const float*)(F.ws + WS_TAPS) + (size_t)c * 10240 + (VAR ? 8192 : 0);
    float acc[NP][4];
    float n0 = 0.f, n1 = 0.f;
#pragma unroll
    for (int k = 0; k < NP; ++k) {
#pragma unroll
        for (int f = 0; f < 4; ++f) acc[k][f] = taps[(size_t)f * 2048 * 10240 + tid + 512 * k];
        n0 += fabsf(acc[k][0]) + fabsf(acc[k][1]); n1 += fabsf(acc[k][2]) + fabsf(acc[k][3]); }
    block_sum2(F, n0, n1);
    const float i0 = 1.0f / n0, i1 = 1.0f / n1;
#pragma unroll
    for (int k = 0; k < NP; ++k) { acc[k][0] *= i0; acc[k][1] *= i0; acc[k][2] *= i1; acc[k][3] *= i1; }
    cpx* spec = (cpx*)(F.ws + WS_BIG + (VAR ? BIG_SPEC1 : BIG_SPEC0));
    if (VAR == 0) {
        float* tmp = (float*)(spec + ((size_t)1 * D + c) * N);
#pragma unroll
        for (int k = 0; k < NP; ++k) *(GAS f32x2*)(tmp + 2 * (tid + 512 * k)) = (f32x2){acc[k][2], acc[k][3]};
        __syncthreads();
#pragma unroll
        for (int k = 0; k < NP; ++k) { const int t = tid + 512 * k; const float hf = acc[k][0], hb = acc[k][1];
            if (t == 0) { X[pidx(0)] = cpx{hf + hb, 0.f}; X[pidx(L)] = cpx{0.f, 0.f}; }
            else { X[pidx(t)] = cpx{hf, 0.f}; X[pidx(N - t)] = cpx{hb, 0.f}; } }
        __syncthreads();
        fft_forward(X, tid, LOGN);
        { cpx* dst = spec + ((size_t)0 * D + c) * N; for (int p = tid; p < N; p += 512) dst[p] = X[pidx(p)]; }
        float h1[NP][2];
#pragma unroll
        for (int k = 0; k < NP; ++k) { const f32x2 v = *(const GAS f32x2*)(tmp + 2 * (tid + 512 * k)); h1[k][0] = v.x; h1[k][1] = v.y; }
        __syncthreads();
#pragma unroll
        for (int k = 0; k < NP; ++k) { const int t = tid + 512 * k; const float hf = h1[k][0], hb = h1[k][1];
            if (t == 0) { X[pidx(0)] = cpx{hf + hb, 0.f}; X[pidx(L)] = cpx{0.f, 0.f}; }
            else { X[pidx(t)] = cpx{hf, 0.f}; X[pidx(N - t)] = cpx{hb, 0.f}; } }
        __syncthreads();
        fft_forward(X, tid, LOGN);
        { cpx* dst = spec + ((size_t)1 * D + c) * N; for (int p = tid; p < N; p += 512) dst[p] = X[pidx(p)]; }
    } else {
        __syncthreads();
#pragma unroll
        for (int k = 0; k < NP; ++k) { const int t = tid + 512 * k;
#pragma unroll
            for (int o = 0; o < 2; ++o) { const float hf = acc[k][2 * o], hb = acc[k][2 * o + 1];
                if (t == 0) { X[pidx(o * N)] = cpx{hf + hb, 0.f}; X[pidx(o * N + L)] = cpx{0.f, 0.f}; }
                else { X[pidx(o * N + t)] = cpx{hf, 0.f}; X[pidx(o * N + N - t)] = cpx{hb, 0.f}; } } }
        for (int p = 2 * N + tid; p < 16384; p += 512) X[pidx(p)] = cpx{0.f, 0.f};
        __syncthreads();
        fft_forward(X, tid, LOGN);
#pragma unroll
        for (int o = 0; o < 2; ++o) { cpx* dst = spec + ((size_t)o * D + c) * N; for (int p = tid; p < N; p += 512) dst[p] = X[pidx(o * N + p)]; }
    }
}
__device__ __forceinline__ void phase_spectra(Frame& F, int jl) {
    for (int u = F.vcu; u < 2 * D; u += F.G) { if (u < D) spec_unit<0>(F, jl, u); else spec_unit<1>(F, jl, u - D); }
    __syncthreads();
}
__device__ __forceinline__ void load_conv16(const bf16* seq, int t0, int L, float w0, float w1, float w2, float cb, float (&out)[16]) {
    const v4u a = *(const GAS v4u*)(seq + t0), b = *(const GAS v4u*)(seq + t0 + 8);
    float u[18];
    u[0] = (t0 > 0) ? bf2f(seq[t0 - 1]) : 0.f; u[17] = (t0 + 16 < L) ? bf2f(seq[t0 + 16]) : 0.f;
    u[1] = bf2f(a.x & 0xffffu); u[2] = bf2f(a.x >> 16); u[3] = bf2f(a.y & 0xffffu); u[4] = bf2f(a.y >> 16); u[5] = bf2f(a.z & 0xffffu); u[6] = bf2f(a.z >> 16); u[7] = bf2f(a.w & 0xffffu); u[8] = bf2f(a.w >> 16);
    u[9] = bf2f(b.x & 0xffffu); u[10] = bf2f(b.x >> 16); u[11] = bf2f(b.y & 0xffffu); u[12] = bf2f(b.y >> 16); u[13] = bf2f(b.z & 0xffffu); u[14] = bf2f(b.z >> 16); u[15] = bf2f(b.w & 0xffffu); u[16] = bf2f(b.w >> 16);
#pragma unroll
    for (int i = 0; i < 16; ++i) out[i] = w0 * u[i] + w1 * u[i + 1] + w2 * u[i + 2] + cb;
}
template <int VAR> __device__ __forceinline__ void conv_unit(Frame& F, int jl, int c, int pair) {
    constexpr int L = VAR ? 2048 : 8192, N = 2 * L, LOGN = VAR ? 12 : 14, TPS = VAR ? 128 : 512;
    LAS cpx* X = (LAS cpx*)(F.lds + RING_OFF);
    int tid = F.tid; asm volatile("" : "+v"(tid));
    const int seg = tid / TPS, t0 = (tid % TPS) * 16;
    const int rowA = VAR ? T_PROMPT + (2 * seg) * L : (2 * pair) * L, rowB = rowA + L;
    const bf16* UT = (const bf16*)(F.ws + WS_BIG + BIG_UT); bf16* Z2T = (bf16*)(F.ws + WS_BIG + BIG_Z2T);
    const float* cw = inp(F, 10) + (size_t)jl * 3 * NHY; const float* cbv = inp(F, 11) + (size_t)jl * NHY; const float* skip = inp(F, 18) + (size_t)jl * 2 * D;
    const cpx* spec = (const cpx*)(F.ws + WS_BIG + (VAR ? BIG_SPEC1 : BIG_SPEC0));
#ifndef CONV_SCALE
#define CONV_SCALE 1.0f
#endif
    const float invN = CONV_SCALE / (float)N;
    float va[16], vb[16];
    { const int ch = c; const float w0 = cw[ch], w1 = cw[NHY + ch], w2 = cw[2 * NHY + ch], cb = cbv[ch];
      load_conv16(UT + (size_t)ch * T + rowA, t0, L, w0, w1, w2, cb, va); load_conv16(UT + (size_t)ch * T + rowB, t0, L, w0, w1, w2, cb, vb); }
    __syncthreads();
#pragma unroll
    for (int i = 0; i < 16; ++i) { X[pidx(seg * N + t0 + i)] = cpx{va[i], vb[i]}; X[pidx(seg * N + L + t0 + i)] = cpx{0.f, 0.f}; }
    __syncthreads();
    fft_forward(X, tid, LOGN);
    { const cpx* H = spec + ((size_t)0 * D + c) * N;
#pragma unroll
      for (int hb = 0; hb < 2; ++hb) { cpx hv[16];
#pragma unroll
        for (int k = 0; k < 16; ++k) hv[k] = H[(tid + 512 * (16 * hb + k)) & (N - 1)];
#pragma unroll
        for (int k = 0; k < 16; ++k) { const int p = tid + 512 * (16 * hb + k); X[pidx(p)] = cmul(X[pidx(p)], hv[k]); } } }
    __syncthreads();
    fft_inverse(X, tid, LOGN);
    {   float ga[16], gb[16];
        const int ch = D + c; const float w0 = cw[ch], w1 = cw[NHY + ch], w2 = cw[2 * NHY + ch], cb = cbv[ch];
        load_conv16(UT + (size_t)ch * T + rowA, t0, L, w0, w1, w2, cb, ga); load_conv16(UT + (size_t)ch * T + rowB, t0, L, w0, w1, w2, cb, gb);
        const float sk = skip[c];
#pragma unroll
        for (int i = 0; i < 16; ++i) { const cpx y = X[pidx(seg * N + t0 + i)]; va[i] = ga[i] * (y.x * invN + sk * va[i]); vb[i] = gb[i] * (y.y * invN + sk * vb[i]); }
#pragma unroll
        for (int i = 0; i < 16; ++i) { X[pidx(seg * N + t0 + i)] = cpx{va[i], vb[i]}; X[pidx(seg * N + L + t0 + i)] = cpx{0.f, 0.f}; }
    }
    __syncthreads();
    fft_forward(X, tid, LOGN);
    { const cpx* H = spec + ((size_t)1 * D + c) * N;
#pragma unroll
      for (int hb = 0; hb < 2; ++hb) { cpx hv[16];
#pragma unroll
        for (int k = 0; k < 16; ++k) hv[k] = H[(tid + 512 * (16 * hb + k)) & (N - 1)];
#pragma unroll
        for (int k = 0; k < 16; ++k) { const int p = tid + 512 * (16 * hb + k); X[pidx(p)] = cmul(X[pidx(p)], hv[k]); } } }
    __syncthreads();
    fft_inverse(X, tid, LOGN);
    {   float ga[16], gb[16];
        const int ch = 2 * D + c; const float w0 = cw[ch], w1 = cw[NHY + ch], w2 = cw[2 * NHY + ch], cb = cbv[ch];
        load_conv16(UT + (size_t)ch * T + rowA, t0, L, w0, w1, w2, cb, ga); load_conv16(UT + (size_t)ch * T + rowB, t0, L, w0, w1, w2, cb, gb);
        const float sk = skip[D + c];
        float ra[16], rb[16];
#pragma unroll
        for (int i = 0; i < 16; ++i) { const cpx y = X[pidx(seg * N + t0 + i)]; ra[i] = ga[i] * (y.x * invN + sk * va[i]); rb[i] = gb[i] * (y.y * invN + sk * vb[i]); }
        v4u o0, o1;
        o0.x = pk2(ra[0], ra[1]); o0.y = pk2(ra[2], ra[3]); o0.z = pk2(ra[4], ra[5]); o0.w = pk2(ra[6], ra[7]); o1.x = pk2(ra[8], ra[9]); o1.y = pk2(ra[10], ra[11]); o1.z = pk2(ra[12], ra[13]); o1.w = pk2(ra[14], ra[15]);
        GAS v4u* da = (GAS v4u*)(Z2T + (size_t)c * T + rowA + t0); da[0] = o0; da[1] = o1;
        o0.x = pk2(rb[0], rb[1]); o0.y = pk2(rb[2], rb[3]); o0.z = pk2(rb[4], rb[5]); o0.w = pk2(rb[6], rb[7]); o1.x = pk2(rb[8], rb[9]); o1.y = pk2(rb[10], rb[11]); o1.z = pk2(rb[12], rb[13]); o1.w = pk2(rb[14], rb[15]);
        GAS v4u* db = (GAS v4u*)(Z2T + (size_t)c * T + rowB + t0); db[0] = o0; db[1] = o1;
    }
}
__device__ __forceinline__ void phase_conv(Frame& F, int jl) {
    for (int u = F.vcu; u < 3 * D; u += F.G) { if (u < 2 * D) conv_unit<0>(F, jl, u >> 1, u & 1); else conv_unit<1>(F, jl, u - 2 * D, 0); }
    __syncthreads();
}
__device__ __forceinline__ unsigned voff_b(unsigned row, unsigned ch) { return 256u * row + 16u * (ch ^ (((row & 3u) << 2) | ((row >> 2) & 3u))); }
__device__ __forceinline__ s16x4 vtr(const LAS unsigned char* p) { typedef short v4i16_t __attribute__((ext_vector_type(4))); return __builtin_bit_cast(s16x4, __builtin_amdgcn_ds_read_tr16_b64_v4i16((LAS v4i16_t*)p)); }
__device__ __forceinline__ unsigned cvtpk(float lo, float hi) { typedef __bf16 bf16x2_t __attribute__((ext_vector_type(2))); f32x2 v = {lo, hi}; bf16x2_t b = __builtin_convertvector(v, bf16x2_t); return __builtin_bit_cast(unsigned, b); }
__device__ __forceinline__ void dma16(const void* gsrc, LAS unsigned char* lds_dst) {
    unsigned keep; const unsigned dst = __builtin_amdgcn_readfirstlane((unsigned)(unsigned long long)lds_dst);
    asm volatile("s_mov_b32 %0, m0\n\ts_mov_b32 m0, %2\n\ts_nop 0\n\tglobal_load_lds_dwordx4 %1, off\n\ts_mov_b32 m0, %0" : "=&s"(keep) : "v"(gsrc), "s"(dst) : "memory");
}
struct TileDesc { int g, kt0; };
constexpr int ATT_NT = 28;
__device__ __forceinline__ TileDesc attn_tile(int it, int T0w) {
    TileDesc t;
    if (it < 12) { t.g = 0; t.kt0 = T0w - 64 + 32 * it; }
    else if (it < 18) { t.g = 1; t.kt0 = T0w - 256 + 128 * (it - 12); }
    else { const int e = it - 18, ch = e / 5, tl = e % 5; t.g = 2; t.kt0 = T0w + 8 * ch - 1024 + 512 * tl; }
    return t;
}
__device__ __forceinline__ void attn_wave_task(const bf16* QKV, bf16* AO, LAS unsigned char* vimg, int blk, int h, int w, int lane) {
    const int r = lane & 31, hh = lane >> 5;
    const int T0 = blk * 256;
    int seq_start, seq_len;
    if (T0 < T_PROMPT) { seq_start = T0 & ~8191; seq_len = 8192; } else { seq_start = T_PROMPT + ((T0 - T_PROMPT) & ~2047); seq_len = 2048; }
    const int seq_end = seq_start + seq_len;
    const int T0w = T0 + w, qt = T0w + 8 * r;
    const float slope2 = __builtin_amdgcn_exp2f(-0.5f * (float)(h + 1)) * LOG2E;
    f32x16 o[4];
#pragma unroll
    for (int dt = 0; dt < 4; ++dt)
#pragma unroll
        for (int i = 0; i < 16; ++i) o[dt][i] = 0.f;
    float m_run = -1e30f, l_run = 0.f;
    bf16x8 qf[8], kf[8];
    const bf16* hb = QKV + h * 128;
    auto issue_tile = [&](const TileDesc& td, LAS unsigned char* img_dst) {
        const int d = 1 << (2 * td.g);
        const bf16* Kb = hb + 6144 + td.g * 2048; const bf16* Vb = hb + 12288 + td.g * 2048;
#pragma unroll
        for (int i = 0; i < 8; ++i) { const int row = 4 * i + (lane >> 4); int vt = td.kt0 + row * d; vt = vt < seq_start ? seq_start : (vt >= seq_end ? seq_end - 1 : vt);
            const int lch = (lane & 15) ^ (((row & 3) << 2) | ((row >> 2) & 3));
            dma16(Vb + (size_t)vt * NQKV + 8 * lch, img_dst + i * 1024); }
        int kt = td.kt0 + r * d; kt = kt < seq_start ? seq_start : (kt >= seq_end ? seq_end - 1 : kt);
        const bf16* kp = Kb + (size_t)kt * NQKV + 8 * hh;
#pragma unroll
        for (int s = 0; s < 8; ++s) kf[s] = *(const GAS bf16x8*)(kp + 16 * s);
    };
    auto load_q = [&](int g) { const bf16* qp = hb + g * 2048 + (size_t)qt * NQKV + 8 * hh;
#pragma unroll
        for (int s = 0; s < 8; ++s) qf[s] = *(const GAS bf16x8*)(qp + 16 * s); };
    TileDesc cur = attn_tile(0, T0w);
    load_q(0);
    issue_tile(cur, vimg);
    for (int it = 0; it < ATT_NT; ++it) {
        LAS unsigned char* img = vimg + (it & 1) * 8192;
        const int d = 1 << (2 * cur.g), win = 64 * d, kt0 = cur.kt0;
        f32x16 st;
#pragma unroll
        for (int i = 0; i < 16; ++i) st[i] = 0.f;
#pragma unroll
        for (int s = 0; s < 8; ++s) st = __builtin_amdgcn_mfma_f32_32x32x16_bf16(kf[s], qf[s], st, 0, 0, 0);
        if (it + 1 < ATT_NT) { const TileDesc nx = attn_tile(it + 1, T0w); if (nx.g != cur.g) load_q(nx.g); issue_tile(nx, vimg + ((it + 1) & 1) * 8192); cur = nx; }
        const int dl0 = kt0 + 4 * hh * d - qt;
        const bool res_ok = (dl0 & (d - 1)) == 0;
        const int lo_i = max(-win, seq_start - qt), hi_i = min(win, seq_end - 1 - qt);
        const float flo = res_ok ? (float)lo_i : 1e30f, fhi = (float)hi_i, fdl0 = (float)dl0, fd = (float)d;
        float mloc = -1e30f;
#pragma unroll
        for (int i = 0; i < 16; ++i) { const float fdl = fdl0 + (float)((i & 3) + 8 * (i >> 2)) * fd;
            const float s = st[i] - slope2 * __builtin_fabsf(fdl);
            const bool ok = (fdl >= flo) && (fdl <= fhi);
            const float sm = ok ? s : -1e30f; st[i] = sm; mloc = fmaxf(mloc, sm); }
        mloc = pg8::xor32_max(mloc);
        const float m_new = fmaxf(m_run, mloc);
        const float m_use = fmaxf(m_new, -1e20f);
        float ls = 0.f;
#pragma unroll
        for (int i = 0; i < 16; ++i) { const float pv = __builtin_amdgcn_exp2f(st[i] - m_use); st[i] = pv; ls += pv; }
        ls = pg8::xor32_sum(ls);
        if (__any(m_new != m_run)) {
            const float alpha = __builtin_amdgcn_exp2f(m_run - m_new);
            l_run *= alpha;
#pragma unroll
            for (int dt = 0; dt < 4; ++dt)
#pragma unroll
                for (int i = 0; i < 16; ++i) o[dt][i] *= alpha;
        }
        l_run += ls; m_run = m_new;
        bf16x8 pb[2];
#pragma unroll
        for (int s2 = 0; s2 < 2; ++s2) { v4u w; w.x = cvtpk(st[8 * s2 + 0], st[8 * s2 + 1]); w.y = cvtpk(st[8 * s2 + 2], st[8 * s2 + 3]); w.z = cvtpk(st[8 * s2 + 4], st[8 * s2 + 5]); w.w = cvtpk(st[8 * s2 + 6], st[8 * s2 + 7]); pb[s2] = __builtin_bit_cast(bf16x8, w); }
        const int q4 = (lane & 15) >> 2, p4 = lane & 3, blk16 = (lane >> 4) & 1;
#pragma unroll
        for (int dt = 0; dt < 4; ++dt)
#pragma unroll
            for (int s2 = 0; s2 < 2; ++s2) {
                const unsigned chn = 4 * dt + 2 * blk16 + (p4 >> 1);
                const s16x4 lo = vtr(img + voff_b(16 * s2 + 4 * hh + q4, chn) + 8 * (p4 & 1));
                const s16x4 hi = vtr(img + voff_b(16 * s2 + 8 + 4 * hh + q4, chn) + 8 * (p4 & 1));
                const bf16x8 va = __builtin_shufflevector(lo, hi, 0, 1, 2, 3, 4, 5, 6, 7);
                o[dt] = __builtin_amdgcn_mfma_f32_32x32x16_bf16(va, pb[s2], o[dt], 0, 0, 0);
            }
    }
    const float inv = 1.0f / l_run;
    bf16* op = AO + (size_t)qt * D + h * 128 + 4 * hh;
#pragma unroll
    for (int dt = 0; dt < 4; ++dt)
#pragma unroll
        for (int i4 = 0; i4 < 4; ++i4) { v2u w; w.x = cvtpk(o[dt][4 * i4] * inv, o[dt][4 * i4 + 1] * inv); w.y = cvtpk(o[dt][4 * i4 + 2] * inv, o[dt][4 * i4 + 3] * inv);
            *(GAS v2u*)(op + 32 * dt + 8 * i4) = w; }
}
__device__ __forceinline__ void phase_attention(Frame& F, int rev) {
    const bf16* QKV = (const bf16*)(F.ws + WS_BIG + BIG_QKV); bf16* AO = (bf16*)(F.ws + WS_BIG + BIG_AO);
    LAS unsigned char* vimg = F.lds + RING_OFF + F.wave * 16384;
    for (int j = F.vcu; j < (T / 256) * 16; j += F.G) {
        const int jj = rev ? (T / 256) * 16 - 1 - j : j; const int h = jj & 15, blk = jj >> 4;
        attn_wave_task(QKV, AO, vimg, blk, h, F.wave, F.lane);
    }
}

#ifdef ATTN_NAIVE
__device__ __forceinline__ void phase_attention_naive(Frame& F) {
    const bf16* QKV = (const bf16*)(F.ws + WS_BIG + BIG_QKV); bf16* AO = (bf16*)(F.ws + WS_BIG + BIG_AO);
    const int gw = F.vcu * NWAVES + F.wave, NGW = F.G * NWAVES, lane = F.lane;
    for (int p = gw; p < T * 16; p += NGW) {
        const int tok = p >> 4, h = p & 15;
        int seq_start, seq_len;
        if (tok < T_PROMPT) { seq_start = tok & ~8191; seq_len = 8192; } else { seq_start = T_PROMPT + ((tok - T_PROMPT) & ~2047); seq_len = 2048; }
        const int seq_end = seq_start + seq_len;
        const float slope2 = __builtin_amdgcn_exp2f(-0.5f * (float)(h + 1)) * LOG2E;
        float m = -1e30f, l = 0.f, o0 = 0.f, o1 = 0.f;
        for (int g = 0; g < 3; ++g) {
            const int d = 1 << (2 * g);
            const unsigned qw = *(const GAS unsigned*)(QKV + (size_t)tok * NQKV + g * 2048 + h * 128 + 2 * lane);
            const float q0 = bf2f(qw & 0xffffu), q1 = bf2f(qw >> 16);
            for (int j = -64; j <= 64; ++j) {
                const int kt = tok + j * d;
                if (kt < seq_start || kt >= seq_end) continue;
                const unsigned kw = *(const GAS unsigned*)(QKV + (size_t)kt * NQKV + 6144 + g * 2048 + h * 128 + 2 * lane);
                const unsigned vw = *(const GAS unsigned*)(QKV + (size_t)kt * NQKV + 12288 + g * 2048 + h * 128 + 2 * lane);
                const float s = wave_sum(q0 * bf2f(kw & 0xffffu) + q1 * bf2f(kw >> 16)) - slope2 * (float)((j < 0 ? -j : j) * d);
                const float mn = fmaxf(m, s), al = __builtin_amdgcn_exp2f(m - mn), pv = __builtin_amdgcn_exp2f(s - mn);
                l = l * al + pv; o0 = o0 * al + pv * bf2f(vw & 0xffffu); o1 = o1 * al + pv * bf2f(vw >> 16); m = mn;
            }
        }
        const float inv = 1.0f / l;
        *(GAS unsigned*)(AO + (size_t)tok * D + h * 128 + 2 * lane) = pk2(o0 * inv, o1 * inv);
    }
}
#endif
constexpr int NPHASE = 54;
#ifndef DUP_PHASE
#define DUP_PHASE (-1)
#define DUP_N 0
#endif
#define REPS(id) for (int rep_ = 0; rep_ < ((DUP_PHASE) == (id) ? 1 + (DUP_N) : 1); ++rep_)
#ifndef ZERO_HY
#define ZERO_HY 0
#endif
#ifndef ZERO_AT
#define ZERO_AT 0
#endif
#ifndef AT_SCALE
#define AT_SCALE 1.0f
#endif
#ifndef HY_SCALE
#define HY_SCALE 1.0f
#endif
#define MIXSCALE(hy) ((hy) ? (ZERO_HY ? 0.0f : HY_SCALE) : (ZERO_AT ? 0.0f : AT_SCALE))
struct Args { const float* in[21]; float* out; unsigned char* ws; int ph_lo, ph_hi; };
static_assert(sizeof(Args) == 21 * 8 + 8 + 8 + 8, "Args has no padding");
__global__ void __launch_bounds__(NWAVES * 64, 2) fwd_kernel(Args args) {
    extern __shared__ __attribute__((aligned(16))) unsigned char lds[];
    unsigned char* const ws0 = args.ws;
    const int wave0 = __builtin_amdgcn_readfirstlane(threadIdx.x >> 6);
    volatile LAS unsigned* MISC = (volatile LAS unsigned*)((LAS unsigned char*)lds + MISC_OFF);
    if (threadIdx.x < 64) MISC[threadIdx.x] = 0u;
    if (threadIdx.x == 64) {
#pragma unroll
        for (int i = 0; i < 21; ++i) ((LAS unsigned long long*)((LAS unsigned char*)lds + PTR_OFF))[i] = (unsigned long long)args.in[i];
    }
    __syncthreads();
    XcdBarrier bar = xcd_barrier_post((unsigned*)(ws0 + WS_CTL), MISC);
#define FRAME() Frame F = make_frame(lds, args.ws, args.out, wave0)
    const int lo = args.ph_lo, hi = args.ph_hi;
#define RUN(id) (lo <= (id) && (id) < hi)
#define SEAM(id) do { if ((id) + 1 < hi) xcd_barrier(bar); } while (0)

#define ZB ((bf16*)(F.ws + WS_ZB))
#define STATS ((float*)(F.ws + WS_STATS))
#define PART ((float*)(F.ws + WS_PART))
#define CDV(off) ((float*)(F.ws + WS_CD) + (off))
#define HID ((bf16*)(F.ws + WS_BIG + BIG_HID))
    constexpr int O_C1 = 0, O_D1 = NFF2, O_CM = 2 * NFF2, O_DM = 2 * NFF2 + NQKV, O_C2 = 2 * NFF2 + 2 * NQKV, O_D2 = 3 * NFF2 + 2 * NQKV;

    if (RUN(0)) { FRAME(); phase_init(F); SEAM(0); }

#pragma unroll
    for (int layer = 0; layer < DEPTH; ++layer) {
        const int pb = 1 + 13 * layer; const bool hy = (layer & 1) != 0; const int jl = layer >> 1;
#define REVF(idx) ((7 * layer + (idx) + 1) & 1)
        if (RUN(pb + 0)) { FRAME(); REPS(0) phase_convert(F, layer); SEAM(pb + 0); }

        if (RUN(pb + 1)) {
            if (hy) {
                FRAME();
                pg8::Gemm gt{(const bf16*)(F.ws + WS_W3T), (const bf16*)(F.ws + WS_H2B), 8192, 10240, 256}; pg8::StaticOrder St; St.init(8192, 10240, F.G, F.bx);
                pg8::EpiTaps Et{(float*)(F.ws + WS_TAPS), MIN_DECAY, (MAX_DECAY - MIN_DECAY) / 2047.0f};
                pg8::gemm_phase<pg8::EpiTaps, pg8::StaticOrder, PG8_ALIGN, PG8_SP2>(F.lds + RING_OFF, gt, St, Et, F.tid);
            }
            FRAME();
            pg8::Gemm g{ZB, (const bf16*)(F.ws + W_IN1), T, NFF2, D}; pg8::StaticOrder S; S.init(T, NFF2, F.G, F.bx);
            pg8::EpiSwiglu E{HID, FF, STATS, CDV(O_C1), CDV(O_D1)};
            REPS(1) pg8::gemm_phase<pg8::EpiSwiglu, pg8::StaticOrder, PG8_ALIGN, PG8_SP2>(F.lds + RING_OFF, g, S, E, F.tid);
            SEAM(pb + 1);
        }
        if (RUN(pb + 2)) {
            FRAME();
            pg8::Gemm g{HID, (const bf16*)(F.ws + W_OUT1), T, D, FF}; pg8::StaticOrder S; S.init(T, D, F.G, F.bx, 1);
            const float* g0 = layer ? inp(F, 2) + (size_t)((layer - 1) * 3 + 2) * D : (const float*)(F.ws + WS_IDG); const float* b0 = layer ? inp(F, 3) + (size_t)((layer - 1) * 3 + 2) * D : (const float*)(F.ws + WS_IDB);
            pg8::EpiResid E{F.z, ZB, STATS, g0, b0, (const float*)(F.ws + WS_IDB), PART, 0.5f, 0};
            pg8::gemm_phase<pg8::EpiResid, pg8::StaticOrder, PG8_ALIGN, PG8_SP2>(F.lds + RING_OFF, g, S, E, F.tid);
            SEAM(pb + 2);
        }
        if (RUN(pb + 3)) { FRAME(); REPS(3) phase_finalize(F); SEAM(pb + 3); }

        if (RUN(pb + 4)) {
            FRAME(); const int N = hy ? NHY : NQKV;
            pg8::Gemm g{ZB, (const bf16*)(F.ws + W_MIN), T, N, D}; pg8::StaticOrder S; S.init(T, N, F.G, F.bx);
            pg8::EpiLnBf16 E{(bf16*)(F.ws + WS_BIG), N, STATS, CDV(O_CM), CDV(O_DM)};
            REPS(4) pg8::gemm_phase<pg8::EpiLnBf16, pg8::StaticOrder, PG8_ALIGN, PG8_SP2>(F.lds + RING_OFF, g, S, E, F.tid);
            SEAM(pb + 4);
        }
        if (RUN(pb + 5)) {
            FRAME();
#ifdef ATTN_NAIVE
            if (!hy) phase_attention_naive(F);
#else
            if (!hy) { REPS(5) phase_attention(F, 0); }
#endif
            else { REPS(15) phase_spectra(F, jl); REPS(25) phase_transpose(F, (const bf16*)(F.ws + WS_BIG + BIG_U), T, NHY, (bf16*)(F.ws + WS_BIG + BIG_UT)); }
            SEAM(pb + 5);
        }
        if (hy) {
            if (RUN(pb + 6)) { FRAME(); REPS(6) phase_conv(F, jl); SEAM(pb + 6); }
            if (RUN(pb + 7)) { FRAME(); REPS(7) phase_transpose(F, (const bf16*)(F.ws + WS_BIG + BIG_Z2T), D, T, (bf16*)(F.ws + WS_BIG + BIG_Z2)); SEAM(pb + 7); }
        }
        if (RUN(pb + 8)) {
            FRAME();
            const bf16* A = hy ? (const bf16*)(F.ws + WS_BIG + BIG_Z2) : (const bf16*)(F.ws + WS_BIG + BIG_AO);
            pg8::Gemm g{A, (const bf16*)(F.ws + W_MOUT), T, D, D}; pg8::StaticOrder S; S.init(T, D, F.G, F.bx);
            pg8::EpiResid E{F.z, ZB, STATS, inp(F, 2) + (size_t)(layer * 3) * D, inp(F, 3) + (size_t)(layer * 3) * D, hy ? inp(F, 20) + (size_t)jl * D : (const float*)(F.ws + WS_IDB), PART, MIXSCALE(hy), 0};
            pg8::gemm_phase<pg8::EpiResid, pg8::StaticOrder, PG8_ALIGN, PG8_SP2>(F.lds + RING_OFF, g, S, E, F.tid);
            SEAM(pb + 8);
        }
        if (RUN(pb + 9)) { FRAME(); phase_finalize(F); SEAM(pb + 9); }

        if (RUN(pb + 10)) {
            FRAME();
            pg8::Gemm g{ZB, (const bf16*)(F.ws + W_IN2), T, NFF2, D}; pg8::StaticOrder S; S.init(T, NFF2, F.G, F.bx);
            pg8::EpiSwiglu E{HID, FF, STATS, CDV(O_C2), CDV(O_D2)};
            pg8::gemm_phase<pg8::EpiSwiglu, pg8::StaticOrder, PG8_ALIGN, PG8_SP2>(F.lds + RING_OFF, g, S, E, F.tid);
            SEAM(pb + 10);
        }
        if (RUN(pb + 11)) {
            FRAME();
            pg8::Gemm g{HID, (const bf16*)(F.ws + W_OUT2), T, D, FF}; pg8::StaticOrder S; S.init(T, D, F.G, F.bx, 1);
            pg8::EpiResid E{F.z, ZB, STATS, inp(F, 2) + (size_t)(layer * 3 + 1) * D, inp(F, 3) + (size_t)(layer * 3 + 1) * D, (const float*)(F.ws + WS_IDB), PART, 0.5f, 0};
            pg8::gemm_phase<pg8::EpiResid, pg8::StaticOrder, PG8_ALIGN, PG8_SP2>(F.lds + RING_OFF, g, S, E, F.tid);
            SEAM(pb + 11);
        }
        if (RUN(pb + 12)) { FRAME(); phase_finalize(F); SEAM(pb + 12); }
    }
#ifdef DBG_CHECK
    if (RUN(NPHASE - 2)) { FRAME(); phase_check_qkv(F); SEAM(NPHASE - 2); }
#endif
    if (RUN(NPHASE - 1)) { FRAME(); phase_final_ln(F); }
#undef REVF
#undef RUN
#undef SEAM
#undef FRAME
}


#ifdef PHASE_PROBE
#define PROBE_FRAME() extern __shared__ __attribute__((aligned(16))) unsigned char lds[]; Frame F = make_frame(lds, args.ws, args.out, __builtin_amdgcn_readfirstlane(threadIdx.x >> 6));
__global__ void __launch_bounds__(NWAVES * 64, 2) probe_init(Args args) { PROBE_FRAME(); phase_init(F); }
__global__ void __launch_bounds__(NWAVES * 64, 2) probe_convert(Args args) { PROBE_FRAME(); phase_convert(F, args.ph_lo); }
__global__ void __launch_bounds__(NWAVES * 64, 2) probe_finalize(Args args) { PROBE_FRAME(); phase_finalize(F); phase_final_ln(F); }
__global__ void __launch_bounds__(NWAVES * 64, 2) probe_transpose(Args args) { PROBE_FRAME(); phase_transpose(F, (const bf16*)(F.ws + WS_BIG + BIG_U), T, NHY, (bf16*)(F.ws + WS_BIG + BIG_UT)); }
__global__ void __launch_bounds__(NWAVES * 64, 2) probe_spectra(Args args) { PROBE_FRAME(); phase_spectra(F, args.ph_lo); }
__global__ void __launch_bounds__(NWAVES * 64, 2) probe_conv(Args args) { PROBE_FRAME(); phase_conv(F, args.ph_lo); }
__global__ void __launch_bounds__(NWAVES * 64, 2) probe_attn(Args args) { PROBE_FRAME(); phase_attention(F, args.ph_lo); }
__global__ void __launch_bounds__(NWAVES * 64, 2) probe_gemm_swiglu(Args args) { PROBE_FRAME(); pg8::Gemm g{(const bf16*)F.ws, (const bf16*)(F.ws + W_IN1), T, NFF2, D}; pg8::StaticOrder S; S.init(T, NFF2, F.G, F.bx); pg8::EpiSwiglu E{(bf16*)(F.ws + WS_BIG), FF, (float*)(F.ws + WS_STATS), (float*)(F.ws + WS_CD), (float*)(F.ws + WS_CD)}; pg8::gemm_phase<pg8::EpiSwiglu, pg8::StaticOrder, PG8_ALIGN, PG8_SP2>(F.lds + RING_OFF, g, S, E, F.tid); }
__global__ void __launch_bounds__(NWAVES * 64, 2) probe_gemm_resid(Args args) { PROBE_FRAME(); pg8::Gemm g{(const bf16*)F.ws, (const bf16*)(F.ws + W_IN1), T, D, FF}; pg8::StaticOrder S; S.init(T, D, F.G, F.bx); pg8::EpiResid E{F.z, (bf16*)(F.ws + WS_ZB), (float*)(F.ws + WS_STATS), inp(F, 2), inp(F, 3), args.ph_lo ? inp(F, 20) : (const float*)(F.ws + WS_IDB), (float*)(F.ws + WS_PART), 0.5f, 0}; pg8::gemm_phase<pg8::EpiResid, pg8::StaticOrder, PG8_ALIGN, PG8_SP2>(F.lds + RING_OFF, g, S, E, F.tid); }
__global__ void __launch_bounds__(NWAVES * 64, 2) probe_gemm_ln(Args args) { PROBE_FRAME(); pg8::Gemm g{(const bf16*)F.ws, (const bf16*)(F.ws + W_IN1), T, NQKV, D}; pg8::StaticOrder S; S.init(T, NQKV, F.G, F.bx); pg8::EpiLnBf16 E{(bf16*)(F.ws + WS_BIG), NQKV, (float*)(F.ws + WS_STATS), (float*)(F.ws + WS_CD), (float*)(F.ws + WS_CD)}; pg8::gemm_phase<pg8::EpiLnBf16, pg8::StaticOrder, PG8_ALIGN, PG8_SP2>(F.lds + RING_OFF, g, S, E, F.tid); }
#endif
#ifndef MK_MULTI
#define MK_MULTI 0
#endif
extern "C" void kernel_launch(void* const* d_in, const int* in_sizes, int n_in, void* d_out, int out_size, void* d_ws, size_t ws_size, hipStream_t stream) {
    static int grid = 0;
    if (grid == 0) {
        if (n_in != 21 || out_size != T * D || ws_size < WS_END) { fprintf(stderr, "kernel_launch: unexpected shapes (n_in %d, out %d, ws %zu, need %zu)\n", n_in, out_size, ws_size, (size_t)WS_END); grid = -1; return; }
        int dev = 0, cus = 0, per_cu = 0;
        if (hipGetDevice(&dev) != hipSuccess || hipDeviceGetAttribute(&cus, hipDeviceAttributeMultiprocessorCount, dev) != hipSuccess) { grid = -1; return; }
        if (hipFuncSetAttribute((const void*)fwd_kernel, hipFuncAttributeMaxDynamicSharedMemorySize, LDS_BYTES) != hipSuccess) { fprintf(stderr, "kernel_launch: hipFuncSetAttribute failed\n"); grid = -1; return; }
        if (hipOccupancyMaxActiveBlocksPerMultiprocessor(&per_cu, (const void*)fwd_kernel, NWAVES * 64, LDS_BYTES) != hipSuccess || per_cu < 1) fprintf(stderr, "kernel_launch: occupancy query reports %d\n", per_cu);
        (void)hipGetLastError();
        grid = cus;
    }
    if (grid < 0) return;
    if (hipMemsetAsync((char*)d_ws + WS_CTL, 0, CTL_ZERO_BYTES, stream) != hipSuccess) return;
    Args a{};
    for (int i = 0; i < 21; ++i) a.in[i] = (const float*)d_in[i];
    a.out = (float*)d_out; a.ws = (unsigned char*)d_ws;
#ifndef STOP_AFTER
#define STOP_AFTER (NPHASE - 1)
#endif
#ifdef DBG_CHECK
#define DBGCHK_ON 1
#else
#define DBGCHK_ON 0
#endif
#if MK_MULTI
    for (int p = 0; p < NPHASE; ++p) { if (p >= STOP_AFTER && p != NPHASE - 1 && !(DBGCHK_ON && p == NPHASE - 2)) continue; a.ph_lo = p; a.ph_hi = p + 1; hipLaunchKernelGGL(fwd_kernel, dim3(grid), dim3(NWAVES * 64), LDS_BYTES, stream, a); }
#else
    a.ph_lo = 0; a.ph_hi = NPHASE;
    hipLaunchKernelGGL(fwd_kernel, dim3(grid), dim3(NWAVES * 64), LDS_BYTES, stream, a);
#endif
}
```

```cpp
#include <hip/hip_runtime.h>
#include <cstdio>
#include <cstdint>
namespace pg8 {
#define PG8_LAS __attribute__((address_space(3)))
typedef unsigned short bf16_t;
typedef short bf16x8 __attribute__((ext_vector_type(8)));
typedef float f32x4 __attribute__((ext_vector_type(4)));
typedef unsigned u32x4 __attribute__((ext_vector_type(4)));
constexpr int BM = 256, BK = 64, HALF = 128, HTB = HALF * BK * 2  , STAGE_BYTES = 8 * HTB, NXCD = 8, WGM = 8;

__host__ __device__ __forceinline__ int lds_byte(int r, int c) { const int st = (r >> 4) * 2 + (c >> 5), rr = r & 15, cc = c & 31, ob = rr * 64 + cc * 2; return st * 1024 + (ob ^ (((ob >> 9) & 1) << 5)); }
__host__ __device__ __forceinline__ void stage_rc(int b, int& R, int& C) { const int st = b / 1024, sb = b % 1024, swz = sb ^ (((sb >> 9) & 1) << 5); R = (st >> 1) * 16 + swz / 64; C = (st & 1) * 32 + (swz % 64) / 2; }
__host__ __device__ __forceinline__ int perm32(int rho) { const int n = rho >> 4, i = rho & 15; return 8 * (i >> 2) + 4 * n + (i & 3); }

struct Unit { int pm, pn; };
struct Gemm { const bf16_t* A; const bf16_t* Bt; int M, N, K; };

struct StaticOrder {
    int nM, nN, nwg, G, c, rev;
    __host__ __device__ void init(int M, int N, int G_, int c_, int rev_ = 0) { nM = M / BM; nN = N / BM; nwg = nM * nN; G = G_; c = c_; rev = rev_; }
    __host__ __device__ bool next(int i, Unit& u) const {
        const int nr = (nwg + G - 1) / G; if (i >= nr) return false;
        const long L = (long)(rev ? nr - 1 - i : i) * G + c; if (L >= nwg) return false;
        int wgid = (int)L; { const int q = nwg / NXCD, r = nwg % NXCD, xcd = wgid % NXCD, off = wgid / NXCD; wgid = (xcd < r ? xcd * (q + 1) : r * (q + 1) + (xcd - r) * q) + off; }
        const int nig = WGM * nN, gid = wgid / nig, fm = gid * WGM, gsz = (nM - fm) < WGM ? (nM - fm) : WGM;
        u.pm = fm + ((wgid % nig) % gsz); u.pn = (wgid % nig) / gsz; return true;
    }
    __device__ __forceinline__ void a_ready(const Unit&) const {}
    __device__ __forceinline__ void done(const Unit&) const {}
};

__device__ __forceinline__ unsigned cvt_pk_bf16(float lo, float hi) { unsigned r; asm volatile("v_cvt_pk_bf16_f32 %0, %1, %2" : "=v"(r) : "v"(lo), "v"(hi)); return r; }
typedef float f32x2 __attribute__((ext_vector_type(2)));
typedef float f32x2v __attribute__((ext_vector_type(2)));
typedef unsigned u32x2v __attribute__((ext_vector_type(2)));
constexpr float DN_ALPHA_F = 1.6817928305074292f;

__device__ __forceinline__ unsigned cvt2(float lo, float hi) { typedef __bf16 bf16x2_t __attribute__((ext_vector_type(2))); const f32x2v v = {lo, hi}; return __builtin_bit_cast(unsigned, __builtin_convertvector(v, bf16x2_t)); }
__device__ __forceinline__ float xor32_sum(float x) { const auto r = __builtin_amdgcn_permlane32_swap(__float_as_uint(x), __float_as_uint(x), false, false); const unsigned r0 = r[0], r1 = r[1]; return __uint_as_float(r0) + __uint_as_float(r1); }
__device__ __forceinline__ float xor32_max(float x) { const auto r = __builtin_amdgcn_permlane32_swap(__float_as_uint(x), __float_as_uint(x), false, false); const unsigned r0 = r[0], r1 = r[1]; return fmaxf(__uint_as_float(r0), __uint_as_float(r1)); }
template <int MASK> __device__ __forceinline__ float swz_xor(float x) { return __builtin_bit_cast(float, __builtin_amdgcn_ds_swizzle(__builtin_bit_cast(int, x), (MASK << 10) | 0x1F)); }
__device__ __forceinline__ float wave_sum64(float v) { v += swz_xor<1>(v); v += swz_xor<2>(v); v += swz_xor<4>(v); v += swz_xor<8>(v); v += swz_xor<16>(v); return xor32_sum(v); }

struct EpiLnBf16 {
    static constexpr bool PERM = true, AFTER_DRAIN = false;
    bf16_t* O; int ldc; const float* stats; const float* cvec; const float* dvec;
    __device__ __forceinline__ void operator()(const f32x4 (&acc)[2][2][4][2], const Unit& u, int wr, int wc, int fr, int fq) const {
        const int row0 = u.pm * BM + wr * 64 + fr, col0 = u.pn * BM + wc * 32 + 8 * fq;
        f32x4 cv[2][2], dv[2][2];
#pragma unroll
        for (int bj = 0; bj < 2; ++bj)
#pragma unroll
            for (int n = 0; n < 2; ++n) { cv[bj][n] = *(const f32x4*)(cvec + col0 + bj * HALF + 4 * n); dv[bj][n] = *(const f32x4*)(dvec + col0 + bj * HALF + 4 * n); }
        f32x2v sts[2][4];
#pragma unroll
        for (int ai = 0; ai < 2; ++ai)
#pragma unroll
            for (int m = 0; m < 4; ++m) sts[ai][m] = *(const f32x2v*)(stats + 2 * (size_t)(row0 + ai * HALF + m * 16));
#pragma unroll
        for (int ai = 0; ai < 2; ++ai)
#pragma unroll
            for (int m = 0; m < 4; ++m) { const int row = row0 + ai * HALF + m * 16; const f32x2v st = sts[ai][m];
                bf16_t* rowp = O + (size_t)row * ldc + col0;
#pragma unroll
                for (int bj = 0; bj < 2; ++bj) { const f32x4 v0 = (acc[ai][bj][m][0] - st.x * cv[bj][0]) * st.y + dv[bj][0], v1 = (acc[ai][bj][m][1] - st.x * cv[bj][1]) * st.y + dv[bj][1];
                    u32x4 w; w.x = cvt2(v0[0], v0[1]); w.y = cvt2(v0[2], v0[3]); w.z = cvt2(v1[0], v1[1]); w.w = cvt2(v1[2], v1[3]);
                    *(u32x4*)(rowp + bj * HALF) = w; } }
    }
};
struct EpiLnBf16T {
    static constexpr bool PERM = true, AFTER_DRAIN = false, HAS_INIT = false;
    bf16_t* O; int ldc; const float* stats; const float* cvec; const float* dvec;
    __device__ __forceinline__ void operator()(const f32x4 (&acc)[2][2][4][2], const Unit& u, int wr, int wc, int fr, int fq) const {
        const int row0 = u.pm * BM + wr * 64 + fr, col0 = u.pn * BM + wc * 32 + 8 * fq;
        f32x4 mean[2][2], rstd[2][2];
#pragma unroll
        for (int bj = 0; bj < 2; ++bj) { const f32x4* sp = (const f32x4*)(stats + 2 * (size_t)(col0 + bj * HALF));
            const f32x4 a = sp[0], b = sp[1], c = sp[2], d = sp[3];
            mean[bj][0] = (f32x4){a[0], a[2], b[0], b[2]}; rstd[bj][0] = (f32x4){a[1], a[3], b[1], b[3]};
            mean[bj][1] = (f32x4){c[0], c[2], d[0], d[2]}; rstd[bj][1] = (f32x4){c[1], c[3], d[1], d[3]}; }
        float cr[2][4], dr[2][4];
#pragma unroll
        for (int ai = 0; ai < 2; ++ai)
#pragma unroll
            for (int m = 0; m < 4; ++m) { const int row = row0 + ai * HALF + m * 16; cr[ai][m] = cvec[row]; dr[ai][m] = dvec[row]; }
#pragma unroll
        for (int ai = 0; ai < 2; ++ai)
#pragma unroll
            for (int m = 0; m < 4; ++m) { const int row = row0 + ai * HALF + m * 16; bf16_t* rowp = O + (size_t)row * ldc + col0;
#pragma unroll
                for (int bj = 0; bj < 2; ++bj) { const f32x4 v0 = (acc[ai][bj][m][0] - mean[bj][0] * cr[ai][m]) * rstd[bj][0] + dr[ai][m], v1 = (acc[ai][bj][m][1] - mean[bj][1] * cr[ai][m]) * rstd[bj][1] + dr[ai][m];
                    u32x4 w; w.x = cvt2(v0[0], v0[1]); w.y = cvt2(v0[2], v0[3]); w.z = cvt2(v1[0], v1[1]); w.w = cvt2(v1[2], v1[3]);
                    *(u32x4*)(rowp + bj * HALF) = w; } }
    }
};
__device__ __forceinline__ float silu_mul(float g, float up) { const float e = __builtin_amdgcn_exp2f(-1.4426950408889634f * g); return g * __builtin_amdgcn_rcpf(1.0f + e) * up; }
struct EpiSwiglu {
    static constexpr bool PERM = true, AFTER_DRAIN = false;
    bf16_t* O; int ldc; const float* stats; const float* cvec; const float* dvec;
    __device__ __forceinline__ void operator()(const f32x4 (&acc)[2][2][4][2], const Unit& u, int wr, int wc, int fr, int fq) const {
        const int row0 = u.pm * BM + wr * 64 + fr, col0 = u.pn * BM + wc * 32 + 8 * fq, ocol = u.pn * HALF + wc * 32 + 8 * fq;
        f32x4 cv[2][2], dv[2][2];
#pragma unroll
        for (int bj = 0; bj < 2; ++bj)
#pragma unroll
            for (int n = 0; n < 2; ++n) { cv[bj][n] = *(const f32x4*)(cvec + col0 + bj * HALF + 4 * n); dv[bj][n] = *(const f32x4*)(dvec + col0 + bj * HALF + 4 * n); }
        f32x2v sts[2][4];
#pragma unroll
        for (int ai = 0; ai < 2; ++ai)
#pragma unroll
            for (int m = 0; m < 4; ++m) sts[ai][m] = *(const f32x2v*)(stats + 2 * (size_t)(row0 + ai * HALF + m * 16));
#pragma unroll
        for (int ai = 0; ai < 2; ++ai)
#pragma unroll
            for (int m = 0; m < 4; ++m) { const int row = row0 + ai * HALF + m * 16; const f32x2v st = sts[ai][m];
                f32x4 h[2];
#pragma unroll
                for (int n = 0; n < 2; ++n) { const f32x4 g = (acc[ai][0][m][n] - st.x * cv[0][n]) * st.y + dv[0][n], up = (acc[ai][1][m][n] - st.x * cv[1][n]) * st.y + dv[1][n];
                    h[n] = (f32x4){silu_mul(g[0], up[0]), silu_mul(g[1], up[1]), silu_mul(g[2], up[2]), silu_mul(g[3], up[3])}; }
                u32x4 w; w.x = cvt2(h[0][0], h[0][1]); w.y = cvt2(h[0][2], h[0][3]); w.z = cvt2(h[1][0], h[1][1]); w.w = cvt2(h[1][2], h[1][3]);
                *(u32x4*)(O + (size_t)row * ldc + ocol) = w; }
    }
};
struct EpiResid {
    static constexpr bool PERM = true, AFTER_DRAIN = false;
    float* Z; bf16_t* ZB; const float* stats; const float* gprev; const float* bprev; const float* bias; float* part; float scale; int pad;
    __device__ __forceinline__ void operator()(const f32x4 (&acc)[2][2][4][2], const Unit& u, int wr, int wc, int fr, int fq) const {
        const int row0 = u.pm * BM + wr * 64 + fr, col0 = u.pn * BM + wc * 32 + 8 * fq;
#pragma unroll
        for (int bj = 0; bj < 2; ++bj) {
            f32x4 gv[2], bv[2];
#pragma unroll
            for (int n = 0; n < 2; ++n) { const int c = col0 + bj * HALF + 4 * n; gv[n] = DN_ALPHA_F * *(const f32x4*)(gprev + c); bv[n] = DN_ALPHA_F * *(const f32x4*)(bprev + c) + scale * *(const f32x4*)(bias + c); }
#pragma unroll
            for (int ai = 0; ai < 2; ++ai)
#pragma unroll
                for (int mp = 0; mp < 2; ++mp) {
                    f32x4 zin[2][2]; f32x2v sts[2];
#pragma unroll
                    for (int mm = 0; mm < 2; ++mm) { const int row = row0 + ai * HALF + (2 * mp + mm) * 16; const float* zp = Z + (size_t)row * 2048 + col0 + bj * HALF;
                        zin[mm][0] = *(const f32x4*)zp; zin[mm][1] = *(const f32x4*)(zp + 4); sts[mm] = *(const f32x2v*)(stats + 2 * (size_t)row); }
#pragma unroll
                    for (int mm = 0; mm < 2; ++mm) { const int m = 2 * mp + mm; const int row = row0 + ai * HALF + m * 16; const f32x2v st = sts[mm];
                        float* zp = Z + (size_t)row * 2048 + col0 + bj * HALF;
                        const f32x4 n0 = (zin[mm][0] - st.x) * st.y * gv[0] + bv[0] + scale * acc[ai][bj][m][0];
                        const f32x4 n1 = (zin[mm][1] - st.x) * st.y * gv[1] + bv[1] + scale * acc[ai][bj][m][1];
                        *(f32x4*)zp = n0; *(f32x4*)(zp + 4) = n1;
                        u32x4 w; w.x = cvt2(n0[0], n0[1]); w.y = cvt2(n0[2], n0[3]); w.z = cvt2(n1[0], n1[1]); w.w = cvt2(n1[2], n1[3]);
                        *(u32x4*)(ZB + (size_t)row * 2048 + col0 + bj * HALF) = w;
                        float s = ((n0[0] + n0[1]) + (n0[2] + n0[3])) + ((n1[0] + n1[1]) + (n1[2] + n1[3]));
                        float q = ((n0[0] * n0[0] + n0[1] * n0[1]) + (n0[2] * n0[2] + n0[3] * n0[3])) + ((n1[0] * n1[0] + n1[1] * n1[1]) + (n1[2] * n1[2] + n1[3] * n1[3]));
                        s += swz_xor<16>(s); s = xor32_sum(s); q += swz_xor<16>(q); q = xor32_sum(q);
                        if (fq == 0) *(f32x2v*)(part + ((size_t)row * 64 + u.pn * 8 + wc * 2 + bj) * 2) = (f32x2v){s, q}; }
                }
        }
    }
};

struct EpiTaps {
    static constexpr bool PERM = false, AFTER_DRAIN = false;
    float* O; float min_decay, dstep;
    __device__ __forceinline__ void operator()(const f32x4 (&acc)[2][2][4][2], const Unit& u, int wr, int wc, int fr, int fq) const {
        int stride = 10240; float i0 = 1.0f / 8191.0f, i1 = 1.0f / 2047.0f; asm volatile("" : "+s"(stride), "+s"(i0), "+s"(i1));
        const int row0 = u.pm * BM + wr * 64 + fr, col0 = u.pn * BM + wc * 32 + 4 * fq;
        const int tbase = (u.pn < 32) ? 0 : 8192; const float ilm1 = (u.pn < 32) ? i0 : i1;
        const float t0 = (float)(col0 - tbase);
#pragma unroll
        for (int ai = 0; ai < 2; ++ai)
#pragma unroll
            for (int m = 0; m < 4; ++m) { const int row = row0 + ai * HALF + m * 16;
                const float a = -1.4426950408889634f * __builtin_fabsf(min_decay + (float)(row & 2047) * dstep) * ilm1;
                const float e0 = __builtin_amdgcn_exp2f(a * t0), s1 = __builtin_amdgcn_exp2f(a), s16 = __builtin_amdgcn_exp2f(16.0f * a), s128 = __builtin_amdgcn_exp2f(128.0f * a);
                float* rowp = O + (size_t)row * stride + col0;
#pragma unroll
                for (int bj = 0; bj < 2; ++bj) { const float eb = bj ? e0 * s128 : e0;
#pragma unroll
                    for (int n = 0; n < 2; ++n) { const float en = n ? eb * s16 : eb, en1 = en * s1, en2 = en1 * s1, en3 = en2 * s1; const f32x4 v = acc[ai][bj][m][n];
                        *(f32x4*)(rowp + bj * HALF + n * 16) = (f32x4){v[0] * en, v[1] * en1, v[2] * en2, v[3] * en3}; } } }
    }
};

template <class Epi, class Sched, bool ALIGN_EPI = false, bool SP2 = false>
__device__ __forceinline__ void gemm_phase(PG8_LAS unsigned char* lds, const Gemm g, const Sched& S, const Epi& E, const int tid_in) {
    int tid_ = tid_in; asm volatile("" : "+v"(tid_));
    const int tid = tid_, wid = __builtin_amdgcn_readfirstlane(tid >> 6), lane = tid & 63, wr = wid >> 2, wc = wid & 3, fr = lane & 15, fq = lane >> 4;
    const int K = g.K, nt = K / BK;
    unsigned voffA[2], voffB[2];
#pragma unroll
    for (int i = 0; i < 2; ++i) { int R, C; stage_rc(tid * 16 + i * 8192, R, C); const int Rb = Epi::PERM ? ((R & ~31) + perm32(R & 31)) : R;
        voffA[i] = (unsigned)(R * K + C) * 2u; voffB[i] = (unsigned)(Rb * K + C) * 2u; }
    const size_t kstep = (size_t)(BK * 2);
    const size_t hstep = (size_t)HALF * K * 2;
    const size_t tstep = 2 * hstep;
    const unsigned ldsw = (unsigned)wid * 1024u;
    const int aoff = lds_byte(wr * 64 + fr, fq * 8), boff = lds_byte(wc * 32 + fr, fq * 8);
#define PG8_SA(b, h) (((b) * 2 + (h)) * HTB)
#define PG8_SB(b, h) ((4 + (b) * 2 + (h)) * HTB)
#define PG8_STAGE(bufoff, gbase, voff) do { _Pragma("unroll") for (int _i = 0; _i < 2; ++_i) \
        __builtin_amdgcn_global_load_lds((const unsigned*)((const char*)(gbase) + (voff)[_i]), (PG8_LAS unsigned*)(lds + (bufoff) + ldsw + _i * 8192), 16, 0, 0); } while (0)
#define PG8_LDA(dst, b, h) do { _Pragma("unroll") for (int m = 0; m < 4; ++m) _Pragma("unroll") for (int k = 0; k < 2; ++k) dst[m][k] = *(const PG8_LAS bf16x8*)(lds + PG8_SA(b, h) + aoff + m * 2048 + k * 1024); } while (0)
#define PG8_LDB(dst, b, h) do { _Pragma("unroll") for (int n = 0; n < 2; ++n) _Pragma("unroll") for (int k = 0; k < 2; ++k) dst[n][k] = *(const PG8_LAS bf16x8*)(lds + PG8_SB(b, h) + boff + n * 2048 + k * 1024); } while (0)
#define PG8_MMA(ai, bj, At, Bt) do { __builtin_amdgcn_s_setprio(1); _Pragma("unroll") for (int m = 0; m < 4; ++m) _Pragma("unroll") for (int n = 0; n < 2; ++n) _Pragma("unroll") for (int k = 0; k < 2; ++k) \
        acc[ai][bj][m][n] = __builtin_amdgcn_mfma_f32_16x16x32_bf16(Bt[n][k], At[m][k], acc[ai][bj][m][n], 0, 0, 0); __builtin_amdgcn_s_setprio(0); } while (0)
#define PG8_WAIT_V(n) asm volatile("s_waitcnt vmcnt(" #n ")" ::: "memory")
#define PG8_WAIT_L(n) asm volatile("s_waitcnt lgkmcnt(" #n ")" ::: "memory")
#define PG8_BAR __builtin_amdgcn_s_barrier()
#define PG8_SCHED __builtin_amdgcn_sched_barrier(0)
    Unit cur, nxt; int ui = 0;
    if (!S.next(0, cur)) return;
    f32x4 acc[2][2][4][2];
    float zero_; asm volatile("v_mov_b32 %0, 0" : "=v"(zero_));
#pragma unroll
    for (int a = 0; a < 2; ++a)
#pragma unroll
        for (int b = 0; b < 2; ++b)
#pragma unroll
            for (int m = 0; m < 4; ++m)
#pragma unroll
                for (int n = 0; n < 2; ++n) acc[a][b][m][n] = (f32x4){zero_, zero_, zero_, zero_};
    bf16x8 At[4][2], B0[2][2], B1[2][2];
    const char* cA = (const char*)g.A + (size_t)cur.pm * tstep; const char* cB = (const char*)g.Bt + (size_t)cur.pn * tstep;
    S.a_ready(cur);
    if constexpr (SP2) {
        PG8_STAGE(PG8_SB(0, 0), cB, voffB); PG8_STAGE(PG8_SB(0, 1), cB + hstep, voffB); PG8_STAGE(PG8_SA(0, 0), cA, voffA); PG8_STAGE(PG8_SA(0, 1), cA + hstep, voffA);
        if (wr == 1) PG8_BAR;
        PG8_WAIT_V(2); PG8_BAR;
        PG8_STAGE(PG8_SB(1, 0), cB + kstep, voffB); PG8_STAGE(PG8_SA(1, 0), cA + kstep, voffA); PG8_STAGE(PG8_SB(1, 1), cB + hstep + kstep, voffB);
        PG8_WAIT_V(6); PG8_BAR;
    } else {
        PG8_STAGE(PG8_SB(0, 0), cB, voffB); PG8_STAGE(PG8_SA(0, 0), cA, voffA); PG8_STAGE(PG8_SB(0, 1), cB + hstep, voffB); PG8_STAGE(PG8_SA(0, 1), cA + hstep, voffA);
        if (wr == 1) PG8_BAR;
        PG8_WAIT_V(4); PG8_BAR;
        PG8_STAGE(PG8_SB(1, 0), cB + kstep, voffB); PG8_STAGE(PG8_SA(1, 0), cA + kstep, voffA); PG8_STAGE(PG8_SB(1, 1), cB + hstep + kstep, voffB);
        PG8_WAIT_V(6); PG8_BAR;
    }
    for (;;) {
        const bool has_next = S.next(ui + 1, nxt);
        const char* nA = has_next ? (const char*)g.A + (size_t)nxt.pm * tstep : cA; const char* nB = has_next ? (const char*)g.Bt + (size_t)nxt.pn * tstep : cB;
        for (int t = 0; t < nt; t += 2) {
            const bool last = (t == nt - 2);
            const char* a1 = cA + (size_t)(t + 1) * kstep;
            const char* a2 = last ? nA : cA + (size_t)(t + 2) * kstep; const char* b2 = last ? nB : cB + (size_t)(t + 2) * kstep;
            const char* a3 = a2 + kstep; const char* b3 = b2 + kstep;
            if (last && has_next) S.a_ready(nxt);
            if constexpr (SP2) {
            PG8_LDB(B0, 0, 0); PG8_LDB(B1, 0, 1); PG8_SCHED; PG8_LDA(At, 0, 0); PG8_STAGE(PG8_SA(1, 1), a1 + hstep, voffA);
            PG8_WAIT_V(8); PG8_WAIT_L(0); PG8_BAR; PG8_MMA(0, 0, At, B0); PG8_MMA(0, 1, At, B1); PG8_BAR; PG8_SCHED;
            PG8_LDA(At, 0, 1); PG8_STAGE(PG8_SB(0, 0), b2, voffB); PG8_STAGE(PG8_SB(0, 1), b2 + hstep, voffB); PG8_STAGE(PG8_SA(0, 0), a2, voffA);
            PG8_WAIT_V(8); PG8_WAIT_L(0); PG8_BAR; PG8_MMA(1, 0, At, B0); PG8_MMA(1, 1, At, B1); PG8_BAR; PG8_SCHED;
            PG8_LDB(B0, 1, 0); PG8_LDB(B1, 1, 1); PG8_SCHED; PG8_LDA(At, 1, 0); PG8_STAGE(PG8_SA(0, 1), a2 + hstep, voffA);
            PG8_WAIT_V(8); PG8_WAIT_L(0); PG8_BAR; PG8_MMA(0, 0, At, B0); PG8_MMA(0, 1, At, B1); PG8_BAR; PG8_SCHED;
            PG8_LDA(At, 1, 1); PG8_STAGE(PG8_SB(1, 0), b3, voffB); PG8_STAGE(PG8_SB(1, 1), b3 + hstep, voffB); PG8_STAGE(PG8_SA(1, 0), a3, voffA);
            PG8_WAIT_V(8); PG8_WAIT_L(0); PG8_BAR; PG8_MMA(1, 0, At, B0); PG8_MMA(1, 1, At, B1); PG8_BAR; PG8_SCHED;
            } else {
            PG8_LDB(B0, 0, 0); PG8_SCHED; PG8_LDA(At, 0, 0); PG8_STAGE(PG8_SA(1, 1), a1 + hstep, voffA);
            PG8_WAIT_L(8); PG8_BAR; PG8_WAIT_L(0); PG8_MMA(0, 0, At, B0); PG8_BAR; PG8_SCHED;
            PG8_LDB(B1, 0, 1); PG8_STAGE(PG8_SB(0, 0), b2, voffB);
            PG8_BAR; PG8_WAIT_L(0); PG8_MMA(0, 1, At, B1); PG8_BAR;
            PG8_LDA(At, 0, 1); PG8_STAGE(PG8_SA(0, 0), a2, voffA);
            PG8_BAR; PG8_WAIT_L(0); PG8_MMA(1, 0, At, B0); PG8_BAR; PG8_SCHED;
            PG8_STAGE(PG8_SB(0, 1), b2 + hstep, voffB);
            PG8_WAIT_V(6); PG8_BAR; PG8_MMA(1, 1, At, B1); PG8_BAR;
            PG8_LDB(B0, 1, 0); PG8_SCHED; PG8_LDA(At, 1, 0); PG8_STAGE(PG8_SA(0, 1), a2 + hstep, voffA);
            PG8_WAIT_L(8); PG8_BAR; PG8_WAIT_L(0); PG8_MMA(0, 0, At, B0); PG8_BAR; PG8_SCHED;
            PG8_LDB(B1, 1, 1); PG8_STAGE(PG8_SB(1, 0), b3, voffB);
            PG8_BAR; PG8_WAIT_L(0); PG8_MMA(0, 1, At, B1); PG8_BAR;
            PG8_LDA(At, 1, 1); PG8_STAGE(PG8_SA(1, 0), a3, voffA);
            PG8_BAR; PG8_WAIT_L(0); PG8_MMA(1, 0, At, B0); PG8_BAR; PG8_SCHED;
            PG8_STAGE(PG8_SB(1, 1), b3 + hstep, voffB);
            PG8_WAIT_V(6); PG8_BAR; PG8_MMA(1, 1, At, B1); PG8_BAR;
            }
        }
        if constexpr (ALIGN_EPI) { if (wr == 0) PG8_BAR; }
        if constexpr (!Epi::AFTER_DRAIN) { E(acc, cur, wr, wc, fr, fq); S.done(cur); }
        if (!has_next) break;
        asm volatile("v_mov_b32 %0, 0" : "=v"(zero_));
#pragma unroll
        for (int a = 0; a < 2; ++a)
#pragma unroll
            for (int b = 0; b < 2; ++b)
#pragma unroll
                for (int m = 0; m < 4; ++m)
#pragma unroll
                    for (int n = 0; n < 2; ++n) acc[a][b][m][n] = (f32x4){zero_, zero_, zero_, zero_};
        cur = nxt; cA = nA; cB = nB; ++ui;
        if constexpr (ALIGN_EPI) { if (wr == 1) PG8_BAR; }
    }
    PG8_WAIT_V(0);
    if constexpr (!ALIGN_EPI) { if (wr == 0) PG8_BAR; }
    PG8_BAR;
    if constexpr (Epi::AFTER_DRAIN) { E.fused(acc, cur, wr, wc, fr, fq, lds, wid, lane); S.done(cur); }
#undef PG8_SA
#undef PG8_SB
#undef PG8_STAGE
#undef PG8_LDA
#undef PG8_LDB
#undef PG8_MMA
#undef PG8_WAIT_V
#undef PG8_WAIT_L
#undef PG8_BAR
#undef PG8_SCHED
}
}

#ifndef PG8_SP2
#define PG8_SP2 true
#endif
#ifndef PG8_ALIGN
#define PG8_ALIGN true
#endif
#define XB_TMO      128
#define XB_XCNT(j)  (256  + 64 * (j))
#define XB_XSUB(j)  (1280 + 64 * (j))
#define XB_XGEN(j)  (2304 + 64 * (j))
#define XB_TOP      3328
#define XB_TOPGEN   3392
#define XCD_BAR_WORDS 3456
#define XB_SPIN_CAP (1u << 18)
#define LAS __attribute__((address_space(3)))

__device__ __forceinline__ unsigned xb_ld(unsigned* p)              { return __hip_atomic_load(p, __ATOMIC_RELAXED, __HIP_MEMORY_SCOPE_AGENT); }
__device__ __forceinline__ unsigned xb_add(unsigned* p, unsigned v) { return __hip_atomic_fetch_add(p, v, __ATOMIC_RELAXED, __HIP_MEMORY_SCOPE_AGENT); }
__device__ __forceinline__ unsigned xb_xcc_id() { return (unsigned)__builtin_amdgcn_s_getreg((3 << 11) | 20) & 0xFu; }
#define XB_SPIN(cond, bar) do { unsigned _sp = 0; while (cond) { __builtin_amdgcn_s_sleep(1); \
    if ((++_sp & 255u) == 0u) { if (xb_ld(&(bar)[XB_TMO])) break; if (_sp > XB_SPIN_CAP) { atomicAdd(&(bar)[XB_TMO], 1u); break; } } } } while (0)

struct XcdBarrier {
    unsigned* bar; unsigned x;
    unsigned w0;
    volatile LAS unsigned* st;
};

__device__ __forceinline__ XcdBarrier xcd_barrier_post(unsigned* bar, volatile LAS unsigned* st) {
    XcdBarrier b; b.bar = bar; b.x = xb_xcc_id(); b.st = st; b.w0 = (unsigned)__builtin_amdgcn_readfirstlane(threadIdx.x >> 6);
    if (threadIdx.x == 0) (void)xb_add(&bar[XB_XCNT(b.x)], 1u);
    return b;
}
__device__ __forceinline__ void xcd_barrier_complete(unsigned* bar, unsigned x, unsigned& nloc, unsigned& nx) {
    const unsigned G = gridDim.x * gridDim.y * gridDim.z;
    unsigned sum, cnt, mine, sp = 0u;
    for (;;) {
        sum = 0u; cnt = 0u; mine = 0u;
#pragma unroll
        for (unsigned j = 0; j < 16; ++j) { const unsigned c = xb_ld(&bar[XB_XCNT(j)]); sum += c; cnt += (c > 0u) ? 1u : 0u; mine = (j == x) ? c : mine; }
        if (sum == G) break;
        __builtin_amdgcn_s_sleep(1);
        if ((++sp & 255u) == 0u) { if (xb_ld(&bar[XB_TMO])) break; if (sp > XB_SPIN_CAP) { atomicAdd(&bar[XB_TMO], 1u); break; } }
    }
    nloc = mine > 0u ? mine : 1u; nx = cnt > 0u ? cnt : 1u;
}

__device__ __forceinline__ void xcd_barrier(const XcdBarrier& b) {
    asm volatile("s_waitcnt vmcnt(0)" ::: "memory");
    __syncthreads();
    unsigned xb_lane; asm volatile("v_mbcnt_lo_u32_b32 %0, -1, 0\n\tv_mbcnt_hi_u32_b32 %0, -1, %0" : "=v"(xb_lane));
    if (b.w0 == 0u && xb_lane == 0u) {
        unsigned* bar = b.bar;
        __builtin_amdgcn_s_waitcnt(0);
        unsigned nloc = b.st[0], nx = b.st[1];
        if (nloc == 0u) { xcd_barrier_complete(bar, b.x, nloc, nx); b.st[0] = nloc; b.st[1] = nx; }
        const unsigned old = xb_add(&bar[XB_XSUB(b.x)], 1u);
        const unsigned gen = old / nloc;
        if (old + 1u == (gen + 1u) * nloc) {
            __builtin_amdgcn_fence(__ATOMIC_RELEASE, "agent");
            asm volatile("s_waitcnt vmcnt(0)" ::: "memory");
            const unsigned og = xb_add(&bar[XB_TOP], 1u);
            const unsigned tg = og / nx;
            if (og + 1u == (tg + 1u) * nx) xb_add(&bar[XB_TOPGEN], 1u);
            else XB_SPIN(xb_ld(&bar[XB_TOPGEN]) == tg, bar);
            __builtin_amdgcn_fence(__ATOMIC_ACQUIRE, "agent");
            xb_add(&bar[XB_XGEN(b.x)], 1u);
            asm volatile("s_waitcnt vmcnt(0)" ::: "memory");
        } else {
            XB_SPIN(xb_ld(&bar[XB_XGEN(b.x)]) == gen, bar);
            __builtin_amdgcn_fence(__ATOMIC_ACQUIRE, "agent");
            asm volatile("s_waitcnt vmcnt(0)" ::: "memory");
        }
    }
    __syncthreads();
}
constexpr int NWAVES = 8;
constexpr int D = 2048, FF = 5632, NFF2 = 2 * FF, NQKV = 18432, NHY = 6144, DEPTH = 4;
constexpr int T_PROMPT = 4 * 8192, T = 49152;
constexpr float LN_EPS = 1e-5f;
constexpr float QSCALE = 0.12751743082459868f;
constexpr float LOG2E = 1.4426950408889634f;
constexpr float MIN_DECAY = -3.0701134573253946f, MAX_DECAY = -15.350567286626973f;

constexpr size_t MiB = 1u << 20;
constexpr size_t WS_CTL = 0, CTL_ZERO_BYTES = 64 * 1024;
constexpr size_t WS_IDG = 1 * MiB, WS_IDB = 1 * MiB + 32768, WS_DUMP = 1 * MiB + 32768 + 131072;
constexpr size_t WS_CD = 2 * MiB;
constexpr size_t WS_STATS = 3 * MiB;
constexpr size_t WS_H2T = 4 * MiB;
constexpr size_t WS_PART = 8 * MiB;
constexpr size_t WS_W = 32 * MiB;
constexpr size_t W_IN1 = WS_W, W_OUT1 = W_IN1 + 44 * MiB, W_IN2 = W_OUT1 + 22 * MiB, W_OUT2 = W_IN2 + 44 * MiB, W_MIN = W_OUT2 + 22 * MiB, W_MOUT = W_MIN + 72 * MiB;
constexpr size_t WS_ZB = W_MOUT + 8 * MiB;
constexpr size_t WS_BIG = WS_ZB + 192 * MiB;
constexpr size_t BIG_HID = 0;
constexpr size_t BIG_QKV = 0, BIG_AO = 1728 * MiB;
constexpr size_t BIG_U = 0, BIG_Z2T = 0, BIG_Z2 = 192 * MiB, BIG_UT = 576 * MiB, BIG_SPEC0 = 1152 * MiB, BIG_SPEC1 = 1664 * MiB;
constexpr size_t WS_TAPS = WS_BIG + 1920 * MiB;
constexpr size_t WS_H2B = WS_TAPS + 320 * MiB, WS_W3T = WS_H2B + 6 * MiB;
constexpr size_t WS_END = WS_W3T + 4 * MiB;
static_assert(WS_ZB == 244 * MiB && WS_BIG == 436 * MiB && (size_t)T * 64 * 8 <= 24 * MiB && WS_END <= 2816 * MiB && (size_t)8192 * 10240 * 4 <= 320 * MiB, "ws map");
static_assert((size_t)T * FF * 2 <= 528 * MiB && (size_t)T * NQKV * 2 <= 1728 * MiB && (size_t)T * NHY * 2 <= 576 * MiB && BIG_SPEC1 + 128 * MiB <= 1920 * MiB, "ws map");

constexpr int RING_OFF = 0;
constexpr int FFT_BYTES = (16384 + 512) * 8;
constexpr int SCR_OFF = FFT_BYTES;
constexpr int MISC_OFF = SCR_OFF + 1024;
constexpr int PTR_OFF = MISC_OFF + 256;
constexpr int LDS_BYTES = PTR_OFF + 256;

#define GAS __attribute__((address_space(1)))
#define LAS __attribute__((address_space(3)))
typedef unsigned short bf16;
typedef unsigned v4u __attribute__((ext_vector_type(4)));
typedef unsigned v2u __attribute__((ext_vector_type(2)));
typedef float f32x4 __attribute__((ext_vector_type(4)));
typedef float f32x2 __attribute__((ext_vector_type(2)));
typedef float f32x16 __attribute__((ext_vector_type(16)));
typedef short bf16x8 __attribute__((ext_vector_type(8)));
typedef short s16x4 __attribute__((ext_vector_type(4)));
#define LDS_WAIT() asm volatile("s_waitcnt lgkmcnt(0)" ::: "memory")
#define VM_WAIT() asm volatile("s_waitcnt vmcnt(0)" ::: "memory")
__device__ __forceinline__ unsigned f2bf(float f) { unsigned u = __builtin_bit_cast(unsigned, f); return (u + 0x7fffu + ((u >> 16) & 1u)) >> 16; }
__device__ __forceinline__ unsigned pk2(float lo, float hi) { return f2bf(lo) | (f2bf(hi) << 16); }
__device__ __forceinline__ float bf2f(unsigned b) { return __builtin_bit_cast(float, b << 16); }
__device__ __forceinline__ float bfround(float f) { return bf2f(f2bf(f)); }

#ifndef FFT_HD
#define FFT_HD __host__ __device__ __forceinline__
#endif
#if defined(__clang__)
typedef float cpx __attribute__((ext_vector_type(2)));
#else
struct cpx { float x, y; };
#endif
FFT_HD cpx cmul(cpx a, cpx b) { return cpx{a.x * b.x - a.y * b.y, a.x * b.y + a.y * b.x}; }
FFT_HD cpx cmulc(cpx a, cpx b) { return cpx{a.x * b.x + a.y * b.y, a.y * b.x - a.x * b.y}; }
FFT_HD cpx cadd(cpx a, cpx b) { return cpx{a.x + b.x, a.y + b.y}; }
FFT_HD cpx csub(cpx a, cpx b) { return cpx{a.x - b.x, a.y - b.y}; }
FFT_HD int pidx(int i) { return i + (i >> 5); }
FFT_HD cpx cis_neg_rev(float rev) {
    const float x8 = rev * 8.0f; int oct = (int)x8; oct = oct > 7 ? 7 : oct; const float f = x8 - (float)oct;
    const float a = (oct & 1) ? (1.0f - f) : f, phi = a * 0.78539816339744831f, p2 = phi * phi;
    const float s = phi * (1.0f + p2 * (-1.6666666666666666e-1f + p2 * (8.3333333333333332e-3f + p2 * (-1.9841269841269841e-4f + p2 * 2.7557319223985893e-6f))));
    const float c = 1.0f + p2 * (-0.5f + p2 * (4.1666666666666664e-2f + p2 * (-1.3888888888888889e-3f + p2 * (2.4801587301587302e-5f + p2 * -2.7557319223985888e-7f))));
    const bool sw = ((oct + 1) & 2) != 0;
    float cc = sw ? s : c, ss = sw ? c : s;
    if (oct >= 2 && oct <= 5) cc = -cc;
    if (oct >= 4) ss = -ss;
    return cpx{cc, -ss};
}
FFT_HD float sin_acc(float x) { float rev = x * 0.15915494309189535f; rev -= floorf(rev); const cpx e = cis_neg_rev(rev); return -e.y; }
FFT_HD float cos_rev(float rev) { rev -= floorf(rev); return cis_neg_rev(rev).x; }
FFT_HD float sin_rev(float rev) { rev -= floorf(rev); return -cis_neg_rev(rev).y; }
FFT_HD cpx w16(int k) {
    constexpr float C1 = 0.92387953251128674f, S1 = 0.38268343236508977f, R2 = 0.70710678118654752f;
    switch (k) { case 0: return cpx{1.f, 0.f}; case 1: return cpx{C1, -S1}; case 2: return cpx{R2, -R2}; case 3: return cpx{S1, -C1};
                 case 4: return cpx{0.f, -1.f}; case 5: return cpx{-S1, -C1}; case 6: return cpx{-R2, -R2}; default: return cpx{-C1, -S1}; }
}
template <int R> FFT_HD constexpr int bitrev(int i) { int r = 0; for (int b = 1, c = R >> 1; b < R; b <<= 1, c >>= 1) if (i & b) r |= c; return r; }
template <int R> FFT_HD void dif_regs(cpx (&a)[R]) {
#pragma unroll
    for (int len = R; len >= 2; len >>= 1) { const int half = len >> 1;
#pragma unroll
        for (int b0 = 0; b0 < R; b0 += len)
#pragma unroll
            for (int j = 0; j < half; ++j) { const cpx u = a[b0 + j], v = a[b0 + j + half]; a[b0 + j] = cadd(u, v); const cpx d = csub(u, v); a[b0 + j + half] = (j == 0) ? d : cmul(d, w16(j * (16 / len))); } }
}
template <int R> FFT_HD void dit_regs(cpx (&a)[R]) {
#pragma unroll
    for (int len = 2; len <= R; len <<= 1) { const int half = len >> 1;
#pragma unroll
        for (int b0 = 0; b0 < R; b0 += len)
#pragma unroll
            for (int j = 0; j < half; ++j) { const cpx u = a[b0 + j]; const cpx v = (j == 0) ? a[b0 + j + half] : cmulc(a[b0 + j + half], w16(j * (16 / len))); a[b0 + j] = cadd(u, v); a[b0 + j + half] = csub(u, v); } }
}
template <int R> FFT_HD void twiddle_powers(cpx w1, cpx (&pw)[R]) {
    pw[0] = cpx{1.f, 0.f}; pw[1] = w1; pw[2] = cmul(w1, w1); pw[3] = cmul(pw[2], w1);
    if constexpr (R > 4) { pw[4] = cmul(pw[2], pw[2]); pw[5] = cmul(pw[4], pw[1]); pw[6] = cmul(pw[4], pw[2]); pw[7] = cmul(pw[4], pw[3]); }
    if constexpr (R > 8) { pw[8] = cmul(pw[4], pw[4]);
#pragma unroll
        for (int k = 1; k < 8; ++k) pw[8 + k] = cmul(pw[8], pw[k]); }
}
template <int R, bool INV, class P> FFT_HD void fft_pass(P X, int tid, int nthr, int logM) {
    constexpr int LOGR = (R == 16) ? 4 : 2;
    const int logs = logM - LOGR, s = 1 << logs;
#pragma unroll 1
    for (int blk = tid; blk < 16384 / R; blk += nthr) {
        const int base = blk & (s - 1), idx0 = ((blk >> logs) << logM) + base;
        cpx a[R], pw[R];
        if (logs > 0) twiddle_powers<R>(cis_neg_rev((float)base / (float)(1 << logM)), pw);
        if (!INV) {
#pragma unroll
            for (int j = 0; j < R; ++j) a[j] = X[pidx(idx0 + (j << logs))];
            dif_regs<R>(a);
#pragma unroll
            for (int i = 0; i < R; ++i) { const int k1 = bitrev<R>(i); cpx v = a[i]; if (logs > 0 && k1 != 0) v = cmul(v, pw[k1]); X[pidx(idx0 + (k1 << logs))] = v; }
        } else {
#pragma unroll
            for (int i = 0; i < R; ++i) { const int k1 = bitrev<R>(i); cpx v = X[pidx(idx0 + (k1 << logs))]; if (logs > 0 && k1 != 0) v = cmulc(v, pw[k1]); a[i] = v; }
            dit_regs<R>(a);
#pragma unroll
            for (int j = 0; j < R; ++j) X[pidx(idx0 + (j << logs))] = a[j];
        }
    }
}
struct Frame {
    LAS unsigned char* lds;
    int tid, lane, wave;
    int vcu, G, bx;
    unsigned char* ws; float* z;
};
__device__ __forceinline__ Frame make_frame(unsigned char* lds_generic, unsigned char* ws, float* out, int wave0) {
    Frame F;
    int lane; asm volatile("v_mbcnt_lo_u32_b32 %0, -1, 0\n\tv_mbcnt_hi_u32_b32 %0, -1, %0" : "=v"(lane));
    int bx = blockIdx.x, G = gridDim.x;
    asm volatile("" : "+v"(lane)); asm volatile("" : "+s"(bx)); asm volatile("" : "+s"(G)); asm volatile("" : "+s"(wave0));
    const int tid = wave0 * 64 + lane;
    unsigned long long w = (unsigned long long)ws, o = (unsigned long long)out; asm volatile("" : "+s"(w)); asm volatile("" : "+s"(o));
    F.lds = (LAS unsigned char*)lds_generic;
    F.tid = tid; F.lane = lane; F.wave = wave0;
    F.G = G; F.bx = bx; F.vcu = (G % 8 == 0) ? (bx % 8) * (G / 8) + bx / 8 : bx;
    F.ws = (unsigned char*)(GAS unsigned char*)w; F.z = (float*)(GAS float*)o;
    return F;
}
__device__ __forceinline__ const float* inp(const Frame& F, int i) {
    const LAS unsigned* t = (const LAS unsigned*)(F.lds + PTR_OFF) + 2 * i;
    const unsigned lo = __builtin_amdgcn_readfirstlane(t[0]), hi = __builtin_amdgcn_readfirstlane(t[1]);
    return (const float*)(const GAS float*)(((unsigned long long)hi << 32) | lo);
}
__device__ __forceinline__ float wave_sum(float v) { return pg8::wave_sum64(v); }
__device__ __forceinline__ void block_sum2(Frame& F, float& a, float& b) {
    LAS float* scr = (LAS float*)(F.lds + SCR_OFF);
    a = wave_sum(a); b = wave_sum(b);
    __syncthreads();
    if (F.lane == 0) { scr[F.wave * 2] = a; scr[F.wave * 2 + 1] = b; }
    __syncthreads();
    float sa = 0.f, sb = 0.f;
#pragma unroll
    for (int w = 0; w < NWAVES; ++w) { sa += scr[w * 2]; sb += scr[w * 2 + 1]; }
    a = sa; b = sb;
}

__device__ __forceinline__ void phase_init(Frame& F) {
    const int gw = F.vcu * NWAVES + F.wave, NGW = F.G * NWAVES;
    bf16* zb = (bf16*)(F.ws + WS_ZB); float* stats = (float*)(F.ws + WS_STATS);
    const float* x0 = inp(F, 0); const float* x1 = inp(F, 1);
    for (int m = gw; m < T; m += NGW) {
        const float* src = (m < T_PROMPT) ? x0 + (size_t)m * D : x1 + (size_t)(m - T_PROMPT) * D;
        const GAS f32x4* s4 = (const GAS f32x4*)src + F.lane; GAS f32x4* d4 = (GAS f32x4*)(F.z + (size_t)m * D) + F.lane; GAS v2u* b4 = (GAS v2u*)(zb + (size_t)m * D) + F.lane;
#pragma unroll
        for (int j = 0; j < 8; ++j) { const f32x4 v = s4[64 * j]; d4[64 * j] = v; v2u o; o.x = pk2(v.x, v.y); o.y = pk2(v.z, v.w); b4[64 * j] = o; }
        if (F.lane == 0) { stats[2 * m] = 0.f; stats[2 * m + 1] = 1.f; }
    }
    const int gt = F.vcu * (NWAVES * 64) + F.tid;
    if (gt < 8192) ((float*)(F.ws + WS_IDG))[gt] = 1.f;
    if (gt < 32768) ((float*)(F.ws + WS_IDB))[gt] = 0.f;
}

struct ConvJob { const float* W; int K, N; bf16* WT; const float* gk; const float* bk; float* cvec; float* dvec; const float* ebias; int mode; };
__device__ __forceinline__ void conv_item(const float* W, int K, int N, bf16* WT, const float* gk, const float* bk, float* cvec, float* dvec, const float* ebias, int mode, int nb, int kbeg, int kend, LAS float* scr, int lane) {
    const int n0 = 32 * nb;
    const float colscale = (mode == 2 && n0 < 6144) ? QSCALE : 1.0f;
    int rbase = n0;
    if (mode == 1) { rbase = (n0 < FF) ? (n0 / 128) * 256 + (n0 % 128) : ((n0 - FF) / 128) * 256 + 128 + ((n0 - FF) % 128); }
    float cs[32], ds[32];
#pragma unroll
    for (int i = 0; i < 32; ++i) { cs[i] = 0.f; ds[i] = 0.f; }
    f32x4 wv[8], wn[8];
    const float* wp = W + (size_t)(kbeg + lane) * N + n0;
#pragma unroll
    for (int j = 0; j < 8; ++j) wv[j] = *(const GAS f32x4*)(wp + 4 * j);
    float g = gk[kbeg + lane], b = bk[kbeg + lane];
    bf16* op = WT + (size_t)rbase * K + lane;
    for (int k0 = kbeg; k0 < kend; k0 += 64) {
        const int k1 = (k0 + 64 < kend) ? k0 + 64 : k0;
        const float* wq = W + (size_t)(k1 + lane) * N + n0;
#pragma unroll
        for (int j = 0; j < 8; ++j) wn[j] = *(const GAS f32x4*)(wq + 4 * j);
        const float gnx = gk[k1 + lane], bnx = bk[k1 + lane];
#pragma unroll
        for (int j = 0; j < 8; ++j)
#pragma unroll
            for (int e = 0; e < 4; ++e) { const int i = 4 * j + e; const float w = wv[j][e] * colscale; const unsigned vb = f2bf(w * g); const float v = bf2f(vb);
                cs[i] += v; ds[i] += b * w; op[(size_t)i * K + k0] = (bf16)vb; }
#pragma unroll
        for (int j = 0; j < 8; ++j) wv[j] = wn[j];
        g = gnx; b = bnx;
    }
    float myc = 0.f, myd = 0.f;
#pragma unroll
    for (int i = 0; i < 32; ++i) { const float c = wave_sum(cs[i]), d = wave_sum(ds[i]); myc = (lane == i) ? c : myc; myd = (lane == i) ? d : myd; }
    if (lane < 32) { cvec[rbase + lane] = myc; dvec[rbase + lane] = myd + ebias[n0 + lane]; }
}
__device__ __forceinline__ void filt_pos(Frame& F, int jl, int var, int t) {
    const int L = var ? 2048 : 8192, lane = F.lane;
    const float* w1 = inp(F, 12) + (size_t)jl * 33 * 64; const float* b1 = inp(F, 13) + jl * 64; const float* w2 = inp(F, 14) + (size_t)jl * 64 * 64; const float* b2 = inp(F, 15) + jl * 64; const float* fr = inp(F, 16) + jl * 64;
    float feat = 0.f;
    if (lane == 0) feat = (float)t / (float)(L - 1);
    else if (lane < 33) { const int bi = (lane - 1) & 15; const float band = 1e-4f + (float)bi * ((15.0f - 1e-4f) / 15.0f); const float rev = band * ((float)t / (float)L);
        feat = (lane < 17) ? cos_rev(rev) : -sin_rev(rev); }
    float acc = b1[lane];
    for (int k = 0; k < 33; ++k) acc += __builtin_bit_cast(float, __builtin_amdgcn_readlane(__builtin_bit_cast(int, feat), k)) * w1[k * 64 + lane];
    const float fq = fr[lane];
    const float h1 = sin_acc(fq * acc);
    float acc2 = b2[lane];
    for (int k = 0; k < 64; ++k) acc2 += __builtin_bit_cast(float, __builtin_amdgcn_readlane(__builtin_bit_cast(int, h1), k)) * w2[k * 64 + lane];
    const float h2 = sin_acc(fq * acc2);
    bf16* hrow = (bf16*)(F.ws + WS_H2B) + (size_t)((var ? 8192 : 0) + t) * 256;
    hrow[lane] = (bf16)f2bf(h2); hrow[64 + lane] = 0; hrow[128 + lane] = 0; hrow[192 + lane] = 0;
}
__device__ __forceinline__ void phase_convert(Frame& F, int layer) {
    LAS float* scr = (LAS float*)(F.lds + RING_OFF + F.wave * 16384);
    const int gw = F.vcu * NWAVES + F.wave, NGW = F.G * NWAVES;
    const int jl = layer >> 1; const bool hy = (layer & 1) != 0;
    const float* ln_g = inp(F, 2); const float* ln_b = inp(F, 3);
    const float* ones = (const float*)(F.ws + WS_IDG); const float* zeros = (const float*)(F.ws + WS_IDB); float* dump = (float*)(F.ws + WS_DUMP);
    float* cd = (float*)(F.ws + WS_CD);
    float* c1 = cd, *d1 = cd + NFF2, *cm = cd + 2 * NFF2, *dm = cm + NQKV, *c2 = dm + NQKV, *d2 = c2 + NFF2;
    const int nb1 = (D / 32) * 4, nb0 = NFF2 / 32, nb4 = (hy ? NHY : NQKV) / 32, nb5 = D / 32;
    const int total = 2 * nb1 + 2 * nb0 + nb4 + nb5;
    for (int it = gw; it < total; it += NGW) {
        int r = it;
        if (r < 2 * nb1) { const int f = r / nb1; r -= f * nb1;
            conv_item(inp(F, 5) + (size_t)(layer * 2 + f) * FF * D, FF, D, (bf16*)(F.ws + (f ? W_OUT2 : W_OUT1)), ones, zeros, dump, dump + NQKV, zeros, 0, r >> 2, (r & 3) * 1408, (r & 3) * 1408 + 1408, scr, F.lane); continue; }
        r -= 2 * nb1;
        if (r < 2 * nb0) { const int f = r / nb0; r -= f * nb0;
            const float* gk = f ? ln_g + (size_t)(layer * 3 + 1) * D : (layer ? ln_g + (size_t)((layer - 1) * 3 + 2) * D : ones);
            const float* bk = f ? ln_b + (size_t)(layer * 3 + 1) * D : (layer ? ln_b + (size_t)((layer - 1) * 3 + 2) * D : zeros);
            conv_item(inp(F, 4) + (size_t)(layer * 2 + f) * D * NFF2, D, NFF2, (bf16*)(F.ws + (f ? W_IN2 : W_IN1)), gk, bk, f ? c2 : c1, f ? d2 : d1, zeros, 1, r, 0, D, scr, F.lane); continue; }
        r -= 2 * nb0;
        if (r < nb4) {
            const float* gk = ln_g + (size_t)(layer * 3) * D; const float* bk = ln_b + (size_t)(layer * 3) * D;
            if (hy) conv_item(inp(F, 8) + (size_t)jl * D * NHY, D, NHY, (bf16*)(F.ws + W_MIN), gk, bk, cm, dm, inp(F, 9) + (size_t)jl * NHY, 0, r, 0, D, scr, F.lane);
            else conv_item(inp(F, 6) + (size_t)jl * D * NQKV, D, NQKV, (bf16*)(F.ws + W_MIN), gk, bk, cm, dm, zeros, 2, r, 0, D, scr, F.lane);
            continue; }
        r -= nb4;
        conv_item((hy ? inp(F, 19) : inp(F, 7)) + (size_t)jl * D * D, D, D, (bf16*)(F.ws + W_MOUT), ones, zeros, dump, dump + NQKV, zeros, 0, r, 0, D, scr, F.lane);
    }
    if (hy) {
        for (int p = gw; p < 8192 + 2048; p += NGW) { if (p < 8192) filt_pos(F, jl, 0, p); else filt_pos(F, jl, 1, p - 8192); }
        const float* w3 = inp(F, 17) + (size_t)jl * 64 * 8192; bf16* w3T = (bf16*)(F.ws + WS_W3T);
        for (int n = gw; n < 8192; n += NGW) { bf16* r = w3T + (size_t)n * 256; r[F.lane] = (bf16)f2bf(w3[(size_t)F.lane * 8192 + n]); r[64 + F.lane] = 0; r[128 + F.lane] = 0; r[192 + F.lane] = 0; }
    }
}

__device__ __forceinline__ void phase_finalize(Frame& F) {
    const float* part = (const float*)(F.ws + WS_PART); float* stats = (float*)(F.ws + WS_STATS);
    for (int row = F.vcu * (NWAVES * 64) + F.tid; row < T; row += F.G * NWAVES * 64) {
        const GAS f32x4* p = (const GAS f32x4*)(part + (size_t)row * 128);
        float s = 0.f, q = 0.f;
#pragma unroll 8
        for (int j = 0; j < 32; ++j) { const f32x4 v = p[j]; s += v.x + v.z; q += v.y + v.w; }
        const float mean = s * (1.0f / D); const float var = fmaxf(q * (1.0f / D) - mean * mean, 0.f);
        *(GAS f32x2*)(stats + 2 * (size_t)row) = (f32x2){mean, 1.0f / sqrtf(var + LN_EPS)};
    }
}

#ifdef DBG_CHECK
__device__ __forceinline__ void phase_check_qkv(Frame& F) {
    const int gw = F.vcu * NWAVES + F.wave, NGW = F.G * NWAVES;
    const float* W = inp(F, 6); const float* g = inp(F, 2); const float* b = inp(F, 3);
    const float* stats = (const float*)(F.ws + WS_STATS); const bf16* QKV = (const bf16*)(F.ws + WS_BIG + BIG_QKV);
#ifndef DBG_ROW0
#define DBG_ROW0 0
#define DBG_ROW1 T
#endif
#ifndef DBG_COL0
#define DBG_COL0 0
#define DBG_COL1 NQKV
#endif
    float worst = 0.f; unsigned nbad = 0;
#ifdef CHK_ROWS
    {
        const bf16* zbp = (const bf16*)(F.ws + WS_ZB);
        for (int s = gw; s < 8192; s += NGW) {
            const unsigned hsh = (unsigned)s * 2654435761u; const int row = (int)(hsh % (unsigned)T);
            float sm = 0.f, sq = 0.f, dz = 0.f;
            for (int k = F.lane; k < D; k += 64) { const float v = F.z[(size_t)row * D + k]; sm += v; sq += v * v; dz = fmaxf(dz, fabsf(bf2f(zbp[(size_t)row * D + k]) - v)); }
            sm = wave_sum(sm); sq = wave_sum(sq); dz = fmaxf(dz, pg8::xor32_max(dz)); dz = fmaxf(dz, pg8::swz_xor<16>(dz)); dz = fmaxf(dz, pg8::swz_xor<8>(dz)); dz = fmaxf(dz, pg8::swz_xor<4>(dz)); dz = fmaxf(dz, pg8::swz_xor<2>(dz)); dz = fmaxf(dz, pg8::swz_xor<1>(dz));
            const float mean = sm * (1.0f / D), var = sq * (1.0f / D) - mean * mean, rstd = 1.0f / sqrtf(var + LN_EPS);
            const bool bad = (CHK_ROWS == 1) ? (fabsf(mean - stats[2 * row]) > CHK_MTOL || fabsf(rstd - stats[2 * row + 1]) > CHK_RTOL * rstd) : (dz > 0.05f);
            nbad += bad ? 1u : 0u;
        }
        if (F.lane == 0 && nbad) atomicAdd((unsigned*)(F.ws + WS_CTL) + 15000, nbad);
        return;
    }
#endif
    for (int s = gw; s < 8192; s += NGW) {
        const unsigned hsh = (unsigned)s * 2654435761u; const int row = DBG_ROW0 + (int)(hsh % (unsigned)(DBG_ROW1 - DBG_ROW0)), col = DBG_COL0 + (int)((hsh >> 7) % (unsigned)(DBG_COL1 - DBG_COL0));
#ifdef CHK_HYP
        const float mean = 0.f, rstd = 1.f;
#else
        const float mean = stats[2 * row], rstd = stats[2 * row + 1];
#endif
        float acc = 0.f;
        for (int k = F.lane; k < D; k += 64) acc += ((F.z[(size_t)row * D + k] - mean) * rstd * g[k] + b[k]) * W[(size_t)k * NQKV + col];
        acc = wave_sum(acc) * (col < 6144 ? QSCALE : 1.0f);
        const float got = bf2f(QKV[(size_t)row * NQKV + col]);
        worst = fmaxf(worst, fabsf(got - acc)); nbad += (fabsf(got - acc) > DBG_THR) ? 1u : 0u;
    }
#ifdef DBG_COUNT
    if (F.lane == 0 && nbad) atomicAdd((unsigned*)(F.ws + WS_CTL) + 15000, nbad);
#else
    if (F.lane == 0) atomicMax((unsigned*)(F.ws + WS_CTL) + 15000, __builtin_bit_cast(unsigned, worst));
#endif
}
#endif
__device__ __forceinline__ void phase_final_ln(Frame& F) {
    const int gw = F.vcu * NWAVES + F.wave, NGW = F.G * NWAVES;
    const float* stats = (const float*)(F.ws + WS_STATS);
    const float* g = inp(F, 2) + (size_t)(3 * 3 + 2) * D; const float* b = inp(F, 3) + (size_t)(3 * 3 + 2) * D;
    for (int m = gw; m < T; m += NGW) {
        const float mean = stats[2 * m], rstd = stats[2 * m + 1];
        GAS f32x4* d4 = (GAS f32x4*)(F.z + (size_t)m * D) + F.lane; const GAS f32x4* g4 = (const GAS f32x4*)g + F.lane; const GAS f32x4* b4 = (const GAS f32x4*)b + F.lane;
        float dbg = 0.f;
#ifdef DBG_CHECK
        #ifdef DBG_COUNT
        const float dbgval = (float)((const unsigned*)(F.ws + WS_CTL))[15000] * DBG_CHECK_SCALE;
#else
        const float dbgval = __builtin_bit_cast(float, ((const unsigned*)(F.ws + WS_CTL))[15000]) * DBG_CHECK_SCALE;
#endif
#endif
#ifdef DBG_BUF
        {
            const bf16* bp = (const bf16*)(F.ws + WS_BIG + DBG_OFF) + (size_t)m * DBG_PITCH; float s = 0.f;
            for (int c = F.lane; c < DBG_COLS; c += 64) s += bf2f(bp[c]) * (float)(1 + (c & 7));
            dbg = wave_sum(s) * 0.01f;
        }
#endif
#pragma unroll
        for (int j = 0; j < 8; ++j) { const f32x4 v = d4[64 * j] + dbg; d4[64 * j] = (v - mean) * rstd * g4[64 * j] + b4[64 * j];
#ifdef DBG_CHECK
            d4[64 * j] = (f32x4){dbgval, dbgval, dbgval, dbgval};
#endif
        }
    }
}

__device__ __forceinline__ void phase_transpose(Frame& F, const bf16* src, int R, int C, bf16* dst) {
    LAS unsigned char* scr = F.lds + RING_OFF + F.wave * 16384;
    const int gw = F.vcu * NWAVES + F.wave, NGW = F.G * NWAVES, tr = R / 64, tc = C / 64, lane = F.lane;
    const size_t sp = (size_t)C, dp = (size_t)R;
    v4u cur[8], nxt[8];
    int it = gw;
    if (it < tr * tc) { const int r0 = 64 * (it / tc), c0 = 64 * (it % tc);
#pragma unroll
        for (int i = 0; i < 8; ++i) cur[i] = *(const GAS v4u*)(src + (size_t)(r0 + (lane >> 3) + 8 * i) * sp + c0 + 8 * (lane & 7)); }
    for (; it < tr * tc; it += NGW) {
        const int r0 = 64 * (it / tc), c0 = 64 * (it % tc);
        const int itn = (it + NGW < tr * tc) ? it + NGW : it;
        { const int rn = 64 * (itn / tc), cn = 64 * (itn % tc);
#pragma unroll
          for (int i = 0; i < 8; ++i) nxt[i] = *(const GAS v4u*)(src + (size_t)(rn + (lane >> 3) + 8 * i) * sp + cn + 8 * (lane & 7)); }
#pragma unroll
        for (int i = 0; i < 8; ++i) { const int row = (lane >> 3) + 8 * i, ch = lane & 7;
            LAS unsigned* w = (LAS unsigned*)(scr + row * 132 + ch * 16); w[0] = cur[i].x; w[1] = cur[i].y; w[2] = cur[i].z; w[3] = cur[i].w; }
        LDS_WAIT(); asm volatile("" ::: "memory");
        const LAS unsigned short* rd = (const LAS unsigned short*)(scr + lane * 132);
#pragma unroll 8
        for (int c = 0; c < 64; ++c) dst[(size_t)(c0 + c) * dp + r0 + lane] = rd[c];
        LDS_WAIT(); asm volatile("" ::: "memory");
#pragma unroll
        for (int i = 0; i < 8; ++i) cur[i] = nxt[i];
    }
}
__device__ __forceinline__ void fft_forward(LAS cpx* X, int tid, int logN) {
    int logM = logN;
    for (; logM >= 4; logM -= 4) { fft_pass<16, false>(X, tid, NWAVES * 64, logM); __syncthreads(); }
    if (logM == 2) { fft_pass<4, false>(X, tid, NWAVES * 64, 2); __syncthreads(); }
}
__device__ __forceinline__ void fft_inverse(LAS cpx* X, int tid, int logN) {
    const int rem = logN & 3;
    if (rem == 2) { fft_pass<4, true>(X, tid, NWAVES * 64, 2); __syncthreads(); }
    for (int logM = 4 + rem; logM <= logN; logM += 4) { fft_pass<16, true>(X, tid, NWAVES * 64, logM); __syncthreads(); }
}
template <int VAR> __device__ __forceinline__ void spec_unit(Frame& F, int jl, int c) {
    constexpr int L = VAR ? 2048 : 8192, N = 2 * L, LOGN = VAR ? 12 : 14, NP = L / 512;
    LAS cpx* X = (LAS cpx*)(F.lds + RING_OFF);
    int tid = F.tid; asm volatile("" : "+v"(tid));
    const float* taps = (const float*)(F.ws + WS_TAPS) + (size_t)c * 10240 + (VAR ? 8192 : 0);
    float acc[NP][4];
    float n0 = 0.f, n1 = 0.f;
#pragma unroll
    for (int k = 0; k < NP; ++k) {
#pragma unroll
        for (int f = 0; f < 4; ++f) acc[k][f] = taps[(size_t)f * 2048 * 10240 + tid + 512 * k];
        n0 += fabsf(acc[k][0]) + fabsf(acc[k][1]); n1 += fabsf(acc[k][2]) + fabsf(acc[k][3]); }
    block_sum2(F, n0, n1);
    const float i0 = 1.0f / n0, i1 = 1.0f / n1;
#pragma unroll
    for (int k = 0; k < NP; ++k) { acc[k][0] *= i0; acc[k][1] *= i0; acc[k][2] *= i1; acc[k][3] *= i1; }
    cpx* spec = (cpx*)(F.ws + WS_BIG + (VAR ? BIG_SPEC1 : BIG_SPEC0));
    if (VAR == 0) {
        float* tmp = (float*)(spec + ((size_t)1 * D + c) * N);
#pragma unroll
        for (int k = 0; k < NP; ++k) *(GAS f32x2*)(tmp + 2 * (tid + 512 * k)) = (f32x2){acc[k][2], acc[k][3]};
        __syncthreads();
#pragma unroll
        for (int k = 0; k < NP; ++k) { const int t = tid + 512 * k; const float hf = acc[k][0], hb = acc[k][1];
            if (t == 0) { X[pidx(0)] = cpx{hf + hb, 0.f}; X[pidx(L)] = cpx{0.f, 0.f}; }
            else { X[pidx(t)] = cpx{hf, 0.f}; X[pidx(N - t)] = cpx{hb, 0.f}; } }
        __syncthreads();
        fft_forward(X, tid, LOGN);
        { cpx* dst = spec + ((size_t)0 * D + c) * N; for (int p = tid; p < N; p += 512) dst[p] = X[pidx(p)]; }
        float h1[NP][2];
#pragma unroll
        for (int k = 0; k < NP; ++k) { const f32x2 v = *(const GAS f32x2*)(tmp + 2 * (tid + 512 * k)); h1[k][0] = v.x; h1[k][1] = v.y; }
        __syncthreads();
#pragma unroll
        for (int k = 0; k < NP; ++k) { const int t = tid + 512 * k; const float hf = h1[k][0], hb = h1[k][1];
            if (t == 0) { X[pidx(0)] = cpx{hf + hb, 0.f}; X[pidx(L)] = cpx{0.f, 0.f}; }
            else { X[pidx(t)] = cpx{hf, 0.f}; X[pidx(N - t)] = cpx{hb, 0.f}; } }
        __syncthreads();
        fft_forward(X, tid, LOGN);
        { cpx* dst = spec + ((size_t)1 * D + c) * N; for (int p = tid; p < N; p += 512) dst[p] = X[pidx(p)]; }
    } else {
        __syncthreads();
#pragma unroll
        for (int k = 0; k < NP; ++k) { const int t = tid + 512 * k;
#pragma unroll
            for (int o = 0; o < 2; ++o) { const float hf = acc[k][2 * o], hb = acc[k][2 * o + 1];
                if (t == 0) { X[pidx(o * N)] = cpx{hf + hb, 0.f}; X[pidx(o * N + L)] = cpx{0.f, 0.f}; }
                else { X[pidx(o * N + t)] = cpx{hf, 0.f}; X[pidx(o * N + N - t)] = cpx{hb, 0.f}; } } }
        for (int p = 2 * N + tid; p < 16384; p += 512) X[pidx(p)] = cpx{0.f, 0.f};
        __syncthreads();
        fft_forward(X, tid, LOGN);
#pragma unroll
        for (int o = 0; o < 2; ++o) { cpx* dst = spec + ((size_t)o * D + c) * N; for (int p = tid; p < N; p += 512) dst[p] = X[pidx(o * N + p)]; }
    }
}
__device__ __forceinline__ void phase_spectra(Frame& F, int jl) {
    for (int u = F.vcu; u < 2 * D; u += F.G) { if (u < D) spec_unit<0>(F, jl, u); else spec_unit<1>(F, jl, u - D); }
    __syncthreads();
}
__device__ __forceinline__ void load_conv16(const bf16* seq, int t0, int L, float w0, float w1, float w2, float cb, float (&out)[16]) {
    const v4u a = *(const GAS v4u*)(seq + t0), b = *(const GAS v4u*)(seq + t0 + 8);
    float u[18];
    u[0] = (t0 > 0) ? bf2f(seq[t0 - 1]) : 0.f; u[17] = (t0 + 16 < L) ? bf2f(seq[t0 + 16]) : 0.f;
    u[1] = bf2f(a.x & 0xffffu); u[2] = bf2f(a.x >> 16); u[3] = bf2f(a.y & 0xffffu); u[4] = bf2f(a.y >> 16); u[5] = bf2f(a.z & 0xffffu); u[6] = bf2f(a.z >> 16); u[7] = bf2f(a.w & 0xffffu); u[8] = bf2f(a.w >> 16);
    u[9] = bf2f(b.x & 0xffffu); u[10] = bf2f(b.x >> 16); u[11] = bf2f(b.y & 0xffffu); u[12] = bf2f(b.y >> 16); u[13] = bf2f(b.z & 0xffffu); u[14] = bf2f(b.z >> 16); u[15] = bf2f(b.w & 0xffffu); u[16] = bf2f(b.w >> 16);
#pragma unroll
    for (int i = 0; i < 16; ++i) out[i] = w0 * u[i] + w1 * u[i + 1] + w2 * u[i + 2] + cb;
}
template <int VAR> __device__ __forceinline__ void conv_unit(Frame& F, int jl, int c, int pair) {
    constexpr int L = VAR ? 2048 : 8192, N = 2 * L, LOGN = VAR ? 12 : 14, TPS = VAR ? 128 : 512;
    LAS cpx* X = (LAS cpx*)(F.lds + RING_OFF);
    int tid = F.tid; asm volatile("" : "+v"(tid));
    const int seg = tid / TPS, t0 = (tid % TPS) * 16;
    const int rowA = VAR ? T_PROMPT + (2 * seg) * L : (2 * pair) * L, rowB = rowA + L;
    const bf16* UT = (const bf16*)(F.ws + WS_BIG + BIG_UT); bf16* Z2T = (bf16*)(F.ws + WS_BIG + BIG_Z2T);
    const float* cw = inp(F, 10) + (size_t)jl * 3 * NHY; const float* cbv = inp(F, 11) + (size_t)jl * NHY; const float* skip = inp(F, 18) + (size_t)jl * 2 * D;
    const cpx* spec = (const cpx*)(F.ws + WS_BIG + (VAR ? BIG_SPEC1 : BIG_SPEC0));
#ifndef CONV_SCALE
#define CONV_SCALE 1.0f
#endif
    const float invN = CONV_SCALE / (float)N;
    float va[16], vb[16];
    { const int ch = c; const float w0 = cw[ch], w1 = cw[NHY + ch], w2 = cw[2 * NHY + ch], cb = cbv[ch];
      load_conv16(UT + (size_t)ch * T + rowA, t0, L, w0, w1, w2, cb, va); load_conv16(UT + (size_t)ch * T + rowB, t0, L, w0, w1, w2, cb, vb); }
    __syncthreads();
#pragma unroll
    for (int i = 0; i < 16; ++i) { X[pidx(seg * N + t0 + i)] = cpx{va[i], vb[i]}; X[pidx(seg * N + L + t0 + i)] = cpx{0.f, 0.f}; }
    __syncthreads();
    fft_forward(X, tid, LOGN);
    { const cpx* H = spec + ((size_t)0 * D + c) * N;
#pragma unroll
      for (int hb = 0; hb < 2; ++hb) { cpx hv[16];
#pragma unroll
        for (int k = 0; k < 16; ++k) hv[k] = H[(tid + 512 * (16 * hb + k)) & (N - 1)];
#pragma unroll
        for (int k = 0; k < 16; ++k) { const int p = tid + 512 * (16 * hb + k); X[pidx(p)] = cmul(X[pidx(p)], hv[k]); } } }
    __syncthreads();
    fft_inverse(X, tid, LOGN);
    {   float ga[16], gb[16];
        const int ch = D + c; const float w0 = cw[ch], w1 = cw[NHY + ch], w2 = cw[2 * NHY + ch], cb = cbv[ch];
        load_conv16(UT + (size_t)ch * T + rowA, t0, L, w0, w1, w2, cb, ga); load_conv16(UT + (size_t)ch * T + rowB, t0, L, w0, w1, w2, cb, gb);
        const float sk = skip[c];
#pragma unroll
        for (int i = 0; i < 16; ++i) { const cpx y = X[pidx(seg * N + t0 + i)]; va[i] = ga[i] * (y.x * invN + sk * va[i]); vb[i] = gb[i] * (y.y * invN + sk * vb[i]); }
#pragma unroll
        for (int i = 0; i < 16; ++i) { X[pidx(seg * N + t0 + i)] = cpx{va[i], vb[i]}; X[pidx(seg * N + L + t0 + i)] = cpx{0.f, 0.f}; }
    }
    __syncthreads();
    fft_forward(X, tid, LOGN);
    { const cpx* H = spec + ((size_t)1 * D + c) * N;
#pragma unroll
      for (int hb = 0; hb < 2; ++hb) { cpx hv[16];
#pragma unroll
        for (int k = 0; k < 16; ++k) hv[k] = H[(tid + 512 * (16 * hb + k)) & (N - 1)];
#pragma unroll
        for (int k = 0; k < 16; ++k) { const int p = tid + 512 * (16 * hb + k); X[pidx(p)] = cmul(X[pidx(p)], hv[k]); } } }
    __syncthreads();
    fft_inverse(X, tid, LOGN);
    {   float ga[16], gb[16];
        const int ch = 2 * D + c; const float w0 = cw[ch], w1 = cw[NHY + ch], w2 = cw[2 * NHY + ch], cb = cbv[ch];
        load_conv16(UT + (size_t)ch * T + rowA, t0, L, w0, w1, w2, cb, ga); load_conv16(UT + (size_t)ch * T + rowB, t0, L, w0, w1, w2, cb, gb);
        const float sk = skip[D + c];
        float ra[16], rb[16];
#pragma unroll
        for (int i = 0; i < 16; ++i) { const cpx y = X[pidx(seg * N + t0 + i)]; ra[i] = ga[i] * (y.x * invN + sk * va[i]); rb[i] = gb[i] * (y.y * invN + sk * vb[i]); }
        v4u o0, o1;
        o0.x = pk2(ra[0], ra[1]); o0.y = pk2(ra[2], ra[3]); o0.z = pk2(ra[4], ra[5]); o0.w = pk2(ra[6], ra[7]); o1.x = pk2(ra[8], ra[9]); o1.y = pk2(ra[10], ra[11]); o1.z = pk2(ra[12], ra[13]); o1.w = pk2(ra[14], ra[15]);
        GAS v4u* da = (GAS v4u*)(Z2T + (size_t)c * T + rowA + t0); da[0] = o0; da[1] = o1;
        o0.x = pk2(rb[0], rb[1]); o0.y = pk2(rb[2], rb[3]); o0.z = pk2(rb[4], rb[5]); o0.w = pk2(rb[6], rb[7]); o1.x = pk2(rb[8], rb[9]); o1.y = pk2(rb[10], rb[11]); o1.z = pk2(rb[12], rb[13]); o1.w = pk2(rb[14], rb[15]);
        GAS v4u* db = (GAS v4u*)(Z2T + (size_t)c * T + rowB + t0); db[0] = o0; db[1] = o1;
    }
}
__device__ __forceinline__ void phase_conv(Frame& F, int jl) {
    for (int u = F.vcu; u < 3 * D; u += F.G) { if (u < 2 * D) conv_unit<0>(F, jl, u >> 1, u & 1); else conv_unit<1>(F, jl, u - 2 * D, 0); }
    __syncthreads();
}
__device__ __forceinline__ unsigned voff_b(unsigned row, unsigned ch) { return 256u * row + 16u * (ch ^ (((row & 3u) << 2) | ((row >> 2) & 3u))); }
__device__ __forceinline__ s16x4 vtr(const LAS unsigned char* p) { typedef short v4i16_t __attribute__((ext_vector_type(4))); return __builtin_bit_cast(s16x4, __builtin_amdgcn_ds_read_tr16_b64_v4i16((LAS v4i16_t*)p)); }
__device__ __forceinline__ unsigned cvtpk(float lo, float hi) { typedef __bf16 bf16x2_t __attribute__((ext_vector_type(2))); f32x2 v = {lo, hi}; bf16x2_t b = __builtin_convertvector(v, bf16x2_t); return __builtin_bit_cast(unsigned, b); }
__device__ __forceinline__ void dma16(const void* gsrc, LAS unsigned char* lds_dst) {
    unsigned keep; const unsigned dst = __builtin_amdgcn_readfirstlane((unsigned)(unsigned long long)lds_dst);
    asm volatile("s_mov_b32 %0, m0\n\ts_mov_b32 m0, %2\n\ts_nop 0\n\tglobal_load_lds_dwordx4 %1, off\n\ts_mov_b32 m0, %0" : "=&s"(keep) : "v"(gsrc), "s"(dst) : "memory");
}
struct TileDesc { int g, kt0; };
constexpr int ATT_NT = 28;
__device__ __forceinline__ TileDesc attn_tile(int it, int T0w) {
    TileDesc t;
    if (it < 12) { t.g = 0; t.kt0 = T0w - 64 + 32 * it; }
    else if (it < 18) { t.g = 1; t.kt0 = T0w - 256 + 128 * (it - 12); }
    else { const int e = it - 18, ch = e / 5, tl = e % 5; t.g = 2; t.kt0 = T0w + 8 * ch - 1024 + 512 * tl; }
    return t;
}
__device__ __forceinline__ void attn_wave_task(const bf16* QKV, bf16* AO, LAS unsigned char* vimg, int blk, int h, int w, int lane) {
    const int r = lane & 31, hh = lane >> 5;
    const int T0 = blk * 256;
    int seq_start, seq_len;
    if (T0 < T_PROMPT) { seq_start = T0 & ~8191; seq_len = 8192; } else { seq_start = T_PROMPT + ((T0 - T_PROMPT) & ~2047); seq_len = 2048; }
    const int seq_end = seq_start + seq_len;
    const int T0w = T0 + w, qt = T0w + 8 * r;
    const float slope2 = __builtin_amdgcn_exp2f(-0.5f * (float)(h + 1)) * LOG2E;
    f32x16 o[4];
#pragma unroll
    for (int dt = 0; dt < 4; ++dt)
#pragma unroll
        for (int i = 0; i < 16; ++i) o[dt][i] = 0.f;
    float m_run = -1e30f, l_run = 0.f;
    bf16x8 qf[8], kf[8];
    const bf16* hb = QKV + h * 128;
    auto issue_tile = [&](const TileDesc& td, LAS unsigned char* img_dst) {
        const int d = 1 << (2 * td.g);
        const bf16* Kb = hb + 6144 + td.g * 2048; const bf16* Vb = hb + 12288 + td.g * 2048;
#pragma unroll
        for (int i = 0; i < 8; ++i) { const int row = 4 * i + (lane >> 4); int vt = td.kt0 + row * d; vt = vt < seq_start ? seq_start : (vt >= seq_end ? seq_end - 1 : vt);
            const int lch = (lane & 15) ^ (((row & 3) << 2) | ((row >> 2) & 3));
            dma16(Vb + (size_t)vt * NQKV + 8 * lch, img_dst + i * 1024); }
        int kt = td.kt0 + r * d; kt = kt < seq_start ? seq_start : (kt >= seq_end ? seq_end - 1 : kt);
        const bf16* kp = Kb + (size_t)kt * NQKV + 8 * hh;
#pragma unroll
        for (int s = 0; s < 8; ++s) kf[s] = *(const GAS bf16x8*)(kp + 16 * s);
    };
    auto load_q = [&](int g) { const bf16* qp = hb + g * 2048 + (size_t)qt * NQKV + 8 * hh;
#pragma unroll
        for (int s = 0; s < 8; ++s) qf[s] = *(const GAS bf16x8*)(qp + 16 * s); };
    TileDesc cur = attn_tile(0, T0w);
    load_q(0);
    issue_tile(cur, vimg);
    for (int it = 0; it < ATT_NT; ++it) {
        LAS unsigned char* img = vimg + (it & 1) * 8192;
        const int d = 1 << (2 * cur.g), win = 64 * d, kt0 = cur.kt0;
        f32x16 st;
#pragma unroll
        for (int i = 0; i < 16; ++i) st[i] = 0.f;
#pragma unroll
        for (int s = 0; s < 8; ++s) st = __builtin_amdgcn_mfma_f32_32x32x16_bf16(kf[s], qf[s], st, 0, 0, 0);
        if (it + 1 < ATT_NT) { const TileDesc nx = attn_tile(it + 1, T0w); if (nx.g != cur.g) load_q(nx.g); issue_tile(nx, vimg + ((it + 1) & 1) * 8192); cur = nx; }
        const int dl0 = kt0 + 4 * hh * d - qt;
        const bool res_ok = (dl0 & (d - 1)) == 0;
        const int lo_i = max(-win, seq_start - qt), hi_i = min(win, seq_end - 1 - qt);
        const float flo = res_ok ? (float)lo_i : 1e30f, fhi = (float)hi_i, fdl0 = (float)dl0, fd = (float)d;
        float mloc = -1e30f;
#pragma unroll
        for (int i = 0; i < 16; ++i) { const float fdl = fdl0 + (float)((i & 3) + 8 * (i >> 2)) * fd;
            const float s = st[i] - slope2 * __builtin_fabsf(fdl);
            const bool ok = (fdl >= flo) && (fdl <= fhi);
            const float sm = ok ? s : -1e30f; st[i] = sm; mloc = fmaxf(mloc, sm); }
        mloc = pg8::xor32_max(mloc);
        const float m_new = fmaxf(m_run, mloc);
        const float m_use = fmaxf(m_new, -1e20f);
        float ls = 0.f;
#pragma unroll
        for (int i = 0; i < 16; ++i) { const float pv = __builtin_amdgcn_exp2f(st[i] - m_use); st[i] = pv; ls += pv; }
        ls = pg8::xor32_sum(ls);
        if (__any(m_new != m_run)) {
            const float alpha = __builtin_amdgcn_exp2f(m_run - m_new);
            l_run *= alpha;
#pragma unroll
            for (int dt = 0; dt < 4; ++dt)
#pragma unroll
                for (int i = 0; i < 16; ++i) o[dt][i] *= alpha;
        }
        l_run += ls; m_run = m_new;
        bf16x8 pb[2];
#pragma unroll
        for (int s2 = 0; s2 < 2; ++s2) { v4u w; w.x = cvtpk(st[8 * s2 + 0], st[8 * s2 + 1]); w.y = cvtpk(st[8 * s2 + 2], st[8 * s2 + 3]); w.z = cvtpk(st[8 * s2 + 4], st[8 * s2 + 5]); w.w = cvtpk(st[8 * s2 + 6], st[8 * s2 + 7]); pb[s2] = __builtin_bit_cast(bf16x8, w); }
        const int q4 = (lane & 15) >> 2, p4 = lane & 3, blk16 = (lane >> 4) & 1;
#pragma unroll
        for (int dt = 0; dt < 4; ++dt)
#pragma unroll
            for (int s2 = 0; s2 < 2; ++s2) {
                const unsigned chn = 4 * dt + 2 * blk16 + (p4 >> 1);
                const s16x4 lo = vtr(img + voff_b(16 * s2 + 4 * hh + q4, chn) + 8 * (p4 & 1));
                const s16x4 hi = vtr(img + voff_b(16 * s2 + 8 + 4 * hh + q4, chn) + 8 * (p4 & 1));
                const bf16x8 va = __builtin_shufflevector(lo, hi, 0, 1, 2, 3, 4, 5, 6, 7);
                o[dt] = __builtin_amdgcn_mfma_f32_32x32x16_bf16(va, pb[s2], o[dt], 0, 0, 0);
            }
    }
    const float inv = 1.0f / l_run;
    bf16* op = AO + (size_t)qt * D + h * 128 + 4 * hh;
#pragma unroll
    for (int dt = 0; dt < 4; ++dt)
#pragma unroll
        for (int i4 = 0; i4 < 4; ++i4) { v2u w; w.x = cvtpk(o[dt][4 * i4] * inv, o[dt][4 * i4 + 1] * inv); w.y = cvtpk(o[dt][4 * i4 + 2] * inv, o[dt][4 * i4 + 3] * inv);
            *(GAS v2u*)(op + 32 * dt + 8 * i4) = w; }
}
__device__ __forceinline__ void phase_attention(Frame& F, int rev) {
    const bf16* QKV = (const bf16*)(F.ws + WS_BIG + BIG_QKV); bf16* AO = (bf16*)(F.ws + WS_BIG + BIG_AO);
    LAS unsigned char* vimg = F.lds + RING_OFF + F.wave * 16384;
    for (int j = F.vcu; j < (T / 256) * 16; j += F.G) {
        const int jj = rev ? (T / 256) * 16 - 1 - j : j; const int h = jj & 15, blk = jj >> 4;
        attn_wave_task(QKV, AO, vimg, blk, h, F.wave, F.lane);
    }
}

#ifdef ATTN_NAIVE
__device__ __forceinline__ void phase_attention_naive(Frame& F) {
    const bf16* QKV = (const bf16*)(F.ws + WS_BIG + BIG_QKV); bf16* AO = (bf16*)(F.ws + WS_BIG + BIG_AO);
    const int gw = F.vcu * NWAVES + F.wave, NGW = F.G * NWAVES, lane = F.lane;
    for (int p = gw; p < T * 16; p += NGW) {
        const int tok = p >> 4, h = p & 15;
        int seq_start, seq_len;
        if (tok < T_PROMPT) { seq_start = tok & ~8191; seq_len = 8192; } else { seq_start = T_PROMPT + ((tok - T_PROMPT) & ~2047); seq_len = 2048; }
        const int seq_end = seq_start + seq_len;
        const float slope2 = __builtin_amdgcn_exp2f(-0.5f * (float)(h + 1)) * LOG2E;
        float m = -1e30f, l = 0.f, o0 = 0.f, o1 = 0.f;
        for (int g = 0; g < 3; ++g) {
            const int d = 1 << (2 * g);
            const unsigned qw = *(const GAS unsigned*)(QKV + (size_t)tok * NQKV + g * 2048 + h * 128 + 2 * lane);
            const float q0 = bf2f(qw & 0xffffu), q1 = bf2f(qw >> 16);
            for (int j = -64; j <= 64; ++j) {
                const int kt = tok + j * d;
                if (kt < seq_start || kt >= seq_end) continue;
                const unsigned kw = *(const GAS unsigned*)(QKV + (size_t)kt * NQKV + 6144 + g * 2048 + h * 128 + 2 * lane);
                const unsigned vw = *(const GAS unsigned*)(QKV + (size_t)kt * NQKV + 12288 + g * 2048 + h * 128 + 2 * lane);
                const float s = wave_sum(q0 * bf2f(kw & 0xffffu) + q1 * bf2f(kw >> 16)) - slope2 * (float)((j < 0 ? -j : j) * d);
                const float mn = fmaxf(m, s), al = __builtin_amdgcn_exp2f(m - mn), pv = __builtin_amdgcn_exp2f(s - mn);
                l = l * al + pv; o0 = o0 * al + pv * bf2f(vw & 0xffffu); o1 = o1 * al + pv * bf2f(vw >> 16); m = mn;
            }
        }
        const float inv = 1.0f / l;
        *(GAS unsigned*)(AO + (size_t)tok * D + h * 128 + 2 * lane) = pk2(o0 * inv, o1 * inv);
    }
}
#endif
constexpr int NPHASE = 54;
#ifndef DUP_PHASE
#define DUP_PHASE (-1)
#define DUP_N 0
#endif
#define REPS(id) for (int rep_ = 0; rep_ < ((DUP_PHASE) == (id) ? 1 + (DUP_N) : 1); ++rep_)
#ifndef ZERO_HY
#define ZERO_HY 0
#endif
#ifndef ZERO_AT
#define ZERO_AT 0
#endif
#ifndef AT_SCALE
#define AT_SCALE 1.0f
#endif
#ifndef HY_SCALE
#define HY_SCALE 1.0f
#endif
#define MIXSCALE(hy) ((hy) ? (ZERO_HY ? 0.0f : HY_SCALE) : (ZERO_AT ? 0.0f : AT_SCALE))
struct Args { const float* in[21]; float* out; unsigned char* ws; int ph_lo, ph_hi; };
static_assert(sizeof(Args) == 21 * 8 + 8 + 8 + 8, "Args has no padding");
__global__ void __launch_bounds__(NWAVES * 64, 2) fwd_kernel(Args args) {
    extern __shared__ __attribute__((aligned(16))) unsigned char lds[];
    unsigned char* const ws0 = args.ws;
    const int wave0 = __builtin_amdgcn_readfirstlane(threadIdx.x >> 6);
    volatile LAS unsigned* MISC = (volatile LAS unsigned*)((LAS unsigned char*)lds + MISC_OFF);
    if (threadIdx.x < 64) MISC[threadIdx.x] = 0u;
    if (threadIdx.x == 64) {
#pragma unroll
        for (int i = 0; i < 21; ++i) ((LAS unsigned long long*)((LAS unsigned char*)lds + PTR_OFF))[i] = (unsigned long long)args.in[i];
    }
    __syncthreads();
    XcdBarrier bar = xcd_barrier_post((unsigned*)(ws0 + WS_CTL), MISC);
#define FRAME() Frame F = make_frame(lds, args.ws, args.out, wave0)
    const int lo = args.ph_lo, hi = args.ph_hi;
#define RUN(id) (lo <= (id) && (id) < hi)
#define SEAM(id) do { if ((id) + 1 < hi) xcd_barrier(bar); } while (0)

#define ZB ((bf16*)(F.ws + WS_ZB))
#define STATS ((float*)(F.ws + WS_STATS))
#define PART ((float*)(F.ws + WS_PART))
#define CDV(off) ((float*)(F.ws + WS_CD) + (off))
#define HID ((bf16*)(F.ws + WS_BIG + BIG_HID))
    constexpr int O_C1 = 0, O_D1 = NFF2, O_CM = 2 * NFF2, O_DM = 2 * NFF2 + NQKV, O_C2 = 2 * NFF2 + 2 * NQKV, O_D2 = 3 * NFF2 + 2 * NQKV;

    if (RUN(0)) { FRAME(); phase_init(F); SEAM(0); }

#pragma unroll
    for (int layer = 0; layer < DEPTH; ++layer) {
        const int pb = 1 + 13 * layer; const bool hy = (layer & 1) != 0; const int jl = layer >> 1;
#define REVF(idx) ((7 * layer + (idx) + 1) & 1)
        if (RUN(pb + 0)) { FRAME(); REPS(0) phase_convert(F, layer); SEAM(pb + 0); }

        if (RUN(pb + 1)) {
            if (hy) {
                FRAME();
                pg8::Gemm gt{(const bf16*)(F.ws + WS_W3T), (const bf16*)(F.ws + WS_H2B), 8192, 10240, 256}; pg8::StaticOrder St; St.init(8192, 10240, F.G, F.bx);
                pg8::EpiTaps Et{(float*)(F.ws + WS_TAPS), MIN_DECAY, (MAX_DECAY - MIN_DECAY) / 2047.0f};
                pg8::gemm_phase<pg8::EpiTaps, pg8::StaticOrder, PG8_ALIGN, PG8_SP2>(F.lds + RING_OFF, gt, St, Et, F.tid);
            }
            FRAME();
            pg8::Gemm g{ZB, (const bf16*)(F.ws + W_IN1), T, NFF2, D}; pg8::StaticOrder S; S.init(T, NFF2, F.G, F.bx);
            pg8::EpiSwiglu E{HID, FF, STATS, CDV(O_C1), CDV(O_D1)};
            REPS(1) pg8::gemm_phase<pg8::EpiSwiglu, pg8::StaticOrder, PG8_ALIGN, PG8_SP2>(F.lds + RING_OFF, g, S, E, F.tid);
            SEAM(pb + 1);
        }
        if (RUN(pb + 2)) {
            FRAME();
            pg8::Gemm g{HID, (const bf16*)(F.ws + W_OUT1), T, D, FF}; pg8::StaticOrder S; S.init(T, D, F.G, F.bx, 1);
            const float* g0 = layer ? inp(F, 2) + (size_t)((layer - 1) * 3 + 2) * D : (const float*)(F.ws + WS_IDG); const float* b0 = layer ? inp(F, 3) + (size_t)((layer - 1) * 3 + 2) * D : (const float*)(F.ws + WS_IDB);
            pg8::EpiResid E{F.z, ZB, STATS, g0, b0, (const float*)(F.ws + WS_IDB), PART, 0.5f, 0};
            pg8::gemm_phase<pg8::EpiResid, pg8::StaticOrder, PG8_ALIGN, PG8_SP2>(F.lds + RING_OFF, g, S, E, F.tid);
            SEAM(pb + 2);
        }
        if (RUN(pb + 3)) { FRAME(); REPS(3) phase_finalize(F); SEAM(pb + 3); }

        if (RUN(pb + 4)) {
            if (!hy) { FRAME();
                pg8::Gemm g{ZB, (const bf16*)(F.ws + W_MIN), T, NQKV, D}; pg8::StaticOrder S; S.init(T, NQKV, F.G, F.bx);
                pg8::EpiLnBf16 E{(bf16*)(F.ws + WS_BIG + BIG_QKV), NQKV, STATS, CDV(O_CM), CDV(O_DM)};
                REPS(4) pg8::gemm_phase<pg8::EpiLnBf16, pg8::StaticOrder, PG8_ALIGN, PG8_SP2>(F.lds + RING_OFF, g, S, E, F.tid);
            } else { FRAME();
                pg8::Gemm g{(const bf16*)(F.ws + W_MIN), ZB, NHY, T, D}; pg8::StaticOrder S; S.init(NHY, T, F.G, F.bx);
                pg8::EpiLnBf16T E{(bf16*)(F.ws + WS_BIG + BIG_UT), T, STATS, CDV(O_CM), CDV(O_DM)};
                REPS(4) pg8::gemm_phase<pg8::EpiLnBf16T, pg8::StaticOrder, PG8_ALIGN, PG8_SP2>(F.lds + RING_OFF, g, S, E, F.tid);
            }
            SEAM(pb + 4);
        }
        if (RUN(pb + 5)) {
            FRAME();
#ifdef ATTN_NAIVE
            if (!hy) phase_attention_naive(F);
#else
            if (!hy) { REPS(5) phase_attention(F, 0); }
#endif
            else { REPS(15) phase_spectra(F, jl); }
            SEAM(pb + 5);
        }
        if (hy) {
            if (RUN(pb + 6)) { FRAME(); REPS(6) phase_conv(F, jl); SEAM(pb + 6); }
            if (RUN(pb + 7)) { FRAME(); REPS(7) phase_transpose(F, (const bf16*)(F.ws + WS_BIG + BIG_Z2T), D, T, (bf16*)(F.ws + WS_BIG + BIG_Z2)); SEAM(pb + 7); }
        }
        if (RUN(pb + 8)) {
            FRAME();
            const bf16* A = hy ? (const bf16*)(F.ws + WS_BIG + BIG_Z2) : (const bf16*)(F.ws + WS_BIG + BIG_AO);
            pg8::Gemm g{A, (const bf16*)(F.ws + W_MOUT), T, D, D}; pg8::StaticOrder S; S.init(T, D, F.G, F.bx);
            pg8::EpiResid E{F.z, ZB, STATS, inp(F, 2) + (size_t)(layer * 3) * D, inp(F, 3) + (size_t)(layer * 3) * D, hy ? inp(F, 20) + (size_t)jl * D : (const float*)(F.ws + WS_IDB), PART, MIXSCALE(hy), 0};
            pg8::gemm_phase<pg8::EpiResid, pg8::StaticOrder, PG8_ALIGN, PG8_SP2>(F.lds + RING_OFF, g, S, E, F.tid);
            SEAM(pb + 8);
        }
        if (RUN(pb + 9)) { FRAME(); phase_finalize(F); SEAM(pb + 9); }

        if (RUN(pb + 10)) {
            FRAME();
            pg8::Gemm g{ZB, (const bf16*)(F.ws + W_IN2), T, NFF2, D}; pg8::StaticOrder S; S.init(T, NFF2, F.G, F.bx);
            pg8::EpiSwiglu E{HID, FF, STATS, CDV(O_C2), CDV(O_D2)};
            pg8::gemm_phase<pg8::EpiSwiglu, pg8::StaticOrder, PG8_ALIGN, PG8_SP2>(F.lds + RING_OFF, g, S, E, F.tid);
            SEAM(pb + 10);
        }
        if (RUN(pb + 11)) {
            FRAME();
            pg8::Gemm g{HID, (const bf16*)(F.ws + W_OUT2), T, D, FF}; pg8::StaticOrder S; S.init(T, D, F.G, F.bx, 1);
            pg8::EpiResid E{F.z, ZB, STATS, inp(F, 2) + (size_t)(layer * 3 + 1) * D, inp(F, 3) + (size_t)(layer * 3 + 1) * D, (const float*)(F.ws + WS_IDB), PART, 0.5f, 0};
            pg8::gemm_phase<pg8::EpiResid, pg8::StaticOrder, PG8_ALIGN, PG8_SP2>(F.lds + RING_OFF, g, S, E, F.tid);
            SEAM(pb + 11);
        }
        if (RUN(pb + 12)) { FRAME(); phase_finalize(F); SEAM(pb + 12); }
    }
#ifdef DBG_CHECK
    if (RUN(NPHASE - 2)) { FRAME(); phase_check_qkv(F); SEAM(NPHASE - 2); }
#endif
    if (RUN(NPHASE - 1)) { FRAME(); phase_final_ln(F); }
#undef REVF
#undef RUN
#undef SEAM
#undef FRAME
}


#ifdef PHASE_PROBE
#define PROBE_FRAME() extern __shared__ __attribute__((aligned(16))) unsigned char lds[]; Frame F = make_frame(lds, args.ws, args.out, __builtin_amdgcn_readfirstlane(threadIdx.x >> 6));
__global__ void __launch_bounds__(NWAVES * 64, 2) probe_init(Args args) { PROBE_FRAME(); phase_init(F); }
__global__ void __launch_bounds__(NWAVES * 64, 2) probe_convert(Args args) { PROBE_FRAME(); phase_convert(F, args.ph_lo); }
__global__ void __launch_bounds__(NWAVES * 64, 2) probe_finalize(Args args) { PROBE_FRAME(); phase_finalize(F); phase_final_ln(F); }
__global__ void __launch_bounds__(NWAVES * 64, 2) probe_transpose(Args args) { PROBE_FRAME(); phase_transpose(F, (const bf16*)(F.ws + WS_BIG + BIG_U), T, NHY, (bf16*)(F.ws + WS_BIG + BIG_UT)); }
__global__ void __launch_bounds__(NWAVES * 64, 2) probe_spectra(Args args) { PROBE_FRAME(); phase_spectra(F, args.ph_lo); }
__global__ void __launch_bounds__(NWAVES * 64, 2) probe_conv(Args args) { PROBE_FRAME(); phase_conv(F, args.ph_lo); }
__global__ void __launch_bounds__(NWAVES * 64, 2) probe_attn(Args args) { PROBE_FRAME(); phase_attention(F, args.ph_lo); }
__global__ void __launch_bounds__(NWAVES * 64, 2) probe_gemm_swiglu(Args args) { PROBE_FRAME(); pg8::Gemm g{(const bf16*)F.ws, (const bf16*)(F.ws + W_IN1), T, NFF2, D}; pg8::StaticOrder S; S.init(T, NFF2, F.G, F.bx); pg8::EpiSwiglu E{(bf16*)(F.ws + WS_BIG), FF, (float*)(F.ws + WS_STATS), (float*)(F.ws + WS_CD), (float*)(F.ws + WS_CD)}; pg8::gemm_phase<pg8::EpiSwiglu, pg8::StaticOrder, PG8_ALIGN, PG8_SP2>(F.lds + RING_OFF, g, S, E, F.tid); }
__global__ void __launch_bounds__(NWAVES * 64, 2) probe_gemm_resid(Args args) { PROBE_FRAME(); pg8::Gemm g{(const bf16*)F.ws, (const bf16*)(F.ws + W_IN1), T, D, FF}; pg8::StaticOrder S; S.init(T, D, F.G, F.bx); pg8::EpiResid E{F.z, (bf16*)(F.ws + WS_ZB), (float*)(F.ws + WS_STATS), inp(F, 2), inp(F, 3), args.ph_lo ? inp(F, 20) : (const float*)(F.ws + WS_IDB), (float*)(F.ws + WS_PART), 0.5f, 0}; pg8::gemm_phase<pg8::EpiResid, pg8::StaticOrder, PG8_ALIGN, PG8_SP2>(F.lds + RING_OFF, g, S, E, F.tid); }
__global__ void __launch_bounds__(NWAVES * 64, 2) probe_gemm_ln(Args args) { PROBE_FRAME(); pg8::Gemm g{(const bf16*)F.ws, (const bf16*)(F.ws + W_IN1), T, NQKV, D}; pg8::StaticOrder S; S.init(T, NQKV, F.G, F.bx); pg8::EpiLnBf16 E{(bf16*)(F.ws + WS_BIG), NQKV, (float*)(F.ws + WS_STATS), (float*)(F.ws + WS_CD), (float*)(F.ws + WS_CD)}; pg8::gemm_phase<pg8::EpiLnBf16, pg8::StaticOrder, PG8_ALIGN, PG8_SP2>(F.lds + RING_OFF, g, S, E, F.tid); }
#endif
#ifndef MK_MULTI
#define MK_MULTI 0
#endif
extern "C" void kernel_launch(void* const* d_in, const int* in_sizes, int n_in, void* d_out, int out_size, void* d_ws, size_t ws_size, hipStream_t stream) {
    static int grid = 0;
    if (grid == 0) {
        if (n_in != 21 || out_size != T * D || ws_size < WS_END) { fprintf(stderr, "kernel_launch: unexpected shapes (n_in %d, out %d, ws %zu, need %zu)\n", n_in, out_size, ws_size, (size_t)WS_END); grid = -1; return; }
        int dev = 0, cus = 0, per_cu = 0;
        if (hipGetDevice(&dev) != hipSuccess || hipDeviceGetAttribute(&cus, hipDeviceAttributeMultiprocessorCount, dev) != hipSuccess) { grid = -1; return; }
        if (hipFuncSetAttribute((const void*)fwd_kernel, hipFuncAttributeMaxDynamicSharedMemorySize, LDS_BYTES) != hipSuccess) { fprintf(stderr, "kernel_launch: hipFuncSetAttribute failed\n"); grid = -1; return; }
        if (hipOccupancyMaxActiveBlocksPerMultiprocessor(&per_cu, (const void*)fwd_kernel, NWAVES * 64, LDS_BYTES) != hipSuccess || per_cu < 1) fprintf(stderr, "kernel_launch: occupancy query reports %d\n", per_cu);
        (void)hipGetLastError();
        grid = cus;
    }
    if (grid < 0) return;
    if (hipMemsetAsync((char*)d_ws + WS_CTL, 0, CTL_ZERO_BYTES, stream) != hipSuccess) return;
    Args a{};
    for (int i = 0; i < 21; ++i) a.in[i] = (const float*)d_in[i];
    a.out = (float*)d_out; a.ws = (unsigned char*)d_ws;
#ifndef STOP_AFTER
#define STOP_AFTER (NPHASE - 1)
#endif
#ifdef DBG_CHECK
#define DBGCHK_ON 1
#else
#define DBGCHK_ON 0
#endif
#if MK_MULTI
    for (int p = 0; p < NPHASE; ++p) { if (p >= STOP_AFTER && p != NPHASE - 1 && !(DBGCHK_ON && p == NPHASE - 2)) continue; a.ph_lo = p; a.ph_hi = p + 1; hipLaunchKernelGGL(fwd_kernel, dim3(grid), dim3(NWAVES * 64), LDS_BYTES, stream, a); }
#else
    a.ph_lo = 0; a.ph_hi = NPHASE;
    hipLaunchKernelGGL(fwd_kernel, dim3(grid), dim3(NWAVES * 64), LDS_BYTES, stream, a);
#endif
}
```

```cpp
#include <hip/hip_runtime.h>
#include <cstdio>
#include <cstdint>
namespace pg8 {
#define PG8_LAS __attribute__((address_space(3)))
typedef unsigned short bf16_t;
typedef short bf16x8 __attribute__((ext_vector_type(8)));
typedef float f32x4 __attribute__((ext_vector_type(4)));
typedef unsigned u32x4 __attribute__((ext_vector_type(4)));
constexpr int BM = 256, BK = 64, HALF = 128, HTB = HALF * BK * 2  , STAGE_BYTES = 8 * HTB, NXCD = 8, WGM = 4;

__host__ __device__ __forceinline__ int lds_byte(int r, int c) { const int st = (r >> 4) * 2 + (c >> 5), rr = r & 15, cc = c & 31, ob = rr * 64 + cc * 2; return st * 1024 + (ob ^ (((ob >> 9) & 1) << 5)); }
__host__ __device__ __forceinline__ void stage_rc(int b, int& R, int& C) { const int st = b / 1024, sb = b % 1024, swz = sb ^ (((sb >> 9) & 1) << 5); R = (st >> 1) * 16 + swz / 64; C = (st & 1) * 32 + (swz % 64) / 2; }
__host__ __device__ __forceinline__ int perm32(int rho) { const int n = rho >> 4, i = rho & 15; return 8 * (i >> 2) + 4 * n + (i & 3); }

struct Unit { int pm, pn; };
struct Gemm { const bf16_t* A; const bf16_t* Bt; int M, N, K; };

struct StaticOrder {
    int nM, nN, nwg, G, c, rev, wgm;
    __host__ __device__ void init(int M, int N, int G_, int c_, int rev_ = 0, int wgm_ = WGM) { nM = M / BM; nN = N / BM; nwg = nM * nN; G = G_; c = c_; rev = rev_; wgm = wgm_; }
    __host__ __device__ bool next(int i, Unit& u) const {
        const int nr = (nwg + G - 1) / G; if (i >= nr) return false;
        const long L = (long)(rev ? nr - 1 - i : i) * G + c; if (L >= nwg) return false;
        int wgid = (int)L; { const int q = nwg / NXCD, r = nwg % NXCD, xcd = wgid % NXCD, off = wgid / NXCD; wgid = (xcd < r ? xcd * (q + 1) : r * (q + 1) + (xcd - r) * q) + off; }
        const int nig = wgm * nN, gid = wgid / nig, fm = gid * wgm, gsz = (nM - fm) < wgm ? (nM - fm) : wgm;
        u.pm = fm + ((wgid % nig) % gsz); u.pn = (wgid % nig) / gsz; return true;
    }
    __device__ __forceinline__ void a_ready(const Unit&) const {}
    __device__ __forceinline__ void done(const Unit&) const {}
};

__device__ __forceinline__ unsigned cvt_pk_bf16(float lo, float hi) { unsigned r; asm volatile("v_cvt_pk_bf16_f32 %0, %1, %2" : "=v"(r) : "v"(lo), "v"(hi)); return r; }
typedef float f32x2 __attribute__((ext_vector_type(2)));
typedef float f32x2v __attribute__((ext_vector_type(2)));
typedef unsigned u32x2v __attribute__((ext_vector_type(2)));
constexpr float DN_ALPHA_F = 1.6817928305074292f;

__device__ __forceinline__ float z20_dec(unsigned zb_hi, unsigned q, int k) { const int c = (int)(q << (28 - 4 * k)) >> 28; return __uint_as_float(zb_hi + ((unsigned)c << 12)); }
__device__ __forceinline__ unsigned z20_zb(float v) { return __float_as_uint(v) + 0x8800u; }
__device__ __forceinline__ unsigned z20_c(float v, int k) { return (((__float_as_uint(v) + 0x800u) >> 12) & 15u) << (4 * k); }

__device__ __forceinline__ unsigned cvt2(float lo, float hi) { typedef __bf16 bf16x2_t __attribute__((ext_vector_type(2))); const f32x2v v = {lo, hi}; return __builtin_bit_cast(unsigned, __builtin_convertvector(v, bf16x2_t)); }
__device__ __forceinline__ float xor32_sum(float x) { const auto r = __builtin_amdgcn_permlane32_swap(__float_as_uint(x), __float_as_uint(x), false, false); const unsigned r0 = r[0], r1 = r[1]; return __uint_as_float(r0) + __uint_as_float(r1); }
__device__ __forceinline__ float xor32_max(float x) { const auto r = __builtin_amdgcn_permlane32_swap(__float_as_uint(x), __float_as_uint(x), false, false); const unsigned r0 = r[0], r1 = r[1]; return fmaxf(__uint_as_float(r0), __uint_as_float(r1)); }
template <int MASK> __device__ __forceinline__ float swz_xor(float x) { return __builtin_bit_cast(float, __builtin_amdgcn_ds_swizzle(__builtin_bit_cast(int, x), (MASK << 10) | 0x1F)); }
__device__ __forceinline__ float wave_sum64(float v) { v += swz_xor<1>(v); v += swz_xor<2>(v); v += swz_xor<4>(v); v += swz_xor<8>(v); v += swz_xor<16>(v); return xor32_sum(v); }

struct EpiLnBf16 {
    static constexpr bool PERM = true, AFTER_DRAIN = false;
    bf16_t* O; int ldc; const float* stats; const float* cvec; const float* dvec;
    __device__ __forceinline__ void operator()(const f32x4 (&acc)[2][2][4][2], const Unit& u, int wr, int wc, int fr, int fq) const {
        const int row0 = u.pm * BM + wr * 64 + fr, col0 = u.pn * BM + wc * 32 + 8 * fq;
        f32x4 cv[2][2], dv[2][2];
#pragma unroll
        for (int bj = 0; bj < 2; ++bj)
#pragma unroll
            for (int n = 0; n < 2; ++n) { cv[bj][n] = *(const f32x4*)(cvec + col0 + bj * HALF + 4 * n); dv[bj][n] = *(const f32x4*)(dvec + col0 + bj * HALF + 4 * n); }
        f32x2v sts[2][4];
#pragma unroll
        for (int ai = 0; ai < 2; ++ai)
#pragma unroll
            for (int m = 0; m < 4; ++m) sts[ai][m] = *(const f32x2v*)(stats + 2 * (size_t)(row0 + ai * HALF + m * 16));
#pragma unroll
        for (int ai = 0; ai < 2; ++ai)
#pragma unroll
            for (int m = 0; m < 4; ++m) { const int row = row0 + ai * HALF + m * 16; const f32x2v st = sts[ai][m];
                bf16_t* rowp = O + (size_t)row * ldc + col0;
#pragma unroll
                for (int bj = 0; bj < 2; ++bj) { const f32x4 v0 = (acc[ai][bj][m][0] - st.x * cv[bj][0]) * st.y + dv[bj][0], v1 = (acc[ai][bj][m][1] - st.x * cv[bj][1]) * st.y + dv[bj][1];
                    u32x4 w; w.x = cvt2(v0[0], v0[1]); w.y = cvt2(v0[2], v0[3]); w.z = cvt2(v1[0], v1[1]); w.w = cvt2(v1[2], v1[3]);
                    *(u32x4*)(rowp + bj * HALF) = w; } }
    }
};
struct EpiLnBf16T {
    static constexpr bool PERM = true, AFTER_DRAIN = false, HAS_INIT = false;
    bf16_t* O; int ldc; const float* stats; const float* cvec; const float* dvec;
    __device__ __forceinline__ void operator()(const f32x4 (&acc)[2][2][4][2], const Unit& u, int wr, int wc, int fr, int fq) const {
        const int row0 = u.pm * BM + wr * 64 + fr, col0 = u.pn * BM + wc * 32 + 8 * fq;
        f32x4 mean[2][2], rstd[2][2];
#pragma unroll
        for (int bj = 0; bj < 2; ++bj) { const f32x4* sp = (const f32x4*)(stats + 2 * (size_t)(col0 + bj * HALF));
            const f32x4 a = sp[0], b = sp[1], c = sp[2], d = sp[3];
            mean[bj][0] = (f32x4){a[0], a[2], b[0], b[2]}; rstd[bj][0] = (f32x4){a[1], a[3], b[1], b[3]};
            mean[bj][1] = (f32x4){c[0], c[2], d[0], d[2]}; rstd[bj][1] = (f32x4){c[1], c[3], d[1], d[3]}; }
        float cr[2][4], dr[2][4];
#pragma unroll
        for (int ai = 0; ai < 2; ++ai)
#pragma unroll
            for (int m = 0; m < 4; ++m) { const int row = row0 + ai * HALF + m * 16; cr[ai][m] = cvec[row]; dr[ai][m] = dvec[row]; }
#pragma unroll
        for (int ai = 0; ai < 2; ++ai)
#pragma unroll
            for (int m = 0; m < 4; ++m) { const int row = row0 + ai * HALF + m * 16; bf16_t* rowp = O + (size_t)row * ldc + col0;
#pragma unroll
                for (int bj = 0; bj < 2; ++bj) { const f32x4 v0 = (acc[ai][bj][m][0] - mean[bj][0] * cr[ai][m]) * rstd[bj][0] + dr[ai][m], v1 = (acc[ai][bj][m][1] - mean[bj][1] * cr[ai][m]) * rstd[bj][1] + dr[ai][m];
                    u32x4 w; w.x = cvt2(v0[0], v0[1]); w.y = cvt2(v0[2], v0[3]); w.z = cvt2(v1[0], v1[1]); w.w = cvt2(v1[2], v1[3]);
                    *(u32x4*)(rowp + bj * HALF) = w; } }
    }
};
__device__ __forceinline__ float silu_mul(float g, float up) { const float e = __builtin_amdgcn_exp2f(-1.4426950408889634f * g); return g * __builtin_amdgcn_rcpf(1.0f + e) * up; }
struct EpiSwiglu {
    static constexpr bool PERM = true, AFTER_DRAIN = false;
    bf16_t* O; int ldc; const float* stats; const float* cvec; const float* dvec;
    __device__ __forceinline__ void operator()(const f32x4 (&acc)[2][2][4][2], const Unit& u, int wr, int wc, int fr, int fq) const {
        const int row0 = u.pm * BM + wr * 64 + fr, col0 = u.pn * BM + wc * 32 + 8 * fq, ocol = u.pn * HALF + wc * 32 + 8 * fq;
        f32x4 cv[2][2], dv[2][2];
#pragma unroll
        for (int bj = 0; bj < 2; ++bj)
#pragma unroll
            for (int n = 0; n < 2; ++n) { cv[bj][n] = *(const f32x4*)(cvec + col0 + bj * HALF + 4 * n); dv[bj][n] = *(const f32x4*)(dvec + col0 + bj * HALF + 4 * n); }
        f32x2v sts[2][4];
#pragma unroll
        for (int ai = 0; ai < 2; ++ai)
#pragma unroll
            for (int m = 0; m < 4; ++m) sts[ai][m] = *(const f32x2v*)(stats + 2 * (size_t)(row0 + ai * HALF + m * 16));
#pragma unroll
        for (int ai = 0; ai < 2; ++ai)
#pragma unroll
            for (int m = 0; m < 4; ++m) { const int row = row0 + ai * HALF + m * 16; const f32x2v st = sts[ai][m];
                f32x4 h[2];
#pragma unroll
                for (int n = 0; n < 2; ++n) { const f32x4 g = (acc[ai][0][m][n] - st.x * cv[0][n]) * st.y + dv[0][n], up = (acc[ai][1][m][n] - st.x * cv[1][n]) * st.y + dv[1][n];
                    h[n] = (f32x4){silu_mul(g[0], up[0]), silu_mul(g[1], up[1]), silu_mul(g[2], up[2]), silu_mul(g[3], up[3])}; }
                u32x4 w; w.x = cvt2(h[0][0], h[0][1]); w.y = cvt2(h[0][2], h[0][3]); w.z = cvt2(h[1][0], h[1][1]); w.w = cvt2(h[1][2], h[1][3]);
                *(u32x4*)(O + (size_t)row * ldc + ocol) = w; }
    }
};
struct EpiResid {
    static constexpr bool PERM = true, AFTER_DRAIN = false;
    unsigned* ZL; bf16_t* ZB; const float* stats; const float* gprev; const float* bprev; const float* bias; float* part; float scale; __attribute__((address_space(3))) float* gb;
    __device__ __forceinline__ void operator()(const f32x4 (&acc)[2][2][4][2], const Unit& u, int wr, int wc, int fr, int fq) const {
        typedef __attribute__((address_space(3))) f32x4 lds_f32x4;
        const int row0 = u.pm * BM + wr * 64 + fr, col0 = u.pn * BM + wc * 32 + 8 * fq;
        lds_f32x4* slot = (lds_f32x4*)(gb + (wr * 4 + wc) * 128) + fq * 8;
        if (fr == 0) {
#pragma unroll
            for (int bj = 0; bj < 2; ++bj)
#pragma unroll
                for (int n = 0; n < 2; ++n) { const int c = col0 + bj * HALF + 4 * n; slot[bj * 4 + n] = DN_ALPHA_F * *(const f32x4*)(gprev + c); slot[bj * 4 + 2 + n] = DN_ALPHA_F * *(const f32x4*)(bprev + c) + scale * *(const f32x4*)(bias + c); }
        }
#pragma unroll
        for (int bj = 0; bj < 2; ++bj) {
#pragma unroll
            for (int ai = 0; ai < 2; ++ai) {
                u32x4 zr[4]; unsigned zq[4]; f32x2v sts[4];
#pragma unroll
                for (int m = 0; m < 4; ++m) { const unsigned row = (unsigned)(row0 + ai * HALF + m * 16), eo = row * 2048u + (unsigned)(col0 + bj * HALF);
                    zr[m] = *(const u32x4*)(ZB + eo); zq[m] = ZL[eo >> 3]; sts[m] = *(const f32x2v*)(stats + 2u * row); }
#pragma unroll
                for (int m = 0; m < 4; ++m) { const unsigned row = (unsigned)(row0 + ai * HALF + m * 16), eo = row * 2048u + (unsigned)(col0 + bj * HALF); const f32x2v st = sts[m]; const u32x4 r = zr[m]; const unsigned q = zq[m];
                    const f32x4 z0 = (f32x4){z20_dec(r.x << 16, q, 0), z20_dec(r.x & 0xffff0000u, q, 1), z20_dec(r.y << 16, q, 2), z20_dec(r.y & 0xffff0000u, q, 3)};
                    const f32x4 z1 = (f32x4){z20_dec(r.z << 16, q, 4), z20_dec(r.z & 0xffff0000u, q, 5), z20_dec(r.w << 16, q, 6), z20_dec(r.w & 0xffff0000u, q, 7)};
                    const f32x4 n0 = (z0 - st.x) * st.y * slot[bj * 4] + slot[bj * 4 + 2] + scale * acc[ai][bj][m][0];
                    const f32x4 n1 = (z1 - st.x) * st.y * slot[bj * 4 + 1] + slot[bj * 4 + 3] + scale * acc[ai][bj][m][1];
                    u32x4 w; w.x = (z20_zb(n0[0]) >> 16) | (z20_zb(n0[1]) & 0xffff0000u); w.y = (z20_zb(n0[2]) >> 16) | (z20_zb(n0[3]) & 0xffff0000u);
                    w.z = (z20_zb(n1[0]) >> 16) | (z20_zb(n1[1]) & 0xffff0000u); w.w = (z20_zb(n1[2]) >> 16) | (z20_zb(n1[3]) & 0xffff0000u);
#ifdef E3_PLAIN_STORES
                    *(u32x4*)(ZB + eo) = w;
#else
                    __builtin_nontemporal_store(w, (u32x4*)(ZB + eo));
#endif
                    const unsigned zlw = ((z20_c(n0[0], 0) | z20_c(n0[1], 1)) | (z20_c(n0[2], 2) | z20_c(n0[3], 3))) | ((z20_c(n1[0], 4) | z20_c(n1[1], 5)) | (z20_c(n1[2], 6) | z20_c(n1[3], 7)));
#ifdef E3_PLAIN_STORES
                    ZL[eo >> 3] = zlw;
#else
                    __builtin_nontemporal_store(zlw, ZL + (eo >> 3));
#endif
                    float s = ((n0[0] + n0[1]) + (n0[2] + n0[3])) + ((n1[0] + n1[1]) + (n1[2] + n1[3]));
                    float q2 = ((n0[0] * n0[0] + n0[1] * n0[1]) + (n0[2] * n0[2] + n0[3] * n0[3])) + ((n1[0] * n1[0] + n1[1] * n1[1]) + (n1[2] * n1[2] + n1[3] * n1[3]));
                    s += swz_xor<16>(s); s = xor32_sum(s); q2 += swz_xor<16>(q2); q2 = xor32_sum(q2);
                    if (fq == 0) *(f32x2v*)(part + (row * 64u + (unsigned)(u.pn * 8 + wc * 2 + bj)) * 2u) = (f32x2v){s, q2}; }
            }
        }
    }
};

struct EpiTaps {
    static constexpr bool PERM = false, AFTER_DRAIN = false;
    float* O; float min_decay, dstep;
    __device__ __forceinline__ void operator()(const f32x4 (&acc)[2][2][4][2], const Unit& u, int wr, int wc, int fr, int fq) const {
        int stride = 10240; float i0 = 1.0f / 8191.0f, i1 = 1.0f / 2047.0f; asm volatile("" : "+s"(stride), "+s"(i0), "+s"(i1));
        const int row0 = u.pm * BM + wr * 64 + fr, col0 = u.pn * BM + wc * 32 + 4 * fq;
        const int tbase = (u.pn < 32) ? 0 : 8192; const float ilm1 = (u.pn < 32) ? i0 : i1;
        const float t0 = (float)(col0 - tbase);
#pragma unroll
        for (int ai = 0; ai < 2; ++ai)
#pragma unroll
            for (int m = 0; m < 4; ++m) { const int row = row0 + ai * HALF + m * 16;
                const float a = -1.4426950408889634f * __builtin_fabsf(min_decay + (float)(row & 2047) * dstep) * ilm1;
                const float e0 = __builtin_amdgcn_exp2f(a * t0), s1 = __builtin_amdgcn_exp2f(a), s16 = __builtin_amdgcn_exp2f(16.0f * a), s128 = __builtin_amdgcn_exp2f(128.0f * a);
                float* rowp = O + (size_t)row * stride + col0;
#pragma unroll
                for (int bj = 0; bj < 2; ++bj) { const float eb = bj ? e0 * s128 : e0;
#pragma unroll
                    for (int n = 0; n < 2; ++n) { const float en = n ? eb * s16 : eb, en1 = en * s1, en2 = en1 * s1, en3 = en2 * s1; const f32x4 v = acc[ai][bj][m][n];
#ifdef TAPS_NT
                        __builtin_nontemporal_store((f32x4){v[0] * en, v[1] * en1, v[2] * en2, v[3] * en3}, (f32x4*)(rowp + bj * HALF + n * 16)); } } }
#else
                        *(f32x4*)(rowp + bj * HALF + n * 16) = (f32x4){v[0] * en, v[1] * en1, v[2] * en2, v[3] * en3}; } } }
#endif
    }
};

template <class Epi, class Sched, bool ALIGN_EPI = false, bool SP2 = false>
__device__ __forceinline__ void gemm_phase(PG8_LAS unsigned char* lds, const Gemm g, const Sched& S, const Epi& E, const int tid_in) {
    int tid_ = tid_in; asm volatile("" : "+v"(tid_));
    const int tid = tid_, wid = __builtin_amdgcn_readfirstlane(tid >> 6), lane = tid & 63, wr = wid >> 2, wc = wid & 3, fr = lane & 15, fq = lane >> 4;
    const int K = g.K, nt = K / BK;
    unsigned voffA[2], voffB[2];
#pragma unroll
    for (int i = 0; i < 2; ++i) { int R, C; stage_rc(tid * 16 + i * 8192, R, C); const int Rb = Epi::PERM ? ((R & ~31) + perm32(R & 31)) : R;
        voffA[i] = (unsigned)(R * K + C) * 2u; voffB[i] = (unsigned)(Rb * K + C) * 2u; }
    const size_t kstep = (size_t)(BK * 2);
    const size_t hstep = (size_t)HALF * K * 2;
    const size_t tstep = 2 * hstep;
    const unsigned ldsw = (unsigned)wid * 1024u;
    const int aoff = lds_byte(wr * 64 + fr, fq * 8), boff = lds_byte(wc * 32 + fr, fq * 8);
#define PG8_SA(b, h) (((b) * 2 + (h)) * HTB)
#define PG8_SB(b, h) ((4 + (b) * 2 + (h)) * HTB)
#define PG8_STAGE(bufoff, gbase, voff) do { _Pragma("unroll") for (int _i = 0; _i < 2; ++_i) \
        __builtin_amdgcn_global_load_lds((const unsigned*)((const char*)(gbase) + (voff)[_i]), (PG8_LAS unsigned*)(lds + (bufoff) + ldsw + _i * 8192), 16, 0, 0); } while (0)
#define PG8_LDA(dst, b, h) do { _Pragma("unroll") for (int m = 0; m < 4; ++m) _Pragma("unroll") for (int k = 0; k < 2; ++k) dst[m][k] = *(const PG8_LAS bf16x8*)(lds + PG8_SA(b, h) + aoff + m * 2048 + k * 1024); } while (0)
#define PG8_LDB(dst, b, h) do { _Pragma("unroll") for (int n = 0; n < 2; ++n) _Pragma("unroll") for (int k = 0; k < 2; ++k) dst[n][k] = *(const PG8_LAS bf16x8*)(lds + PG8_SB(b, h) + boff + n * 2048 + k * 1024); } while (0)
#define PG8_MMA(ai, bj, At, Bt) do { __builtin_amdgcn_s_setprio(1); _Pragma("unroll") for (int m = 0; m < 4; ++m) _Pragma("unroll") for (int n = 0; n < 2; ++n) _Pragma("unroll") for (int k = 0; k < 2; ++k) \
        acc[ai][bj][m][n] = __builtin_amdgcn_mfma_f32_16x16x32_bf16(Bt[n][k], At[m][k], acc[ai][bj][m][n], 0, 0, 0); __builtin_amdgcn_s_setprio(0); } while (0)
#define PG8_WAIT_V(n) asm volatile("s_waitcnt vmcnt(" #n ")" ::: "memory")
#define PG8_WAIT_L(n) asm volatile("s_waitcnt lgkmcnt(" #n ")" ::: "memory")
#define PG8_BAR __builtin_amdgcn_s_barrier()
#define PG8_SCHED __builtin_amdgcn_sched_barrier(0)
    Unit cur, nxt; int ui = 0;
    if (!S.next(0, cur)) return;
    f32x4 acc[2][2][4][2];
    float zero_; asm volatile("v_mov_b32 %0, 0" : "=v"(zero_));
#pragma unroll
    for (int a = 0; a < 2; ++a)
#pragma unroll
        for (int b = 0; b < 2; ++b)
#pragma unroll
            for (int m = 0; m < 4; ++m)
#pragma unroll
                for (int n = 0; n < 2; ++n) acc[a][b][m][n] = (f32x4){zero_, zero_, zero_, zero_};
    bf16x8 At[4][2], B0[2][2], B1[2][2];
    const char* cA = (const char*)g.A + (size_t)cur.pm * tstep; const char* cB = (const char*)g.Bt + (size_t)cur.pn * tstep;
    S.a_ready(cur);
    if constexpr (SP2) {
        PG8_STAGE(PG8_SB(0, 0), cB, voffB); PG8_STAGE(PG8_SB(0, 1), cB + hstep, voffB); PG8_STAGE(PG8_SA(0, 0), cA, voffA); PG8_STAGE(PG8_SA(0, 1), cA + hstep, voffA);
        if (wr == 1) PG8_BAR;
        PG8_WAIT_V(2); PG8_BAR;
        PG8_STAGE(PG8_SB(1, 0), cB + kstep, voffB); PG8_STAGE(PG8_SA(1, 0), cA + kstep, voffA); PG8_STAGE(PG8_SB(1, 1), cB + hstep + kstep, voffB);
        PG8_WAIT_V(6); PG8_BAR;
    } else {
        PG8_STAGE(PG8_SB(0, 0), cB, voffB); PG8_STAGE(PG8_SA(0, 0), cA, voffA); PG8_STAGE(PG8_SB(0, 1), cB + hstep, voffB); PG8_STAGE(PG8_SA(0, 1), cA + hstep, voffA);
        if (wr == 1) PG8_BAR;
        PG8_WAIT_V(4); PG8_BAR;
        PG8_STAGE(PG8_SB(1, 0), cB + kstep, voffB); PG8_STAGE(PG8_SA(1, 0), cA + kstep, voffA); PG8_STAGE(PG8_SB(1, 1), cB + hstep + kstep, voffB);
        PG8_WAIT_V(6); PG8_BAR;
    }
    for (;;) {
        const bool has_next = S.next(ui + 1, nxt);
        const char* nA = has_next ? (const char*)g.A + (size_t)nxt.pm * tstep : cA; const char* nB = has_next ? (const char*)g.Bt + (size_t)nxt.pn * tstep : cB;
        for (int t = 0; t < nt; t += 2) {
            const bool last = (t == nt - 2);
            const char* a1 = cA + (size_t)(t + 1) * kstep;
            const char* a2 = last ? nA : cA + (size_t)(t + 2) * kstep; const char* b2 = last ? nB : cB + (size_t)(t + 2) * kstep;
            const char* a3 = a2 + kstep; const char* b3 = b2 + kstep;
            if (last && has_next) S.a_ready(nxt);
            if constexpr (SP2) {
            PG8_LDB(B0, 0, 0); PG8_LDB(B1, 0, 1); PG8_SCHED; PG8_LDA(At, 0, 0); PG8_STAGE(PG8_SA(1, 1), a1 + hstep, voffA);
            PG8_WAIT_V(8); PG8_WAIT_L(0); PG8_BAR; PG8_MMA(0, 0, At, B0); PG8_MMA(0, 1, At, B1); PG8_BAR; PG8_SCHED;
            PG8_LDA(At, 0, 1); PG8_STAGE(PG8_SB(0, 0), b2, voffB); PG8_STAGE(PG8_SB(0, 1), b2 + hstep, voffB); PG8_STAGE(PG8_SA(0, 0), a2, voffA);
            PG8_WAIT_V(8); PG8_WAIT_L(0); PG8_BAR; PG8_MMA(1, 0, At, B0); PG8_MMA(1, 1, At, B1); PG8_BAR; PG8_SCHED;
            PG8_LDB(B0, 1, 0); PG8_LDB(B1, 1, 1); PG8_SCHED; PG8_LDA(At, 1, 0); PG8_STAGE(PG8_SA(0, 1), a2 + hstep, voffA);
            PG8_WAIT_V(8); PG8_WAIT_L(0); PG8_BAR; PG8_MMA(0, 0, At, B0); PG8_MMA(0, 1, At, B1); PG8_BAR; PG8_SCHED;
            PG8_LDA(At, 1, 1); PG8_STAGE(PG8_SB(1, 0), b3, voffB); PG8_STAGE(PG8_SB(1, 1), b3 + hstep, voffB); PG8_STAGE(PG8_SA(1, 0), a3, voffA);
            PG8_WAIT_V(8); PG8_WAIT_L(0); PG8_BAR; PG8_MMA(1, 0, At, B0); PG8_MMA(1, 1, At, B1); PG8_BAR; PG8_SCHED;
            } else {
            PG8_LDB(B0, 0, 0); PG8_SCHED; PG8_LDA(At, 0, 0); PG8_STAGE(PG8_SA(1, 1), a1 + hstep, voffA);
            PG8_WAIT_L(8); PG8_BAR; PG8_WAIT_L(0); PG8_MMA(0, 0, At, B0); PG8_BAR; PG8_SCHED;
            PG8_LDB(B1, 0, 1); PG8_STAGE(PG8_SB(0, 0), b2, voffB);
            PG8_BAR; PG8_WAIT_L(0); PG8_MMA(0, 1, At, B1); PG8_BAR;
            PG8_LDA(At, 0, 1); PG8_STAGE(PG8_SA(0, 0), a2, voffA);
            PG8_BAR; PG8_WAIT_L(0); PG8_MMA(1, 0, At, B0); PG8_BAR; PG8_SCHED;
            PG8_STAGE(PG8_SB(0, 1), b2 + hstep, voffB);
            PG8_WAIT_V(6); PG8_BAR; PG8_MMA(1, 1, At, B1); PG8_BAR;
            PG8_LDB(B0, 1, 0); PG8_SCHED; PG8_LDA(At, 1, 0); PG8_STAGE(PG8_SA(0, 1), a2 + hstep, voffA);
            PG8_WAIT_L(8); PG8_BAR; PG8_WAIT_L(0); PG8_MMA(0, 0, At, B0); PG8_BAR; PG8_SCHED;
            PG8_LDB(B1, 1, 1); PG8_STAGE(PG8_SB(1, 0), b3, voffB);
            PG8_BAR; PG8_WAIT_L(0); PG8_MMA(0, 1, At, B1); PG8_BAR;
            PG8_LDA(At, 1, 1); PG8_STAGE(PG8_SA(1, 0), a3, voffA);
            PG8_BAR; PG8_WAIT_L(0); PG8_MMA(1, 0, At, B0); PG8_BAR; PG8_SCHED;
            PG8_STAGE(PG8_SB(1, 1), b3 + hstep, voffB);
            PG8_WAIT_V(6); PG8_BAR; PG8_MMA(1, 1, At, B1); PG8_BAR;
            }
        }
        if constexpr (ALIGN_EPI) { if (wr == 0) PG8_BAR; }
        if constexpr (!Epi::AFTER_DRAIN) { E(acc, cur, wr, wc, fr, fq); S.done(cur); }
        if (!has_next) break;
        asm volatile("v_mov_b32 %0, 0" : "=v"(zero_));
#pragma unroll
        for (int a = 0; a < 2; ++a)
#pragma unroll
            for (int b = 0; b < 2; ++b)
#pragma unroll
                for (int m = 0; m < 4; ++m)
#pragma unroll
                    for (int n = 0; n < 2; ++n) acc[a][b][m][n] = (f32x4){zero_, zero_, zero_, zero_};
        cur = nxt; cA = nA; cB = nB; ++ui;
        if constexpr (ALIGN_EPI) { if (wr == 1) PG8_BAR; }
    }
    PG8_WAIT_V(0);
    if constexpr (!ALIGN_EPI) { if (wr == 0) PG8_BAR; }
    PG8_BAR;
    if constexpr (Epi::AFTER_DRAIN) { E.fused(acc, cur, wr, wc, fr, fq, lds, wid, lane); S.done(cur); }
#undef PG8_SA
#undef PG8_SB
#undef PG8_STAGE
#undef PG8_LDA
#undef PG8_LDB
#undef PG8_MMA
#undef PG8_WAIT_V
#undef PG8_WAIT_L
#undef PG8_BAR
#undef PG8_SCHED
}
}

#ifndef PG8_SP2
#define PG8_SP2 true
#endif
#ifndef PG8_ALIGN
#define PG8_ALIGN true
#endif
#define XB_TMO      128
#define XB_XCNT(j)  (256  + 64 * (j))
#define XB_XSUB(j)  (1280 + 64 * (j))
#define XB_XGEN(j)  (2304 + 64 * (j))
#define XB_TOP      3328
#define XB_TOPGEN   3392
#define XCD_BAR_WORDS 3456
#define XB_SPIN_CAP (1u << 18)
#define LAS __attribute__((address_space(3)))

__device__ __forceinline__ unsigned xb_ld(unsigned* p)              { return __hip_atomic_load(p, __ATOMIC_RELAXED, __HIP_MEMORY_SCOPE_AGENT); }
__device__ __forceinline__ unsigned xb_add(unsigned* p, unsigned v) { return __hip_atomic_fetch_add(p, v, __ATOMIC_RELAXED, __HIP_MEMORY_SCOPE_AGENT); }
__device__ __forceinline__ unsigned xb_xcc_id() { return (unsigned)__builtin_amdgcn_s_getreg((3 << 11) | 20) & 0xFu; }
#define XB_SPIN(cond, bar) do { unsigned _sp = 0; while (cond) { __builtin_amdgcn_s_sleep(1); \
    if ((++_sp & 255u) == 0u) { if (xb_ld(&(bar)[XB_TMO])) break; if (_sp > XB_SPIN_CAP) { atomicAdd(&(bar)[XB_TMO], 1u); break; } } } } while (0)

struct XcdBarrier {
    unsigned* bar; unsigned x;
    unsigned w0;
    volatile LAS unsigned* st;
};

__device__ __forceinline__ XcdBarrier xcd_barrier_post(unsigned* bar, volatile LAS unsigned* st) {
    XcdBarrier b; b.bar = bar; b.x = xb_xcc_id(); b.st = st; b.w0 = (unsigned)__builtin_amdgcn_readfirstlane(threadIdx.x >> 6);
    if (threadIdx.x == 0) (void)xb_add(&bar[XB_XCNT(b.x)], 1u);
    return b;
}
__device__ __forceinline__ void xcd_barrier_complete(unsigned* bar, unsigned x, unsigned& nloc, unsigned& nx) {
    const unsigned G = gridDim.x * gridDim.y * gridDim.z;
    unsigned sum, cnt, mine, sp = 0u;
    for (;;) {
        sum = 0u; cnt = 0u; mine = 0u;
#pragma unroll
        for (unsigned j = 0; j < 16; ++j) { const unsigned c = xb_ld(&bar[XB_XCNT(j)]); sum += c; cnt += (c > 0u) ? 1u : 0u; mine = (j == x) ? c : mine; }
        if (sum == G) break;
        __builtin_amdgcn_s_sleep(1);
        if ((++sp & 255u) == 0u) { if (xb_ld(&bar[XB_TMO])) break; if (sp > XB_SPIN_CAP) { atomicAdd(&bar[XB_TMO], 1u); break; } }
    }
    nloc = mine > 0u ? mine : 1u; nx = cnt > 0u ? cnt : 1u;
}

__device__ __forceinline__ void xcd_barrier(const XcdBarrier& b) {
    asm volatile("s_waitcnt vmcnt(0)" ::: "memory");
    __syncthreads();
    unsigned xb_lane; asm volatile("v_mbcnt_lo_u32_b32 %0, -1, 0\n\tv_mbcnt_hi_u32_b32 %0, -1, %0" : "=v"(xb_lane));
    if (b.w0 == 0u && xb_lane == 0u) {
        unsigned* bar = b.bar;
        __builtin_amdgcn_s_waitcnt(0);
        unsigned nloc = b.st[0], nx = b.st[1];
        if (nloc == 0u) { xcd_barrier_complete(bar, b.x, nloc, nx); b.st[0] = nloc; b.st[1] = nx; }
        const unsigned old = xb_add(&bar[XB_XSUB(b.x)], 1u);
        const unsigned gen = old / nloc;
        if (old + 1u == (gen + 1u) * nloc) {
            __builtin_amdgcn_fence(__ATOMIC_RELEASE, "agent");
            asm volatile("s_waitcnt vmcnt(0)" ::: "memory");
            const unsigned og = xb_add(&bar[XB_TOP], 1u);
            const unsigned tg = og / nx;
            if (og + 1u == (tg + 1u) * nx) xb_add(&bar[XB_TOPGEN], 1u);
            else XB_SPIN(xb_ld(&bar[XB_TOPGEN]) == tg, bar);
            __builtin_amdgcn_fence(__ATOMIC_ACQUIRE, "agent");
            xb_add(&bar[XB_XGEN(b.x)], 1u);
            asm volatile("s_waitcnt vmcnt(0)" ::: "memory");
        } else {
            XB_SPIN(xb_ld(&bar[XB_XGEN(b.x)]) == gen, bar);
            __builtin_amdgcn_fence(__ATOMIC_ACQUIRE, "agent");
            asm volatile("s_waitcnt vmcnt(0)" ::: "memory");
        }
    }
    __syncthreads();
}
constexpr int NWAVES = 8;
constexpr int D = 2048, FF = 5632, NFF2 = 2 * FF, NQKV = 18432, NHY = 6144, DEPTH = 4;
constexpr int T_PROMPT = 4 * 8192, T = 49152;
constexpr float LN_EPS = 1e-5f;
constexpr float QSCALE = 0.12751743082459868f;
constexpr float LOG2E = 1.4426950408889634f;
constexpr float MIN_DECAY = -3.0701134573253946f, MAX_DECAY = -15.350567286626973f;

constexpr size_t MiB = 1u << 20;
constexpr size_t WS_CTL = 0, CTL_ZERO_BYTES = 64 * 1024;
constexpr size_t WS_IDG = 1 * MiB, WS_IDB = 1 * MiB + 32768, WS_DUMP = 1 * MiB + 32768 + 131072;
constexpr size_t WS_CD = 2 * MiB;
constexpr size_t WS_STATS = 3 * MiB;
constexpr size_t WS_H2T = 4 * MiB;
constexpr size_t WS_PART = 8 * MiB;
constexpr size_t WS_W = 32 * MiB;
constexpr size_t W_IN1 = WS_W, W_OUT1 = W_IN1 + 44 * MiB, W_IN2 = W_OUT1 + 22 * MiB, W_OUT2 = W_IN2 + 44 * MiB, W_MIN = W_OUT2 + 22 * MiB, W_MOUT = W_MIN + 72 * MiB;
constexpr size_t WS_ZB = W_MOUT + 8 * MiB;
constexpr size_t WS_BIG = WS_ZB + 192 * MiB;
constexpr size_t BIG_HID = 0;
constexpr size_t BIG_QKV = 0, BIG_AO = 1728 * MiB;
constexpr size_t BIG_U = 0, BIG_Z2T = 0, BIG_Z2 = 192 * MiB, BIG_UT = 576 * MiB, BIG_SPEC0 = 1152 * MiB, BIG_SPEC1 = 1664 * MiB;
constexpr size_t WS_TAPS = WS_BIG + 1920 * MiB;
constexpr size_t WS_H2B = WS_TAPS + 320 * MiB, WS_W3T = WS_H2B + 6 * MiB;
constexpr size_t WS_ZL = WS_W3T + 4 * MiB;
constexpr size_t WS_END = WS_ZL + 48 * MiB;
static_assert(WS_ZB == 244 * MiB && WS_BIG == 436 * MiB && (size_t)T * 64 * 8 <= 24 * MiB && WS_END <= 2816 * MiB && (size_t)8192 * 10240 * 4 <= 320 * MiB, "ws map");
static_assert((size_t)T * FF * 2 <= 528 * MiB && (size_t)T * NQKV * 2 <= 1728 * MiB && (size_t)T * NHY * 2 <= 576 * MiB && BIG_SPEC1 + 128 * MiB <= 1920 * MiB, "ws map");

constexpr int RING_OFF = 0;
constexpr int FFT_BYTES = (16384 + 512) * 8;
constexpr int SCR_OFF = FFT_BYTES;
constexpr int MISC_OFF = SCR_OFF + 1024;
constexpr int PTR_OFF = MISC_OFF + 256;
constexpr int EPI_OFF = PTR_OFF + 256;
constexpr int LDS_BYTES = EPI_OFF + 4096;

#define GAS __attribute__((address_space(1)))
#define LAS __attribute__((address_space(3)))
typedef unsigned short bf16;
typedef unsigned v4u __attribute__((ext_vector_type(4)));
typedef unsigned v2u __attribute__((ext_vector_type(2)));
typedef float f32x4 __attribute__((ext_vector_type(4)));
typedef float f32x2 __attribute__((ext_vector_type(2)));
typedef float f32x16 __attribute__((ext_vector_type(16)));
typedef short bf16x8 __attribute__((ext_vector_type(8)));
typedef short s16x4 __attribute__((ext_vector_type(4)));
#define LDS_WAIT() asm volatile("s_waitcnt lgkmcnt(0)" ::: "memory")
#define VM_WAIT() asm volatile("s_waitcnt vmcnt(0)" ::: "memory")
__device__ __forceinline__ unsigned f2bf(float f) { unsigned u = __builtin_bit_cast(unsigned, f); return (u + 0x7fffu + ((u >> 16) & 1u)) >> 16; }
__device__ __forceinline__ unsigned pk2(float lo, float hi) { return f2bf(lo) | (f2bf(hi) << 16); }
__device__ __forceinline__ float bf2f(unsigned b) { return __builtin_bit_cast(float, b << 16); }
__device__ __forceinline__ float bfround(float f) { return bf2f(f2bf(f)); }

#ifndef FFT_HD
#define FFT_HD __host__ __device__ __forceinline__
#endif
#if defined(__clang__)
typedef float cpx __attribute__((ext_vector_type(2)));
#else
struct cpx { float x, y; };
#endif
#if defined(__HIP_DEVICE_COMPILE__)
#define FFT_PK2(name, T2, C2, I1, I2) \
    __device__ __forceinline__ cpx name(cpx a, T2 b) { cpx t, r; asm(I1 : "=v"(t) : "v"(a), C2(b)); asm(I2 : "=v"(r) : "v"(a), C2(b), "v"(t)); return r; }
FFT_PK2(cmul,  cpx, "v", "v_pk_mul_f32 %0, %1, %2 op_sel:[0,0] op_sel_hi:[1,0]", "v_pk_fma_f32 %0, %1, %2, %3 op_sel:[1,1,0] op_sel_hi:[0,1,1] neg_lo:[1,0,0]")
FFT_PK2(cmulc, cpx, "v", "v_pk_mul_f32 %0, %1, %2 op_sel:[0,0] op_sel_hi:[1,0]", "v_pk_fma_f32 %0, %1, %2, %3 op_sel:[1,1,0] op_sel_hi:[0,1,1] neg_hi:[1,0,0]")
FFT_PK2(cmul_k,  cpx, "s", "v_pk_mul_f32 %0, %1, %2 op_sel:[0,0] op_sel_hi:[1,0]", "v_pk_fma_f32 %0, %1, %2, %3 op_sel:[1,1,0] op_sel_hi:[0,1,1] neg_lo:[1,0,0]")
FFT_PK2(cmulc_k, cpx, "s", "v_pk_mul_f32 %0, %1, %2 op_sel:[0,0] op_sel_hi:[1,0]", "v_pk_fma_f32 %0, %1, %2, %3 op_sel:[1,1,0] op_sel_hi:[0,1,1] neg_hi:[1,0,0]")
#define FFT_PK1(name, I1) __device__ __forceinline__ cpx name(cpx u, cpx v) { cpx r; asm(I1 : "=v"(r) : "v"(u), "v"(v)); return r; }
FFT_PK1(sub_mi, "v_pk_add_f32 %0, %1, %2 op_sel:[1,1] op_sel_hi:[0,0] neg_lo:[0,1] neg_hi:[1,0]")
FFT_PK1(add_iv, "v_pk_add_f32 %0, %1, %2 op_sel:[0,1] op_sel_hi:[1,0] neg_lo:[0,1]")
FFT_PK1(sub_iv, "v_pk_add_f32 %0, %1, %2 op_sel:[0,1] op_sel_hi:[1,0] neg_hi:[0,1]")
#else
FFT_HD cpx cmul(cpx a, cpx b) { return cpx{a.x * b.x - a.y * b.y, a.x * b.y + a.y * b.x}; }
FFT_HD cpx cmulc(cpx a, cpx b) { return cpx{a.x * b.x + a.y * b.y, a.y * b.x - a.x * b.y}; }
FFT_HD cpx cmul_k(cpx a, cpx b) { return cmul(a, b); }
FFT_HD cpx cmulc_k(cpx a, cpx b) { return cmulc(a, b); }
FFT_HD cpx sub_mi(cpx u, cpx v) { return cpx{u.y - v.y, v.x - u.x}; }
FFT_HD cpx add_iv(cpx u, cpx v) { return cpx{u.x - v.y, u.y + v.x}; }
FFT_HD cpx sub_iv(cpx u, cpx v) { return cpx{u.x + v.y, u.y - v.x}; }
#endif
#if defined(__clang__)
FFT_HD cpx cadd(cpx a, cpx b) { return a + b; }
FFT_HD cpx csub(cpx a, cpx b) { return a - b; }
#else
FFT_HD cpx cadd(cpx a, cpx b) { return cpx{a.x + b.x, a.y + b.y}; }
FFT_HD cpx csub(cpx a, cpx b) { return cpx{a.x - b.x, a.y - b.y}; }
#endif
FFT_HD int pidx(int i) { return i + (i >> 5); }
FFT_HD cpx cis_neg_rev(float rev) {
    const float x8 = rev * 8.0f; int oct = (int)x8; oct = oct > 7 ? 7 : oct; const float f = x8 - (float)oct;
    const float a = (oct & 1) ? (1.0f - f) : f, phi = a * 0.78539816339744831f, p2 = phi * phi;
    const float s = phi * (1.0f + p2 * (-1.6666666666666666e-1f + p2 * (8.3333333333333332e-3f + p2 * (-1.9841269841269841e-4f + p2 * 2.7557319223985893e-6f))));
    const float c = 1.0f + p2 * (-0.5f + p2 * (4.1666666666666664e-2f + p2 * (-1.3888888888888889e-3f + p2 * (2.4801587301587302e-5f + p2 * -2.7557319223985888e-7f))));
    const bool sw = ((oct + 1) & 2) != 0;
    float cc = sw ? s : c, ss = sw ? c : s;
    if (oct >= 2 && oct <= 5) cc = -cc;
    if (oct >= 4) ss = -ss;
    return cpx{cc, -ss};
}
FFT_HD float sin_acc(float x) { float rev = x * 0.15915494309189535f; rev -= floorf(rev); const cpx e = cis_neg_rev(rev); return -e.y; }
FFT_HD float cos_rev(float rev) { rev -= floorf(rev); return cis_neg_rev(rev).x; }
FFT_HD float sin_rev(float rev) { rev -= floorf(rev); return -cis_neg_rev(rev).y; }
FFT_HD cpx w16(int k) {
    constexpr float C1 = 0.92387953251128674f, S1 = 0.38268343236508977f, R2 = 0.70710678118654752f;
    switch (k) { case 0: return cpx{1.f, 0.f}; case 1: return cpx{C1, -S1}; case 2: return cpx{R2, -R2}; case 3: return cpx{S1, -C1};
                 case 4: return cpx{0.f, -1.f}; case 5: return cpx{-S1, -C1}; case 6: return cpx{-R2, -R2}; default: return cpx{-C1, -S1}; }
}
template <int R> FFT_HD constexpr int bitrev(int i) { int r = 0; for (int b = 1, c = R >> 1; b < R; b <<= 1, c >>= 1) if (i & b) r |= c; return r; }
template <int K> FFT_HD void dif_bf(cpx& x, cpx& y) { const cpx u = x, v = y; x = cadd(u, v); if constexpr (K == 0) y = csub(u, v); else if constexpr (K == 4) y = sub_mi(u, v); else y = cmul_k(csub(u, v), w16(K)); }
template <int K> FFT_HD void dit_bf(cpx& x, cpx& y) { const cpx u = x, t = y; if constexpr (K == 4) { x = add_iv(u, t); y = sub_iv(u, t); } else { cpx v = t; if constexpr (K != 0) v = cmulc_k(t, w16(K)); x = cadd(u, v); y = csub(u, v); } }
template <int R> FFT_HD void dif_regs(cpx (&a)[R]);
template <> FFT_HD void dif_regs<16>(cpx (&a)[16]) {
    dif_bf<0>(a[0], a[8]); dif_bf<1>(a[1], a[9]); dif_bf<2>(a[2], a[10]); dif_bf<3>(a[3], a[11]); dif_bf<4>(a[4], a[12]); dif_bf<5>(a[5], a[13]); dif_bf<6>(a[6], a[14]); dif_bf<7>(a[7], a[15]);
    dif_bf<0>(a[0], a[4]); dif_bf<2>(a[1], a[5]); dif_bf<4>(a[2], a[6]); dif_bf<6>(a[3], a[7]); dif_bf<0>(a[8], a[12]); dif_bf<2>(a[9], a[13]); dif_bf<4>(a[10], a[14]); dif_bf<6>(a[11], a[15]);
    dif_bf<0>(a[0], a[2]); dif_bf<4>(a[1], a[3]); dif_bf<0>(a[4], a[6]); dif_bf<4>(a[5], a[7]); dif_bf<0>(a[8], a[10]); dif_bf<4>(a[9], a[11]); dif_bf<0>(a[12], a[14]); dif_bf<4>(a[13], a[15]);
    dif_bf<0>(a[0], a[1]); dif_bf<0>(a[2], a[3]); dif_bf<0>(a[4], a[5]); dif_bf<0>(a[6], a[7]); dif_bf<0>(a[8], a[9]); dif_bf<0>(a[10], a[11]); dif_bf<0>(a[12], a[13]); dif_bf<0>(a[14], a[15]);
}
template <> FFT_HD void dif_regs<4>(cpx (&a)[4]) {
    dif_bf<0>(a[0], a[2]); dif_bf<4>(a[1], a[3]);
    dif_bf<0>(a[0], a[1]); dif_bf<0>(a[2], a[3]);
}
template <int R> FFT_HD void dit_regs(cpx (&a)[R]);
template <> FFT_HD void dit_regs<16>(cpx (&a)[16]) {
    dit_bf<0>(a[0], a[1]); dit_bf<0>(a[2], a[3]); dit_bf<0>(a[4], a[5]); dit_bf<0>(a[6], a[7]); dit_bf<0>(a[8], a[9]); dit_bf<0>(a[10], a[11]); dit_bf<0>(a[12], a[13]); dit_bf<0>(a[14], a[15]);
    dit_bf<0>(a[0], a[2]); dit_bf<4>(a[1], a[3]); dit_bf<0>(a[4], a[6]); dit_bf<4>(a[5], a[7]); dit_bf<0>(a[8], a[10]); dit_bf<4>(a[9], a[11]); dit_bf<0>(a[12], a[14]); dit_bf<4>(a[13], a[15]);
    dit_bf<0>(a[0], a[4]); dit_bf<2>(a[1], a[5]); dit_bf<4>(a[2], a[6]); dit_bf<6>(a[3], a[7]); dit_bf<0>(a[8], a[12]); dit_bf<2>(a[9], a[13]); dit_bf<4>(a[10], a[14]); dit_bf<6>(a[11], a[15]);
    dit_bf<0>(a[0], a[8]); dit_bf<1>(a[1], a[9]); dit_bf<2>(a[2], a[10]); dit_bf<3>(a[3], a[11]); dit_bf<4>(a[4], a[12]); dit_bf<5>(a[5], a[13]); dit_bf<6>(a[6], a[14]); dit_bf<7>(a[7], a[15]);
}
template <> FFT_HD void dit_regs<4>(cpx (&a)[4]) {
    dit_bf<0>(a[0], a[1]); dit_bf<0>(a[2], a[3]);
    dit_bf<0>(a[0], a[2]); dit_bf<4>(a[1], a[3]);
}
template <int R> FFT_HD void twiddle_powers(cpx w1, cpx (&pw)[R]) {
    pw[0] = cpx{1.f, 0.f}; pw[1] = w1; pw[2] = cmul(w1, w1); pw[3] = cmul(pw[2], w1);
    if constexpr (R > 4) { pw[4] = cmul(pw[2], pw[2]); pw[5] = cmul(pw[4], pw[1]); pw[6] = cmul(pw[4], pw[2]); pw[7] = cmul(pw[4], pw[3]); }
    if constexpr (R > 8) { pw[8] = cmul(pw[4], pw[4]);
#pragma unroll
        for (int k = 1; k < 8; ++k) pw[8 + k] = cmul(pw[8], pw[k]); }
}
template <int R, bool INV, int LOGM, class P> FFT_HD void fft_pass(P X, int tid, int nthr) {
    constexpr int LOGR = (R == 16) ? 4 : 2, logs = LOGM - LOGR, s = 1 << logs;
    constexpr bool SHARED_TW = (s <= 512);
    cpx pw[R];
    if (logs > 0 && SHARED_TW) twiddle_powers<R>(cis_neg_rev((float)(tid & (s - 1)) * (1.0f / (float)(1 << LOGM))), pw);
#pragma unroll 2
    for (int blk = tid; blk < 16384 / R; blk += nthr) {
        const int base = blk & (s - 1), idx0 = ((blk >> logs) << LOGM) + base;
        P X0 = X + pidx(idx0);
        cpx a[R];
        if (logs > 0 && !SHARED_TW) twiddle_powers<R>(cis_neg_rev((float)base * (1.0f / (float)(1 << LOGM))), pw);
        if (!INV) {
#pragma unroll
            for (int j = 0; j < R; ++j) a[j] = X0[j * s + ((j * s) >> 5)];
            dif_regs<R>(a);
#pragma unroll
            for (int i = 0; i < R; ++i) { const int k1 = bitrev<R>(i); cpx v = a[i]; if (logs > 0 && k1 != 0) v = cmul(v, pw[k1]); X0[k1 * s + ((k1 * s) >> 5)] = v; }
        } else {
#pragma unroll
            for (int i = 0; i < R; ++i) { const int k1 = bitrev<R>(i); cpx v = X0[k1 * s + ((k1 * s) >> 5)]; if (logs > 0 && k1 != 0) v = cmulc(v, pw[k1]); a[i] = v; }
            dit_regs<R>(a);
#pragma unroll
            for (int j = 0; j < R; ++j) X0[j * s + ((j * s) >> 5)] = a[j];
        }
    }
}
template <int R, int NB, class HP> FFT_HD void fft_mid_load(HP H, int tid, int nthr, int nmask, cpx (&h)[NB][R]) {
#pragma unroll
    for (int b = 0; b < NB; ++b) { const int p0 = ((tid + b * nthr) * R) & nmask;
#pragma unroll
        for (int k = 0; k < R; ++k) h[b][k] = H[p0 + k]; }
}
template <int R, int NB, class P> FFT_HD void fft_mid_apply(P X, const cpx (&h)[NB][R], int tid, int nthr) {
#pragma unroll
    for (int b = 0; b < NB; ++b) { P X0 = X + pidx((tid + b * nthr) * R); cpx a[R];
#pragma unroll
        for (int j = 0; j < R; ++j) a[j] = X0[j];
        dif_regs<R>(a);
#pragma unroll
        for (int i = 0; i < R; ++i) a[i] = cmul(a[i], h[b][bitrev<R>(i)]);
        dit_regs<R>(a);
#pragma unroll
        for (int j = 0; j < R; ++j) X0[j] = a[j]; }
}
template <int LOGN> FFT_HD int mirror_pos(int p) {
    if (LOGN == 14) { const int k = (p >> 10) | (((p >> 6) & 15) << 4) | (((p >> 2) & 15) << 8) | ((p & 3) << 12), km = (16384 - k) & 16383;
                      return ((km & 15) << 10) | (((km >> 4) & 15) << 6) | (((km >> 8) & 15) << 2) | (km >> 12); }
    else { const int k = (p >> 8) | (((p >> 4) & 15) << 4) | ((p & 15) << 8), km = (4096 - k) & 4095;
           return ((km & 15) << 8) | (((km >> 4) & 15) << 4) | (km >> 8); }
}
FFT_HD void split_two_real(cpx A, cpx B, cpx& H0, cpx& H1) { H0 = cpx{0.5f * (A.x + B.x), 0.5f * (A.y - B.y)}; H1 = cpx{0.5f * (A.y + B.y), 0.5f * (B.x - A.x)}; }
struct Frame {
    LAS unsigned char* lds;
    int tid, lane, wave;
    int vcu, G, bx;
    unsigned char* ws; float* z;
};
__device__ __forceinline__ Frame make_frame(unsigned char* lds_generic, unsigned char* ws, float* out, int wave0) {
    Frame F;
    int lane; asm volatile("v_mbcnt_lo_u32_b32 %0, -1, 0\n\tv_mbcnt_hi_u32_b32 %0, -1, %0" : "=v"(lane));
    int bx = blockIdx.x, G = gridDim.x;
    asm volatile("" : "+v"(lane)); asm volatile("" : "+s"(bx)); asm volatile("" : "+s"(G)); asm volatile("" : "+s"(wave0));
    const int tid = wave0 * 64 + lane;
    unsigned long long w = (unsigned long long)ws, o = (unsigned long long)out; asm volatile("" : "+s"(w)); asm volatile("" : "+s"(o));
    F.lds = (LAS unsigned char*)lds_generic;
    F.tid = tid; F.lane = lane; F.wave = wave0;
    F.G = G; F.bx = bx; F.vcu = (G % 8 == 0) ? (bx % 8) * (G / 8) + bx / 8 : bx;
    F.ws = (unsigned char*)(GAS unsigned char*)w; F.z = (float*)(GAS float*)o;
    return F;
}
__device__ __forceinline__ const float* inp(const Frame& F, int i) {
    const LAS unsigned* t = (const LAS unsigned*)(F.lds + PTR_OFF) + 2 * i;
    const unsigned lo = __builtin_amdgcn_readfirstlane(t[0]), hi = __builtin_amdgcn_readfirstlane(t[1]);
    return (const float*)(const GAS float*)(((unsigned long long)hi << 32) | lo);
}
__device__ __forceinline__ float wave_sum(float v) { return pg8::wave_sum64(v); }
__device__ __forceinline__ void block_sum2(Frame& F, float& a, float& b) {
    LAS float* scr = (LAS float*)(F.lds + SCR_OFF);
    a = wave_sum(a); b = wave_sum(b);
    __syncthreads();
    if (F.lane == 0) { scr[F.wave * 2] = a; scr[F.wave * 2 + 1] = b; }
    __syncthreads();
    float sa = 0.f, sb = 0.f;
#pragma unroll
    for (int w = 0; w < NWAVES; ++w) { sa += scr[w * 2]; sb += scr[w * 2 + 1]; }
    a = sa; b = sb;
}

__device__ __forceinline__ void phase_init(Frame& F) {
    const int gw = F.vcu * NWAVES + F.wave, NGW = F.G * NWAVES;
    bf16* zb = (bf16*)(F.ws + WS_ZB); float* stats = (float*)(F.ws + WS_STATS);
    const float* x0 = inp(F, 0); const float* x1 = inp(F, 1);
    for (int m = gw; m < T; m += NGW) {
        const float* src = (m < T_PROMPT) ? x0 + (size_t)m * D : x1 + (size_t)(m - T_PROMPT) * D;
        const GAS f32x4* s4 = (const GAS f32x4*)src + F.lane; GAS v2u* b4 = (GAS v2u*)(zb + (size_t)m * D) + F.lane; GAS unsigned short* l4 = (GAS unsigned short*)(F.ws + WS_ZL) + (size_t)m * (D / 4) + F.lane;
#pragma unroll
        for (int j = 0; j < 8; ++j) { const f32x4 v = s4[64 * j];
            v2u o; o.x = (pg8::z20_zb(v.x) >> 16) | (pg8::z20_zb(v.y) & 0xffff0000u); o.y = (pg8::z20_zb(v.z) >> 16) | (pg8::z20_zb(v.w) & 0xffff0000u); b4[64 * j] = o;
            l4[64 * j] = (unsigned short)((pg8::z20_c(v.x, 0) | pg8::z20_c(v.y, 1)) | (pg8::z20_c(v.z, 2) | pg8::z20_c(v.w, 3))); }
        if (F.lane == 0) { stats[2 * m] = 0.f; stats[2 * m + 1] = 1.f; }
    }
    const int gt = F.vcu * (NWAVES * 64) + F.tid;
    if (gt < 8192) ((float*)(F.ws + WS_IDG))[gt] = 1.f;
    if (gt < 32768) ((float*)(F.ws + WS_IDB))[gt] = 0.f;
}

struct ConvJob { const float* W; int K, N; bf16* WT; const float* gk; const float* bk; float* cvec; float* dvec; const float* ebias; int mode; };
__device__ __forceinline__ void conv_item(const float* W, int K, int N, bf16* WT, const float* gk, const float* bk, float* cvec, float* dvec, const float* ebias, int mode, int nb, int kbeg, int kend, LAS float* scr, int lane) {
    const int n0 = 32 * nb;
    const float colscale = (mode == 2 && n0 < 6144) ? QSCALE : 1.0f;
    int rbase = n0;
    if (mode == 1) { rbase = (n0 < FF) ? (n0 / 128) * 256 + (n0 % 128) : ((n0 - FF) / 128) * 256 + 128 + ((n0 - FF) % 128); }
    float cs[32], ds[32];
#pragma unroll
    for (int i = 0; i < 32; ++i) { cs[i] = 0.f; ds[i] = 0.f; }
    f32x4 wv[8], wn[8];
    const float* wp = W + (size_t)(kbeg + lane) * N + n0;
#pragma unroll
    for (int j = 0; j < 8; ++j) wv[j] = *(const GAS f32x4*)(wp + 4 * j);
    float g = gk[kbeg + lane], b = bk[kbeg + lane];
    bf16* op = WT + (size_t)rbase * K + lane;
    for (int k0 = kbeg; k0 < kend; k0 += 64) {
        const int k1 = (k0 + 64 < kend) ? k0 + 64 : k0;
        const float* wq = W + (size_t)(k1 + lane) * N + n0;
#pragma unroll
        for (int j = 0; j < 8; ++j) wn[j] = *(const GAS f32x4*)(wq + 4 * j);
        const float gnx = gk[k1 + lane], bnx = bk[k1 + lane];
#pragma unroll
        for (int j = 0; j < 8; ++j)
#pragma unroll
            for (int e = 0; e < 4; ++e) { const int i = 4 * j + e; const float w = wv[j][e] * colscale; const unsigned vb = f2bf(w * g); const float v = bf2f(vb);
                cs[i] += v; ds[i] += b * w; op[(size_t)i * K + k0] = (bf16)vb; }
#pragma unroll
        for (int j = 0; j < 8; ++j) wv[j] = wn[j];
        g = gnx; b = bnx;
    }
    float myc = 0.f, myd = 0.f;
#pragma unroll
    for (int i = 0; i < 32; ++i) { const float c = wave_sum(cs[i]), d = wave_sum(ds[i]); myc = (lane == i) ? c : myc; myd = (lane == i) ? d : myd; }
    if (lane < 32) { cvec[rbase + lane] = myc; dvec[rbase + lane] = myd + ebias[n0 + lane]; }
}
__device__ __forceinline__ void filt_pos(Frame& F, int jl, int var, int t) {
    const int L = var ? 2048 : 8192, lane = F.lane;
    const float* w1 = inp(F, 12) + (size_t)jl * 33 * 64; const float* b1 = inp(F, 13) + jl * 64; const float* w2 = inp(F, 14) + (size_t)jl * 64 * 64; const float* b2 = inp(F, 15) + jl * 64; const float* fr = inp(F, 16) + jl * 64;
    float feat = 0.f;
    if (lane == 0) feat = (float)t / (float)(L - 1);
    else if (lane < 33) { const int bi = (lane - 1) & 15; const float band = 1e-4f + (float)bi * ((15.0f - 1e-4f) / 15.0f); const float rev = band * ((float)t / (float)L);
        feat = (lane < 17) ? cos_rev(rev) : -sin_rev(rev); }
    float acc = b1[lane];
    for (int k = 0; k < 33; ++k) acc += __builtin_bit_cast(float, __builtin_amdgcn_readlane(__builtin_bit_cast(int, feat), k)) * w1[k * 64 + lane];
    const float fq = fr[lane];
    const float h1 = sin_acc(fq * acc);
    float acc2 = b2[lane];
    for (int k = 0; k < 64; ++k) acc2 += __builtin_bit_cast(float, __builtin_amdgcn_readlane(__builtin_bit_cast(int, h1), k)) * w2[k * 64 + lane];
    const float h2 = sin_acc(fq * acc2);
    bf16* hrow = (bf16*)(F.ws + WS_H2B) + (size_t)((var ? 8192 : 0) + t) * 256;
    hrow[lane] = (bf16)f2bf(h2); hrow[64 + lane] = 0; hrow[128 + lane] = 0; hrow[192 + lane] = 0;
}
__device__ __forceinline__ void phase_convert(Frame& F, int layer) {
    LAS float* scr = (LAS float*)(F.lds + RING_OFF + F.wave * 16384);
    const int gw = F.vcu * NWAVES + F.wave, NGW = F.G * NWAVES;
    const int jl = layer >> 1; const bool hy = (layer & 1) != 0;
    const float* ln_g = inp(F, 2); const float* ln_b = inp(F, 3);
    const float* ones = (const float*)(F.ws + WS_IDG); const float* zeros = (const float*)(F.ws + WS_IDB); float* dump = (float*)(F.ws + WS_DUMP);
    float* cd = (float*)(F.ws + WS_CD);
    float* c1 = cd, *d1 = cd + NFF2, *cm = cd + 2 * NFF2, *dm = cm + NQKV, *c2 = dm + NQKV, *d2 = c2 + NFF2;
    const int nb1 = (D / 32) * 4, nb0 = NFF2 / 32, nb4 = (hy ? NHY : NQKV) / 32, nb5 = D / 32;
    const int total = 2 * nb1 + 2 * nb0 + nb4 + nb5;
    for (int it = gw; it < total; it += NGW) {
        int r = it;
        if (r < 2 * nb1) { const int f = r / nb1; r -= f * nb1;
            conv_item(inp(F, 5) + (size_t)(layer * 2 + f) * FF * D, FF, D, (bf16*)(F.ws + (f ? W_OUT2 : W_OUT1)), ones, zeros, dump, dump + NQKV, zeros, 0, r >> 2, (r & 3) * 1408, (r & 3) * 1408 + 1408, scr, F.lane); continue; }
        r -= 2 * nb1;
        if (r < 2 * nb0) { const int f = r / nb0; r -= f * nb0;
            const float* gk = f ? ln_g + (size_t)(layer * 3 + 1) * D : (layer ? ln_g + (size_t)((layer - 1) * 3 + 2) * D : ones);
            const float* bk = f ? ln_b + (size_t)(layer * 3 + 1) * D : (layer ? ln_b + (size_t)((layer - 1) * 3 + 2) * D : zeros);
            conv_item(inp(F, 4) + (size_t)(layer * 2 + f) * D * NFF2, D, NFF2, (bf16*)(F.ws + (f ? W_IN2 : W_IN1)), gk, bk, f ? c2 : c1, f ? d2 : d1, zeros, 1, r, 0, D, scr, F.lane); continue; }
        r -= 2 * nb0;
        if (r < nb4) {
            const float* gk = ln_g + (size_t)(layer * 3) * D; const float* bk = ln_b + (size_t)(layer * 3) * D;
            if (hy) conv_item(inp(F, 8) + (size_t)jl * D * NHY, D, NHY, (bf16*)(F.ws + W_MIN), gk, bk, cm, dm, inp(F, 9) + (size_t)jl * NHY, 0, r, 0, D, scr, F.lane);
            else conv_item(inp(F, 6) + (size_t)jl * D * NQKV, D, NQKV, (bf16*)(F.ws + W_MIN), gk, bk, cm, dm, zeros, 2, r, 0, D, scr, F.lane);
            continue; }
        r -= nb4;
        conv_item((hy ? inp(F, 19) : inp(F, 7)) + (size_t)jl * D * D, D, D, (bf16*)(F.ws + W_MOUT), ones, zeros, dump, dump + NQKV, zeros, 0, r, 0, D, scr, F.lane);
    }
    if (hy) {
        for (int p = gw; p < 8192 + 2048; p += NGW) { if (p < 8192) filt_pos(F, jl, 0, p); else filt_pos(F, jl, 1, p - 8192); }
        const float* w3 = inp(F, 17) + (size_t)jl * 64 * 8192; bf16* w3T = (bf16*)(F.ws + WS_W3T);
        for (int n = gw; n < 8192; n += NGW) { bf16* r = w3T + (size_t)n * 256; r[F.lane] = (bf16)f2bf(w3[(size_t)F.lane * 8192 + n]); r[64 + F.lane] = 0; r[128 + F.lane] = 0; r[192 + F.lane] = 0; }
    }
}

__device__ __forceinline__ void phase_finalize(Frame& F) {
    const float* part = (const float*)(F.ws + WS_PART); float* stats = (float*)(F.ws + WS_STATS);
    for (int row = F.vcu * (NWAVES * 64) + F.tid; row < T; row += F.G * NWAVES * 64) {
        const GAS f32x4* p = (const GAS f32x4*)(part + (size_t)row * 128);
        float s = 0.f, q = 0.f;
#pragma unroll 8
        for (int j = 0; j < 32; ++j) { const f32x4 v = p[j]; s += v.x + v.z; q += v.y + v.w; }
        const float mean = s * (1.0f / D); const float var = fmaxf(q * (1.0f / D) - mean * mean, 0.f);
        *(GAS f32x2*)(stats + 2 * (size_t)row) = (f32x2){mean, 1.0f / sqrtf(var + LN_EPS)};
    }
}

#ifdef DBG_CHECK
__device__ __forceinline__ void phase_check_qkv(Frame& F) {
    const int gw = F.vcu * NWAVES + F.wave, NGW = F.G * NWAVES;
    const float* W = inp(F, 6); const float* g = inp(F, 2); const float* b = inp(F, 3);
    const float* stats = (const float*)(F.ws + WS_STATS); const bf16* QKV = (const bf16*)(F.ws + WS_BIG + BIG_QKV);
#ifndef DBG_ROW0
#define DBG_ROW0 0
#define DBG_ROW1 T
#endif
#ifndef DBG_COL0
#define DBG_COL0 0
#define DBG_COL1 NQKV
#endif
    float worst = 0.f; unsigned nbad = 0;
#ifdef CHK_ROWS
    {
        const bf16* zbp = (const bf16*)(F.ws + WS_ZB);
        for (int s = gw; s < 8192; s += NGW) {
            const unsigned hsh = (unsigned)s * 2654435761u; const int row = (int)(hsh % (unsigned)T);
            float sm = 0.f, sq = 0.f, dz = 0.f;
            for (int k = F.lane; k < D; k += 64) { const float v = F.z[(size_t)row * D + k]; sm += v; sq += v * v; dz = fmaxf(dz, fabsf(bf2f(zbp[(size_t)row * D + k]) - v)); }
            sm = wave_sum(sm); sq = wave_sum(sq); dz = fmaxf(dz, pg8::xor32_max(dz)); dz = fmaxf(dz, pg8::swz_xor<16>(dz)); dz = fmaxf(dz, pg8::swz_xor<8>(dz)); dz = fmaxf(dz, pg8::swz_xor<4>(dz)); dz = fmaxf(dz, pg8::swz_xor<2>(dz)); dz = fmaxf(dz, pg8::swz_xor<1>(dz));
            const float mean = sm * (1.0f / D), var = sq * (1.0f / D) - mean * mean, rstd = 1.0f / sqrtf(var + LN_EPS);
            const bool bad = (CHK_ROWS == 1) ? (fabsf(mean - stats[2 * row]) > CHK_MTOL || fabsf(rstd - stats[2 * row + 1]) > CHK_RTOL * rstd) : (dz > 0.05f);
            nbad += bad ? 1u : 0u;
        }
        if (F.lane == 0 && nbad) atomicAdd((unsigned*)(F.ws + WS_CTL) + 15000, nbad);
        return;
    }
#endif
    for (int s = gw; s < 8192; s += NGW) {
        const unsigned hsh = (unsigned)s * 2654435761u; const int row = DBG_ROW0 + (int)(hsh % (unsigned)(DBG_ROW1 - DBG_ROW0)), col = DBG_COL0 + (int)((hsh >> 7) % (unsigned)(DBG_COL1 - DBG_COL0));
#ifdef CHK_HYP
        const float mean = 0.f, rstd = 1.f;
#else
        const float mean = stats[2 * row], rstd = stats[2 * row + 1];
#endif
        float acc = 0.f;
        for (int k = F.lane; k < D; k += 64) acc += ((F.z[(size_t)row * D + k] - mean) * rstd * g[k] + b[k]) * W[(size_t)k * NQKV + col];
        acc = wave_sum(acc) * (col < 6144 ? QSCALE : 1.0f);
        const float got = bf2f(QKV[(size_t)row * NQKV + col]);
        worst = fmaxf(worst, fabsf(got - acc)); nbad += (fabsf(got - acc) > DBG_THR) ? 1u : 0u;
    }
#ifdef DBG_COUNT
    if (F.lane == 0 && nbad) atomicAdd((unsigned*)(F.ws + WS_CTL) + 15000, nbad);
#else
    if (F.lane == 0) atomicMax((unsigned*)(F.ws + WS_CTL) + 15000, __builtin_bit_cast(unsigned, worst));
#endif
}
#endif
__device__ __forceinline__ void phase_final_ln(Frame& F) {
    const int gw = F.vcu * NWAVES + F.wave, NGW = F.G * NWAVES;
    const float* g = inp(F, 2) + (size_t)(3 * 3 + 2) * D; const float* b = inp(F, 3) + (size_t)(3 * 3 + 2) * D;
    for (int m = gw; m < T; m += NGW) {
        GAS f32x4* d4 = (GAS f32x4*)(F.z + (size_t)m * D) + F.lane; const GAS f32x4* g4 = (const GAS f32x4*)g + F.lane; const GAS f32x4* b4 = (const GAS f32x4*)b + F.lane;
        f32x4 v[8]; float s = 0.f, q = 0.f;
#pragma unroll
        for (int j = 0; j < 8; ++j) {
            const v2u zr = ((const GAS v2u*)((const bf16*)(F.ws + WS_ZB) + (size_t)m * D) + F.lane)[64 * j]; const unsigned qc = ((const GAS unsigned short*)(F.ws + WS_ZL) + (size_t)m * (D / 4) + F.lane)[64 * j];
            v[j] = (f32x4){pg8::z20_dec(zr.x << 16, qc, 0), pg8::z20_dec(zr.x & 0xffff0000u, qc, 1), pg8::z20_dec(zr.y << 16, qc, 2), pg8::z20_dec(zr.y & 0xffff0000u, qc, 3)};
            s += (v[j].x + v[j].y) + (v[j].z + v[j].w); q += (v[j].x * v[j].x + v[j].y * v[j].y) + (v[j].z * v[j].z + v[j].w * v[j].w); }
        s = wave_sum(s); q = wave_sum(q);
        const float mean = s * (1.0f / D), var = fmaxf(q * (1.0f / D) - mean * mean, 0.f), rstd = 1.0f / sqrtf(var + LN_EPS);
#pragma unroll
        for (int j = 0; j < 8; ++j) d4[64 * j] = (v[j] - mean) * rstd * g4[64 * j] + b4[64 * j];
    }
}

__device__ __forceinline__ void phase_transpose(Frame& F, const bf16* src, int R, int C, bf16* dst) {
    LAS unsigned char* scr = F.lds + RING_OFF + F.wave * 16384;
    const int gw = F.vcu * NWAVES + F.wave, NGW = F.G * NWAVES, tr = R / 64, tc = C / 64, lane = F.lane;
    const size_t sp = (size_t)C, dp = (size_t)R;
    v4u cur[8], nxt[8];
    int it = gw;
    if (it < tr * tc) { const int r0 = 64 * (it / tc), c0 = 64 * (it % tc);
#pragma unroll
        for (int i = 0; i < 8; ++i) cur[i] = *(const GAS v4u*)(src + (size_t)(r0 + (lane >> 3) + 8 * i) * sp + c0 + 8 * (lane & 7)); }
    for (; it < tr * tc; it += NGW) {
        const int r0 = 64 * (it / tc), c0 = 64 * (it % tc);
        const int itn = (it + NGW < tr * tc) ? it + NGW : it;
        { const int rn = 64 * (itn / tc), cn = 64 * (itn % tc);
#pragma unroll
          for (int i = 0; i < 8; ++i) nxt[i] = *(const GAS v4u*)(src + (size_t)(rn + (lane >> 3) + 8 * i) * sp + cn + 8 * (lane & 7)); }
#pragma unroll
        for (int i = 0; i < 8; ++i) { const int row = (lane >> 3) + 8 * i, ch = lane & 7;
            LAS unsigned* w = (LAS unsigned*)(scr + row * 132 + ch * 16); w[0] = cur[i].x; w[1] = cur[i].y; w[2] = cur[i].z; w[3] = cur[i].w; }
        LDS_WAIT(); asm volatile("" ::: "memory");
        const LAS unsigned short* rd = (const LAS unsigned short*)(scr + lane * 132);
#pragma unroll 8
        for (int c = 0; c < 64; ++c) dst[(size_t)(c0 + c) * dp + r0 + lane] = rd[c];
        LDS_WAIT(); asm volatile("" ::: "memory");
#pragma unroll
        for (int i = 0; i < 8; ++i) cur[i] = nxt[i];
    }
}
template <int LOGN> __device__ __forceinline__ void fft_forward(LAS cpx* X, int tid) {
    fft_pass<16, false, LOGN>(X, tid, NWAVES * 64); __syncthreads();
    fft_pass<16, false, LOGN - 4>(X, tid, NWAVES * 64); __syncthreads();
    fft_pass<16, false, LOGN - 8>(X, tid, NWAVES * 64); __syncthreads();
    if constexpr (LOGN == 14) { fft_pass<4, false, 2>(X, tid, NWAVES * 64); __syncthreads(); }
}
template <int LOGN> __device__ __forceinline__ void fft_inverse(LAS cpx* X, int tid) {
    if constexpr (LOGN == 14) { fft_pass<4, true, 2>(X, tid, NWAVES * 64); __syncthreads(); }
    fft_pass<16, true, LOGN - 8>(X, tid, NWAVES * 64); __syncthreads();
    fft_pass<16, true, LOGN - 4>(X, tid, NWAVES * 64); __syncthreads();
    fft_pass<16, true, LOGN>(X, tid, NWAVES * 64); __syncthreads();
}
template <int LOGN> __device__ __forceinline__ void conv_fft(LAS cpx* X, const GAS cpx* H, int tid) {
    constexpr int R = (LOGN == 14) ? 4 : 16, NB = 16384 / R / (NWAVES * 64);
    fft_pass<16, false, LOGN>(X, tid, NWAVES * 64); __syncthreads();
    if constexpr (LOGN == 14) { fft_pass<16, false, LOGN - 4>(X, tid, NWAVES * 64); __syncthreads(); }
    cpx h[NB][R];
    fft_mid_load<R, NB>(H, tid, NWAVES * 64, (1 << LOGN) - 1, h);
    fft_pass<16, false, (LOGN == 14) ? LOGN - 8 : LOGN - 4>(X, tid, NWAVES * 64); __syncthreads();
    fft_mid_apply<R, NB>(X, h, tid, NWAVES * 64); __syncthreads();
}
template <int LOGN> __device__ __forceinline__ void fft_tail(LAS cpx* X, int tid) {
    if constexpr (LOGN == 14) { fft_pass<16, true, LOGN - 8>(X, tid, NWAVES * 64); __syncthreads(); }
    fft_pass<16, true, LOGN - 4>(X, tid, NWAVES * 64); __syncthreads();
    fft_pass<16, true, LOGN>(X, tid, NWAVES * 64); __syncthreads();
}
template <int VAR> __device__ __forceinline__ void spec_unit(Frame& F, int jl, int c) {
    constexpr int L = VAR ? 2048 : 8192, N = 2 * L, LOGN = VAR ? 12 : 14, TPS = VAR ? 128 : 512, NP = L / TPS;
    LAS cpx* X = (LAS cpx*)(F.lds + RING_OFF);
    int tid = F.tid; asm volatile("" : "+v"(tid));
    const int seg = tid / TPS, lt = tid % TPS, ch = c + seg;
    const float* taps = (const float*)(F.ws + WS_TAPS) + (size_t)ch * 10240 + (VAR ? 8192 : 0);
    float acc[NP][4];
    float n0 = 0.f, n1 = 0.f;
#pragma unroll
    for (int k = 0; k < NP; ++k) {
#pragma unroll
        for (int f = 0; f < 4; ++f) acc[k][f] = taps[(size_t)f * 2048 * 10240 + lt + TPS * k];
        n0 += fabsf(acc[k][0]) + fabsf(acc[k][1]); n1 += fabsf(acc[k][2]) + fabsf(acc[k][3]); }
    if (VAR == 0) block_sum2(F, n0, n1);
    else {
        LAS float* scr = (LAS float*)(F.lds + SCR_OFF);
        n0 = wave_sum(n0); n1 = wave_sum(n1);
        __syncthreads();
        if (F.lane == 0) { scr[F.wave * 2] = n0; scr[F.wave * 2 + 1] = n1; }
        __syncthreads();
        n0 = scr[4 * seg] + scr[4 * seg + 2]; n1 = scr[4 * seg + 1] + scr[4 * seg + 3];
    }
    const float i0 = 1.0f / n0, i1 = 1.0f / n1;
    __syncthreads();
#pragma unroll
    for (int k = 0; k < NP; ++k) { const int t = lt + TPS * k; const cpx hf = cpx{acc[k][0] * i0, acc[k][2] * i1}, hb = cpx{acc[k][1] * i0, acc[k][3] * i1};
        if (t == 0) { float zf = 0.f; asm volatile("" : "+v"(zf));
                      X[pidx(seg * N)] = cadd(hf, hb); X[pidx(seg * N + L)] = cpx{zf, zf}; }
        else { X[pidx(seg * N + t)] = hf; X[pidx(seg * N + N - t)] = hb; } }
    __syncthreads();
    fft_forward<LOGN>(X, tid);
    cpx* spec = (cpx*)(F.ws + WS_BIG + (VAR ? BIG_SPEC1 : BIG_SPEC0));
    GAS cpx* d0 = (GAS cpx*)(spec + ((size_t)0 * D + ch) * N); GAS cpx* d1 = (GAS cpx*)(spec + ((size_t)1 * D + ch) * N);
#pragma unroll 4
    for (int pl = lt; pl < N; pl += TPS) { cpx H0, H1; split_two_real(X[pidx(seg * N + pl)], X[pidx(seg * N + mirror_pos<LOGN>(pl))], H0, H1); d0[pl] = H0; d1[pl] = H1; }
}
__device__ __forceinline__ void phase_spectra(Frame& F, int jl) {
    for (int u = F.vcu; u < D + D / 4; u += F.G) { if (u < D) spec_unit<0>(F, jl, u); else spec_unit<1>(F, jl, 4 * (u - D)); }
    __syncthreads();
}
__device__ __forceinline__ void load_conv16(const bf16* seq, int t0, int L, float w0, float w1, float w2, float cb, float (&out)[16]) {
    const v4u a = *(const GAS v4u*)(seq + t0), b = *(const GAS v4u*)(seq + t0 + 8);
    float u[18];
    u[0] = (t0 > 0) ? bf2f(seq[t0 - 1]) : 0.f; u[17] = (t0 + 16 < L) ? bf2f(seq[t0 + 16]) : 0.f;
    u[1] = bf2f(a.x & 0xffffu); u[2] = bf2f(a.x >> 16); u[3] = bf2f(a.y & 0xffffu); u[4] = bf2f(a.y >> 16); u[5] = bf2f(a.z & 0xffffu); u[6] = bf2f(a.z >> 16); u[7] = bf2f(a.w & 0xffffu); u[8] = bf2f(a.w >> 16);
    u[9] = bf2f(b.x & 0xffffu); u[10] = bf2f(b.x >> 16); u[11] = bf2f(b.y & 0xffffu); u[12] = bf2f(b.y >> 16); u[13] = bf2f(b.z & 0xffffu); u[14] = bf2f(b.z >> 16); u[15] = bf2f(b.w & 0xffffu); u[16] = bf2f(b.w >> 16);
#pragma unroll
    for (int i = 0; i < 16; ++i) out[i] = w0 * u[i] + w1 * u[i + 1] + w2 * u[i + 2] + cb;
}
template <int VAR> __device__ __forceinline__ void conv_unit(Frame& F, int jl, int c, int pair) {
    constexpr int L = VAR ? 2048 : 8192, N = 2 * L, LOGN = VAR ? 12 : 14, TPS = VAR ? 128 : 512;
    LAS cpx* X = (LAS cpx*)(F.lds + RING_OFF);
    int tid = F.tid; asm volatile("" : "+v"(tid));
    const int seg = tid / TPS, t0 = (tid % TPS) * 16;
    const int rowA = VAR ? T_PROMPT + (2 * seg) * L : (2 * pair) * L, rowB = rowA + L;
    const bf16* UT = (const bf16*)(F.ws + WS_BIG + BIG_UT); bf16* Z2T = (bf16*)(F.ws + WS_BIG + BIG_Z2T);
    const float* cw = inp(F, 10) + (size_t)jl * 3 * NHY; const float* cbv = inp(F, 11) + (size_t)jl * NHY; const float* skip = inp(F, 18) + (size_t)jl * 2 * D;
    const cpx* spec = (const cpx*)(F.ws + WS_BIG + (VAR ? BIG_SPEC1 : BIG_SPEC0));
#ifndef CONV_SCALE
#define CONV_SCALE 1.0f
#endif
    const float invN = CONV_SCALE / (float)N;
    float va[16], vb[16];
    { const int ch = c; const float w0 = cw[ch], w1 = cw[NHY + ch], w2 = cw[2 * NHY + ch], cb = cbv[ch];
      load_conv16(UT + (size_t)ch * T + rowA, t0, L, w0, w1, w2, cb, va); load_conv16(UT + (size_t)ch * T + rowB, t0, L, w0, w1, w2, cb, vb); }
    __syncthreads();
#pragma unroll
    for (int i = 0; i < 16; ++i) { X[pidx(seg * N + t0 + i)] = cpx{va[i], vb[i]}; X[pidx(seg * N + L + t0 + i)] = cpx{0.f, 0.f}; }
    __syncthreads();
    conv_fft<LOGN>(X, (const GAS cpx*)(spec + ((size_t)0 * D + c) * N), tid);
    fft_tail<LOGN>(X, tid);
    {   float ga[16], gb[16];
        const int ch = D + c; const float w0 = cw[ch], w1 = cw[NHY + ch], w2 = cw[2 * NHY + ch], cb = cbv[ch];
        load_conv16(UT + (size_t)ch * T + rowA, t0, L, w0, w1, w2, cb, ga); load_conv16(UT + (size_t)ch * T + rowB, t0, L, w0, w1, w2, cb, gb);
        const float sk = skip[c];
#pragma unroll
        for (int i = 0; i < 16; ++i) { const cpx y = X[pidx(seg * N + t0 + i)]; va[i] = ga[i] * (y.x * invN + sk * va[i]); vb[i] = gb[i] * (y.y * invN + sk * vb[i]); }
#pragma unroll
        for (int i = 0; i < 16; ++i) { X[pidx(seg * N + t0 + i)] = cpx{va[i], vb[i]}; X[pidx(seg * N + L + t0 + i)] = cpx{0.f, 0.f}; }
    }
    __syncthreads();
    conv_fft<LOGN>(X, (const GAS cpx*)(spec + ((size_t)1 * D + c) * N), tid);
    fft_tail<LOGN>(X, tid);
    {   float ga[16], gb[16];
        const int ch = 2 * D + c; const float w0 = cw[ch], w1 = cw[NHY + ch], w2 = cw[2 * NHY + ch], cb = cbv[ch];
        load_conv16(UT + (size_t)ch * T + rowA, t0, L, w0, w1, w2, cb, ga); load_conv16(UT + (size_t)ch * T + rowB, t0, L, w0, w1, w2, cb, gb);
        const float sk = skip[D + c];
        float ra[16], rb[16];
#pragma unroll
        for (int i = 0; i < 16; ++i) { const cpx y = X[pidx(seg * N + t0 + i)]; ra[i] = ga[i] * (y.x * invN + sk * va[i]); rb[i] = gb[i] * (y.y * invN + sk * vb[i]); }
        v4u o0, o1;
        o0.x = pk2(ra[0], ra[1]); o0.y = pk2(ra[2], ra[3]); o0.z = pk2(ra[4], ra[5]); o0.w = pk2(ra[6], ra[7]); o1.x = pk2(ra[8], ra[9]); o1.y = pk2(ra[10], ra[11]); o1.z = pk2(ra[12], ra[13]); o1.w = pk2(ra[14], ra[15]);
        GAS v4u* da = (GAS v4u*)(Z2T + (size_t)c * T + rowA + t0); da[0] = o0; da[1] = o1;
        o0.x = pk2(rb[0], rb[1]); o0.y = pk2(rb[2], rb[3]); o0.z = pk2(rb[4], rb[5]); o0.w = pk2(rb[6], rb[7]); o1.x = pk2(rb[8], rb[9]); o1.y = pk2(rb[10], rb[11]); o1.z = pk2(rb[12], rb[13]); o1.w = pk2(rb[14], rb[15]);
        GAS v4u* db = (GAS v4u*)(Z2T + (size_t)c * T + rowB + t0); db[0] = o0; db[1] = o1;
    }
}
__device__ __forceinline__ void phase_conv(Frame& F, int jl) {
    for (int u = F.vcu; u < 3 * D; u += F.G) { if (u < 2 * D) conv_unit<0>(F, jl, u >> 1, u & 1); else conv_unit<1>(F, jl, u - 2 * D, 0); }
    __syncthreads();
}
__device__ __forceinline__ unsigned voff_b(unsigned row, unsigned ch) { return 256u * row + 16u * (ch ^ (((row & 3u) << 2) | ((row >> 2) & 3u))); }
__device__ __forceinline__ s16x4 vtr(const LAS unsigned char* p) { typedef short v4i16_t __attribute__((ext_vector_type(4))); return __builtin_bit_cast(s16x4, __builtin_amdgcn_ds_read_tr16_b64_v4i16((LAS v4i16_t*)p)); }
__device__ __forceinline__ unsigned cvtpk(float lo, float hi) { typedef __bf16 bf16x2_t __attribute__((ext_vector_type(2))); f32x2 v = {lo, hi}; bf16x2_t b = __builtin_convertvector(v, bf16x2_t); return __builtin_bit_cast(unsigned, b); }
__device__ __forceinline__ void dma16(const void* gsrc, LAS unsigned char* lds_dst) {
    unsigned keep; const unsigned dst = __builtin_amdgcn_readfirstlane((unsigned)(unsigned long long)lds_dst);
    asm volatile("s_mov_b32 %0, m0\n\ts_mov_b32 m0, %2\n\ts_nop 0\n\tglobal_load_lds_dwordx4 %1, off\n\ts_mov_b32 m0, %0" : "=&s"(keep) : "v"(gsrc), "s"(dst) : "memory");
}
struct TileDesc { int g, kt0; };
constexpr int ATT_NT = 28;
__device__ __forceinline__ TileDesc attn_tile(int it, int T0w) {
    TileDesc t;
    if (it < 12) { t.g = 0; t.kt0 = (T0w & ~255) - 64 + 32 * it; }
    else if (it < 18) { t.g = 1; t.kt0 = T0w - 256 + 128 * (it - 12); }
    else { const int e = it - 18, ch = e / 5, tl = e % 5; t.g = 2; t.kt0 = T0w + 8 * ch - 1024 + 512 * tl; }
    return t;
}
__device__ __forceinline__ void attn_wave_task(const bf16* QKV, bf16* AO, LAS unsigned char* ring, int blk, int h, int w, int lane) {
    LAS unsigned char* vimg = ring + w * 16384;
    const int r = lane & 31, hh = lane >> 5;
    const int T0 = blk * 256;
    int seq_start, seq_len;
    if (T0 < T_PROMPT) { seq_start = T0 & ~8191; seq_len = 8192; } else { seq_start = T_PROMPT + ((T0 - T_PROMPT) & ~2047); seq_len = 2048; }
    const int seq_end = seq_start + seq_len;
    const int T0w = T0 + w, qt = T0w + 8 * r;
    const float slope2 = __builtin_amdgcn_exp2f(-0.5f * (float)(h + 1)) * LOG2E;
    f32x16 o[4];
#pragma unroll
    for (int dt = 0; dt < 4; ++dt)
#pragma unroll
        for (int i = 0; i < 16; ++i) o[dt][i] = 0.f;
    float m_run = -1e30f, l_run = 0.f;
    bf16x8 qf[8], kf[8];
    const bf16* hb = QKV + h * 128;
    auto issue_tile = [&](const TileDesc& td, LAS unsigned char* img_dst) {
        const int d = 1 << (2 * td.g);
        const bf16* Kb = hb + 6144 + td.g * 2048; const bf16* Vb = hb + 12288 + td.g * 2048;
#pragma unroll
        for (int i = 0; i < 8; ++i) { const int row = 4 * i + (lane >> 4); int vt = td.kt0 + row * d; vt = vt < seq_start ? seq_start : (vt >= seq_end ? seq_end - 1 : vt);
            const int lch = (lane & 15) ^ (((row & 3) << 2) | ((row >> 2) & 3));
            dma16(Vb + (size_t)vt * NQKV + 8 * lch, img_dst + i * 1024); }
        int kt = td.kt0 + r * d; kt = kt < seq_start ? seq_start : (kt >= seq_end ? seq_end - 1 : kt);
        const bf16* kp = Kb + (size_t)kt * NQKV + 8 * hh;
#pragma unroll
        for (int s = 0; s < 8; ++s) kf[s] = *(const GAS bf16x8*)(kp + 16 * s);
    };
    auto load_q = [&](int g) { const bf16* qp = hb + g * 2048 + (size_t)qt * NQKV + 8 * hh;
#pragma unroll
        for (int s = 0; s < 8; ++s) qf[s] = *(const GAS bf16x8*)(qp + 16 * s); };
    auto coop_issue = [&](int t) {
        const int row = 4 * w + (lane >> 4); int vt = T0 - 64 + 32 * t + row; vt = vt < seq_start ? seq_start : (vt >= seq_end ? seq_end - 1 : vt);
        const int lck = (lane & 15) ^ (row & 15), lcv = (lane & 15) ^ (((row & 3) << 2) | ((row >> 2) & 3));
        const int sl = t % 3;
        dma16(hb + 6144 + (size_t)vt * NQKV + 8 * lck, ring + (2 * sl) * 16384 + 8192 + w * 1024);
        dma16(hb + 12288 + (size_t)vt * NQKV + 8 * lcv, ring + (2 * sl + 1) * 16384 + 8192 + w * 1024);
    };
    auto pv_tile = [&](const LAS unsigned char* img, const bf16x8 (&pb)[2]) {
        const int q4 = (lane & 15) >> 2, p4 = lane & 3, blk16 = (lane >> 4) & 1;
#pragma unroll
        for (int dt = 0; dt < 4; ++dt)
#pragma unroll
            for (int s2 = 0; s2 < 2; ++s2) {
                const unsigned chn = 4 * dt + 2 * blk16 + (p4 >> 1);
                const s16x4 lo = vtr(img + voff_b(16 * s2 + 4 * hh + q4, chn) + 8 * (p4 & 1));
                const s16x4 hi = vtr(img + voff_b(16 * s2 + 8 + 4 * hh + q4, chn) + 8 * (p4 & 1));
                const bf16x8 va = __builtin_shufflevector(lo, hi, 0, 1, 2, 3, 4, 5, 6, 7);
                o[dt] = __builtin_amdgcn_mfma_f32_32x32x16_bf16(va, pb[s2], o[dt], 0, 0, 0);
            }
    };
    TileDesc cur = attn_tile(0, T0w);
    __builtin_amdgcn_s_barrier();
    coop_issue(0);
    load_q(0);
    bf16x8 pprev[2]; const LAS unsigned char* img_prev = vimg;
#pragma unroll
    for (int s2 = 0; s2 < 2; ++s2)
#pragma unroll
        for (int e = 0; e < 8; ++e) pprev[s2][e] = 0;
    for (int it = 0; it < ATT_NT; ++it) {
        if (it < 12) {
            VM_WAIT();
            __builtin_amdgcn_s_barrier();
            if (it + 1 < 12) coop_issue(it + 1);
            const LAS unsigned char* kimg = ring + (2 * (it % 3)) * 16384 + 8192 + 256 * r;
#pragma unroll
            for (int s = 0; s < 8; ++s) kf[s] = *(const LAS bf16x8*)(kimg + 16 * ((2 * s + hh) ^ (r & 15)));
        }
        const int d = 1 << (2 * cur.g), win = 64 * d, kt0 = cur.kt0;
        f32x16 st;
#pragma unroll
        for (int i = 0; i < 16; ++i) st[i] = 0.f;
#pragma unroll
        for (int s = 0; s < 8; ++s) st = __builtin_amdgcn_mfma_f32_32x32x16_bf16(kf[s], qf[s], st, 0, 0, 0);
        if (it > 0) pv_tile(img_prev, pprev);
        if (it == 12) __builtin_amdgcn_s_barrier();
        if (it + 1 < ATT_NT) { const TileDesc nx = attn_tile(it + 1, T0w); if (nx.g != cur.g) load_q(nx.g); if (it + 1 >= 12) issue_tile(nx, vimg + ((it + 1) & 1) * 8192); cur = nx; }
        const int dl0 = kt0 + 4 * hh * d - qt;
        const bool res_ok = (dl0 & (d - 1)) == 0;
        const int lo_i = max(-win, seq_start - qt), hi_i = min(win, seq_end - 1 - qt);
        const float flo = res_ok ? (float)lo_i : 1e30f, fhi = (float)hi_i, fdl0 = (float)dl0, fd = (float)d;
        float mloc = -1e30f;
#pragma unroll
        for (int i = 0; i < 16; ++i) { const float fdl = fdl0 + (float)((i & 3) + 8 * (i >> 2)) * fd;
            const float s = st[i] - slope2 * __builtin_fabsf(fdl);
            const bool ok = (fdl >= flo) && (fdl <= fhi);
            const float sm = ok ? s : -1e30f; st[i] = sm; mloc = fmaxf(mloc, sm); }
        mloc = pg8::xor32_max(mloc);
        const bool fire = __any(mloc > m_run + 8.0f);
        const float m_new = fire ? fmaxf(m_run, mloc) : m_run;
        const float m_use = fmaxf(m_new, -1e20f);
        float ls = 0.f;
#pragma unroll
        for (int i = 0; i < 16; ++i) { const float pv = __builtin_amdgcn_exp2f(st[i] - m_use); st[i] = pv; ls += pv; }
        ls = pg8::xor32_sum(ls);
        if (fire) {
            const float alpha = __builtin_amdgcn_exp2f(m_run - m_new);
            l_run *= alpha;
#pragma unroll
            for (int dt = 0; dt < 4; ++dt)
#pragma unroll
                for (int i = 0; i < 16; ++i) o[dt][i] *= alpha;
        }
        l_run += ls; m_run = m_new;
#pragma unroll
        for (int s2 = 0; s2 < 2; ++s2) { v4u w; w.x = cvtpk(st[8 * s2 + 0], st[8 * s2 + 1]); w.y = cvtpk(st[8 * s2 + 2], st[8 * s2 + 3]); w.z = cvtpk(st[8 * s2 + 4], st[8 * s2 + 5]); w.w = cvtpk(st[8 * s2 + 6], st[8 * s2 + 7]); pprev[s2] = __builtin_bit_cast(bf16x8, w); }
        img_prev = (it < 12) ? ring + (2 * (it % 3) + 1) * 16384 + 8192 : vimg + (it & 1) * 8192;
    }
    pv_tile(img_prev, pprev);
    const float inv = 1.0f / l_run;
    bf16* op = AO + (size_t)qt * D + h * 128 + 4 * hh;
#pragma unroll
    for (int dt = 0; dt < 4; ++dt)
#pragma unroll
        for (int i4 = 0; i4 < 4; ++i4) { v2u w; w.x = cvtpk(o[dt][4 * i4] * inv, o[dt][4 * i4 + 1] * inv); w.y = cvtpk(o[dt][4 * i4 + 2] * inv, o[dt][4 * i4 + 3] * inv);
            *(GAS v2u*)(op + 32 * dt + 8 * i4) = w; }
}
__device__ __forceinline__ void phase_attention(Frame& F, int rev) {
    const bf16* QKV = (const bf16*)(F.ws + WS_BIG + BIG_QKV); bf16* AO = (bf16*)(F.ws + WS_BIG + BIG_AO);
    LAS unsigned char* vimg = F.lds + RING_OFF;
    for (int j = F.vcu; j < (T / 256) * 16; j += F.G) {
        const int jj = rev ? (T / 256) * 16 - 1 - j : j; int h = jj & 15, blk = jj >> 4;
        if (F.G == 256) { const int n = jj >> 8, x = (jj >> 5) & 7, i = jj & 31; h = 2 * x + (i & 1); blk = 16 * n + (i >> 1); }
        attn_wave_task(QKV, AO, vimg, blk, h, F.wave, F.lane);
    }
}

#ifdef ATTN_NAIVE
__device__ __forceinline__ void phase_attention_naive(Frame& F) {
    const bf16* QKV = (const bf16*)(F.ws + WS_BIG + BIG_QKV); bf16* AO = (bf16*)(F.ws + WS_BIG + BIG_AO);
    const int gw = F.vcu * NWAVES + F.wave, NGW = F.G * NWAVES, lane = F.lane;
    for (int p = gw; p < T * 16; p += NGW) {
        const int tok = p >> 4, h = p & 15;
        int seq_start, seq_len;
        if (tok < T_PROMPT) { seq_start = tok & ~8191; seq_len = 8192; } else { seq_start = T_PROMPT + ((tok - T_PROMPT) & ~2047); seq_len = 2048; }
        const int seq_end = seq_start + seq_len;
        const float slope2 = __builtin_amdgcn_exp2f(-0.5f * (float)(h + 1)) * LOG2E;
        float m = -1e30f, l = 0.f, o0 = 0.f, o1 = 0.f;
        for (int g = 0; g < 3; ++g) {
            const int d = 1 << (2 * g);
            const unsigned qw = *(const GAS unsigned*)(QKV + (size_t)tok * NQKV + g * 2048 + h * 128 + 2 * lane);
            const float q0 = bf2f(qw & 0xffffu), q1 = bf2f(qw >> 16);
            for (int j = -64; j <= 64; ++j) {
                const int kt = tok + j * d;
                if (kt < seq_start || kt >= seq_end) continue;
                const unsigned kw = *(const GAS unsigned*)(QKV + (size_t)kt * NQKV + 6144 + g * 2048 + h * 128 + 2 * lane);
                const unsigned vw = *(const GAS unsigned*)(QKV + (size_t)kt * NQKV + 12288 + g * 2048 + h * 128 + 2 * lane);
                const float s = wave_sum(q0 * bf2f(kw & 0xffffu) + q1 * bf2f(kw >> 16)) - slope2 * (float)((j < 0 ? -j : j) * d);
                const float mn = fmaxf(m, s), al = __builtin_amdgcn_exp2f(m - mn), pv = __builtin_amdgcn_exp2f(s - mn);
                l = l * al + pv; o0 = o0 * al + pv * bf2f(vw & 0xffffu); o1 = o1 * al + pv * bf2f(vw >> 16); m = mn;
            }
        }
        const float inv = 1.0f / l;
        *(GAS unsigned*)(AO + (size_t)tok * D + h * 128 + 2 * lane) = pk2(o0 * inv, o1 * inv);
    }
}
#endif
constexpr int NPHASE = 54;
#ifndef FFN1_IN_REV
#define FFN1_IN_REV 0
#endif
#ifndef FFN1_OUT_REV
#define FFN1_OUT_REV 1
#endif
#ifndef MIX_IN_REV
#define MIX_IN_REV 0
#endif
#ifndef MIX_OUT_REV
#define MIX_OUT_REV 0
#endif
#ifndef FFN2_OUT_REV
#define FFN2_OUT_REV 0
#endif
#ifndef FFN2_IN_REV
#define FFN2_IN_REV 1
#endif
#ifndef FFN_OUT_REV
#define FFN_OUT_REV 1
#endif
#ifndef WGM_QKV
#define WGM_QKV 4
#endif
#ifndef WGM_HY
#define WGM_HY 4
#endif
#ifndef WGM_E3
#define WGM_E3 4
#endif
#ifndef WGM_IN
#define WGM_IN 4
#endif
#ifndef DUP_PHASE
#define DUP_PHASE (-1)
#define DUP_N 0
#endif
#define REPS(id) for (int rep_ = 0; rep_ < ((DUP_PHASE) == (id) ? 1 + (DUP_N) : 1); ++rep_)
#ifndef ZERO_HY
#define ZERO_HY 0
#endif
#ifndef ZERO_AT
#define ZERO_AT 0
#endif
#ifndef AT_SCALE
#define AT_SCALE 1.0f
#endif
#ifndef HY_SCALE
#define HY_SCALE 1.0f
#endif
#define MIXSCALE(hy) ((hy) ? (ZERO_HY ? 0.0f : HY_SCALE) : (ZERO_AT ? 0.0f : AT_SCALE))
struct Args { const float* in[21]; float* out; unsigned char* ws; int ph_lo, ph_hi; };
static_assert(sizeof(Args) == 21 * 8 + 8 + 8 + 8, "Args has no padding");
__global__ void __launch_bounds__(NWAVES * 64, 2) fwd_kernel(Args args) {
    extern __shared__ __attribute__((aligned(16))) unsigned char lds[];
    unsigned char* const ws0 = args.ws;
    const int wave0 = __builtin_amdgcn_readfirstlane(threadIdx.x >> 6);
    volatile LAS unsigned* MISC = (volatile LAS unsigned*)((LAS unsigned char*)lds + MISC_OFF);
    if (threadIdx.x < 64) MISC[threadIdx.x] = 0u;
    if (threadIdx.x == 64) {
#pragma unroll
        for (int i = 0; i < 21; ++i) ((LAS unsigned long long*)((LAS unsigned char*)lds + PTR_OFF))[i] = (unsigned long long)args.in[i];
    }
    __syncthreads();
    XcdBarrier bar = xcd_barrier_post((unsigned*)(ws0 + WS_CTL), MISC);
#define FRAME() Frame F = make_frame(lds, args.ws, args.out, wave0)
    const int lo = args.ph_lo, hi = args.ph_hi;
#define RUN(id) (lo <= (id) && (id) < hi)
#define SEAM(id) do { if ((id) + 1 < hi) xcd_barrier(bar); } while (0)

#define ZB ((bf16*)(F.ws + WS_ZB))
#define STATS ((float*)(F.ws + WS_STATS))
#define PART ((float*)(F.ws + WS_PART))
#define CDV(off) ((float*)(F.ws + WS_CD) + (off))
#define HID ((bf16*)(F.ws + WS_BIG + BIG_HID))
    constexpr int O_C1 = 0, O_D1 = NFF2, O_CM = 2 * NFF2, O_DM = 2 * NFF2 + NQKV, O_C2 = 2 * NFF2 + 2 * NQKV, O_D2 = 3 * NFF2 + 2 * NQKV;

    if (RUN(0)) { FRAME(); phase_init(F); SEAM(0); }

#pragma unroll
    for (int layer = 0; layer < DEPTH; ++layer) {
        const int pb = 1 + 13 * layer; const bool hy = (layer & 1) != 0; const int jl = layer >> 1;
#define REVF(idx) ((7 * layer + (idx) + 1) & 1)
        if (RUN(pb + 0)) { FRAME(); REPS(0) phase_convert(F, layer); SEAM(pb + 0); }

        if (RUN(pb + 1)) {
            if (hy) {
                FRAME();
                pg8::Gemm gt{(const bf16*)(F.ws + WS_W3T), (const bf16*)(F.ws + WS_H2B), 8192, 10240, 256}; pg8::StaticOrder St; St.init(8192, 10240, F.G, F.bx);
                pg8::EpiTaps Et{(float*)(F.ws + WS_TAPS), MIN_DECAY, (MAX_DECAY - MIN_DECAY) / 2047.0f};
                pg8::gemm_phase<pg8::EpiTaps, pg8::StaticOrder, PG8_ALIGN, PG8_SP2>(F.lds + RING_OFF, gt, St, Et, F.tid);
            }
            FRAME();
            pg8::Gemm g{ZB, (const bf16*)(F.ws + W_IN1), T, NFF2, D}; pg8::StaticOrder S; S.init(T, NFF2, F.G, F.bx, FFN1_IN_REV, WGM_IN);
            pg8::EpiSwiglu E{HID, FF, STATS, CDV(O_C1), CDV(O_D1)};
            REPS(1) pg8::gemm_phase<pg8::EpiSwiglu, pg8::StaticOrder, PG8_ALIGN, PG8_SP2>(F.lds + RING_OFF, g, S, E, F.tid);
            SEAM(pb + 1);
        }
        if (RUN(pb + 2)) {
            FRAME();
            pg8::Gemm g{HID, (const bf16*)(F.ws + W_OUT1), T, D, FF}; pg8::StaticOrder S; S.init(T, D, F.G, F.bx, FFN1_OUT_REV, WGM_E3);
            const float* g0 = layer ? inp(F, 2) + (size_t)((layer - 1) * 3 + 2) * D : (const float*)(F.ws + WS_IDG); const float* b0 = layer ? inp(F, 3) + (size_t)((layer - 1) * 3 + 2) * D : (const float*)(F.ws + WS_IDB);
            pg8::EpiResid E{(unsigned*)(F.ws + WS_ZL), ZB, STATS, g0, b0, (const float*)(F.ws + WS_IDB), PART, 0.5f, (LAS float*)(F.lds + EPI_OFF)};
            pg8::gemm_phase<pg8::EpiResid, pg8::StaticOrder, PG8_ALIGN, PG8_SP2>(F.lds + RING_OFF, g, S, E, F.tid);
            SEAM(pb + 2);
        }
        if (RUN(pb + 3)) { FRAME(); REPS(3) phase_finalize(F); SEAM(pb + 3); }

        if (RUN(pb + 4)) {
            if (!hy) { FRAME();
                pg8::Gemm g{ZB, (const bf16*)(F.ws + W_MIN), T, NQKV, D}; pg8::StaticOrder S; S.init(T, NQKV, F.G, F.bx, MIX_IN_REV, WGM_QKV);
                pg8::EpiLnBf16 E{(bf16*)(F.ws + WS_BIG + BIG_QKV), NQKV, STATS, CDV(O_CM), CDV(O_DM)};
                REPS(4) pg8::gemm_phase<pg8::EpiLnBf16, pg8::StaticOrder, PG8_ALIGN, PG8_SP2>(F.lds + RING_OFF, g, S, E, F.tid);
            } else { FRAME();
                pg8::Gemm g{(const bf16*)(F.ws + W_MIN), ZB, NHY, T, D}; pg8::StaticOrder S; S.init(NHY, T, F.G, F.bx, 0, WGM_HY);
                pg8::EpiLnBf16T E{(bf16*)(F.ws + WS_BIG + BIG_UT), T, STATS, CDV(O_CM), CDV(O_DM)};
                REPS(4) pg8::gemm_phase<pg8::EpiLnBf16T, pg8::StaticOrder, PG8_ALIGN, PG8_SP2>(F.lds + RING_OFF, g, S, E, F.tid);
            }
            SEAM(pb + 4);
        }
        if (RUN(pb + 5)) {
            FRAME();
#ifdef ATTN_NAIVE
            if (!hy) phase_attention_naive(F);
#else
            if (!hy) { REPS(5) phase_attention(F, 0); }
#endif
            else { REPS(15) phase_spectra(F, jl); }
            SEAM(pb + 5);
        }
        if (hy) {
            if (RUN(pb + 6)) { FRAME(); REPS(6) phase_conv(F, jl); SEAM(pb + 6); }
            if (RUN(pb + 7)) { FRAME(); REPS(7) phase_transpose(F, (const bf16*)(F.ws + WS_BIG + BIG_Z2T), D, T, (bf16*)(F.ws + WS_BIG + BIG_Z2)); SEAM(pb + 7); }
        }
        if (RUN(pb + 8)) {
            FRAME();
            const bf16* A = hy ? (const bf16*)(F.ws + WS_BIG + BIG_Z2) : (const bf16*)(F.ws + WS_BIG + BIG_AO);
            pg8::Gemm g{A, (const bf16*)(F.ws + W_MOUT), T, D, D}; pg8::StaticOrder S; S.init(T, D, F.G, F.bx, MIX_OUT_REV, WGM_E3);
            pg8::EpiResid E{(unsigned*)(F.ws + WS_ZL), ZB, STATS, inp(F, 2) + (size_t)(layer * 3) * D, inp(F, 3) + (size_t)(layer * 3) * D, hy ? inp(F, 20) + (size_t)jl * D : (const float*)(F.ws + WS_IDB), PART, MIXSCALE(hy), (LAS float*)(F.lds + EPI_OFF)};
            pg8::gemm_phase<pg8::EpiResid, pg8::StaticOrder, PG8_ALIGN, PG8_SP2>(F.lds + RING_OFF, g, S, E, F.tid);
            SEAM(pb + 8);
        }
        if (RUN(pb + 9)) { FRAME(); phase_finalize(F); SEAM(pb + 9); }

        if (RUN(pb + 10)) {
            FRAME();
            pg8::Gemm g{ZB, (const bf16*)(F.ws + W_IN2), T, NFF2, D}; pg8::StaticOrder S; S.init(T, NFF2, F.G, F.bx, FFN2_IN_REV, WGM_IN);
            pg8::EpiSwiglu E{HID, FF, STATS, CDV(O_C2), CDV(O_D2)};
            pg8::gemm_phase<pg8::EpiSwiglu, pg8::StaticOrder, PG8_ALIGN, PG8_SP2>(F.lds + RING_OFF, g, S, E, F.tid);
            SEAM(pb + 10);
        }
        if (RUN(pb + 11)) {
            FRAME();
            pg8::Gemm g{HID, (const bf16*)(F.ws + W_OUT2), T, D, FF}; pg8::StaticOrder S; S.init(T, D, F.G, F.bx, FFN2_OUT_REV, WGM_E3);
            pg8::EpiResid E{(unsigned*)(F.ws + WS_ZL), ZB, STATS, inp(F, 2) + (size_t)(layer * 3 + 1) * D, inp(F, 3) + (size_t)(layer * 3 + 1) * D, (const float*)(F.ws + WS_IDB), PART, 0.5f, (LAS float*)(F.lds + EPI_OFF)};
            pg8::gemm_phase<pg8::EpiResid, pg8::StaticOrder, PG8_ALIGN, PG8_SP2>(F.lds + RING_OFF, g, S, E, F.tid);
            SEAM(pb + 11);
        }
        if (RUN(pb + 12) && layer + 1 < DEPTH) { FRAME(); phase_finalize(F); SEAM(pb + 12); }
    }
#ifdef DBG_CHECK
    if (RUN(NPHASE - 2)) { FRAME(); phase_check_qkv(F); SEAM(NPHASE - 2); }
#endif
    if (RUN(NPHASE - 1)) { FRAME(); phase_final_ln(F); }
#undef REVF
#undef RUN
#undef SEAM
#undef FRAME
}


#ifdef PHASE_PROBE
#define PROBE_FRAME() extern __shared__ __attribute__((aligned(16))) unsigned char lds[]; Frame F = make_frame(lds, args.ws, args.out, __builtin_amdgcn_readfirstlane(threadIdx.x >> 6));
__global__ void __launch_bounds__(NWAVES * 64, 2) probe_init(Args args) { PROBE_FRAME(); phase_init(F); }
__global__ void __launch_bounds__(NWAVES * 64, 2) probe_convert(Args args) { PROBE_FRAME(); phase_convert(F, args.ph_lo); }
__global__ void __launch_bounds__(NWAVES * 64, 2) probe_finalize(Args args) { PROBE_FRAME(); phase_finalize(F); phase_final_ln(F); }
__global__ void __launch_bounds__(NWAVES * 64, 2) probe_transpose(Args args) { PROBE_FRAME(); phase_transpose(F, (const bf16*)(F.ws + WS_BIG + BIG_U), T, NHY, (bf16*)(F.ws + WS_BIG + BIG_UT)); }
__global__ void __launch_bounds__(NWAVES * 64, 2) probe_spectra(Args args) { PROBE_FRAME(); phase_spectra(F, args.ph_lo); }
__global__ void __launch_bounds__(NWAVES * 64, 2) probe_conv(Args args) { PROBE_FRAME(); phase_conv(F, args.ph_lo); }
__global__ void __launch_bounds__(NWAVES * 64, 2) probe_attn(Args args) { PROBE_FRAME(); phase_attention(F, args.ph_lo); }
__global__ void __launch_bounds__(NWAVES * 64, 2) probe_gemm_swiglu(Args args) { PROBE_FRAME(); pg8::Gemm g{(const bf16*)F.ws, (const bf16*)(F.ws + W_IN1), T, NFF2, D}; pg8::StaticOrder S; S.init(T, NFF2, F.G, F.bx, 0, WGM_IN); pg8::EpiSwiglu E{(bf16*)(F.ws + WS_BIG), FF, (float*)(F.ws + WS_STATS), (float*)(F.ws + WS_CD), (float*)(F.ws + WS_CD)}; pg8::gemm_phase<pg8::EpiSwiglu, pg8::StaticOrder, PG8_ALIGN, PG8_SP2>(F.lds + RING_OFF, g, S, E, F.tid); }
__global__ void __launch_bounds__(NWAVES * 64, 2) probe_gemm_resid(Args args) { PROBE_FRAME(); pg8::Gemm g{(const bf16*)F.ws, (const bf16*)(F.ws + W_IN1), T, D, FF}; pg8::StaticOrder S; S.init(T, D, F.G, F.bx); pg8::EpiResid E{(unsigned*)(F.ws + WS_ZL), (bf16*)(F.ws + WS_ZB), (float*)(F.ws + WS_STATS), inp(F, 2), inp(F, 3), args.ph_lo ? inp(F, 20) : (const float*)(F.ws + WS_IDB), (float*)(F.ws + WS_PART), 0.5f, (LAS float*)(F.lds + EPI_OFF)}; pg8::gemm_phase<pg8::EpiResid, pg8::StaticOrder, PG8_ALIGN, PG8_SP2>(F.lds + RING_OFF, g, S, E, F.tid); }
__global__ void __launch_bounds__(NWAVES * 64, 2) probe_gemm_ln(Args args) { PROBE_FRAME(); pg8::Gemm g{(const bf16*)F.ws, (const bf16*)(F.ws + W_IN1), T, NQKV, D}; pg8::StaticOrder S; S.init(T, NQKV, F.G, F.bx, 0, WGM_IN); pg8::EpiLnBf16 E{(bf16*)(F.ws + WS_BIG), NQKV, (float*)(F.ws + WS_STATS), (float*)(F.ws + WS_CD), (float*)(F.ws + WS_CD)}; pg8::gemm_phase<pg8::EpiLnBf16, pg8::StaticOrder, PG8_ALIGN, PG8_SP2>(F.lds + RING_OFF, g, S, E, F.tid); }
#endif
#ifndef MK_MULTI
#define MK_MULTI 0
#endif
extern "C" void kernel_launch(void* const* d_in, const int* in_sizes, int n_in, void* d_out, int out_size, void* d_ws, size_t ws_size, hipStream_t stream) {
    static int grid = 0;
    if (grid == 0) {
        if (n_in != 21 || out_size != T * D || ws_size < WS_END) { fprintf(stderr, "kernel_launch: unexpected shapes (n_in %d, out %d, ws %zu, need %zu)\n", n_in, out_size, ws_size, (size_t)WS_END); grid = -1; return; }
        int dev = 0, cus = 0, per_cu = 0;
        if (hipGetDevice(&dev) != hipSuccess || hipDeviceGetAttribute(&cus, hipDeviceAttributeMultiprocessorCount, dev) != hipSuccess) { grid = -1; return; }
        if (hipFuncSetAttribute((const void*)fwd_kernel, hipFuncAttributeMaxDynamicSharedMemorySize, LDS_BYTES) != hipSuccess) { fprintf(stderr, "kernel_launch: hipFuncSetAttribute failed\n"); grid = -1; return; }
        if (hipOccupancyMaxActiveBlocksPerMultiprocessor(&per_cu, (const void*)fwd_kernel, NWAVES * 64, LDS_BYTES) != hipSuccess || per_cu < 1) fprintf(stderr, "kernel_launch: occupancy query reports %d\n", per_cu);
        (void)hipGetLastError();
        grid = cus;
    }
    if (grid < 0) return;
    if (hipMemsetAsync((char*)d_ws + WS_CTL, 0, CTL_ZERO_BYTES, stream) != hipSuccess) return;
    Args a{};
    for (int i = 0; i < 21; ++i) a.in[i] = (const float*)d_in[i];
    a.out = (float*)d_out; a.ws = (unsigned char*)d_ws;
#ifndef STOP_AFTER
#define STOP_AFTER (NPHASE - 1)
#endif
#ifdef DBG_CHECK
#define DBGCHK_ON 1
#else
#define DBGCHK_ON 0
#endif
#if MK_MULTI
    for (int p = 0; p < NPHASE; ++p) { if (p >= STOP_AFTER && p != NPHASE - 1 && !(DBGCHK_ON && p == NPHASE - 2)) continue; a.ph_lo = p; a.ph_hi = p + 1; hipLaunchKernelGGL(fwd_kernel, dim3(grid), dim3(NWAVES * 64), LDS_BYTES, stream, a); }
#else
    a.ph_lo = 0; a.ph_hi = NPHASE;
    hipLaunchKernelGGL(fwd_kernel, dim3(grid), dim3(NWAVES * 64), LDS_BYTES, stream, a);
#endif
}
```

```cpp
#include <hip/hip_runtime.h>
#include <cstdio>
#include <cstdint>
namespace pg8 {
#define PG8_LAS __attribute__((address_space(3)))
typedef unsigned short bf16_t;
typedef short bf16x8 __attribute__((ext_vector_type(8)));
typedef float f32x4 __attribute__((ext_vector_type(4)));
typedef unsigned u32x4 __attribute__((ext_vector_type(4)));
constexpr int BM = 256, BK = 64, HALF = 128, HTB = HALF * BK * 2  , STAGE_BYTES = 8 * HTB, NXCD = 8, WGM = 4;

__host__ __device__ __forceinline__ int lds_byte(int r, int c) { const int st = (r >> 4) * 2 + (c >> 5), rr = r & 15, cc = c & 31, ob = rr * 64 + cc * 2; return st * 1024 + (ob ^ (((ob >> 9) & 1) << 5)); }
__host__ __device__ __forceinline__ void stage_rc(int b, int& R, int& C) { const int st = b / 1024, sb = b % 1024, swz = sb ^ (((sb >> 9) & 1) << 5); R = (st >> 1) * 16 + swz / 64; C = (st & 1) * 32 + (swz % 64) / 2; }
__host__ __device__ __forceinline__ int perm32(int rho) { const int n = rho >> 4, i = rho & 15; return 8 * (i >> 2) + 4 * n + (i & 3); }

struct Unit { int pm, pn; };
struct Gemm { const bf16_t* A; const bf16_t* Bt; int M, N, K; };

struct StaticOrder {
    int nM, nN, nwg, G, c, rev, wgm;
    __host__ __device__ void init(int M, int N, int G_, int c_, int rev_ = 0, int wgm_ = WGM) { nM = M / BM; nN = N / BM; nwg = nM * nN; G = G_; c = c_; rev = rev_; wgm = wgm_; }
    __host__ __device__ bool next(int i, Unit& u) const {
        const int nr = (nwg + G - 1) / G; if (i >= nr) return false;
        const long L = (long)(rev ? nr - 1 - i : i) * G + c; if (L >= nwg) return false;
        int wgid = (int)L; { const int q = nwg / NXCD, r = nwg % NXCD, xcd = wgid % NXCD, off = wgid / NXCD; wgid = (xcd < r ? xcd * (q + 1) : r * (q + 1) + (xcd - r) * q) + off; }
        const int nig = wgm * nN, gid = wgid / nig, fm = gid * wgm, gsz = (nM - fm) < wgm ? (nM - fm) : wgm;
        u.pm = fm + ((wgid % nig) % gsz); u.pn = (wgid % nig) / gsz; return true;
    }
    __device__ __forceinline__ void a_ready(const Unit&) const {}
    __device__ __forceinline__ void done(const Unit&) const {}
};

__device__ __forceinline__ unsigned cvt_pk_bf16(float lo, float hi) { unsigned r; asm volatile("v_cvt_pk_bf16_f32 %0, %1, %2" : "=v"(r) : "v"(lo), "v"(hi)); return r; }
typedef float f32x2 __attribute__((ext_vector_type(2)));
typedef float f32x2v __attribute__((ext_vector_type(2)));
typedef unsigned u32x2v __attribute__((ext_vector_type(2)));
constexpr float DN_ALPHA_F = 1.6817928305074292f;

__device__ __forceinline__ float z20_dec(unsigned zb_hi, unsigned q, int k) { const int c = (int)(q << (28 - 4 * k)) >> 28; return __uint_as_float(zb_hi + ((unsigned)c << 12)); }
__device__ __forceinline__ unsigned z20_zb(float v) { return __float_as_uint(v) + 0x8800u; }
__device__ __forceinline__ unsigned z20_c(float v, int k) { return (((__float_as_uint(v) + 0x800u) >> 12) & 15u) << (4 * k); }

__device__ __forceinline__ unsigned cvt2(float lo, float hi) { typedef __bf16 bf16x2_t __attribute__((ext_vector_type(2))); const f32x2v v = {lo, hi}; return __builtin_bit_cast(unsigned, __builtin_convertvector(v, bf16x2_t)); }
__device__ __forceinline__ float xor32_sum(float x) { const auto r = __builtin_amdgcn_permlane32_swap(__float_as_uint(x), __float_as_uint(x), false, false); const unsigned r0 = r[0], r1 = r[1]; return __uint_as_float(r0) + __uint_as_float(r1); }
__device__ __forceinline__ float xor32_max(float x) { const auto r = __builtin_amdgcn_permlane32_swap(__float_as_uint(x), __float_as_uint(x), false, false); const unsigned r0 = r[0], r1 = r[1]; return fmaxf(__uint_as_float(r0), __uint_as_float(r1)); }
template <int MASK> __device__ __forceinline__ float swz_xor(float x) { return __builtin_bit_cast(float, __builtin_amdgcn_ds_swizzle(__builtin_bit_cast(int, x), (MASK << 10) | 0x1F)); }
__device__ __forceinline__ float wave_sum64(float v) { v += swz_xor<1>(v); v += swz_xor<2>(v); v += swz_xor<4>(v); v += swz_xor<8>(v); v += swz_xor<16>(v); return xor32_sum(v); }

struct EpiLnBf16 {
    static constexpr bool PERM = true, AFTER_DRAIN = false;
    bf16_t* O; int ldc; const float* stats; const float* cvec; const float* dvec;
    __device__ __forceinline__ void operator()(const f32x4 (&acc)[2][2][4][2], const Unit& u, int wr, int wc, int fr, int fq) const {
        const int row0 = u.pm * BM + wr * 64 + fr, col0 = u.pn * BM + wc * 32 + 8 * fq;
        f32x4 cv[2][2], dv[2][2];
#pragma unroll
        for (int bj = 0; bj < 2; ++bj)
#pragma unroll
            for (int n = 0; n < 2; ++n) { cv[bj][n] = *(const f32x4*)(cvec + col0 + bj * HALF + 4 * n); dv[bj][n] = *(const f32x4*)(dvec + col0 + bj * HALF + 4 * n); }
        f32x2v sts[2][4];
#pragma unroll
        for (int ai = 0; ai < 2; ++ai)
#pragma unroll
            for (int m = 0; m < 4; ++m) sts[ai][m] = *(const f32x2v*)(stats + 2 * (size_t)(row0 + ai * HALF + m * 16));
#pragma unroll
        for (int ai = 0; ai < 2; ++ai)
#pragma unroll
            for (int m = 0; m < 4; ++m) { const int row = row0 + ai * HALF + m * 16; const f32x2v st = sts[ai][m];
                bf16_t* rowp = O + (size_t)row * ldc + col0;
#pragma unroll
                for (int bj = 0; bj < 2; ++bj) { const f32x4 v0 = (acc[ai][bj][m][0] - st.x * cv[bj][0]) * st.y + dv[bj][0], v1 = (acc[ai][bj][m][1] - st.x * cv[bj][1]) * st.y + dv[bj][1];
                    u32x4 w; w.x = cvt2(v0[0], v0[1]); w.y = cvt2(v0[2], v0[3]); w.z = cvt2(v1[0], v1[1]); w.w = cvt2(v1[2], v1[3]);
                    *(u32x4*)(rowp + bj * HALF) = w; } }
    }
};
struct EpiLnBf16T {
    static constexpr bool PERM = true, AFTER_DRAIN = false, HAS_INIT = false;
    bf16_t* O; int ldc; const float* stats; const float* cvec; const float* dvec;
    __device__ __forceinline__ void operator()(const f32x4 (&acc)[2][2][4][2], const Unit& u, int wr, int wc, int fr, int fq) const {
        const int row0 = u.pm * BM + wr * 64 + fr, col0 = u.pn * BM + wc * 32 + 8 * fq;
        f32x4 mean[2][2], rstd[2][2];
#pragma unroll
        for (int bj = 0; bj < 2; ++bj) { const f32x4* sp = (const f32x4*)(stats + 2 * (size_t)(col0 + bj * HALF));
            const f32x4 a = sp[0], b = sp[1], c = sp[2], d = sp[3];
            mean[bj][0] = (f32x4){a[0], a[2], b[0], b[2]}; rstd[bj][0] = (f32x4){a[1], a[3], b[1], b[3]};
            mean[bj][1] = (f32x4){c[0], c[2], d[0], d[2]}; rstd[bj][1] = (f32x4){c[1], c[3], d[1], d[3]}; }
        float cr[2][4], dr[2][4];
#pragma unroll
        for (int ai = 0; ai < 2; ++ai)
#pragma unroll
            for (int m = 0; m < 4; ++m) { const int row = row0 + ai * HALF + m * 16; cr[ai][m] = cvec[row]; dr[ai][m] = dvec[row]; }
#pragma unroll
        for (int ai = 0; ai < 2; ++ai)
#pragma unroll
            for (int m = 0; m < 4; ++m) { const int row = row0 + ai * HALF + m * 16; bf16_t* rowp = O + (size_t)row * ldc + col0;
#pragma unroll
                for (int bj = 0; bj < 2; ++bj) { const f32x4 v0 = (acc[ai][bj][m][0] - mean[bj][0] * cr[ai][m]) * rstd[bj][0] + dr[ai][m], v1 = (acc[ai][bj][m][1] - mean[bj][1] * cr[ai][m]) * rstd[bj][1] + dr[ai][m];
                    u32x4 w; w.x = cvt2(v0[0], v0[1]); w.y = cvt2(v0[2], v0[3]); w.z = cvt2(v1[0], v1[1]); w.w = cvt2(v1[2], v1[3]);
                    *(u32x4*)(rowp + bj * HALF) = w; } }
    }
};
__device__ __forceinline__ float silu_mul(float g, float up) { const float e = __builtin_amdgcn_exp2f(-1.4426950408889634f * g); return g * __builtin_amdgcn_rcpf(1.0f + e) * up; }
struct EpiSwiglu {
    static constexpr bool PERM = true, AFTER_DRAIN = false;
    bf16_t* O; int ldc; const float* stats; const float* cvec; const float* dvec;
    __device__ __forceinline__ void operator()(const f32x4 (&acc)[2][2][4][2], const Unit& u, int wr, int wc, int fr, int fq) const {
        const int row0 = u.pm * BM + wr * 64 + fr, col0 = u.pn * BM + wc * 32 + 8 * fq, ocol = u.pn * HALF + wc * 32 + 8 * fq;
        f32x4 cv[2][2], dv[2][2];
#pragma unroll
        for (int bj = 0; bj < 2; ++bj)
#pragma unroll
            for (int n = 0; n < 2; ++n) { cv[bj][n] = *(const f32x4*)(cvec + col0 + bj * HALF + 4 * n); dv[bj][n] = *(const f32x4*)(dvec + col0 + bj * HALF + 4 * n); }
        f32x2v sts[2][4];
#pragma unroll
        for (int ai = 0; ai < 2; ++ai)
#pragma unroll
            for (int m = 0; m < 4; ++m) sts[ai][m] = *(const f32x2v*)(stats + 2 * (size_t)(row0 + ai * HALF + m * 16));
#pragma unroll
        for (int ai = 0; ai < 2; ++ai)
#pragma unroll
            for (int m = 0; m < 4; ++m) { const int row = row0 + ai * HALF + m * 16; const f32x2v st = sts[ai][m];
                f32x4 h[2];
#pragma unroll
                for (int n = 0; n < 2; ++n) { const f32x4 g = (acc[ai][0][m][n] - st.x * cv[0][n]) * st.y + dv[0][n], up = (acc[ai][1][m][n] - st.x * cv[1][n]) * st.y + dv[1][n];
                    h[n] = (f32x4){silu_mul(g[0], up[0]), silu_mul(g[1], up[1]), silu_mul(g[2], up[2]), silu_mul(g[3], up[3])}; }
                u32x4 w; w.x = cvt2(h[0][0], h[0][1]); w.y = cvt2(h[0][2], h[0][3]); w.z = cvt2(h[1][0], h[1][1]); w.w = cvt2(h[1][2], h[1][3]);
                *(u32x4*)(O + (size_t)row * ldc + ocol) = w; }
    }
};
struct EpiResid {
    static constexpr bool PERM = true, AFTER_DRAIN = false;
    unsigned* ZL; bf16_t* ZB; const float* stats; const float* gprev; const float* bprev; const float* bias; float* part; float scale; __attribute__((address_space(3))) float* gb;
    __device__ __forceinline__ void operator()(const f32x4 (&acc)[2][2][4][2], const Unit& u, int wr, int wc, int fr, int fq) const {
        typedef __attribute__((address_space(3))) f32x4 lds_f32x4;
        const int row0 = u.pm * BM + wr * 64 + fr, col0 = u.pn * BM + wc * 32 + 8 * fq;
        lds_f32x4* slot = (lds_f32x4*)(gb + (wr * 4 + wc) * 128) + fq * 8;
        if (fr == 0) {
#pragma unroll
            for (int bj = 0; bj < 2; ++bj)
#pragma unroll
                for (int n = 0; n < 2; ++n) { const int c = col0 + bj * HALF + 4 * n; slot[bj * 4 + n] = DN_ALPHA_F * *(const f32x4*)(gprev + c); slot[bj * 4 + 2 + n] = DN_ALPHA_F * *(const f32x4*)(bprev + c) + scale * *(const f32x4*)(bias + c); }
        }
#pragma unroll
        for (int bj = 0; bj < 2; ++bj) {
#pragma unroll
            for (int ai = 0; ai < 2; ++ai) {
                u32x4 zr[4]; unsigned zq[4]; f32x2v sts[4];
#pragma unroll
                for (int m = 0; m < 4; ++m) { const unsigned row = (unsigned)(row0 + ai * HALF + m * 16), eo = row * 2048u + (unsigned)(col0 + bj * HALF);
                    zr[m] = *(const u32x4*)(ZB + eo); zq[m] = ZL[eo >> 3]; sts[m] = *(const f32x2v*)(stats + 2u * row); }
#pragma unroll
                for (int m = 0; m < 4; ++m) { const unsigned row = (unsigned)(row0 + ai * HALF + m * 16), eo = row * 2048u + (unsigned)(col0 + bj * HALF); const f32x2v st = sts[m]; const u32x4 r = zr[m]; const unsigned q = zq[m];
                    const f32x4 z0 = (f32x4){z20_dec(r.x << 16, q, 0), z20_dec(r.x & 0xffff0000u, q, 1), z20_dec(r.y << 16, q, 2), z20_dec(r.y & 0xffff0000u, q, 3)};
                    const f32x4 z1 = (f32x4){z20_dec(r.z << 16, q, 4), z20_dec(r.z & 0xffff0000u, q, 5), z20_dec(r.w << 16, q, 6), z20_dec(r.w & 0xffff0000u, q, 7)};
                    const f32x4 n0 = (z0 - st.x) * st.y * slot[bj * 4] + slot[bj * 4 + 2] + scale * acc[ai][bj][m][0];
                    const f32x4 n1 = (z1 - st.x) * st.y * slot[bj * 4 + 1] + slot[bj * 4 + 3] + scale * acc[ai][bj][m][1];
                    u32x4 w; w.x = (z20_zb(n0[0]) >> 16) | (z20_zb(n0[1]) & 0xffff0000u); w.y = (z20_zb(n0[2]) >> 16) | (z20_zb(n0[3]) & 0xffff0000u);
                    w.z = (z20_zb(n1[0]) >> 16) | (z20_zb(n1[1]) & 0xffff0000u); w.w = (z20_zb(n1[2]) >> 16) | (z20_zb(n1[3]) & 0xffff0000u);
#ifdef E3_PLAIN_STORES
                    *(u32x4*)(ZB + eo) = w;
#else
                    __builtin_nontemporal_store(w, (u32x4*)(ZB + eo));
#endif
                    const unsigned zlw = ((z20_c(n0[0], 0) | z20_c(n0[1], 1)) | (z20_c(n0[2], 2) | z20_c(n0[3], 3))) | ((z20_c(n1[0], 4) | z20_c(n1[1], 5)) | (z20_c(n1[2], 6) | z20_c(n1[3], 7)));
#ifdef E3_PLAIN_STORES
                    ZL[eo >> 3] = zlw;
#else
                    __builtin_nontemporal_store(zlw, ZL + (eo >> 3));
#endif
                    float s = ((n0[0] + n0[1]) + (n0[2] + n0[3])) + ((n1[0] + n1[1]) + (n1[2] + n1[3]));
                    float q2 = ((n0[0] * n0[0] + n0[1] * n0[1]) + (n0[2] * n0[2] + n0[3] * n0[3])) + ((n1[0] * n1[0] + n1[1] * n1[1]) + (n1[2] * n1[2] + n1[3] * n1[3]));
                    s += swz_xor<16>(s); s = xor32_sum(s); q2 += swz_xor<16>(q2); q2 = xor32_sum(q2);
                    if (fq == 0) *(f32x2v*)(part + (row * 64u + (unsigned)(u.pn * 8 + wc * 2 + bj)) * 2u) = (f32x2v){s, q2}; }
            }
        }
    }
};

struct EpiTaps {
    static constexpr bool PERM = false, AFTER_DRAIN = false;
    float* O; float min_decay, dstep;
    __device__ __forceinline__ void operator()(const f32x4 (&acc)[2][2][4][2], const Unit& u, int wr, int wc, int fr, int fq) const {
        int stride = 10240; float i0 = 1.0f / 8191.0f, i1 = 1.0f / 2047.0f; asm volatile("" : "+s"(stride), "+s"(i0), "+s"(i1));
        const int row0 = u.pm * BM + wr * 64 + fr, col0 = u.pn * BM + wc * 32 + 4 * fq;
        const int tbase = (u.pn < 32) ? 0 : 8192; const float ilm1 = (u.pn < 32) ? i0 : i1;
        const float t0 = (float)(col0 - tbase);
#pragma unroll
        for (int ai = 0; ai < 2; ++ai)
#pragma unroll
            for (int m = 0; m < 4; ++m) { const int row = row0 + ai * HALF + m * 16;
                const float a = -1.4426950408889634f * __builtin_fabsf(min_decay + (float)(row & 2047) * dstep) * ilm1;
                const float e0 = __builtin_amdgcn_exp2f(a * t0), s1 = __builtin_amdgcn_exp2f(a), s16 = __builtin_amdgcn_exp2f(16.0f * a), s128 = __builtin_amdgcn_exp2f(128.0f * a);
                float* rowp = O + (size_t)row * stride + col0;
#pragma unroll
                for (int bj = 0; bj < 2; ++bj) { const float eb = bj ? e0 * s128 : e0;
#pragma unroll
                    for (int n = 0; n < 2; ++n) { const float en = n ? eb * s16 : eb, en1 = en * s1, en2 = en1 * s1, en3 = en2 * s1; const f32x4 v = acc[ai][bj][m][n];
#ifdef TAPS_NT
                        __builtin_nontemporal_store((f32x4){v[0] * en, v[1] * en1, v[2] * en2, v[3] * en3}, (f32x4*)(rowp + bj * HALF + n * 16)); } } }
#else
                        *(f32x4*)(rowp + bj * HALF + n * 16) = (f32x4){v[0] * en, v[1] * en1, v[2] * en2, v[3] * en3}; } } }
#endif
    }
};

template <class Epi, class Sched, bool ALIGN_EPI = false, bool SP2 = false>
__device__ __forceinline__ void gemm_phase(PG8_LAS unsigned char* lds, const Gemm g, const Sched& S, const Epi& E, const int tid_in) {
    int tid_ = tid_in; asm volatile("" : "+v"(tid_));
    const int tid = tid_, wid = __builtin_amdgcn_readfirstlane(tid >> 6), lane = tid & 63, wr = wid >> 2, wc = wid & 3, fr = lane & 15, fq = lane >> 4;
    const int K = g.K, nt = K / BK;
    unsigned voffA[2], voffB[2];
#pragma unroll
    for (int i = 0; i < 2; ++i) { int R, C; stage_rc(tid * 16 + i * 8192, R, C); const int Rb = Epi::PERM ? ((R & ~31) + perm32(R & 31)) : R;
        voffA[i] = (unsigned)(R * K + C) * 2u; voffB[i] = (unsigned)(Rb * K + C) * 2u; }
    const size_t kstep = (size_t)(BK * 2);
    const size_t hstep = (size_t)HALF * K * 2;
    const size_t tstep = 2 * hstep;
    const unsigned ldsw = (unsigned)wid * 1024u;
    const int aoff = lds_byte(wr * 64 + fr, fq * 8), boff = lds_byte(wc * 32 + fr, fq * 8);
#define PG8_SA(b, h) (((b) * 2 + (h)) * HTB)
#define PG8_SB(b, h) ((4 + (b) * 2 + (h)) * HTB)
#define PG8_STAGE(bufoff, gbase, voff) do { _Pragma("unroll") for (int _i = 0; _i < 2; ++_i) \
        __builtin_amdgcn_global_load_lds((const unsigned*)((const char*)(gbase) + (voff)[_i]), (PG8_LAS unsigned*)(lds + (bufoff) + ldsw + _i * 8192), 16, 0, 0); } while (0)
#define PG8_LDA(dst, b, h) do { _Pragma("unroll") for (int m = 0; m < 4; ++m) _Pragma("unroll") for (int k = 0; k < 2; ++k) dst[m][k] = *(const PG8_LAS bf16x8*)(lds + PG8_SA(b, h) + aoff + m * 2048 + k * 1024); } while (0)
#define PG8_LDB(dst, b, h) do { _Pragma("unroll") for (int n = 0; n < 2; ++n) _Pragma("unroll") for (int k = 0; k < 2; ++k) dst[n][k] = *(const PG8_LAS bf16x8*)(lds + PG8_SB(b, h) + boff + n * 2048 + k * 1024); } while (0)
#define PG8_MMA(ai, bj, At, Bt) do { __builtin_amdgcn_s_setprio(1); _Pragma("unroll") for (int m = 0; m < 4; ++m) _Pragma("unroll") for (int n = 0; n < 2; ++n) _Pragma("unroll") for (int k = 0; k < 2; ++k) \
        acc[ai][bj][m][n] = __builtin_amdgcn_mfma_f32_16x16x32_bf16(Bt[n][k], At[m][k], acc[ai][bj][m][n], 0, 0, 0); __builtin_amdgcn_s_setprio(0); } while (0)
#define PG8_WAIT_V(n) asm volatile("s_waitcnt vmcnt(" #n ")" ::: "memory")
#define PG8_WAIT_L(n) asm volatile("s_waitcnt lgkmcnt(" #n ")" ::: "memory")
#define PG8_BAR __builtin_amdgcn_s_barrier()
#define PG8_SCHED __builtin_amdgcn_sched_barrier(0)
    Unit cur, nxt; int ui = 0;
    if (!S.next(0, cur)) return;
    f32x4 acc[2][2][4][2];
    float zero_; asm volatile("v_mov_b32 %0, 0" : "=v"(zero_));
#pragma unroll
    for (int a = 0; a < 2; ++a)
#pragma unroll
        for (int b = 0; b < 2; ++b)
#pragma unroll
            for (int m = 0; m < 4; ++m)
#pragma unroll
                for (int n = 0; n < 2; ++n) acc[a][b][m][n] = (f32x4){zero_, zero_, zero_, zero_};
    bf16x8 At[4][2], B0[2][2], B1[2][2];
    const char* cA = (const char*)g.A + (size_t)cur.pm * tstep; const char* cB = (const char*)g.Bt + (size_t)cur.pn * tstep;
    S.a_ready(cur);
    if constexpr (SP2) {
        PG8_STAGE(PG8_SB(0, 0), cB, voffB); PG8_STAGE(PG8_SB(0, 1), cB + hstep, voffB); PG8_STAGE(PG8_SA(0, 0), cA, voffA); PG8_STAGE(PG8_SA(0, 1), cA + hstep, voffA);
        if (wr == 1) PG8_BAR;
        PG8_WAIT_V(2); PG8_BAR;
        PG8_STAGE(PG8_SB(1, 0), cB + kstep, voffB); PG8_STAGE(PG8_SA(1, 0), cA + kstep, voffA); PG8_STAGE(PG8_SB(1, 1), cB + hstep + kstep, voffB);
        PG8_WAIT_V(6); PG8_BAR;
    } else {
        PG8_STAGE(PG8_SB(0, 0), cB, voffB); PG8_STAGE(PG8_SA(0, 0), cA, voffA); PG8_STAGE(PG8_SB(0, 1), cB + hstep, voffB); PG8_STAGE(PG8_SA(0, 1), cA + hstep, voffA);
        if (wr == 1) PG8_BAR;
        PG8_WAIT_V(4); PG8_BAR;
        PG8_STAGE(PG8_SB(1, 0), cB + kstep, voffB); PG8_STAGE(PG8_SA(1, 0), cA + kstep, voffA); PG8_STAGE(PG8_SB(1, 1), cB + hstep + kstep, voffB);
        PG8_WAIT_V(6); PG8_BAR;
    }
    for (;;) {
        const bool has_next = S.next(ui + 1, nxt);
        const char* nA = has_next ? (const char*)g.A + (size_t)nxt.pm * tstep : cA; const char* nB = has_next ? (const char*)g.Bt + (size_t)nxt.pn * tstep : cB;
        for (int t = 0; t < nt; t += 2) {
            const bool last = (t == nt - 2);
            const char* a1 = cA + (size_t)(t + 1) * kstep;
            const char* a2 = last ? nA : cA + (size_t)(t + 2) * kstep; const char* b2 = last ? nB : cB + (size_t)(t + 2) * kstep;
            const char* a3 = a2 + kstep; const char* b3 = b2 + kstep;
            if (last && has_next) S.a_ready(nxt);
            if constexpr (SP2) {
            PG8_LDB(B0, 0, 0); PG8_LDB(B1, 0, 1); PG8_SCHED; PG8_LDA(At, 0, 0); PG8_STAGE(PG8_SA(1, 1), a1 + hstep, voffA);
            PG8_WAIT_V(8); PG8_WAIT_L(0); PG8_BAR; PG8_MMA(0, 0, At, B0); PG8_MMA(0, 1, At, B1); PG8_BAR; PG8_SCHED;
            PG8_LDA(At, 0, 1); PG8_STAGE(PG8_SB(0, 0), b2, voffB); PG8_STAGE(PG8_SB(0, 1), b2 + hstep, voffB); PG8_STAGE(PG8_SA(0, 0), a2, voffA);
            PG8_WAIT_V(8); PG8_WAIT_L(0); PG8_BAR; PG8_MMA(1, 0, At, B0); PG8_MMA(1, 1, At, B1); PG8_BAR; PG8_SCHED;
            PG8_LDB(B0, 1, 0); PG8_LDB(B1, 1, 1); PG8_SCHED; PG8_LDA(At, 1, 0); PG8_STAGE(PG8_SA(0, 1), a2 + hstep, voffA);
            PG8_WAIT_V(8); PG8_WAIT_L(0); PG8_BAR; PG8_MMA(0, 0, At, B0); PG8_MMA(0, 1, At, B1); PG8_BAR; PG8_SCHED;
            PG8_LDA(At, 1, 1); PG8_STAGE(PG8_SB(1, 0), b3, voffB); PG8_STAGE(PG8_SB(1, 1), b3 + hstep, voffB); PG8_STAGE(PG8_SA(1, 0), a3, voffA);
            PG8_WAIT_V(8); PG8_WAIT_L(0); PG8_BAR; PG8_MMA(1, 0, At, B0); PG8_MMA(1, 1, At, B1); PG8_BAR; PG8_SCHED;
            } else {
            PG8_LDB(B0, 0, 0); PG8_SCHED; PG8_LDA(At, 0, 0); PG8_STAGE(PG8_SA(1, 1), a1 + hstep, voffA);
            PG8_WAIT_L(8); PG8_BAR; PG8_WAIT_L(0); PG8_MMA(0, 0, At, B0); PG8_BAR; PG8_SCHED;
            PG8_LDB(B1, 0, 1); PG8_STAGE(PG8_SB(0, 0), b2, voffB);
            PG8_BAR; PG8_WAIT_L(0); PG8_MMA(0, 1, At, B1); PG8_BAR;
            PG8_LDA(At, 0, 1); PG8_STAGE(PG8_SA(0, 0), a2, voffA);
            PG8_BAR; PG8_WAIT_L(0); PG8_MMA(1, 0, At, B0); PG8_BAR; PG8_SCHED;
            PG8_STAGE(PG8_SB(0, 1), b2 + hstep, voffB);
            PG8_WAIT_V(6); PG8_BAR; PG8_MMA(1, 1, At, B1); PG8_BAR;
            PG8_LDB(B0, 1, 0); PG8_SCHED; PG8_LDA(At, 1, 0); PG8_STAGE(PG8_SA(0, 1), a2 + hstep, voffA);
            PG8_WAIT_L(8); PG8_BAR; PG8_WAIT_L(0); PG8_MMA(0, 0, At, B0); PG8_BAR; PG8_SCHED;
            PG8_LDB(B1, 1, 1); PG8_STAGE(PG8_SB(1, 0), b3, voffB);
            PG8_BAR; PG8_WAIT_L(0); PG8_MMA(0, 1, At, B1); PG8_BAR;
            PG8_LDA(At, 1, 1); PG8_STAGE(PG8_SA(1, 0), a3, voffA);
            PG8_BAR; PG8_WAIT_L(0); PG8_MMA(1, 0, At, B0); PG8_BAR; PG8_SCHED;
            PG8_STAGE(PG8_SB(1, 1), b3 + hstep, voffB);
            PG8_WAIT_V(6); PG8_BAR; PG8_MMA(1, 1, At, B1); PG8_BAR;
            }
        }
        if constexpr (ALIGN_EPI) { if (wr == 0) PG8_BAR; }
        if constexpr (!Epi::AFTER_DRAIN) { E(acc, cur, wr, wc, fr, fq); S.done(cur); }
        if (!has_next) break;
        asm volatile("v_mov_b32 %0, 0" : "=v"(zero_));
#pragma unroll
        for (int a = 0; a < 2; ++a)
#pragma unroll
            for (int b = 0; b < 2; ++b)
#pragma unroll
                for (int m = 0; m < 4; ++m)
#pragma unroll
                    for (int n = 0; n < 2; ++n) acc[a][b][m][n] = (f32x4){zero_, zero_, zero_, zero_};
        cur = nxt; cA = nA; cB = nB; ++ui;
        if constexpr (ALIGN_EPI) { if (wr == 1) PG8_BAR; }
    }
    PG8_WAIT_V(0);
    if constexpr (!ALIGN_EPI) { if (wr == 0) PG8_BAR; }
    PG8_BAR;
    if constexpr (Epi::AFTER_DRAIN) { E.fused(acc, cur, wr, wc, fr, fq, lds, wid, lane); S.done(cur); }
#undef PG8_SA
#undef PG8_SB
#undef PG8_STAGE
#undef PG8_LDA
#undef PG8_LDB
#undef PG8_MMA
#undef PG8_WAIT_V
#undef PG8_WAIT_L
#undef PG8_BAR
#undef PG8_SCHED
}
}

#ifndef PG8_SP2
#define PG8_SP2 true
#endif
#ifndef PG8_ALIGN
#define PG8_ALIGN true
#endif
#define XB_TMO      128
#define XB_XCNT(j)  (256  + 64 * (j))
#define XB_XSUB(j)  (1280 + 64 * (j))
#define XB_XGEN(j)  (2304 + 64 * (j))
#define XB_TOP      3328
#define XB_TOPGEN   3392
#define XCD_BAR_WORDS 3456
#define XB_SPIN_CAP (1u << 18)
#define LAS __attribute__((address_space(3)))

__device__ __forceinline__ unsigned xb_ld(unsigned* p)              { return __hip_atomic_load(p, __ATOMIC_RELAXED, __HIP_MEMORY_SCOPE_AGENT); }
__device__ __forceinline__ unsigned xb_add(unsigned* p, unsigned v) { return __hip_atomic_fetch_add(p, v, __ATOMIC_RELAXED, __HIP_MEMORY_SCOPE_AGENT); }
__device__ __forceinline__ unsigned xb_xcc_id() { return (unsigned)__builtin_amdgcn_s_getreg((3 << 11) | 20) & 0xFu; }
#define XB_SPIN(cond, bar) do { unsigned _sp = 0; while (cond) { __builtin_amdgcn_s_sleep(1); \
    if ((++_sp & 255u) == 0u) { if (xb_ld(&(bar)[XB_TMO])) break; if (_sp > XB_SPIN_CAP) { atomicAdd(&(bar)[XB_TMO], 1u); break; } } } } while (0)

struct XcdBarrier {
    unsigned* bar; unsigned x;
    unsigned w0;
    volatile LAS unsigned* st;
};

__device__ __forceinline__ XcdBarrier xcd_barrier_post(unsigned* bar, volatile LAS unsigned* st) {
    XcdBarrier b; b.bar = bar; b.x = xb_xcc_id(); b.st = st; b.w0 = (unsigned)__builtin_amdgcn_readfirstlane(threadIdx.x >> 6);
    if (threadIdx.x == 0) (void)xb_add(&bar[XB_XCNT(b.x)], 1u);
    return b;
}
__device__ __forceinline__ void xcd_barrier_complete(unsigned* bar, unsigned x, unsigned& nloc, unsigned& nx) {
    const unsigned G = gridDim.x * gridDim.y * gridDim.z;
    unsigned sum, cnt, mine, sp = 0u;
    for (;;) {
        sum = 0u; cnt = 0u; mine = 0u;
#pragma unroll
        for (unsigned j = 0; j < 16; ++j) { const unsigned c = xb_ld(&bar[XB_XCNT(j)]); sum += c; cnt += (c > 0u) ? 1u : 0u; mine = (j == x) ? c : mine; }
        if (sum == G) break;
        __builtin_amdgcn_s_sleep(1);
        if ((++sp & 255u) == 0u) { if (xb_ld(&bar[XB_TMO])) break; if (sp > XB_SPIN_CAP) { atomicAdd(&bar[XB_TMO], 1u); break; } }
    }
    nloc = mine > 0u ? mine : 1u; nx = cnt > 0u ? cnt : 1u;
}

__device__ __forceinline__ void xcd_barrier(const XcdBarrier& b) {
    asm volatile("s_waitcnt vmcnt(0)" ::: "memory");
    __syncthreads();
    unsigned xb_lane; asm volatile("v_mbcnt_lo_u32_b32 %0, -1, 0\n\tv_mbcnt_hi_u32_b32 %0, -1, %0" : "=v"(xb_lane));
    if (b.w0 == 0u && xb_lane == 0u) {
        unsigned* bar = b.bar;
        __builtin_amdgcn_s_waitcnt(0);
        unsigned nloc = b.st[0], nx = b.st[1];
        if (nloc == 0u) { xcd_barrier_complete(bar, b.x, nloc, nx); b.st[0] = nloc; b.st[1] = nx; }
        const unsigned old = xb_add(&bar[XB_XSUB(b.x)], 1u);
        const unsigned gen = old / nloc;
        if (old + 1u == (gen + 1u) * nloc) {
            __builtin_amdgcn_fence(__ATOMIC_RELEASE, "agent");
            asm volatile("s_waitcnt vmcnt(0)" ::: "memory");
            const unsigned og = xb_add(&bar[XB_TOP], 1u);
            const unsigned tg = og / nx;
            if (og + 1u == (tg + 1u) * nx) xb_add(&bar[XB_TOPGEN], 1u);
            else XB_SPIN(xb_ld(&bar[XB_TOPGEN]) == tg, bar);
            __builtin_amdgcn_fence(__ATOMIC_ACQUIRE, "agent");
            xb_add(&bar[XB_XGEN(b.x)], 1u);
            asm volatile("s_waitcnt vmcnt(0)" ::: "memory");
        } else {
            XB_SPIN(xb_ld(&bar[XB_XGEN(b.x)]) == gen, bar);
            __builtin_amdgcn_fence(__ATOMIC_ACQUIRE, "agent");
            asm volatile("s_waitcnt vmcnt(0)" ::: "memory");
        }
    }
    __syncthreads();
}
constexpr int NWAVES = 8;
constexpr int D = 2048, FF = 5632, NFF2 = 2 * FF, NQKV = 18432, NHY = 6144, DEPTH = 4;
constexpr int T_PROMPT = 4 * 8192, T = 49152;
constexpr float LN_EPS = 1e-5f;
constexpr float QSCALE = 0.12751743082459868f;
constexpr float LOG2E = 1.4426950408889634f;
constexpr float MIN_DECAY = -3.0701134573253946f, MAX_DECAY = -15.350567286626973f;

constexpr size_t MiB = 1u << 20;
constexpr size_t WS_CTL = 0, CTL_ZERO_BYTES = 64 * 1024;
constexpr size_t WS_IDG = 1 * MiB, WS_IDB = 1 * MiB + 32768, WS_DUMP = 1 * MiB + 32768 + 131072;
constexpr size_t WS_CD = 2 * MiB;
constexpr size_t WS_STATS = 3 * MiB;
constexpr size_t WS_H2T = 4 * MiB;
constexpr size_t WS_PART = 8 * MiB;
constexpr size_t WS_W = 32 * MiB;
constexpr size_t W_IN1 = WS_W, W_OUT1 = W_IN1 + 44 * MiB, W_IN2 = W_OUT1 + 22 * MiB, W_OUT2 = W_IN2 + 44 * MiB, W_MIN = W_OUT2 + 22 * MiB, W_MOUT = W_MIN + 72 * MiB;
constexpr size_t WS_ZB = W_MOUT + 8 * MiB;
constexpr size_t WS_BIG = WS_ZB + 192 * MiB;
constexpr size_t BIG_HID = 0;
constexpr size_t BIG_QKV = 0, BIG_AO = 1728 * MiB;
constexpr size_t BIG_U = 0, BIG_Z2T = 0, BIG_Z2 = 192 * MiB, BIG_UT = 576 * MiB, BIG_SPEC0 = 1152 * MiB, BIG_SPEC1 = 1664 * MiB;
constexpr size_t WS_TAPS = WS_BIG + 1920 * MiB;
constexpr size_t WS_H2B = WS_TAPS + 320 * MiB, WS_W3T = WS_H2B + 6 * MiB;
constexpr size_t WS_ZL = WS_W3T + 4 * MiB;
constexpr size_t WS_END = WS_ZL + 48 * MiB;
static_assert(WS_ZB == 244 * MiB && WS_BIG == 436 * MiB && (size_t)T * 64 * 8 <= 24 * MiB && WS_END <= 2816 * MiB && (size_t)8192 * 10240 * 4 <= 320 * MiB, "ws map");
static_assert((size_t)T * FF * 2 <= 528 * MiB && (size_t)T * NQKV * 2 <= 1728 * MiB && (size_t)T * NHY * 2 <= 576 * MiB && BIG_SPEC1 + 128 * MiB <= 1920 * MiB, "ws map");

constexpr int RING_OFF = 0;
constexpr int FFT_BYTES = (16384 + 512) * 8;
constexpr int SCR_OFF = FFT_BYTES;
constexpr int MISC_OFF = SCR_OFF + 1024;
constexpr int PTR_OFF = MISC_OFF + 256;
constexpr int EPI_OFF = PTR_OFF + 256;
constexpr int LDS_BYTES = EPI_OFF + 4096;

#define GAS __attribute__((address_space(1)))
#define LAS __attribute__((address_space(3)))
typedef unsigned short bf16;
typedef unsigned v4u __attribute__((ext_vector_type(4)));
typedef unsigned v2u __attribute__((ext_vector_type(2)));
typedef float f32x4 __attribute__((ext_vector_type(4)));
typedef float f32x2 __attribute__((ext_vector_type(2)));
typedef float f32x16 __attribute__((ext_vector_type(16)));
typedef short bf16x8 __attribute__((ext_vector_type(8)));
typedef short s16x4 __attribute__((ext_vector_type(4)));
#define LDS_WAIT() asm volatile("s_waitcnt lgkmcnt(0)" ::: "memory")
#define VM_WAIT() asm volatile("s_waitcnt vmcnt(0)" ::: "memory")
__device__ __forceinline__ unsigned f2bf(float f) { unsigned u = __builtin_bit_cast(unsigned, f); return (u + 0x7fffu + ((u >> 16) & 1u)) >> 16; }
__device__ __forceinline__ unsigned pk2(float lo, float hi) { return f2bf(lo) | (f2bf(hi) << 16); }
__device__ __forceinline__ float bf2f(unsigned b) { return __builtin_bit_cast(float, b << 16); }
__device__ __forceinline__ float bfround(float f) { return bf2f(f2bf(f)); }

#ifndef FFT_HD
#define FFT_HD __host__ __device__ __forceinline__
#endif
#if defined(__clang__)
typedef float cpx __attribute__((ext_vector_type(2)));
#else
struct cpx { float x, y; };
#endif
#if defined(__HIP_DEVICE_COMPILE__)
#define FFT_PK2(name, T2, C2, I1, I2) \
    __device__ __forceinline__ cpx name(cpx a, T2 b) { cpx t, r; asm(I1 : "=v"(t) : "v"(a), C2(b)); asm(I2 : "=v"(r) : "v"(a), C2(b), "v"(t)); return r; }
FFT_PK2(cmul,  cpx, "v", "v_pk_mul_f32 %0, %1, %2 op_sel:[0,0] op_sel_hi:[1,0]", "v_pk_fma_f32 %0, %1, %2, %3 op_sel:[1,1,0] op_sel_hi:[0,1,1] neg_lo:[1,0,0]")
FFT_PK2(cmulc, cpx, "v", "v_pk_mul_f32 %0, %1, %2 op_sel:[0,0] op_sel_hi:[1,0]", "v_pk_fma_f32 %0, %1, %2, %3 op_sel:[1,1,0] op_sel_hi:[0,1,1] neg_hi:[1,0,0]")
FFT_PK2(cmul_k,  cpx, "s", "v_pk_mul_f32 %0, %1, %2 op_sel:[0,0] op_sel_hi:[1,0]", "v_pk_fma_f32 %0, %1, %2, %3 op_sel:[1,1,0] op_sel_hi:[0,1,1] neg_lo:[1,0,0]")
FFT_PK2(cmulc_k, cpx, "s", "v_pk_mul_f32 %0, %1, %2 op_sel:[0,0] op_sel_hi:[1,0]", "v_pk_fma_f32 %0, %1, %2, %3 op_sel:[1,1,0] op_sel_hi:[0,1,1] neg_hi:[1,0,0]")
#define FFT_PK1(name, I1) __device__ __forceinline__ cpx name(cpx u, cpx v) { cpx r; asm(I1 : "=v"(r) : "v"(u), "v"(v)); return r; }
FFT_PK1(sub_mi, "v_pk_add_f32 %0, %1, %2 op_sel:[1,1] op_sel_hi:[0,0] neg_lo:[0,1] neg_hi:[1,0]")
FFT_PK1(add_iv, "v_pk_add_f32 %0, %1, %2 op_sel:[0,1] op_sel_hi:[1,0] neg_lo:[0,1]")
FFT_PK1(sub_iv, "v_pk_add_f32 %0, %1, %2 op_sel:[0,1] op_sel_hi:[1,0] neg_hi:[0,1]")
#else
FFT_HD cpx cmul(cpx a, cpx b) { return cpx{a.x * b.x - a.y * b.y, a.x * b.y + a.y * b.x}; }
FFT_HD cpx cmulc(cpx a, cpx b) { return cpx{a.x * b.x + a.y * b.y, a.y * b.x - a.x * b.y}; }
FFT_HD cpx cmul_k(cpx a, cpx b) { return cmul(a, b); }
FFT_HD cpx cmulc_k(cpx a, cpx b) { return cmulc(a, b); }
FFT_HD cpx sub_mi(cpx u, cpx v) { return cpx{u.y - v.y, v.x - u.x}; }
FFT_HD cpx add_iv(cpx u, cpx v) { return cpx{u.x - v.y, u.y + v.x}; }
FFT_HD cpx sub_iv(cpx u, cpx v) { return cpx{u.x + v.y, u.y - v.x}; }
#endif
#if defined(__clang__)
FFT_HD cpx cadd(cpx a, cpx b) { return a + b; }
FFT_HD cpx csub(cpx a, cpx b) { return a - b; }
#else
FFT_HD cpx cadd(cpx a, cpx b) { return cpx{a.x + b.x, a.y + b.y}; }
FFT_HD cpx csub(cpx a, cpx b) { return cpx{a.x - b.x, a.y - b.y}; }
#endif
FFT_HD int pidx(int i) { return i + (i >> 5); }
FFT_HD cpx cis_neg_rev(float rev) {
    const float x8 = rev * 8.0f; int oct = (int)x8; oct = oct > 7 ? 7 : oct; const float f = x8 - (float)oct;
    const float a = (oct & 1) ? (1.0f - f) : f, phi = a * 0.78539816339744831f, p2 = phi * phi;
    const float s = phi * (1.0f + p2 * (-1.6666666666666666e-1f + p2 * (8.3333333333333332e-3f + p2 * (-1.9841269841269841e-4f + p2 * 2.7557319223985893e-6f))));
    const float c = 1.0f + p2 * (-0.5f + p2 * (4.1666666666666664e-2f + p2 * (-1.3888888888888889e-3f + p2 * (2.4801587301587302e-5f + p2 * -2.7557319223985888e-7f))));
    const bool sw = ((oct + 1) & 2) != 0;
    float cc = sw ? s : c, ss = sw ? c : s;
    if (oct >= 2 && oct <= 5) cc = -cc;
    if (oct >= 4) ss = -ss;
    return cpx{cc, -ss};
}
FFT_HD float sin_acc(float x) { float rev = x * 0.15915494309189535f; rev -= floorf(rev); const cpx e = cis_neg_rev(rev); return -e.y; }
FFT_HD float cos_rev(float rev) { rev -= floorf(rev); return cis_neg_rev(rev).x; }
FFT_HD float sin_rev(float rev) { rev -= floorf(rev); return -cis_neg_rev(rev).y; }
FFT_HD cpx w16(int k) {
    constexpr float C1 = 0.92387953251128674f, S1 = 0.38268343236508977f, R2 = 0.70710678118654752f;
    switch (k) { case 0: return cpx{1.f, 0.f}; case 1: return cpx{C1, -S1}; case 2: return cpx{R2, -R2}; case 3: return cpx{S1, -C1};
                 case 4: return cpx{0.f, -1.f}; case 5: return cpx{-S1, -C1}; case 6: return cpx{-R2, -R2}; default: return cpx{-C1, -S1}; }
}
template <int R> FFT_HD constexpr int bitrev(int i) { int r = 0; for (int b = 1, c = R >> 1; b < R; b <<= 1, c >>= 1) if (i & b) r |= c; return r; }
template <int K> FFT_HD void dif_bf(cpx& x, cpx& y) { const cpx u = x, v = y; x = cadd(u, v); if constexpr (K == 0) y = csub(u, v); else if constexpr (K == 4) y = sub_mi(u, v); else y = cmul_k(csub(u, v), w16(K)); }
template <int K> FFT_HD void dit_bf(cpx& x, cpx& y) { const cpx u = x, t = y; if constexpr (K == 4) { x = add_iv(u, t); y = sub_iv(u, t); } else { cpx v = t; if constexpr (K != 0) v = cmulc_k(t, w16(K)); x = cadd(u, v); y = csub(u, v); } }
template <int R> FFT_HD void dif_regs(cpx (&a)[R]);
template <> FFT_HD void dif_regs<16>(cpx (&a)[16]) {
    dif_bf<0>(a[0], a[8]); dif_bf<1>(a[1], a[9]); dif_bf<2>(a[2], a[10]); dif_bf<3>(a[3], a[11]); dif_bf<4>(a[4], a[12]); dif_bf<5>(a[5], a[13]); dif_bf<6>(a[6], a[14]); dif_bf<7>(a[7], a[15]);
    dif_bf<0>(a[0], a[4]); dif_bf<2>(a[1], a[5]); dif_bf<4>(a[2], a[6]); dif_bf<6>(a[3], a[7]); dif_bf<0>(a[8], a[12]); dif_bf<2>(a[9], a[13]); dif_bf<4>(a[10], a[14]); dif_bf<6>(a[11], a[15]);
    dif_bf<0>(a[0], a[2]); dif_bf<4>(a[1], a[3]); dif_bf<0>(a[4], a[6]); dif_bf<4>(a[5], a[7]); dif_bf<0>(a[8], a[10]); dif_bf<4>(a[9], a[11]); dif_bf<0>(a[12], a[14]); dif_bf<4>(a[13], a[15]);
    dif_bf<0>(a[0], a[1]); dif_bf<0>(a[2], a[3]); dif_bf<0>(a[4], a[5]); dif_bf<0>(a[6], a[7]); dif_bf<0>(a[8], a[9]); dif_bf<0>(a[10], a[11]); dif_bf<0>(a[12], a[13]); dif_bf<0>(a[14], a[15]);
}
template <> FFT_HD void dif_regs<4>(cpx (&a)[4]) {
    dif_bf<0>(a[0], a[2]); dif_bf<4>(a[1], a[3]);
    dif_bf<0>(a[0], a[1]); dif_bf<0>(a[2], a[3]);
}
template <int R> FFT_HD void dit_regs(cpx (&a)[R]);
template <> FFT_HD void dit_regs<16>(cpx (&a)[16]) {
    dit_bf<0>(a[0], a[1]); dit_bf<0>(a[2], a[3]); dit_bf<0>(a[4], a[5]); dit_bf<0>(a[6], a[7]); dit_bf<0>(a[8], a[9]); dit_bf<0>(a[10], a[11]); dit_bf<0>(a[12], a[13]); dit_bf<0>(a[14], a[15]);
    dit_bf<0>(a[0], a[2]); dit_bf<4>(a[1], a[3]); dit_bf<0>(a[4], a[6]); dit_bf<4>(a[5], a[7]); dit_bf<0>(a[8], a[10]); dit_bf<4>(a[9], a[11]); dit_bf<0>(a[12], a[14]); dit_bf<4>(a[13], a[15]);
    dit_bf<0>(a[0], a[4]); dit_bf<2>(a[1], a[5]); dit_bf<4>(a[2], a[6]); dit_bf<6>(a[3], a[7]); dit_bf<0>(a[8], a[12]); dit_bf<2>(a[9], a[13]); dit_bf<4>(a[10], a[14]); dit_bf<6>(a[11], a[15]);
    dit_bf<0>(a[0], a[8]); dit_bf<1>(a[1], a[9]); dit_bf<2>(a[2], a[10]); dit_bf<3>(a[3], a[11]); dit_bf<4>(a[4], a[12]); dit_bf<5>(a[5], a[13]); dit_bf<6>(a[6], a[14]); dit_bf<7>(a[7], a[15]);
}
template <> FFT_HD void dit_regs<4>(cpx (&a)[4]) {
    dit_bf<0>(a[0], a[1]); dit_bf<0>(a[2], a[3]);
    dit_bf<0>(a[0], a[2]); dit_bf<4>(a[1], a[3]);
}
template <int R> FFT_HD void twiddle_powers(cpx w1, cpx (&pw)[R]) {
    pw[0] = cpx{1.f, 0.f}; pw[1] = w1; pw[2] = cmul(w1, w1); pw[3] = cmul(pw[2], w1);
    if constexpr (R > 4) { pw[4] = cmul(pw[2], pw[2]); pw[5] = cmul(pw[4], pw[1]); pw[6] = cmul(pw[4], pw[2]); pw[7] = cmul(pw[4], pw[3]); }
    if constexpr (R > 8) { pw[8] = cmul(pw[4], pw[4]);
#pragma unroll
        for (int k = 1; k < 8; ++k) pw[8 + k] = cmul(pw[8], pw[k]); }
}
template <int R, bool INV, int LOGM, class P> FFT_HD void fft_pass(P X, int tid, int nthr) {
    constexpr int LOGR = (R == 16) ? 4 : 2, logs = LOGM - LOGR, s = 1 << logs;
    constexpr bool SHARED_TW = (s <= 512);
    cpx pw[R];
    if (logs > 0 && SHARED_TW) twiddle_powers<R>(cis_neg_rev((float)(tid & (s - 1)) * (1.0f / (float)(1 << LOGM))), pw);
#pragma unroll 2
    for (int blk = tid; blk < 16384 / R; blk += nthr) {
        const int base = blk & (s - 1), idx0 = ((blk >> logs) << LOGM) + base;
        P X0 = X + pidx(idx0);
        cpx a[R];
        if (logs > 0 && !SHARED_TW) twiddle_powers<R>(cis_neg_rev((float)base * (1.0f / (float)(1 << LOGM))), pw);
        if (!INV) {
#pragma unroll
            for (int j = 0; j < R; ++j) a[j] = X0[j * s + ((j * s) >> 5)];
            dif_regs<R>(a);
#pragma unroll
            for (int i = 0; i < R; ++i) { const int k1 = bitrev<R>(i); cpx v = a[i]; if (logs > 0 && k1 != 0) v = cmul(v, pw[k1]); X0[k1 * s + ((k1 * s) >> 5)] = v; }
        } else {
#pragma unroll
            for (int i = 0; i < R; ++i) { const int k1 = bitrev<R>(i); cpx v = X0[k1 * s + ((k1 * s) >> 5)]; if (logs > 0 && k1 != 0) v = cmulc(v, pw[k1]); a[i] = v; }
            dit_regs<R>(a);
#pragma unroll
            for (int j = 0; j < R; ++j) X0[j * s + ((j * s) >> 5)] = a[j];
        }
    }
}
template <int R, int NB, class HP> FFT_HD void fft_mid_load(HP H, int tid, int nthr, int nmask, cpx (&h)[NB][R]) {
#pragma unroll
    for (int b = 0; b < NB; ++b) { const int p0 = ((tid + b * nthr) * R) & nmask;
#pragma unroll
        for (int k = 0; k < R; ++k) h[b][k] = H[p0 + k]; }
}
template <int R, int NB, class P> FFT_HD void fft_mid_apply(P X, const cpx (&h)[NB][R], int tid, int nthr) {
#pragma unroll
    for (int b = 0; b < NB; ++b) { P X0 = X + pidx((tid + b * nthr) * R); cpx a[R];
#pragma unroll
        for (int j = 0; j < R; ++j) a[j] = X0[j];
        dif_regs<R>(a);
#pragma unroll
        for (int i = 0; i < R; ++i) a[i] = cmul(a[i], h[b][bitrev<R>(i)]);
        dit_regs<R>(a);
#pragma unroll
        for (int j = 0; j < R; ++j) X0[j] = a[j]; }
}
template <int LOGN> FFT_HD int mirror_pos(int p) {
    if (LOGN == 14) { const int k = (p >> 10) | (((p >> 6) & 15) << 4) | (((p >> 2) & 15) << 8) | ((p & 3) << 12), km = (16384 - k) & 16383;
                      return ((km & 15) << 10) | (((km >> 4) & 15) << 6) | (((km >> 8) & 15) << 2) | (km >> 12); }
    else { const int k = (p >> 8) | (((p >> 4) & 15) << 4) | ((p & 15) << 8), km = (4096 - k) & 4095;
           return ((km & 15) << 8) | (((km >> 4) & 15) << 4) | (km >> 8); }
}
FFT_HD void split_two_real(cpx A, cpx B, cpx& H0, cpx& H1) { H0 = cpx{0.5f * (A.x + B.x), 0.5f * (A.y - B.y)}; H1 = cpx{0.5f * (A.y + B.y), 0.5f * (B.x - A.x)}; }
struct Frame {
    LAS unsigned char* lds;
    int tid, lane, wave;
    int vcu, G, bx;
    unsigned char* ws; float* z;
};
__device__ __forceinline__ Frame make_frame(unsigned char* lds_generic, unsigned char* ws, float* out, int wave0) {
    Frame F;
    int lane; asm volatile("v_mbcnt_lo_u32_b32 %0, -1, 0\n\tv_mbcnt_hi_u32_b32 %0, -1, %0" : "=v"(lane));
    int bx = blockIdx.x, G = gridDim.x;
    asm volatile("" : "+v"(lane)); asm volatile("" : "+s"(bx)); asm volatile("" : "+s"(G)); asm volatile("" : "+s"(wave0));
    const int tid = wave0 * 64 + lane;
    unsigned long long w = (unsigned long long)ws, o = (unsigned long long)out; asm volatile("" : "+s"(w)); asm volatile("" : "+s"(o));
    F.lds = (LAS unsigned char*)lds_generic;
    F.tid = tid; F.lane = lane; F.wave = wave0;
    F.G = G; F.bx = bx; F.vcu = (G % 8 == 0) ? (bx % 8) * (G / 8) + bx / 8 : bx;
    F.ws = (unsigned char*)(GAS unsigned char*)w; F.z = (float*)(GAS float*)o;
    return F;
}
__device__ __forceinline__ const float* inp(const Frame& F, int i) {
    const LAS unsigned* t = (const LAS unsigned*)(F.lds + PTR_OFF) + 2 * i;
    const unsigned lo = __builtin_amdgcn_readfirstlane(t[0]), hi = __builtin_amdgcn_readfirstlane(t[1]);
    return (const float*)(const GAS float*)(((unsigned long long)hi << 32) | lo);
}
__device__ __forceinline__ float wave_sum(float v) { return pg8::wave_sum64(v); }
__device__ __forceinline__ void block_sum2(Frame& F, float& a, float& b) {
    LAS float* scr = (LAS float*)(F.lds + SCR_OFF);
    a = wave_sum(a); b = wave_sum(b);
    __syncthreads();
    if (F.lane == 0) { scr[F.wave * 2] = a; scr[F.wave * 2 + 1] = b; }
    __syncthreads();
    float sa = 0.f, sb = 0.f;
#pragma unroll
    for (int w = 0; w < NWAVES; ++w) { sa += scr[w * 2]; sb += scr[w * 2 + 1]; }
    a = sa; b = sb;
}

__device__ __forceinline__ void phase_init(Frame& F) {
    const int gw = F.vcu * NWAVES + F.wave, NGW = F.G * NWAVES;
    bf16* zb = (bf16*)(F.ws + WS_ZB); float* stats = (float*)(F.ws + WS_STATS);
    const float* x0 = inp(F, 0); const float* x1 = inp(F, 1);
    for (int m = gw; m < T; m += NGW) {
        const float* src = (m < T_PROMPT) ? x0 + (size_t)m * D : x1 + (size_t)(m - T_PROMPT) * D;
        const GAS f32x4* s4 = (const GAS f32x4*)src + F.lane; GAS v2u* b4 = (GAS v2u*)(zb + (size_t)m * D) + F.lane; GAS unsigned short* l4 = (GAS unsigned short*)(F.ws + WS_ZL) + (size_t)m * (D / 4) + F.lane;
#pragma unroll
        for (int j = 0; j < 8; ++j) { const f32x4 v = s4[64 * j];
            v2u o; o.x = (pg8::z20_zb(v.x) >> 16) | (pg8::z20_zb(v.y) & 0xffff0000u); o.y = (pg8::z20_zb(v.z) >> 16) | (pg8::z20_zb(v.w) & 0xffff0000u); b4[64 * j] = o;
            l4[64 * j] = (unsigned short)((pg8::z20_c(v.x, 0) | pg8::z20_c(v.y, 1)) | (pg8::z20_c(v.z, 2) | pg8::z20_c(v.w, 3))); }
        if (F.lane == 0) { stats[2 * m] = 0.f; stats[2 * m + 1] = 1.f; }
    }
    const int gt = F.vcu * (NWAVES * 64) + F.tid;
    if (gt < 8192) ((float*)(F.ws + WS_IDG))[gt] = 1.f;
    if (gt < 32768) ((float*)(F.ws + WS_IDB))[gt] = 0.f;
}

struct ConvJob { const float* W; int K, N; bf16* WT; const float* gk; const float* bk; float* cvec; float* dvec; const float* ebias; int mode; };
__device__ __forceinline__ void conv_item(const float* W, int K, int N, bf16* WT, const float* gk, const float* bk, float* cvec, float* dvec, const float* ebias, int mode, int nb, int kbeg, int kend, LAS float* scr, int lane) {
    const int n0 = 32 * nb;
    const float colscale = (mode == 2 && n0 < 6144) ? QSCALE : 1.0f;
    int rbase = n0;
    if (mode == 1) { rbase = (n0 < FF) ? (n0 / 128) * 256 + (n0 % 128) : ((n0 - FF) / 128) * 256 + 128 + ((n0 - FF) % 128); }
    float cs[32], ds[32];
#pragma unroll
    for (int i = 0; i < 32; ++i) { cs[i] = 0.f; ds[i] = 0.f; }
    f32x4 wv[8], wn[8];
    const float* wp = W + (size_t)(kbeg + lane) * N + n0;
#pragma unroll
    for (int j = 0; j < 8; ++j) wv[j] = *(const GAS f32x4*)(wp + 4 * j);
    float g = gk[kbeg + lane], b = bk[kbeg + lane];
    bf16* op = WT + (size_t)rbase * K + lane;
    for (int k0 = kbeg; k0 < kend; k0 += 64) {
        const int k1 = (k0 + 64 < kend) ? k0 + 64 : k0;
        const float* wq = W + (size_t)(k1 + lane) * N + n0;
#pragma unroll
        for (int j = 0; j < 8; ++j) wn[j] = *(const GAS f32x4*)(wq + 4 * j);
        const float gnx = gk[k1 + lane], bnx = bk[k1 + lane];
#pragma unroll
        for (int j = 0; j < 8; ++j)
#pragma unroll
            for (int e = 0; e < 4; ++e) { const int i = 4 * j + e; const float w = wv[j][e] * colscale; const unsigned vb = f2bf(w * g); const float v = bf2f(vb);
                cs[i] += v; ds[i] += b * w; op[(size_t)i * K + k0] = (bf16)vb; }
#pragma unroll
        for (int j = 0; j < 8; ++j) wv[j] = wn[j];
        g = gnx; b = bnx;
    }
    float myc = 0.f, myd = 0.f;
#pragma unroll
    for (int i = 0; i < 32; ++i) { const float c = wave_sum(cs[i]), d = wave_sum(ds[i]); myc = (lane == i) ? c : myc; myd = (lane == i) ? d : myd; }
    if (lane < 32) { cvec[rbase + lane] = myc; dvec[rbase + lane] = myd + ebias[n0 + lane]; }
}
__device__ __forceinline__ void filt_pos(Frame& F, int jl, int var, int t) {
    const int L = var ? 2048 : 8192, lane = F.lane;
    const float* w1 = inp(F, 12) + (size_t)jl * 33 * 64; const float* b1 = inp(F, 13) + jl * 64; const float* w2 = inp(F, 14) + (size_t)jl * 64 * 64; const float* b2 = inp(F, 15) + jl * 64; const float* fr = inp(F, 16) + jl * 64;
    float feat = 0.f;
    if (lane == 0) feat = (float)t / (float)(L - 1);
    else if (lane < 33) { const int bi = (lane - 1) & 15; const float band = 1e-4f + (float)bi * ((15.0f - 1e-4f) / 15.0f); const float rev = band * ((float)t / (float)L);
        feat = (lane < 17) ? cos_rev(rev) : -sin_rev(rev); }
    float acc = b1[lane];
    for (int k = 0; k < 33; ++k) acc += __builtin_bit_cast(float, __builtin_amdgcn_readlane(__builtin_bit_cast(int, feat), k)) * w1[k * 64 + lane];
    const float fq = fr[lane];
    const float h1 = sin_acc(fq * acc);
    float acc2 = b2[lane];
    for (int k = 0; k < 64; ++k) acc2 += __builtin_bit_cast(float, __builtin_amdgcn_readlane(__builtin_bit_cast(int, h1), k)) * w2[k * 64 + lane];
    const float h2 = sin_acc(fq * acc2);
    bf16* hrow = (bf16*)(F.ws + WS_H2B) + (size_t)((var ? 8192 : 0) + t) * 256;
    hrow[lane] = (bf16)f2bf(h2); hrow[64 + lane] = 0; hrow[128 + lane] = 0; hrow[192 + lane] = 0;
}
__device__ __forceinline__ void phase_convert(Frame& F, int layer) {
    LAS float* scr = (LAS float*)(F.lds + RING_OFF + F.wave * 16384);
    const int gw = F.vcu * NWAVES + F.wave, NGW = F.G * NWAVES;
    const int jl = layer >> 1; const bool hy = (layer & 1) != 0;
    const float* ln_g = inp(F, 2); const float* ln_b = inp(F, 3);
    const float* ones = (const float*)(F.ws + WS_IDG); const float* zeros = (const float*)(F.ws + WS_IDB); float* dump = (float*)(F.ws + WS_DUMP);
    float* cd = (float*)(F.ws + WS_CD);
    float* c1 = cd, *d1 = cd + NFF2, *cm = cd + 2 * NFF2, *dm = cm + NQKV, *c2 = dm + NQKV, *d2 = c2 + NFF2;
    const int nb1 = (D / 32) * 4, nb0 = NFF2 / 32, nb4 = (hy ? NHY : NQKV) / 32, nb5 = D / 32;
    const int total = 2 * nb1 + 2 * nb0 + nb4 + nb5;
    for (int it = gw; it < total; it += NGW) {
        int r = it;
        if (r < 2 * nb1) { const int f = r / nb1; r -= f * nb1;
            conv_item(inp(F, 5) + (size_t)(layer * 2 + f) * FF * D, FF, D, (bf16*)(F.ws + (f ? W_OUT2 : W_OUT1)), ones, zeros, dump, dump + NQKV, zeros, 0, r >> 2, (r & 3) * 1408, (r & 3) * 1408 + 1408, scr, F.lane); continue; }
        r -= 2 * nb1;
        if (r < 2 * nb0) { const int f = r / nb0; r -= f * nb0;
            const float* gk = f ? ln_g + (size_t)(layer * 3 + 1) * D : (layer ? ln_g + (size_t)((layer - 1) * 3 + 2) * D : ones);
            const float* bk = f ? ln_b + (size_t)(layer * 3 + 1) * D : (layer ? ln_b + (size_t)((layer - 1) * 3 + 2) * D : zeros);
            conv_item(inp(F, 4) + (size_t)(layer * 2 + f) * D * NFF2, D, NFF2, (bf16*)(F.ws + (f ? W_IN2 : W_IN1)), gk, bk, f ? c2 : c1, f ? d2 : d1, zeros, 1, r, 0, D, scr, F.lane); continue; }
        r -= 2 * nb0;
        if (r < nb4) {
            const float* gk = ln_g + (size_t)(layer * 3) * D; const float* bk = ln_b + (size_t)(layer * 3) * D;
            if (hy) conv_item(inp(F, 8) + (size_t)jl * D * NHY, D, NHY, (bf16*)(F.ws + W_MIN), gk, bk, cm, dm, inp(F, 9) + (size_t)jl * NHY, 0, r, 0, D, scr, F.lane);
            else conv_item(inp(F, 6) + (size_t)jl * D * NQKV, D, NQKV, (bf16*)(F.ws + W_MIN), gk, bk, cm, dm, zeros, 2, r, 0, D, scr, F.lane);
            continue; }
        r -= nb4;
        conv_item((hy ? inp(F, 19) : inp(F, 7)) + (size_t)jl * D * D, D, D, (bf16*)(F.ws + W_MOUT), ones, zeros, dump, dump + NQKV, zeros, 0, r, 0, D, scr, F.lane);
    }
    if (hy) {
        for (int p = gw; p < 8192 + 2048; p += NGW) { if (p < 8192) filt_pos(F, jl, 0, p); else filt_pos(F, jl, 1, p - 8192); }
        const float* w3 = inp(F, 17) + (size_t)jl * 64 * 8192; bf16* w3T = (bf16*)(F.ws + WS_W3T);
        for (int n = gw; n < 8192; n += NGW) { bf16* r = w3T + (size_t)n * 256; r[F.lane] = (bf16)f2bf(w3[(size_t)F.lane * 8192 + n]); r[64 + F.lane] = 0; r[128 + F.lane] = 0; r[192 + F.lane] = 0; }
    }
}

__device__ __forceinline__ void phase_finalize(Frame& F) {
    const float* part = (const float*)(F.ws + WS_PART); float* stats = (float*)(F.ws + WS_STATS);
    for (int row = F.vcu * (NWAVES * 64) + F.tid; row < T; row += F.G * NWAVES * 64) {
        const GAS f32x4* p = (const GAS f32x4*)(part + (size_t)row * 128);
        float s = 0.f, q = 0.f;
#pragma unroll 8
        for (int j = 0; j < 32; ++j) { const f32x4 v = p[j]; s += v.x + v.z; q += v.y + v.w; }
        const float mean = s * (1.0f / D); const float var = fmaxf(q * (1.0f / D) - mean * mean, 0.f);
        *(GAS f32x2*)(stats + 2 * (size_t)row) = (f32x2){mean, 1.0f / sqrtf(var + LN_EPS)};
    }
}

#ifdef DBG_CHECK
__device__ __forceinline__ void phase_check_qkv(Frame& F) {
    const int gw = F.vcu * NWAVES + F.wave, NGW = F.G * NWAVES;
    const float* W = inp(F, 6); const float* g = inp(F, 2); const float* b = inp(F, 3);
    const float* stats = (const float*)(F.ws + WS_STATS); const bf16* QKV = (const bf16*)(F.ws + WS_BIG + BIG_QKV);
#ifndef DBG_ROW0
#define DBG_ROW0 0
#define DBG_ROW1 T
#endif
#ifndef DBG_COL0
#define DBG_COL0 0
#define DBG_COL1 NQKV
#endif
    float worst = 0.f; unsigned nbad = 0;
#ifdef CHK_ROWS
    {
        const bf16* zbp = (const bf16*)(F.ws + WS_ZB);
        for (int s = gw; s < 8192; s += NGW) {
            const unsigned hsh = (unsigned)s * 2654435761u; const int row = (int)(hsh % (unsigned)T);
            float sm = 0.f, sq = 0.f, dz = 0.f;
            for (int k = F.lane; k < D; k += 64) { const float v = F.z[(size_t)row * D + k]; sm += v; sq += v * v; dz = fmaxf(dz, fabsf(bf2f(zbp[(size_t)row * D + k]) - v)); }
            sm = wave_sum(sm); sq = wave_sum(sq); dz = fmaxf(dz, pg8::xor32_max(dz)); dz = fmaxf(dz, pg8::swz_xor<16>(dz)); dz = fmaxf(dz, pg8::swz_xor<8>(dz)); dz = fmaxf(dz, pg8::swz_xor<4>(dz)); dz = fmaxf(dz, pg8::swz_xor<2>(dz)); dz = fmaxf(dz, pg8::swz_xor<1>(dz));
            const float mean = sm * (1.0f / D), var = sq * (1.0f / D) - mean * mean, rstd = 1.0f / sqrtf(var + LN_EPS);
            const bool bad = (CHK_ROWS == 1) ? (fabsf(mean - stats[2 * row]) > CHK_MTOL || fabsf(rstd - stats[2 * row + 1]) > CHK_RTOL * rstd) : (dz > 0.05f);
            nbad += bad ? 1u : 0u;
        }
        if (F.lane == 0 && nbad) atomicAdd((unsigned*)(F.ws + WS_CTL) + 15000, nbad);
        return;
    }
#endif
    for (int s = gw; s < 8192; s += NGW) {
        const unsigned hsh = (unsigned)s * 2654435761u; const int row = DBG_ROW0 + (int)(hsh % (unsigned)(DBG_ROW1 - DBG_ROW0)), col = DBG_COL0 + (int)((hsh >> 7) % (unsigned)(DBG_COL1 - DBG_COL0));
#ifdef CHK_HYP
        const float mean = 0.f, rstd = 1.f;
#else
        const float mean = stats[2 * row], rstd = stats[2 * row + 1];
#endif
        float acc = 0.f;
        for (int k = F.lane; k < D; k += 64) acc += ((F.z[(size_t)row * D + k] - mean) * rstd * g[k] + b[k]) * W[(size_t)k * NQKV + col];
        acc = wave_sum(acc) * (col < 6144 ? QSCALE : 1.0f);
        const float got = bf2f(QKV[(size_t)row * NQKV + col]);
        worst = fmaxf(worst, fabsf(got - acc)); nbad += (fabsf(got - acc) > DBG_THR) ? 1u : 0u;
    }
#ifdef DBG_COUNT
    if (F.lane == 0 && nbad) atomicAdd((unsigned*)(F.ws + WS_CTL) + 15000, nbad);
#else
    if (F.lane == 0) atomicMax((unsigned*)(F.ws + WS_CTL) + 15000, __builtin_bit_cast(unsigned, worst));
#endif
}
#endif
__device__ __forceinline__ void phase_final_ln(Frame& F) {
    const int gw = F.vcu * NWAVES + F.wave, NGW = F.G * NWAVES;
    const float* stats = (const float*)(F.ws + WS_STATS);
    const float* g = inp(F, 2) + (size_t)(3 * 3 + 2) * D; const float* b = inp(F, 3) + (size_t)(3 * 3 + 2) * D;
    for (int m = gw; m < T; m += NGW) {
        const float mean = stats[2 * m], rstd = stats[2 * m + 1];
        GAS f32x4* d4 = (GAS f32x4*)(F.z + (size_t)m * D) + F.lane; const GAS f32x4* g4 = (const GAS f32x4*)g + F.lane; const GAS f32x4* b4 = (const GAS f32x4*)b + F.lane;
        float dbg = 0.f;
#ifdef DBG_CHECK
        #ifdef DBG_COUNT
        const float dbgval = (float)((const unsigned*)(F.ws + WS_CTL))[15000] * DBG_CHECK_SCALE;
#else
        const float dbgval = __builtin_bit_cast(float, ((const unsigned*)(F.ws + WS_CTL))[15000]) * DBG_CHECK_SCALE;
#endif
#endif
#ifdef DBG_BUF
        {
            const bf16* bp = (const bf16*)(F.ws + WS_BIG + DBG_OFF) + (size_t)m * DBG_PITCH; float s = 0.f;
            for (int c = F.lane; c < DBG_COLS; c += 64) s += bf2f(bp[c]) * (float)(1 + (c & 7));
            dbg = wave_sum(s) * 0.01f;
        }
#endif
#pragma unroll
        for (int j = 0; j < 8; ++j) {
            const v2u zr = ((const GAS v2u*)((const bf16*)(F.ws + WS_ZB) + (size_t)m * D) + F.lane)[64 * j]; const unsigned q = ((const GAS unsigned short*)(F.ws + WS_ZL) + (size_t)m * (D / 4) + F.lane)[64 * j];
            const f32x4 v = (f32x4){pg8::z20_dec(zr.x << 16, q, 0), pg8::z20_dec(zr.x & 0xffff0000u, q, 1), pg8::z20_dec(zr.y << 16, q, 2), pg8::z20_dec(zr.y & 0xffff0000u, q, 3)} + dbg;
            d4[64 * j] = (v - mean) * rstd * g4[64 * j] + b4[64 * j];
#ifdef DBG_CHECK
            d4[64 * j] = (f32x4){dbgval, dbgval, dbgval, dbgval};
#endif
        }
    }
}

__device__ __forceinline__ void phase_transpose(Frame& F, const bf16* src, int R, int C, bf16* dst) {
    LAS unsigned char* scr = F.lds + RING_OFF + F.wave * 16384;
    const int gw = F.vcu * NWAVES + F.wave, NGW = F.G * NWAVES, tr = R / 64, tc = C / 64, lane = F.lane;
    const size_t sp = (size_t)C, dp = (size_t)R;
    v4u cur[8], nxt[8];
    int it = gw;
    if (it < tr * tc) { const int r0 = 64 * (it / tc), c0 = 64 * (it % tc);
#pragma unroll
        for (int i = 0; i < 8; ++i) cur[i] = *(const GAS v4u*)(src + (size_t)(r0 + (lane >> 3) + 8 * i) * sp + c0 + 8 * (lane & 7)); }
    for (; it < tr * tc; it += NGW) {
        const int r0 = 64 * (it / tc), c0 = 64 * (it % tc);
        const int itn = (it + NGW < tr * tc) ? it + NGW : it;
        { const int rn = 64 * (itn / tc), cn = 64 * (itn % tc);
#pragma unroll
          for (int i = 0; i < 8; ++i) nxt[i] = *(const GAS v4u*)(src + (size_t)(rn + (lane >> 3) + 8 * i) * sp + cn + 8 * (lane & 7)); }
#pragma unroll
        for (int i = 0; i < 8; ++i) { const int row = (lane >> 3) + 8 * i, ch = lane & 7;
            LAS unsigned* w = (LAS unsigned*)(scr + row * 132 + ch * 16); w[0] = cur[i].x; w[1] = cur[i].y; w[2] = cur[i].z; w[3] = cur[i].w; }
        LDS_WAIT(); asm volatile("" ::: "memory");
        const LAS unsigned short* rd = (const LAS unsigned short*)(scr + lane * 132);
#pragma unroll 8
        for (int c = 0; c < 64; ++c) dst[(size_t)(c0 + c) * dp + r0 + lane] = rd[c];
        LDS_WAIT(); asm volatile("" ::: "memory");
#pragma unroll
        for (int i = 0; i < 8; ++i) cur[i] = nxt[i];
    }
}
template <int LOGN> __device__ __forceinline__ void fft_forward(LAS cpx* X, int tid) {
    fft_pass<16, false, LOGN>(X, tid, NWAVES * 64); __syncthreads();
    fft_pass<16, false, LOGN - 4>(X, tid, NWAVES * 64); __syncthreads();
    fft_pass<16, false, LOGN - 8>(X, tid, NWAVES * 64); __syncthreads();
    if constexpr (LOGN == 14) { fft_pass<4, false, 2>(X, tid, NWAVES * 64); __syncthreads(); }
}
template <int LOGN> __device__ __forceinline__ void fft_inverse(LAS cpx* X, int tid) {
    if constexpr (LOGN == 14) { fft_pass<4, true, 2>(X, tid, NWAVES * 64); __syncthreads(); }
    fft_pass<16, true, LOGN - 8>(X, tid, NWAVES * 64); __syncthreads();
    fft_pass<16, true, LOGN - 4>(X, tid, NWAVES * 64); __syncthreads();
    fft_pass<16, true, LOGN>(X, tid, NWAVES * 64); __syncthreads();
}
template <int LOGN> __device__ __forceinline__ void conv_fft(LAS cpx* X, const GAS cpx* H, int tid) {
    constexpr int R = (LOGN == 14) ? 4 : 16, NB = 16384 / R / (NWAVES * 64);
    fft_pass<16, false, LOGN>(X, tid, NWAVES * 64); __syncthreads();
    if constexpr (LOGN == 14) { fft_pass<16, false, LOGN - 4>(X, tid, NWAVES * 64); __syncthreads(); }
    cpx h[NB][R];
    fft_mid_load<R, NB>(H, tid, NWAVES * 64, (1 << LOGN) - 1, h);
    fft_pass<16, false, (LOGN == 14) ? LOGN - 8 : LOGN - 4>(X, tid, NWAVES * 64); __syncthreads();
    fft_mid_apply<R, NB>(X, h, tid, NWAVES * 64); __syncthreads();
}
template <int LOGN> __device__ __forceinline__ void fft_tail(LAS cpx* X, int tid) {
    if constexpr (LOGN == 14) { fft_pass<16, true, LOGN - 8>(X, tid, NWAVES * 64); __syncthreads(); }
    fft_pass<16, true, LOGN - 4>(X, tid, NWAVES * 64); __syncthreads();
    fft_pass<16, true, LOGN>(X, tid, NWAVES * 64); __syncthreads();
}
template <int VAR> __device__ __forceinline__ void spec_unit(Frame& F, int jl, int c) {
    constexpr int L = VAR ? 2048 : 8192, N = 2 * L, LOGN = VAR ? 12 : 14, TPS = VAR ? 128 : 512, NP = L / TPS;
    LAS cpx* X = (LAS cpx*)(F.lds + RING_OFF);
    int tid = F.tid; asm volatile("" : "+v"(tid));
    const int seg = tid / TPS, lt = tid % TPS, ch = c + seg;
    const float* taps = (const float*)(F.ws + WS_TAPS) + (size_t)ch * 10240 + (VAR ? 8192 : 0);
    float acc[NP][4];
    float n0 = 0.f, n1 = 0.f;
#pragma unroll
    for (int k = 0; k < NP; ++k) {
#pragma unroll
        for (int f = 0; f < 4; ++f) acc[k][f] = taps[(size_t)f * 2048 * 10240 + lt + TPS * k];
        n0 += fabsf(acc[k][0]) + fabsf(acc[k][1]); n1 += fabsf(acc[k][2]) + fabsf(acc[k][3]); }
    if (VAR == 0) block_sum2(F, n0, n1);
    else {
        LAS float* scr = (LAS float*)(F.lds + SCR_OFF);
        n0 = wave_sum(n0); n1 = wave_sum(n1);
        __syncthreads();
        if (F.lane == 0) { scr[F.wave * 2] = n0; scr[F.wave * 2 + 1] = n1; }
        __syncthreads();
        n0 = scr[4 * seg] + scr[4 * seg + 2]; n1 = scr[4 * seg + 1] + scr[4 * seg + 3];
    }
    const float i0 = 1.0f / n0, i1 = 1.0f / n1;
    __syncthreads();
#pragma unroll
    for (int k = 0; k < NP; ++k) { const int t = lt + TPS * k; const cpx hf = cpx{acc[k][0] * i0, acc[k][2] * i1}, hb = cpx{acc[k][1] * i0, acc[k][3] * i1};
        if (t == 0) { float zf = 0.f; asm volatile("" : "+v"(zf));
                      X[pidx(seg * N)] = cadd(hf, hb); X[pidx(seg * N + L)] = cpx{zf, zf}; }
        else { X[pidx(seg * N + t)] = hf; X[pidx(seg * N + N - t)] = hb; } }
    __syncthreads();
    fft_forward<LOGN>(X, tid);
    cpx* spec = (cpx*)(F.ws + WS_BIG + (VAR ? BIG_SPEC1 : BIG_SPEC0));
    GAS cpx* d0 = (GAS cpx*)(spec + ((size_t)0 * D + ch) * N); GAS cpx* d1 = (GAS cpx*)(spec + ((size_t)1 * D + ch) * N);
#pragma unroll 4
    for (int pl = lt; pl < N; pl += TPS) { cpx H0, H1; split_two_real(X[pidx(seg * N + pl)], X[pidx(seg * N + mirror_pos<LOGN>(pl))], H0, H1); d0[pl] = H0; d1[pl] = H1; }
}
__device__ __forceinline__ void phase_spectra(Frame& F, int jl) {
    for (int u = F.vcu; u < D + D / 4; u += F.G) { if (u < D) spec_unit<0>(F, jl, u); else spec_unit<1>(F, jl, 4 * (u - D)); }
    __syncthreads();
}
__device__ __forceinline__ void load_conv16(const bf16* seq, int t0, int L, float w0, float w1, float w2, float cb, float (&out)[16]) {
    const v4u a = *(const GAS v4u*)(seq + t0), b = *(const GAS v4u*)(seq + t0 + 8);
    float u[18];
    u[0] = (t0 > 0) ? bf2f(seq[t0 - 1]) : 0.f; u[17] = (t0 + 16 < L) ? bf2f(seq[t0 + 16]) : 0.f;
    u[1] = bf2f(a.x & 0xffffu); u[2] = bf2f(a.x >> 16); u[3] = bf2f(a.y & 0xffffu); u[4] = bf2f(a.y >> 16); u[5] = bf2f(a.z & 0xffffu); u[6] = bf2f(a.z >> 16); u[7] = bf2f(a.w & 0xffffu); u[8] = bf2f(a.w >> 16);
    u[9] = bf2f(b.x & 0xffffu); u[10] = bf2f(b.x >> 16); u[11] = bf2f(b.y & 0xffffu); u[12] = bf2f(b.y >> 16); u[13] = bf2f(b.z & 0xffffu); u[14] = bf2f(b.z >> 16); u[15] = bf2f(b.w & 0xffffu); u[16] = bf2f(b.w >> 16);
#pragma unroll
    for (int i = 0; i < 16; ++i) out[i] = w0 * u[i] + w1 * u[i + 1] + w2 * u[i + 2] + cb;
}
template <int VAR> __device__ __forceinline__ void conv_unit(Frame& F, int jl, int c, int pair) {
    constexpr int L = VAR ? 2048 : 8192, N = 2 * L, LOGN = VAR ? 12 : 14, TPS = VAR ? 128 : 512;
    LAS cpx* X = (LAS cpx*)(F.lds + RING_OFF);
    int tid = F.tid; asm volatile("" : "+v"(tid));
    const int seg = tid / TPS, t0 = (tid % TPS) * 16;
    const int rowA = VAR ? T_PROMPT + (2 * seg) * L : (2 * pair) * L, rowB = rowA + L;
    const bf16* UT = (const bf16*)(F.ws + WS_BIG + BIG_UT); bf16* Z2T = (bf16*)(F.ws + WS_BIG + BIG_Z2T);
    const float* cw = inp(F, 10) + (size_t)jl * 3 * NHY; const float* cbv = inp(F, 11) + (size_t)jl * NHY; const float* skip = inp(F, 18) + (size_t)jl * 2 * D;
    const cpx* spec = (const cpx*)(F.ws + WS_BIG + (VAR ? BIG_SPEC1 : BIG_SPEC0));
#ifndef CONV_SCALE
#define CONV_SCALE 1.0f
#endif
    const float invN = CONV_SCALE / (float)N;
    float va[16], vb[16];
    { const int ch = c; const float w0 = cw[ch], w1 = cw[NHY + ch], w2 = cw[2 * NHY + ch], cb = cbv[ch];
      load_conv16(UT + (size_t)ch * T + rowA, t0, L, w0, w1, w2, cb, va); load_conv16(UT + (size_t)ch * T + rowB, t0, L, w0, w1, w2, cb, vb); }
    __syncthreads();
#pragma unroll
    for (int i = 0; i < 16; ++i) { X[pidx(seg * N + t0 + i)] = cpx{va[i], vb[i]}; X[pidx(seg * N + L + t0 + i)] = cpx{0.f, 0.f}; }
    __syncthreads();
    conv_fft<LOGN>(X, (const GAS cpx*)(spec + ((size_t)0 * D + c) * N), tid);
    fft_tail<LOGN>(X, tid);
    {   float ga[16], gb[16];
        const int ch = D + c; const float w0 = cw[ch], w1 = cw[NHY + ch], w2 = cw[2 * NHY + ch], cb = cbv[ch];
        load_conv16(UT + (size_t)ch * T + rowA, t0, L, w0, w1, w2, cb, ga); load_conv16(UT + (size_t)ch * T + rowB, t0, L, w0, w1, w2, cb, gb);
        const float sk = skip[c];
#pragma unroll
        for (int i = 0; i < 16; ++i) { const cpx y = X[pidx(seg * N + t0 + i)]; va[i] = ga[i] * (y.x * invN + sk * va[i]); vb[i] = gb[i] * (y.y * invN + sk * vb[i]); }
#pragma unroll
        for (int i = 0; i < 16; ++i) { X[pidx(seg * N + t0 + i)] = cpx{va[i], vb[i]}; X[pidx(seg * N + L + t0 + i)] = cpx{0.f, 0.f}; }
    }
    __syncthreads();
    conv_fft<LOGN>(X, (const GAS cpx*)(spec + ((size_t)1 * D + c) * N), tid);
    fft_tail<LOGN>(X, tid);
    {   float ga[16], gb[16];
        const int ch = 2 * D + c; const float w0 = cw[ch], w1 = cw[NHY + ch], w2 = cw[2 * NHY + ch], cb = cbv[ch];
        load_conv16(UT + (size_t)ch * T + rowA, t0, L, w0, w1, w2, cb, ga); load_conv16(UT + (size_t)ch * T + rowB, t0, L, w0, w1, w2, cb, gb);
        const float sk = skip[D + c];
        float ra[16], rb[16];
#pragma unroll
        for (int i = 0; i < 16; ++i) { const cpx y = X[pidx(seg * N + t0 + i)]; ra[i] = ga[i] * (y.x * invN + sk * va[i]); rb[i] = gb[i] * (y.y * invN + sk * vb[i]); }
        v4u o0, o1;
        o0.x = pk2(ra[0], ra[1]); o0.y = pk2(ra[2], ra[3]); o0.z = pk2(ra[4], ra[5]); o0.w = pk2(ra[6], ra[7]); o1.x = pk2(ra[8], ra[9]); o1.y = pk2(ra[10], ra[11]); o1.z = pk2(ra[12], ra[13]); o1.w = pk2(ra[14], ra[15]);
        GAS v4u* da = (GAS v4u*)(Z2T + (size_t)c * T + rowA + t0); da[0] = o0; da[1] = o1;
        o0.x = pk2(rb[0], rb[1]); o0.y = pk2(rb[2], rb[3]); o0.z = pk2(rb[4], rb[5]); o0.w = pk2(rb[6], rb[7]); o1.x = pk2(rb[8], rb[9]); o1.y = pk2(rb[10], rb[11]); o1.z = pk2(rb[12], rb[13]); o1.w = pk2(rb[14], rb[15]);
        GAS v4u* db = (GAS v4u*)(Z2T + (size_t)c * T + rowB + t0); db[0] = o0; db[1] = o1;
    }
}
__device__ __forceinline__ void phase_conv(Frame& F, int jl) {
    for (int u = F.vcu; u < 3 * D; u += F.G) { if (u < 2 * D) conv_unit<0>(F, jl, u >> 1, u & 1); else conv_unit<1>(F, jl, u - 2 * D, 0); }
    __syncthreads();
}
__device__ __forceinline__ unsigned voff_b(unsigned row, unsigned ch) { return 256u * row + 16u * (ch ^ (((row & 3u) << 2) | ((row >> 2) & 3u))); }
__device__ __forceinline__ s16x4 vtr(const LAS unsigned char* p) { typedef short v4i16_t __attribute__((ext_vector_type(4))); return __builtin_bit_cast(s16x4, __builtin_amdgcn_ds_read_tr16_b64_v4i16((LAS v4i16_t*)p)); }
__device__ __forceinline__ unsigned cvtpk(float lo, float hi) { typedef __bf16 bf16x2_t __attribute__((ext_vector_type(2))); f32x2 v = {lo, hi}; bf16x2_t b = __builtin_convertvector(v, bf16x2_t); return __builtin_bit_cast(unsigned, b); }
__device__ __forceinline__ void dma16(const void* gsrc, LAS unsigned char* lds_dst) {
    unsigned keep; const unsigned dst = __builtin_amdgcn_readfirstlane((unsigned)(unsigned long long)lds_dst);
    asm volatile("s_mov_b32 %0, m0\n\ts_mov_b32 m0, %2\n\ts_nop 0\n\tglobal_load_lds_dwordx4 %1, off\n\ts_mov_b32 m0, %0" : "=&s"(keep) : "v"(gsrc), "s"(dst) : "memory");
}
struct TileDesc { int g, kt0; };
constexpr int ATT_NT = 28;
__device__ __forceinline__ TileDesc attn_tile(int it, int T0w) {
    TileDesc t;
    if (it < 12) { t.g = 0; t.kt0 = (T0w & ~255) - 64 + 32 * it; }
    else if (it < 18) { t.g = 1; t.kt0 = T0w - 256 + 128 * (it - 12); }
    else { const int e = it - 18, ch = e / 5, tl = e % 5; t.g = 2; t.kt0 = T0w + 8 * ch - 1024 + 512 * tl; }
    return t;
}
__device__ __forceinline__ void attn_wave_task(const bf16* QKV, bf16* AO, LAS unsigned char* ring, int blk, int h, int w, int lane) {
    LAS unsigned char* vimg = ring + w * 16384;
    const int r = lane & 31, hh = lane >> 5;
    const int T0 = blk * 256;
    int seq_start, seq_len;
    if (T0 < T_PROMPT) { seq_start = T0 & ~8191; seq_len = 8192; } else { seq_start = T_PROMPT + ((T0 - T_PROMPT) & ~2047); seq_len = 2048; }
    const int seq_end = seq_start + seq_len;
    const int T0w = T0 + w, qt = T0w + 8 * r;
    const float slope2 = __builtin_amdgcn_exp2f(-0.5f * (float)(h + 1)) * LOG2E;
    f32x16 o[4];
#pragma unroll
    for (int dt = 0; dt < 4; ++dt)
#pragma unroll
        for (int i = 0; i < 16; ++i) o[dt][i] = 0.f;
    float m_run = -1e30f, l_run = 0.f;
    bf16x8 qf[8], kf[8];
    const bf16* hb = QKV + h * 128;
    auto issue_tile = [&](const TileDesc& td, LAS unsigned char* img_dst) {
        const int d = 1 << (2 * td.g);
        const bf16* Kb = hb + 6144 + td.g * 2048; const bf16* Vb = hb + 12288 + td.g * 2048;
#pragma unroll
        for (int i = 0; i < 8; ++i) { const int row = 4 * i + (lane >> 4); int vt = td.kt0 + row * d; vt = vt < seq_start ? seq_start : (vt >= seq_end ? seq_end - 1 : vt);
            const int lch = (lane & 15) ^ (((row & 3) << 2) | ((row >> 2) & 3));
            dma16(Vb + (size_t)vt * NQKV + 8 * lch, img_dst + i * 1024); }
        int kt = td.kt0 + r * d; kt = kt < seq_start ? seq_start : (kt >= seq_end ? seq_end - 1 : kt);
        const bf16* kp = Kb + (size_t)kt * NQKV + 8 * hh;
#pragma unroll
        for (int s = 0; s < 8; ++s) kf[s] = *(const GAS bf16x8*)(kp + 16 * s);
    };
    auto load_q = [&](int g) { const bf16* qp = hb + g * 2048 + (size_t)qt * NQKV + 8 * hh;
#pragma unroll
        for (int s = 0; s < 8; ++s) qf[s] = *(const GAS bf16x8*)(qp + 16 * s); };
    auto coop_issue = [&](int t) {
        const int row = 4 * w + (lane >> 4); int vt = T0 - 64 + 32 * t + row; vt = vt < seq_start ? seq_start : (vt >= seq_end ? seq_end - 1 : vt);
        const int lck = (lane & 15) ^ (row & 15), lcv = (lane & 15) ^ (((row & 3) << 2) | ((row >> 2) & 3));
        const int sl = t % 3;
        dma16(hb + 6144 + (size_t)vt * NQKV + 8 * lck, ring + (2 * sl) * 16384 + 8192 + w * 1024);
        dma16(hb + 12288 + (size_t)vt * NQKV + 8 * lcv, ring + (2 * sl + 1) * 16384 + 8192 + w * 1024);
    };
    auto pv_tile = [&](const LAS unsigned char* img, const bf16x8 (&pb)[2]) {
        const int q4 = (lane & 15) >> 2, p4 = lane & 3, blk16 = (lane >> 4) & 1;
#pragma unroll
        for (int dt = 0; dt < 4; ++dt)
#pragma unroll
            for (int s2 = 0; s2 < 2; ++s2) {
                const unsigned chn = 4 * dt + 2 * blk16 + (p4 >> 1);
                const s16x4 lo = vtr(img + voff_b(16 * s2 + 4 * hh + q4, chn) + 8 * (p4 & 1));
                const s16x4 hi = vtr(img + voff_b(16 * s2 + 8 + 4 * hh + q4, chn) + 8 * (p4 & 1));
                const bf16x8 va = __builtin_shufflevector(lo, hi, 0, 1, 2, 3, 4, 5, 6, 7);
                o[dt] = __builtin_amdgcn_mfma_f32_32x32x16_bf16(va, pb[s2], o[dt], 0, 0, 0);
            }
    };
    TileDesc cur = attn_tile(0, T0w);
    __builtin_amdgcn_s_barrier();
    coop_issue(0);
    load_q(0);
    bf16x8 pprev[2]; const LAS unsigned char* img_prev = vimg;
#pragma unroll
    for (int s2 = 0; s2 < 2; ++s2)
#pragma unroll
        for (int e = 0; e < 8; ++e) pprev[s2][e] = 0;
    for (int it = 0; it < ATT_NT; ++it) {
        if (it < 12) {
            VM_WAIT();
            __builtin_amdgcn_s_barrier();
            if (it + 1 < 12) coop_issue(it + 1);
            const LAS unsigned char* kimg = ring + (2 * (it % 3)) * 16384 + 8192 + 256 * r;
#pragma unroll
            for (int s = 0; s < 8; ++s) kf[s] = *(const LAS bf16x8*)(kimg + 16 * ((2 * s + hh) ^ (r & 15)));
        }
        const int d = 1 << (2 * cur.g), win = 64 * d, kt0 = cur.kt0;
        f32x16 st;
#pragma unroll
        for (int i = 0; i < 16; ++i) st[i] = 0.f;
#pragma unroll
        for (int s = 0; s < 8; ++s) st = __builtin_amdgcn_mfma_f32_32x32x16_bf16(kf[s], qf[s], st, 0, 0, 0);
        if (it > 0) pv_tile(img_prev, pprev);
        if (it == 12) __builtin_amdgcn_s_barrier();
        if (it + 1 < ATT_NT) { const TileDesc nx = attn_tile(it + 1, T0w); if (nx.g != cur.g) load_q(nx.g); if (it + 1 >= 12) issue_tile(nx, vimg + ((it + 1) & 1) * 8192); cur = nx; }
        const int dl0 = kt0 + 4 * hh * d - qt;
        const bool res_ok = (dl0 & (d - 1)) == 0;
        const int lo_i = max(-win, seq_start - qt), hi_i = min(win, seq_end - 1 - qt);
        const float flo = res_ok ? (float)lo_i : 1e30f, fhi = (float)hi_i, fdl0 = (float)dl0, fd = (float)d;
        float mloc = -1e30f;
#pragma unroll
        for (int i = 0; i < 16; ++i) { const float fdl = fdl0 + (float)((i & 3) + 8 * (i >> 2)) * fd;
            const float s = st[i] - slope2 * __builtin_fabsf(fdl);
            const bool ok = (fdl >= flo) && (fdl <= fhi);
            const float sm = ok ? s : -1e30f; st[i] = sm; mloc = fmaxf(mloc, sm); }
        mloc = pg8::xor32_max(mloc);
        const bool fire = __any(mloc > m_run + 8.0f);
        const float m_new = fire ? fmaxf(m_run, mloc) : m_run;
        const float m_use = fmaxf(m_new, -1e20f);
        float ls = 0.f;
#pragma unroll
        for (int i = 0; i < 16; ++i) { const float pv = __builtin_amdgcn_exp2f(st[i] - m_use); st[i] = pv; ls += pv; }
        ls = pg8::xor32_sum(ls);
        if (fire) {
            const float alpha = __builtin_amdgcn_exp2f(m_run - m_new);
            l_run *= alpha;
#pragma unroll
            for (int dt = 0; dt < 4; ++dt)
#pragma unroll
                for (int i = 0; i < 16; ++i) o[dt][i] *= alpha;
        }
        l_run += ls; m_run = m_new;
#pragma unroll
        for (int s2 = 0; s2 < 2; ++s2) { v4u w; w.x = cvtpk(st[8 * s2 + 0], st[8 * s2 + 1]); w.y = cvtpk(st[8 * s2 + 2], st[8 * s2 + 3]); w.z = cvtpk(st[8 * s2 + 4], st[8 * s2 + 5]); w.w = cvtpk(st[8 * s2 + 6], st[8 * s2 + 7]); pprev[s2] = __builtin_bit_cast(bf16x8, w); }
        img_prev = (it < 12) ? ring + (2 * (it % 3) + 1) * 16384 + 8192 : vimg + (it & 1) * 8192;
    }
    pv_tile(img_prev, pprev);
    const float inv = 1.0f / l_run;
    bf16* op = AO + (size_t)qt * D + h * 128 + 4 * hh;
#pragma unroll
    for (int dt = 0; dt < 4; ++dt)
#pragma unroll
        for (int i4 = 0; i4 < 4; ++i4) { v2u w; w.x = cvtpk(o[dt][4 * i4] * inv, o[dt][4 * i4 + 1] * inv); w.y = cvtpk(o[dt][4 * i4 + 2] * inv, o[dt][4 * i4 + 3] * inv);
            *(GAS v2u*)(op + 32 * dt + 8 * i4) = w; }
}
__device__ __forceinline__ void phase_attention(Frame& F, int rev) {
    const bf16* QKV = (const bf16*)(F.ws + WS_BIG + BIG_QKV); bf16* AO = (bf16*)(F.ws + WS_BIG + BIG_AO);
    LAS unsigned char* vimg = F.lds + RING_OFF;
    for (int j = F.vcu; j < (T / 256) * 16; j += F.G) {
        const int jj = rev ? (T / 256) * 16 - 1 - j : j; int h = jj & 15, blk = jj >> 4;
        if (F.G == 256) { const int n = jj >> 8, x = (jj >> 5) & 7, i = jj & 31; h = 2 * x + (i & 1); blk = 16 * n + (i >> 1); }
        attn_wave_task(QKV, AO, vimg, blk, h, F.wave, F.lane);
    }
}

#ifdef ATTN_NAIVE
__device__ __forceinline__ void phase_attention_naive(Frame& F) {
    const bf16* QKV = (const bf16*)(F.ws + WS_BIG + BIG_QKV); bf16* AO = (bf16*)(F.ws + WS_BIG + BIG_AO);
    const int gw = F.vcu * NWAVES + F.wave, NGW = F.G * NWAVES, lane = F.lane;
    for (int p = gw; p < T * 16; p += NGW) {
        const int tok = p >> 4, h = p & 15;
        int seq_start, seq_len;
        if (tok < T_PROMPT) { seq_start = tok & ~8191; seq_len = 8192; } else { seq_start = T_PROMPT + ((tok - T_PROMPT) & ~2047); seq_len = 2048; }
        const int seq_end = seq_start + seq_len;
        const float slope2 = __builtin_amdgcn_exp2f(-0.5f * (float)(h + 1)) * LOG2E;
        float m = -1e30f, l = 0.f, o0 = 0.f, o1 = 0.f;
        for (int g = 0; g < 3; ++g) {
            const int d = 1 << (2 * g);
            const unsigned qw = *(const GAS unsigned*)(QKV + (size_t)tok * NQKV + g * 2048 + h * 128 + 2 * lane);
            const float q0 = bf2f(qw & 0xffffu), q1 = bf2f(qw >> 16);
            for (int j = -64; j <= 64; ++j) {
                const int kt = tok + j * d;
                if (kt < seq_start || kt >= seq_end) continue;
                const unsigned kw = *(const GAS unsigned*)(QKV + (size_t)kt * NQKV + 6144 + g * 2048 + h * 128 + 2 * lane);
                const unsigned vw = *(const GAS unsigned*)(QKV + (size_t)kt * NQKV + 12288 + g * 2048 + h * 128 + 2 * lane);
                const float s = wave_sum(q0 * bf2f(kw & 0xffffu) + q1 * bf2f(kw >> 16)) - slope2 * (float)((j < 0 ? -j : j) * d);
                const float mn = fmaxf(m, s), al = __builtin_amdgcn_exp2f(m - mn), pv = __builtin_amdgcn_exp2f(s - mn);
                l = l * al + pv; o0 = o0 * al + pv * bf2f(vw & 0xffffu); o1 = o1 * al + pv * bf2f(vw >> 16); m = mn;
            }
        }
        const float inv = 1.0f / l;
        *(GAS unsigned*)(AO + (size_t)tok * D + h * 128 + 2 * lane) = pk2(o0 * inv, o1 * inv);
    }
}
#endif
constexpr int NPHASE = 54;
#ifndef FFN1_IN_REV
#define FFN1_IN_REV 0
#endif
#ifndef FFN1_OUT_REV
#define FFN1_OUT_REV 1
#endif
#ifndef MIX_IN_REV
#define MIX_IN_REV 0
#endif
#ifndef MIX_OUT_REV
#define MIX_OUT_REV 0
#endif
#ifndef FFN2_OUT_REV
#define FFN2_OUT_REV 0
#endif
#ifndef FFN2_IN_REV
#define FFN2_IN_REV 1
#endif
#ifndef FFN_OUT_REV
#define FFN_OUT_REV 1
#endif
#ifndef WGM_QKV
#define WGM_QKV 4
#endif
#ifndef WGM_HY
#define WGM_HY 4
#endif
#ifndef WGM_E3
#define WGM_E3 4
#endif
#ifndef WGM_IN
#define WGM_IN 4
#endif
#ifndef DUP_PHASE
#define DUP_PHASE (-1)
#define DUP_N 0
#endif
#define REPS(id) for (int rep_ = 0; rep_ < ((DUP_PHASE) == (id) ? 1 + (DUP_N) : 1); ++rep_)
#ifndef ZERO_HY
#define ZERO_HY 0
#endif
#ifndef ZERO_AT
#define ZERO_AT 0
#endif
#ifndef AT_SCALE
#define AT_SCALE 1.0f
#endif
#ifndef HY_SCALE
#define HY_SCALE 1.0f
#endif
#define MIXSCALE(hy) ((hy) ? (ZERO_HY ? 0.0f : HY_SCALE) : (ZERO_AT ? 0.0f : AT_SCALE))
struct Args { const float* in[21]; float* out; unsigned char* ws; int ph_lo, ph_hi; };
static_assert(sizeof(Args) == 21 * 8 + 8 + 8 + 8, "Args has no padding");
__global__ void __launch_bounds__(NWAVES * 64, 2) fwd_kernel(Args args) {
    extern __shared__ __attribute__((aligned(16))) unsigned char lds[];
    unsigned char* const ws0 = args.ws;
    const int wave0 = __builtin_amdgcn_readfirstlane(threadIdx.x >> 6);
    volatile LAS unsigned* MISC = (volatile LAS unsigned*)((LAS unsigned char*)lds + MISC_OFF);
    if (threadIdx.x < 64) MISC[threadIdx.x] = 0u;
    if (threadIdx.x == 64) {
#pragma unroll
        for (int i = 0; i < 21; ++i) ((LAS unsigned long long*)((LAS unsigned char*)lds + PTR_OFF))[i] = (unsigned long long)args.in[i];
    }
    __syncthreads();
    XcdBarrier bar = xcd_barrier_post((unsigned*)(ws0 + WS_CTL), MISC);
#define FRAME() Frame F = make_frame(lds, args.ws, args.out, wave0)
    const int lo = args.ph_lo, hi = args.ph_hi;
#define RUN(id) (lo <= (id) && (id) < hi)
#define SEAM(id) do { if ((id) + 1 < hi) xcd_barrier(bar); } while (0)

#define ZB ((bf16*)(F.ws + WS_ZB))
#define STATS ((float*)(F.ws + WS_STATS))
#define PART ((float*)(F.ws + WS_PART))
#define CDV(off) ((float*)(F.ws + WS_CD) + (off))
#define HID ((bf16*)(F.ws + WS_BIG + BIG_HID))
    constexpr int O_C1 = 0, O_D1 = NFF2, O_CM = 2 * NFF2, O_DM = 2 * NFF2 + NQKV, O_C2 = 2 * NFF2 + 2 * NQKV, O_D2 = 3 * NFF2 + 2 * NQKV;

    if (RUN(0)) { FRAME(); phase_init(F); SEAM(0); }

#pragma unroll
    for (int layer = 0; layer < DEPTH; ++layer) {
        const int pb = 1 + 13 * layer; const bool hy = (layer & 1) != 0; const int jl = layer >> 1;
#define REVF(idx) ((7 * layer + (idx) + 1) & 1)
        if (RUN(pb + 0)) { FRAME(); REPS(0) phase_convert(F, layer); SEAM(pb + 0); }

        if (RUN(pb + 1)) {
            if (hy) {
                FRAME();
                pg8::Gemm gt{(const bf16*)(F.ws + WS_W3T), (const bf16*)(F.ws + WS_H2B), 8192, 10240, 256}; pg8::StaticOrder St; St.init(8192, 10240, F.G, F.bx);
                pg8::EpiTaps Et{(float*)(F.ws + WS_TAPS), MIN_DECAY, (MAX_DECAY - MIN_DECAY) / 2047.0f};
                pg8::gemm_phase<pg8::EpiTaps, pg8::StaticOrder, PG8_ALIGN, PG8_SP2>(F.lds + RING_OFF, gt, St, Et, F.tid);
            }
            FRAME();
            pg8::Gemm g{ZB, (const bf16*)(F.ws + W_IN1), T, NFF2, D}; pg8::StaticOrder S; S.init(T, NFF2, F.G, F.bx, FFN1_IN_REV, WGM_IN);
            pg8::EpiSwiglu E{HID, FF, STATS, CDV(O_C1), CDV(O_D1)};
            REPS(1) pg8::gemm_phase<pg8::EpiSwiglu, pg8::StaticOrder, PG8_ALIGN, PG8_SP2>(F.lds + RING_OFF, g, S, E, F.tid);
            SEAM(pb + 1);
        }
        if (RUN(pb + 2)) {
            FRAME();
            pg8::Gemm g{HID, (const bf16*)(F.ws + W_OUT1), T, D, FF}; pg8::StaticOrder S; S.init(T, D, F.G, F.bx, FFN1_OUT_REV, WGM_E3);
            const float* g0 = layer ? inp(F, 2) + (size_t)((layer - 1) * 3 + 2) * D : (const float*)(F.ws + WS_IDG); const float* b0 = layer ? inp(F, 3) + (size_t)((layer - 1) * 3 + 2) * D : (const float*)(F.ws + WS_IDB);
            pg8::EpiResid E{(unsigned*)(F.ws + WS_ZL), ZB, STATS, g0, b0, (const float*)(F.ws + WS_IDB), PART, 0.5f, (LAS float*)(F.lds + EPI_OFF)};
            pg8::gemm_phase<pg8::EpiResid, pg8::StaticOrder, PG8_ALIGN, PG8_SP2>(F.lds + RING_OFF, g, S, E, F.tid);
            SEAM(pb + 2);
        }
        if (RUN(pb + 3)) { FRAME(); REPS(3) phase_finalize(F); SEAM(pb + 3); }

        if (RUN(pb + 4)) {
            if (!hy) { FRAME();
                pg8::Gemm g{ZB, (const bf16*)(F.ws + W_MIN), T, NQKV, D}; pg8::StaticOrder S; S.init(T, NQKV, F.G, F.bx, MIX_IN_REV, WGM_QKV);
                pg8::EpiLnBf16 E{(bf16*)(F.ws + WS_BIG + BIG_QKV), NQKV, STATS, CDV(O_CM), CDV(O_DM)};
                REPS(4) pg8::gemm_phase<pg8::EpiLnBf16, pg8::StaticOrder, PG8_ALIGN, PG8_SP2>(F.lds + RING_OFF, g, S, E, F.tid);
            } else { FRAME();
                pg8::Gemm g{(const bf16*)(F.ws + W_MIN), ZB, NHY, T, D}; pg8::StaticOrder S; S.init(NHY, T, F.G, F.bx, 0, WGM_HY);
                pg8::EpiLnBf16T E{(bf16*)(F.ws + WS_BIG + BIG_UT), T, STATS, CDV(O_CM), CDV(O_DM)};
                REPS(4) pg8::gemm_phase<pg8::EpiLnBf16T, pg8::StaticOrder, PG8_ALIGN, PG8_SP2>(F.lds + RING_OFF, g, S, E, F.tid);
            }
            if (hy) { FRAME(); REPS(15) phase_spectra(F, jl); }
            SEAM(pb + 4);
        }
        if (RUN(pb + 5) && !hy) {
            FRAME();
#ifdef ATTN_NAIVE
            if (!hy) phase_attention_naive(F);
#else
            if (!hy) { REPS(5) phase_attention(F, 0); }
#endif
            SEAM(pb + 5);
        }
        if (hy) {
            if (RUN(pb + 6)) { FRAME(); REPS(6) phase_conv(F, jl); SEAM(pb + 6); }
            if (RUN(pb + 7)) { FRAME(); REPS(7) phase_transpose(F, (const bf16*)(F.ws + WS_BIG + BIG_Z2T), D, T, (bf16*)(F.ws + WS_BIG + BIG_Z2)); SEAM(pb + 7); }
        }
        if (RUN(pb + 8)) {
            FRAME();
            const bf16* A = hy ? (const bf16*)(F.ws + WS_BIG + BIG_Z2) : (const bf16*)(F.ws + WS_BIG + BIG_AO);
            pg8::Gemm g{A, (const bf16*)(F.ws + W_MOUT), T, D, D}; pg8::StaticOrder S; S.init(T, D, F.G, F.bx, MIX_OUT_REV, WGM_E3);
            pg8::EpiResid E{(unsigned*)(F.ws + WS_ZL), ZB, STATS, inp(F, 2) + (size_t)(layer * 3) * D, inp(F, 3) + (size_t)(layer * 3) * D, hy ? inp(F, 20) + (size_t)jl * D : (const float*)(F.ws + WS_IDB), PART, MIXSCALE(hy), (LAS float*)(F.lds + EPI_OFF)};
            pg8::gemm_phase<pg8::EpiResid, pg8::StaticOrder, PG8_ALIGN, PG8_SP2>(F.lds + RING_OFF, g, S, E, F.tid);
            SEAM(pb + 8);
        }
        if (RUN(pb + 9)) { FRAME(); phase_finalize(F); SEAM(pb + 9); }

        if (RUN(pb + 10)) {
            FRAME();
            pg8::Gemm g{ZB, (const bf16*)(F.ws + W_IN2), T, NFF2, D}; pg8::StaticOrder S; S.init(T, NFF2, F.G, F.bx, FFN2_IN_REV, WGM_IN);
            pg8::EpiSwiglu E{HID, FF, STATS, CDV(O_C2), CDV(O_D2)};
            pg8::gemm_phase<pg8::EpiSwiglu, pg8::StaticOrder, PG8_ALIGN, PG8_SP2>(F.lds + RING_OFF, g, S, E, F.tid);
            SEAM(pb + 10);
        }
        if (RUN(pb + 11)) {
            FRAME();
            pg8::Gemm g{HID, (const bf16*)(F.ws + W_OUT2), T, D, FF}; pg8::StaticOrder S; S.init(T, D, F.G, F.bx, FFN2_OUT_REV, WGM_E3);
            pg8::EpiResid E{(unsigned*)(F.ws + WS_ZL), ZB, STATS, inp(F, 2) + (size_t)(layer * 3 + 1) * D, inp(F, 3) + (size_t)(layer * 3 + 1) * D, (const float*)(F.ws + WS_IDB), PART, 0.5f, (LAS float*)(F.lds + EPI_OFF)};
            pg8::gemm_phase<pg8::EpiResid, pg8::StaticOrder, PG8_ALIGN, PG8_SP2>(F.lds + RING_OFF, g, S, E, F.tid);
            SEAM(pb + 11);
        }
        if (RUN(pb + 12)) { FRAME(); phase_finalize(F); SEAM(pb + 12); }
    }
#ifdef DBG_CHECK
    if (RUN(NPHASE - 2)) { FRAME(); phase_check_qkv(F); SEAM(NPHASE - 2); }
#endif
    if (RUN(NPHASE - 1)) { FRAME(); phase_final_ln(F); }
#undef REVF
#undef RUN
#undef SEAM
#undef FRAME
}


#ifdef PHASE_PROBE
#define PROBE_FRAME() extern __shared__ __attribute__((aligned(16))) unsigned char lds[]; Frame F = make_frame(lds, args.ws, args.out, __builtin_amdgcn_readfirstlane(threadIdx.x >> 6));
__global__ void __launch_bounds__(NWAVES * 64, 2) probe_init(Args args) { PROBE_FRAME(); phase_init(F); }
__global__ void __launch_bounds__(NWAVES * 64, 2) probe_convert(Args args) { PROBE_FRAME(); phase_convert(F, args.ph_lo); }
__global__ void __launch_bounds__(NWAVES * 64, 2) probe_finalize(Args args) { PROBE_FRAME(); phase_finalize(F); phase_final_ln(F); }
__global__ void __launch_bounds__(NWAVES * 64, 2) probe_transpose(Args args) { PROBE_FRAME(); phase_transpose(F, (const bf16*)(F.ws + WS_BIG + BIG_U), T, NHY, (bf16*)(F.ws + WS_BIG + BIG_UT)); }
__global__ void __launch_bounds__(NWAVES * 64, 2) probe_spectra(Args args) { PROBE_FRAME(); phase_spectra(F, args.ph_lo); }
__global__ void __launch_bounds__(NWAVES * 64, 2) probe_conv(Args args) { PROBE_FRAME(); phase_conv(F, args.ph_lo); }
__global__ void __launch_bounds__(NWAVES * 64, 2) probe_attn(Args args) { PROBE_FRAME(); phase_attention(F, args.ph_lo); }
__global__ void __launch_bounds__(NWAVES * 64, 2) probe_gemm_swiglu(Args args) { PROBE_FRAME(); pg8::Gemm g{(const bf16*)F.ws, (const bf16*)(F.ws + W_IN1), T, NFF2, D}; pg8::StaticOrder S; S.init(T, NFF2, F.G, F.bx, 0, WGM_IN); pg8::EpiSwiglu E{(bf16*)(F.ws + WS_BIG), FF, (float*)(F.ws + WS_STATS), (float*)(F.ws + WS_CD), (float*)(F.ws + WS_CD)}; pg8::gemm_phase<pg8::EpiSwiglu, pg8::StaticOrder, PG8_ALIGN, PG8_SP2>(F.lds + RING_OFF, g, S, E, F.tid); }
__global__ void __launch_bounds__(NWAVES * 64, 2) probe_gemm_resid(Args args) { PROBE_FRAME(); pg8::Gemm g{(const bf16*)F.ws, (const bf16*)(F.ws + W_IN1), T, D, FF}; pg8::StaticOrder S; S.init(T, D, F.G, F.bx); pg8::EpiResid E{(unsigned*)(F.ws + WS_ZL), (bf16*)(F.ws + WS_ZB), (float*)(F.ws + WS_STATS), inp(F, 2), inp(F, 3), args.ph_lo ? inp(F, 20) : (const float*)(F.ws + WS_IDB), (float*)(F.ws + WS_PART), 0.5f, (LAS float*)(F.lds + EPI_OFF)}; pg8::gemm_phase<pg8::EpiResid, pg8::StaticOrder, PG8_ALIGN, PG8_SP2>(F.lds + RING_OFF, g, S, E, F.tid); }
__global__ void __launch_bounds__(NWAVES * 64, 2) probe_gemm_ln(Args args) { PROBE_FRAME(); pg8::Gemm g{(const bf16*)F.ws, (const bf16*)(F.ws + W_IN1), T, NQKV, D}; pg8::StaticOrder S; S.init(T, NQKV, F.G, F.bx, 0, WGM_IN); pg8::EpiLnBf16 E{(bf16*)(F.ws + WS_BIG), NQKV, (float*)(F.ws + WS_STATS), (float*)(F.ws + WS_CD), (float*)(F.ws + WS_CD)}; pg8::gemm_phase<pg8::EpiLnBf16, pg8::StaticOrder, PG8_ALIGN, PG8_SP2>(F.lds + RING_OFF, g, S, E, F.tid); }
#endif
#ifndef MK_MULTI
#define MK_MULTI 0
#endif
extern "C" void kernel_launch(void* const* d_in, const int* in_sizes, int n_in, void* d_out, int out_size, void* d_ws, size_t ws_size, hipStream_t stream) {
    static int grid = 0;
    if (grid == 0) {
        if (n_in != 21 || out_size != T * D || ws_size < WS_END) { fprintf(stderr, "kernel_launch: unexpected shapes (n_in %d, out %d, ws %zu, need %zu)\n", n_in, out_size, ws_size, (size_t)WS_END); grid = -1; return; }
        int dev = 0, cus = 0, per_cu = 0;
        if (hipGetDevice(&dev) != hipSuccess || hipDeviceGetAttribute(&cus, hipDeviceAttributeMultiprocessorCount, dev) != hipSuccess) { grid = -1; return; }
        if (hipFuncSetAttribute((const void*)fwd_kernel, hipFuncAttributeMaxDynamicSharedMemorySize, LDS_BYTES) != hipSuccess) { fprintf(stderr, "kernel_launch: hipFuncSetAttribute failed\n"); grid = -1; return; }
        if (hipOccupancyMaxActiveBlocksPerMultiprocessor(&per_cu, (const void*)fwd_kernel, NWAVES * 64, LDS_BYTES) != hipSuccess || per_cu < 1) fprintf(stderr, "kernel_launch: occupancy query reports %d\n", per_cu);
        (void)hipGetLastError();
        grid = cus;
    }
    if (grid < 0) return;
    if (hipMemsetAsync((char*)d_ws + WS_CTL, 0, CTL_ZERO_BYTES, stream) != hipSuccess) return;
    Args a{};
    for (int i = 0; i < 21; ++i) a.in[i] = (const float*)d_in[i];
    a.out = (float*)d_out; a.ws = (unsigned char*)d_ws;
#ifndef STOP_AFTER
#define STOP_AFTER (NPHASE - 1)
#endif
#ifdef DBG_CHECK
#define DBGCHK_ON 1
#else
#define DBGCHK_ON 0
#endif
#if MK_MULTI
    for (int p = 0; p < NPHASE; ++p) { if (p >= STOP_AFTER && p != NPHASE - 1 && !(DBGCHK_ON && p == NPHASE - 2)) continue; a.ph_lo = p; a.ph_hi = p + 1; hipLaunchKernelGGL(fwd_kernel, dim3(grid), dim3(NWAVES * 64), LDS_BYTES, stream, a); }
#else
    a.ph_lo = 0; a.ph_hi = NPHASE;
    hipLaunchKernelGGL(fwd_kernel, dim3(grid), dim3(NWAVES * 64), LDS_BYTES, stream, a);
#endif
}
```

```cpp
#include <hip/hip_runtime.h>
#include <cstdio>
#include <cstdint>
namespace pg8 {
#define PG8_LAS __attribute__((address_space(3)))
typedef unsigned short bf16_t;
typedef short bf16x8 __attribute__((ext_vector_type(8)));
typedef float f32x4 __attribute__((ext_vector_type(4)));
typedef unsigned u32x4 __attribute__((ext_vector_type(4)));
constexpr int BM = 256, BK = 64, HALF = 128, HTB = HALF * BK * 2  , STAGE_BYTES = 8 * HTB, NXCD = 8, WGM = 4;

__host__ __device__ __forceinline__ int lds_byte(int r, int c) { const int st = (r >> 4) * 2 + (c >> 5), rr = r & 15, cc = c & 31, ob = rr * 64 + cc * 2; return st * 1024 + (ob ^ (((ob >> 9) & 1) << 5)); }
__host__ __device__ __forceinline__ void stage_rc(int b, int& R, int& C) { const int st = b / 1024, sb = b % 1024, swz = sb ^ (((sb >> 9) & 1) << 5); R = (st >> 1) * 16 + swz / 64; C = (st & 1) * 32 + (swz % 64) / 2; }
__host__ __device__ __forceinline__ int perm32(int rho) { const int n = rho >> 4, i = rho & 15; return 8 * (i >> 2) + 4 * n + (i & 3); }

struct Unit { int pm, pn; };
struct Gemm { const bf16_t* A; const bf16_t* Bt; int M, N, K; };

struct StaticOrder {
    int nM, nN, nwg, G, c, rev, wgm;
    __host__ __device__ void init(int M, int N, int G_, int c_, int rev_ = 0, int wgm_ = WGM) { nM = M / BM; nN = N / BM; nwg = nM * nN; G = G_; c = c_; rev = rev_; wgm = wgm_; }
    __host__ __device__ bool next(int i, Unit& u) const {
        const int nr = (nwg + G - 1) / G; if (i >= nr) return false;
        const long L = (long)(rev ? nr - 1 - i : i) * G + c; if (L >= nwg) return false;
        int wgid = (int)L; { const int q = nwg / NXCD, r = nwg % NXCD, xcd = wgid % NXCD, off = wgid / NXCD; wgid = (xcd < r ? xcd * (q + 1) : r * (q + 1) + (xcd - r) * q) + off; }
        const int nig = wgm * nN, gid = wgid / nig, fm = gid * wgm, gsz = (nM - fm) < wgm ? (nM - fm) : wgm;
        u.pm = fm + ((wgid % nig) % gsz); u.pn = (wgid % nig) / gsz; return true;
    }
    __device__ __forceinline__ void a_ready(const Unit&) const {}
    __device__ __forceinline__ void done(const Unit&) const {}
};

__device__ __forceinline__ unsigned cvt_pk_bf16(float lo, float hi) { unsigned r; asm volatile("v_cvt_pk_bf16_f32 %0, %1, %2" : "=v"(r) : "v"(lo), "v"(hi)); return r; }
typedef float f32x2 __attribute__((ext_vector_type(2)));
typedef float f32x2v __attribute__((ext_vector_type(2)));
typedef unsigned u32x2v __attribute__((ext_vector_type(2)));
constexpr float DN_ALPHA_F = 1.6817928305074292f;

__device__ __forceinline__ float z20_dec(unsigned zb_hi, unsigned q, int k) { const int c = (int)(q << (28 - 4 * k)) >> 28; return __uint_as_float(zb_hi + ((unsigned)c << 12)); }
__device__ __forceinline__ unsigned z20_zb(float v) { return __float_as_uint(v) + 0x8800u; }
__device__ __forceinline__ unsigned z20_c(float v, int k) { return (((__float_as_uint(v) + 0x800u) >> 12) & 15u) << (4 * k); }

__device__ __forceinline__ unsigned cvt2(float lo, float hi) { typedef __bf16 bf16x2_t __attribute__((ext_vector_type(2))); const f32x2v v = {lo, hi}; return __builtin_bit_cast(unsigned, __builtin_convertvector(v, bf16x2_t)); }
__device__ __forceinline__ float xor32_sum(float x) { const auto r = __builtin_amdgcn_permlane32_swap(__float_as_uint(x), __float_as_uint(x), false, false); const unsigned r0 = r[0], r1 = r[1]; return __uint_as_float(r0) + __uint_as_float(r1); }
__device__ __forceinline__ float xor32_max(float x) { const auto r = __builtin_amdgcn_permlane32_swap(__float_as_uint(x), __float_as_uint(x), false, false); const unsigned r0 = r[0], r1 = r[1]; return fmaxf(__uint_as_float(r0), __uint_as_float(r1)); }
template <int MASK> __device__ __forceinline__ float swz_xor(float x) { return __builtin_bit_cast(float, __builtin_amdgcn_ds_swizzle(__builtin_bit_cast(int, x), (MASK << 10) | 0x1F)); }
__device__ __forceinline__ float wave_sum64(float v) { v += swz_xor<1>(v); v += swz_xor<2>(v); v += swz_xor<4>(v); v += swz_xor<8>(v); v += swz_xor<16>(v); return xor32_sum(v); }

struct EpiLnBf16 {
    static constexpr bool PERM = true, AFTER_DRAIN = false;
    bf16_t* O; int ldc; const float* stats; const float* cvec; const float* dvec;
    __device__ __forceinline__ void operator()(const f32x4 (&acc)[2][2][4][2], const Unit& u, int wr, int wc, int fr, int fq) const {
        const int row0 = u.pm * BM + wr * 64 + fr, col0 = u.pn * BM + wc * 32 + 8 * fq;
        f32x4 cv[2][2], dv[2][2];
#pragma unroll
        for (int bj = 0; bj < 2; ++bj)
#pragma unroll
            for (int n = 0; n < 2; ++n) { cv[bj][n] = *(const f32x4*)(cvec + col0 + bj * HALF + 4 * n); dv[bj][n] = *(const f32x4*)(dvec + col0 + bj * HALF + 4 * n); }
        f32x2v sts[2][4];
#pragma unroll
        for (int ai = 0; ai < 2; ++ai)
#pragma unroll
            for (int m = 0; m < 4; ++m) sts[ai][m] = *(const f32x2v*)(stats + 2 * (size_t)(row0 + ai * HALF + m * 16));
#pragma unroll
        for (int ai = 0; ai < 2; ++ai)
#pragma unroll
            for (int m = 0; m < 4; ++m) { const int row = row0 + ai * HALF + m * 16; const f32x2v st = sts[ai][m];
                bf16_t* rowp = O + (size_t)row * ldc + col0;
#pragma unroll
                for (int bj = 0; bj < 2; ++bj) { const f32x4 v0 = (acc[ai][bj][m][0] - st.x * cv[bj][0]) * st.y + dv[bj][0], v1 = (acc[ai][bj][m][1] - st.x * cv[bj][1]) * st.y + dv[bj][1];
                    u32x4 w; w.x = cvt2(v0[0], v0[1]); w.y = cvt2(v0[2], v0[3]); w.z = cvt2(v1[0], v1[1]); w.w = cvt2(v1[2], v1[3]);
                    *(u32x4*)(rowp + bj * HALF) = w; } }
    }
};
struct EpiLnBf16T {
    static constexpr bool PERM = true, AFTER_DRAIN = false, HAS_INIT = false;
    bf16_t* O; int ldc; const float* stats; const float* cvec; const float* dvec;
    __device__ __forceinline__ void operator()(const f32x4 (&acc)[2][2][4][2], const Unit& u, int wr, int wc, int fr, int fq) const {
        const int row0 = u.pm * BM + wr * 64 + fr, col0 = u.pn * BM + wc * 32 + 8 * fq;
        f32x4 mean[2][2], rstd[2][2];
#pragma unroll
        for (int bj = 0; bj < 2; ++bj) { const f32x4* sp = (const f32x4*)(stats + 2 * (size_t)(col0 + bj * HALF));
            const f32x4 a = sp[0], b = sp[1], c = sp[2], d = sp[3];
            mean[bj][0] = (f32x4){a[0], a[2], b[0], b[2]}; rstd[bj][0] = (f32x4){a[1], a[3], b[1], b[3]};
            mean[bj][1] = (f32x4){c[0], c[2], d[0], d[2]}; rstd[bj][1] = (f32x4){c[1], c[3], d[1], d[3]}; }
        float cr[2][4], dr[2][4];
#pragma unroll
        for (int ai = 0; ai < 2; ++ai)
#pragma unroll
            for (int m = 0; m < 4; ++m) { const int row = row0 + ai * HALF + m * 16; cr[ai][m] = cvec[row]; dr[ai][m] = dvec[row]; }
#pragma unroll
        for (int ai = 0; ai < 2; ++ai)
#pragma unroll
            for (int m = 0; m < 4; ++m) { const int row = row0 + ai * HALF + m * 16; bf16_t* rowp = O + (size_t)row * ldc + col0;
#pragma unroll
                for (int bj = 0; bj < 2; ++bj) { const f32x4 v0 = (acc[ai][bj][m][0] - mean[bj][0] * cr[ai][m]) * rstd[bj][0] + dr[ai][m], v1 = (acc[ai][bj][m][1] - mean[bj][1] * cr[ai][m]) * rstd[bj][1] + dr[ai][m];
                    u32x4 w; w.x = cvt2(v0[0], v0[1]); w.y = cvt2(v0[2], v0[3]); w.z = cvt2(v1[0], v1[1]); w.w = cvt2(v1[2], v1[3]);
                    *(u32x4*)(rowp + bj * HALF) = w; } }
    }
};
__device__ __forceinline__ float silu_mul(float g, float up) { const float e = __builtin_amdgcn_exp2f(-1.4426950408889634f * g); return g * __builtin_amdgcn_rcpf(1.0f + e) * up; }
struct EpiSwiglu {
    static constexpr bool PERM = true, AFTER_DRAIN = false;
    bf16_t* O; int ldc; const float* stats; const float* cvec; const float* dvec;
    __device__ __forceinline__ void operator()(const f32x4 (&acc)[2][2][4][2], const Unit& u, int wr, int wc, int fr, int fq) const {
        const int row0 = u.pm * BM + wr * 64 + fr, col0 = u.pn * BM + wc * 32 + 8 * fq, ocol = u.pn * HALF + wc * 32 + 8 * fq;
        f32x4 cv[2][2], dv[2][2];
#pragma unroll
        for (int bj = 0; bj < 2; ++bj)
#pragma unroll
            for (int n = 0; n < 2; ++n) { cv[bj][n] = *(const f32x4*)(cvec + col0 + bj * HALF + 4 * n); dv[bj][n] = *(const f32x4*)(dvec + col0 + bj * HALF + 4 * n); }
        f32x2v sts[2][4];
#pragma unroll
        for (int ai = 0; ai < 2; ++ai)
#pragma unroll
            for (int m = 0; m < 4; ++m) sts[ai][m] = *(const f32x2v*)(stats + 2 * (size_t)(row0 + ai * HALF + m * 16));
#pragma unroll
        for (int ai = 0; ai < 2; ++ai)
#pragma unroll
            for (int m = 0; m < 4; ++m) { const int row = row0 + ai * HALF + m * 16; const f32x2v st = sts[ai][m];
                f32x4 h[2];
#pragma unroll
                for (int n = 0; n < 2; ++n) { const f32x4 g = (acc[ai][0][m][n] - st.x * cv[0][n]) * st.y + dv[0][n], up = (acc[ai][1][m][n] - st.x * cv[1][n]) * st.y + dv[1][n];
                    h[n] = (f32x4){silu_mul(g[0], up[0]), silu_mul(g[1], up[1]), silu_mul(g[2], up[2]), silu_mul(g[3], up[3])}; }
                u32x4 w; w.x = cvt2(h[0][0], h[0][1]); w.y = cvt2(h[0][2], h[0][3]); w.z = cvt2(h[1][0], h[1][1]); w.w = cvt2(h[1][2], h[1][3]);
                *(u32x4*)(O + (size_t)row * ldc + ocol) = w; }
    }
};
struct EpiResid {
    static constexpr bool PERM = true, AFTER_DRAIN = false;
    unsigned* ZL; bf16_t* ZB; const float* stats; const float* gprev; const float* bprev; const float* bias; float* part; float scale; __attribute__((address_space(3))) float* gb;
    __device__ __forceinline__ void operator()(const f32x4 (&acc)[2][2][4][2], const Unit& u, int wr, int wc, int fr, int fq) const {
        typedef __attribute__((address_space(3))) f32x4 lds_f32x4;
        const int row0 = u.pm * BM + wr * 64 + fr, col0 = u.pn * BM + wc * 32 + 8 * fq;
        lds_f32x4* slot = (lds_f32x4*)(gb + (wr * 4 + wc) * 128) + fq * 8;
        if (fr == 0) {
#pragma unroll
            for (int bj = 0; bj < 2; ++bj)
#pragma unroll
                for (int n = 0; n < 2; ++n) { const int c = col0 + bj * HALF + 4 * n; slot[bj * 4 + n] = DN_ALPHA_F * *(const f32x4*)(gprev + c); slot[bj * 4 + 2 + n] = DN_ALPHA_F * *(const f32x4*)(bprev + c) + scale * *(const f32x4*)(bias + c); }
        }
#pragma unroll
        for (int bj = 0; bj < 2; ++bj) {
#pragma unroll
            for (int ai = 0; ai < 2; ++ai) {
                u32x4 zr[4]; unsigned zq[4]; f32x2v sts[4];
#pragma unroll
                for (int m = 0; m < 4; ++m) { const unsigned row = (unsigned)(row0 + ai * HALF + m * 16), eo = row * 2048u + (unsigned)(col0 + bj * HALF);
                    zr[m] = *(const u32x4*)(ZB + eo); zq[m] = ZL[eo >> 3]; sts[m] = *(const f32x2v*)(stats + 2u * row); }
#pragma unroll
                for (int m = 0; m < 4; ++m) { const unsigned row = (unsigned)(row0 + ai * HALF + m * 16), eo = row * 2048u + (unsigned)(col0 + bj * HALF); const f32x2v st = sts[m]; const u32x4 r = zr[m]; const unsigned q = zq[m];
                    const f32x4 z0 = (f32x4){z20_dec(r.x << 16, q, 0), z20_dec(r.x & 0xffff0000u, q, 1), z20_dec(r.y << 16, q, 2), z20_dec(r.y & 0xffff0000u, q, 3)};
                    const f32x4 z1 = (f32x4){z20_dec(r.z << 16, q, 4), z20_dec(r.z & 0xffff0000u, q, 5), z20_dec(r.w << 16, q, 6), z20_dec(r.w & 0xffff0000u, q, 7)};
                    const f32x4 n0 = (z0 - st.x) * st.y * slot[bj * 4] + slot[bj * 4 + 2] + scale * acc[ai][bj][m][0];
                    const f32x4 n1 = (z1 - st.x) * st.y * slot[bj * 4 + 1] + slot[bj * 4 + 3] + scale * acc[ai][bj][m][1];
                    u32x4 w; w.x = (z20_zb(n0[0]) >> 16) | (z20_zb(n0[1]) & 0xffff0000u); w.y = (z20_zb(n0[2]) >> 16) | (z20_zb(n0[3]) & 0xffff0000u);
                    w.z = (z20_zb(n1[0]) >> 16) | (z20_zb(n1[1]) & 0xffff0000u); w.w = (z20_zb(n1[2]) >> 16) | (z20_zb(n1[3]) & 0xffff0000u);
#ifdef E3_PLAIN_STORES
                    *(u32x4*)(ZB + eo) = w;
#else
                    __builtin_nontemporal_store(w, (u32x4*)(ZB + eo));
#endif
                    const unsigned zlw = ((z20_c(n0[0], 0) | z20_c(n0[1], 1)) | (z20_c(n0[2], 2) | z20_c(n0[3], 3))) | ((z20_c(n1[0], 4) | z20_c(n1[1], 5)) | (z20_c(n1[2], 6) | z20_c(n1[3], 7)));
#ifdef E3_PLAIN_STORES
                    ZL[eo >> 3] = zlw;
#else
                    __builtin_nontemporal_store(zlw, ZL + (eo >> 3));
#endif
                    float s = ((n0[0] + n0[1]) + (n0[2] + n0[3])) + ((n1[0] + n1[1]) + (n1[2] + n1[3]));
                    float q2 = ((n0[0] * n0[0] + n0[1] * n0[1]) + (n0[2] * n0[2] + n0[3] * n0[3])) + ((n1[0] * n1[0] + n1[1] * n1[1]) + (n1[2] * n1[2] + n1[3] * n1[3]));
                    s += swz_xor<16>(s); s = xor32_sum(s); q2 += swz_xor<16>(q2); q2 = xor32_sum(q2);
                    if (fq == 0) *(f32x2v*)(part + (row * 64u + (unsigned)(u.pn * 8 + wc * 2 + bj)) * 2u) = (f32x2v){s, q2}; }
            }
        }
    }
};

struct EpiTaps {
    static constexpr bool PERM = false, AFTER_DRAIN = false;
    float* O; float min_decay, dstep;
    __device__ __forceinline__ void operator()(const f32x4 (&acc)[2][2][4][2], const Unit& u, int wr, int wc, int fr, int fq) const {
        int stride = 10240; float i0 = 1.0f / 8191.0f, i1 = 1.0f / 2047.0f; asm volatile("" : "+s"(stride), "+s"(i0), "+s"(i1));
        const int row0 = u.pm * BM + wr * 64 + fr, col0 = u.pn * BM + wc * 32 + 4 * fq;
        const int tbase = (u.pn < 32) ? 0 : 8192; const float ilm1 = (u.pn < 32) ? i0 : i1;
        const float t0 = (float)(col0 - tbase);
#pragma unroll
        for (int ai = 0; ai < 2; ++ai)
#pragma unroll
            for (int m = 0; m < 4; ++m) { const int row = row0 + ai * HALF + m * 16;
                const float a = -1.4426950408889634f * __builtin_fabsf(min_decay + (float)(row & 2047) * dstep) * ilm1;
                const float e0 = __builtin_amdgcn_exp2f(a * t0), s1 = __builtin_amdgcn_exp2f(a), s16 = __builtin_amdgcn_exp2f(16.0f * a), s128 = __builtin_amdgcn_exp2f(128.0f * a);
                float* rowp = O + (size_t)row * stride + col0;
#pragma unroll
                for (int bj = 0; bj < 2; ++bj) { const float eb = bj ? e0 * s128 : e0;
#pragma unroll
                    for (int n = 0; n < 2; ++n) { const float en = n ? eb * s16 : eb, en1 = en * s1, en2 = en1 * s1, en3 = en2 * s1; const f32x4 v = acc[ai][bj][m][n];
#ifdef TAPS_NT
                        __builtin_nontemporal_store((f32x4){v[0] * en, v[1] * en1, v[2] * en2, v[3] * en3}, (f32x4*)(rowp + bj * HALF + n * 16)); } } }
#else
                        *(f32x4*)(rowp + bj * HALF + n * 16) = (f32x4){v[0] * en, v[1] * en1, v[2] * en2, v[3] * en3}; } } }
#endif
    }
};

template <class Epi, class Sched, bool ALIGN_EPI = false, bool SP2 = false>
__device__ __forceinline__ void gemm_phase(PG8_LAS unsigned char* lds, const Gemm g, const Sched& S, const Epi& E, const int tid_in) {
    int tid_ = tid_in; asm volatile("" : "+v"(tid_));
    const int tid = tid_, wid = __builtin_amdgcn_readfirstlane(tid >> 6), lane = tid & 63, wr = wid >> 2, wc = wid & 3, fr = lane & 15, fq = lane >> 4;
    const int K = g.K, nt = K / BK;
    unsigned voffA[2], voffB[2];
#pragma unroll
    for (int i = 0; i < 2; ++i) { int R, C; stage_rc(tid * 16 + i * 8192, R, C); const int Rb = Epi::PERM ? ((R & ~31) + perm32(R & 31)) : R;
        voffA[i] = (unsigned)(R * K + C) * 2u; voffB[i] = (unsigned)(Rb * K + C) * 2u; }
    const size_t kstep = (size_t)(BK * 2);
    const size_t hstep = (size_t)HALF * K * 2;
    const size_t tstep = 2 * hstep;
    const unsigned ldsw = (unsigned)wid * 1024u;
    const int aoff = lds_byte(wr * 64 + fr, fq * 8), boff = lds_byte(wc * 32 + fr, fq * 8);
#define PG8_SA(b, h) (((b) * 2 + (h)) * HTB)
#define PG8_SB(b, h) ((4 + (b) * 2 + (h)) * HTB)
#define PG8_STAGE(bufoff, gbase, voff) do { _Pragma("unroll") for (int _i = 0; _i < 2; ++_i) \
        __builtin_amdgcn_global_load_lds((const unsigned*)((const char*)(gbase) + (voff)[_i]), (PG8_LAS unsigned*)(lds + (bufoff) + ldsw + _i * 8192), 16, 0, 0); } while (0)
#define PG8_LDA(dst, b, h) do { _Pragma("unroll") for (int m = 0; m < 4; ++m) _Pragma("unroll") for (int k = 0; k < 2; ++k) dst[m][k] = *(const PG8_LAS bf16x8*)(lds + PG8_SA(b, h) + aoff + m * 2048 + k * 1024); } while (0)
#define PG8_LDB(dst, b, h) do { _Pragma("unroll") for (int n = 0; n < 2; ++n) _Pragma("unroll") for (int k = 0; k < 2; ++k) dst[n][k] = *(const PG8_LAS bf16x8*)(lds + PG8_SB(b, h) + boff + n * 2048 + k * 1024); } while (0)
#define PG8_MMA(ai, bj, At, Bt) do { __builtin_amdgcn_s_setprio(1); _Pragma("unroll") for (int m = 0; m < 4; ++m) _Pragma("unroll") for (int n = 0; n < 2; ++n) _Pragma("unroll") for (int k = 0; k < 2; ++k) \
        acc[ai][bj][m][n] = __builtin_amdgcn_mfma_f32_16x16x32_bf16(Bt[n][k], At[m][k], acc[ai][bj][m][n], 0, 0, 0); __builtin_amdgcn_s_setprio(0); } while (0)
#define PG8_WAIT_V(n) asm volatile("s_waitcnt vmcnt(" #n ")" ::: "memory")
#define PG8_WAIT_L(n) asm volatile("s_waitcnt lgkmcnt(" #n ")" ::: "memory")
#define PG8_BAR __builtin_amdgcn_s_barrier()
#define PG8_SCHED __builtin_amdgcn_sched_barrier(0)
    Unit cur, nxt; int ui = 0;
    if (!S.next(0, cur)) return;
    f32x4 acc[2][2][4][2];
    float zero_; asm volatile("v_mov_b32 %0, 0" : "=v"(zero_));
#pragma unroll
    for (int a = 0; a < 2; ++a)
#pragma unroll
        for (int b = 0; b < 2; ++b)
#pragma unroll
            for (int m = 0; m < 4; ++m)
#pragma unroll
                for (int n = 0; n < 2; ++n) acc[a][b][m][n] = (f32x4){zero_, zero_, zero_, zero_};
    bf16x8 At[4][2], B0[2][2], B1[2][2];
    const char* cA = (const char*)g.A + (size_t)cur.pm * tstep; const char* cB = (const char*)g.Bt + (size_t)cur.pn * tstep;
    S.a_ready(cur);
    if constexpr (SP2) {
        PG8_STAGE(PG8_SB(0, 0), cB, voffB); PG8_STAGE(PG8_SB(0, 1), cB + hstep, voffB); PG8_STAGE(PG8_SA(0, 0), cA, voffA); PG8_STAGE(PG8_SA(0, 1), cA + hstep, voffA);
        if (wr == 1) PG8_BAR;
        PG8_WAIT_V(2); PG8_BAR;
        PG8_STAGE(PG8_SB(1, 0), cB + kstep, voffB); PG8_STAGE(PG8_SA(1, 0), cA + kstep, voffA); PG8_STAGE(PG8_SB(1, 1), cB + hstep + kstep, voffB);
        PG8_WAIT_V(6); PG8_BAR;
    } else {
        PG8_STAGE(PG8_SB(0, 0), cB, voffB); PG8_STAGE(PG8_SA(0, 0), cA, voffA); PG8_STAGE(PG8_SB(0, 1), cB + hstep, voffB); PG8_STAGE(PG8_SA(0, 1), cA + hstep, voffA);
        if (wr == 1) PG8_BAR;
        PG8_WAIT_V(4); PG8_BAR;
        PG8_STAGE(PG8_SB(1, 0), cB + kstep, voffB); PG8_STAGE(PG8_SA(1, 0), cA + kstep, voffA); PG8_STAGE(PG8_SB(1, 1), cB + hstep + kstep, voffB);
        PG8_WAIT_V(6); PG8_BAR;
    }
    for (;;) {
        const bool has_next = S.next(ui + 1, nxt);
        const char* nA = has_next ? (const char*)g.A + (size_t)nxt.pm * tstep : cA; const char* nB = has_next ? (const char*)g.Bt + (size_t)nxt.pn * tstep : cB;
        for (int t = 0; t < nt; t += 2) {
            const bool last = (t == nt - 2);
            const char* a1 = cA + (size_t)(t + 1) * kstep;
            const char* a2 = last ? nA : cA + (size_t)(t + 2) * kstep; const char* b2 = last ? nB : cB + (size_t)(t + 2) * kstep;
            const char* a3 = a2 + kstep; const char* b3 = b2 + kstep;
            if (last && has_next) S.a_ready(nxt);
            if constexpr (SP2) {
            PG8_LDB(B0, 0, 0); PG8_LDB(B1, 0, 1); PG8_SCHED; PG8_LDA(At, 0, 0); PG8_STAGE(PG8_SA(1, 1), a1 + hstep, voffA);
            PG8_WAIT_V(8); PG8_WAIT_L(0); PG8_BAR; PG8_MMA(0, 0, At, B0); PG8_MMA(0, 1, At, B1); PG8_BAR; PG8_SCHED;
            PG8_LDA(At, 0, 1); PG8_STAGE(PG8_SB(0, 0), b2, voffB); PG8_STAGE(PG8_SB(0, 1), b2 + hstep, voffB); PG8_STAGE(PG8_SA(0, 0), a2, voffA);
            PG8_WAIT_V(8); PG8_WAIT_L(0); PG8_BAR; PG8_MMA(1, 0, At, B0); PG8_MMA(1, 1, At, B1); PG8_BAR; PG8_SCHED;
            PG8_LDB(B0, 1, 0); PG8_LDB(B1, 1, 1); PG8_SCHED; PG8_LDA(At, 1, 0); PG8_STAGE(PG8_SA(0, 1), a2 + hstep, voffA);
            PG8_WAIT_V(8); PG8_WAIT_L(0); PG8_BAR; PG8_MMA(0, 0, At, B0); PG8_MMA(0, 1, At, B1); PG8_BAR; PG8_SCHED;
            PG8_LDA(At, 1, 1); PG8_STAGE(PG8_SB(1, 0), b3, voffB); PG8_STAGE(PG8_SB(1, 1), b3 + hstep, voffB); PG8_STAGE(PG8_SA(1, 0), a3, voffA);
            PG8_WAIT_V(8); PG8_WAIT_L(0); PG8_BAR; PG8_MMA(1, 0, At, B0); PG8_MMA(1, 1, At, B1); PG8_BAR; PG8_SCHED;
            } else {
            PG8_LDB(B0, 0, 0); PG8_SCHED; PG8_LDA(At, 0, 0); PG8_STAGE(PG8_SA(1, 1), a1 + hstep, voffA);
            PG8_WAIT_L(8); PG8_BAR; PG8_WAIT_L(0); PG8_MMA(0, 0, At, B0); PG8_BAR; PG8_SCHED;
            PG8_LDB(B1, 0, 1); PG8_STAGE(PG8_SB(0, 0), b2, voffB);
            PG8_BAR; PG8_WAIT_L(0); PG8_MMA(0, 1, At, B1); PG8_BAR;
            PG8_LDA(At, 0, 1); PG8_STAGE(PG8_SA(0, 0), a2, voffA);
            PG8_BAR; PG8_WAIT_L(0); PG8_MMA(1, 0, At, B0); PG8_BAR; PG8_SCHED;
            PG8_STAGE(PG8_SB(0, 1), b2 + hstep, voffB);
            PG8_WAIT_V(6); PG8_BAR; PG8_MMA(1, 1, At, B1); PG8_BAR;
            PG8_LDB(B0, 1, 0); PG8_SCHED; PG8_LDA(At, 1, 0); PG8_STAGE(PG8_SA(0, 1), a2 + hstep, voffA);
            PG8_WAIT_L(8); PG8_BAR; PG8_WAIT_L(0); PG8_MMA(0, 0, At, B0); PG8_BAR; PG8_SCHED;
            PG8_LDB(B1, 1, 1); PG8_STAGE(PG8_SB(1, 0), b3, voffB);
            PG8_BAR; PG8_WAIT_L(0); PG8_MMA(0, 1, At, B1); PG8_BAR;
            PG8_LDA(At, 1, 1); PG8_STAGE(PG8_SA(1, 0), a3, voffA);
            PG8_BAR; PG8_WAIT_L(0); PG8_MMA(1, 0, At, B0); PG8_BAR; PG8_SCHED;
            PG8_STAGE(PG8_SB(1, 1), b3 + hstep, voffB);
            PG8_WAIT_V(6); PG8_BAR; PG8_MMA(1, 1, At, B1); PG8_BAR;
            }
        }
        if constexpr (ALIGN_EPI) { if (wr == 0) PG8_BAR; }
        if constexpr (!Epi::AFTER_DRAIN) { E(acc, cur, wr, wc, fr, fq); S.done(cur); }
        if (!has_next) break;
        asm volatile("v_mov_b32 %0, 0" : "=v"(zero_));
#pragma unroll
        for (int a = 0; a < 2; ++a)
#pragma unroll
            for (int b = 0; b < 2; ++b)
#pragma unroll
                for (int m = 0; m < 4; ++m)
#pragma unroll
                    for (int n = 0; n < 2; ++n) acc[a][b][m][n] = (f32x4){zero_, zero_, zero_, zero_};
        cur = nxt; cA = nA; cB = nB; ++ui;
        if constexpr (ALIGN_EPI) { if (wr == 1) PG8_BAR; }
    }
    PG8_WAIT_V(0);
    if constexpr (!ALIGN_EPI) { if (wr == 0) PG8_BAR; }
    PG8_BAR;
    if constexpr (Epi::AFTER_DRAIN) { E.fused(acc, cur, wr, wc, fr, fq, lds, wid, lane); S.done(cur); }
#undef PG8_SA
#undef PG8_SB
#undef PG8_STAGE
#undef PG8_LDA
#undef PG8_LDB
#undef PG8_MMA
#undef PG8_WAIT_V
#undef PG8_WAIT_L
#undef PG8_BAR
#undef PG8_SCHED
}
}

#ifndef PG8_SP2
#define PG8_SP2 true
#endif
#ifndef PG8_ALIGN
#define PG8_ALIGN true
#endif
#define XB_TMO      128
#define XB_XCNT(j)  (256  + 64 * (j))
#define XB_XSUB(j)  (1280 + 64 * (j))
#define XB_XGEN(j)  (2304 + 64 * (j))
#define XB_TOP      3328
#define XB_TOPGEN   3392
#define XCD_BAR_WORDS 3456
#define XB_SPIN_CAP (1u << 18)
#define LAS __attribute__((address_space(3)))

__device__ __forceinline__ unsigned xb_ld(unsigned* p)              { return __hip_atomic_load(p, __ATOMIC_RELAXED, __HIP_MEMORY_SCOPE_AGENT); }
__device__ __forceinline__ unsigned xb_add(unsigned* p, unsigned v) { return __hip_atomic_fetch_add(p, v, __ATOMIC_RELAXED, __HIP_MEMORY_SCOPE_AGENT); }
__device__ __forceinline__ unsigned xb_xcc_id() { return (unsigned)__builtin_amdgcn_s_getreg((3 << 11) | 20) & 0xFu; }
#define XB_SPIN(cond, bar) do { unsigned _sp = 0; while (cond) { __builtin_amdgcn_s_sleep(1); \
    if ((++_sp & 255u) == 0u) { if (xb_ld(&(bar)[XB_TMO])) break; if (_sp > XB_SPIN_CAP) { atomicAdd(&(bar)[XB_TMO], 1u); break; } } } } while (0)

struct XcdBarrier {
    unsigned* bar; unsigned x;
    unsigned w0;
    volatile LAS unsigned* st;
};

__device__ __forceinline__ XcdBarrier xcd_barrier_post(unsigned* bar, volatile LAS unsigned* st) {
    XcdBarrier b; b.bar = bar; b.x = xb_xcc_id(); b.st = st; b.w0 = (unsigned)__builtin_amdgcn_readfirstlane(threadIdx.x >> 6);
    if (threadIdx.x == 0) (void)xb_add(&bar[XB_XCNT(b.x)], 1u);
    return b;
}
__device__ __forceinline__ void xcd_barrier_complete(unsigned* bar, unsigned x, unsigned& nloc, unsigned& nx) {
    const unsigned G = gridDim.x * gridDim.y * gridDim.z;
    unsigned sum, cnt, mine, sp = 0u;
    for (;;) {
        sum = 0u; cnt = 0u; mine = 0u;
#pragma unroll
        for (unsigned j = 0; j < 16; ++j) { const unsigned c = xb_ld(&bar[XB_XCNT(j)]); sum += c; cnt += (c > 0u) ? 1u : 0u; mine = (j == x) ? c : mine; }
        if (sum == G) break;
        __builtin_amdgcn_s_sleep(1);
        if ((++sp & 255u) == 0u) { if (xb_ld(&bar[XB_TMO])) break; if (sp > XB_SPIN_CAP) { atomicAdd(&bar[XB_TMO], 1u); break; } }
    }
    nloc = mine > 0u ? mine : 1u; nx = cnt > 0u ? cnt : 1u;
}

__device__ __forceinline__ void xcd_barrier(const XcdBarrier& b) {
    asm volatile("s_waitcnt vmcnt(0)" ::: "memory");
    __syncthreads();
    unsigned xb_lane; asm volatile("v_mbcnt_lo_u32_b32 %0, -1, 0\n\tv_mbcnt_hi_u32_b32 %0, -1, %0" : "=v"(xb_lane));
    if (b.w0 == 0u && xb_lane == 0u) {
        unsigned* bar = b.bar;
        __builtin_amdgcn_s_waitcnt(0);
        unsigned nloc = b.st[0], nx = b.st[1];
        if (nloc == 0u) { xcd_barrier_complete(bar, b.x, nloc, nx); b.st[0] = nloc; b.st[1] = nx; }
        const unsigned old = xb_add(&bar[XB_XSUB(b.x)], 1u);
        const unsigned gen = old / nloc;
        if (old + 1u == (gen + 1u) * nloc) {
            __builtin_amdgcn_fence(__ATOMIC_RELEASE, "agent");
            asm volatile("s_waitcnt vmcnt(0)" ::: "memory");
            const unsigned og = xb_add(&bar[XB_TOP], 1u);
            const unsigned tg = og / nx;
            if (og + 1u == (tg + 1u) * nx) xb_add(&bar[XB_TOPGEN], 1u);
            else XB_SPIN(xb_ld(&bar[XB_TOPGEN]) == tg, bar);
            __builtin_amdgcn_fence(__ATOMIC_ACQUIRE, "agent");
            xb_add(&bar[XB_XGEN(b.x)], 1u);
            asm volatile("s_waitcnt vmcnt(0)" ::: "memory");
        } else {
            XB_SPIN(xb_ld(&bar[XB_XGEN(b.x)]) == gen, bar);
            __builtin_amdgcn_fence(__ATOMIC_ACQUIRE, "agent");
            asm volatile("s_waitcnt vmcnt(0)" ::: "memory");
        }
    }
    __syncthreads();
}
constexpr int NWAVES = 8;
constexpr int D = 2048, FF = 5632, NFF2 = 2 * FF, NQKV = 18432, NHY = 6144, DEPTH = 4;
constexpr int T_PROMPT = 4 * 8192, T = 49152;
constexpr float LN_EPS = 1e-5f;
constexpr float QSCALE = 0.12751743082459868f;
constexpr float LOG2E = 1.4426950408889634f;
constexpr float MIN_DECAY = -3.0701134573253946f, MAX_DECAY = -15.350567286626973f;

constexpr size_t MiB = 1u << 20;
constexpr size_t WS_CTL = 0, CTL_ZERO_BYTES = 64 * 1024;
constexpr size_t WS_IDG = 1 * MiB, WS_IDB = 1 * MiB + 32768, WS_DUMP = 1 * MiB + 32768 + 131072;
constexpr size_t WS_CD = 2 * MiB;
constexpr size_t WS_STATS = 3 * MiB;
constexpr size_t WS_H2T = 4 * MiB;
constexpr size_t WS_PART = 8 * MiB;
constexpr size_t WS_W = 32 * MiB;
constexpr size_t W_IN1 = WS_W, W_OUT1 = W_IN1 + 44 * MiB, W_IN2 = W_OUT1 + 22 * MiB, W_OUT2 = W_IN2 + 44 * MiB, W_MIN = W_OUT2 + 22 * MiB, W_MOUT = W_MIN + 72 * MiB;
constexpr size_t WS_ZB = W_MOUT + 8 * MiB;
constexpr size_t WS_BIG = WS_ZB + 192 * MiB;
constexpr size_t BIG_HID = 0;
constexpr size_t BIG_QKV = 0, BIG_AO = 1728 * MiB;
constexpr size_t BIG_U = 0, BIG_Z2T = 0, BIG_Z2 = 192 * MiB, BIG_UT = 576 * MiB, BIG_SPEC0 = 1152 * MiB, BIG_SPEC1 = 1664 * MiB;
constexpr size_t WS_TAPS = WS_BIG + 1920 * MiB;
constexpr size_t WS_H2B = WS_TAPS + 320 * MiB, WS_W3T = WS_H2B + 6 * MiB;
constexpr size_t WS_ZL = WS_W3T + 4 * MiB;
constexpr size_t WS_END = WS_ZL + 48 * MiB;
static_assert(WS_ZB == 244 * MiB && WS_BIG == 436 * MiB && (size_t)T * 64 * 8 <= 24 * MiB && WS_END <= 2816 * MiB && (size_t)8192 * 10240 * 4 <= 320 * MiB, "ws map");
static_assert((size_t)T * FF * 2 <= 528 * MiB && (size_t)T * NQKV * 2 <= 1728 * MiB && (size_t)T * NHY * 2 <= 576 * MiB && BIG_SPEC1 + 128 * MiB <= 1920 * MiB, "ws map");

constexpr int RING_OFF = 0;
constexpr int FFT_BYTES = (16384 + 512) * 8;
constexpr int SCR_OFF = FFT_BYTES;
constexpr int MISC_OFF = SCR_OFF + 1024;
constexpr int PTR_OFF = MISC_OFF + 256;
constexpr int EPI_OFF = PTR_OFF + 256;
constexpr int LDS_BYTES = EPI_OFF + 4096;

#define GAS __attribute__((address_space(1)))
#define LAS __attribute__((address_space(3)))
typedef unsigned short bf16;
typedef unsigned v4u __attribute__((ext_vector_type(4)));
typedef unsigned v2u __attribute__((ext_vector_type(2)));
typedef float f32x4 __attribute__((ext_vector_type(4)));
typedef float f32x2 __attribute__((ext_vector_type(2)));
typedef float f32x16 __attribute__((ext_vector_type(16)));
typedef short bf16x8 __attribute__((ext_vector_type(8)));
typedef short s16x4 __attribute__((ext_vector_type(4)));
#define LDS_WAIT() asm volatile("s_waitcnt lgkmcnt(0)" ::: "memory")
#define VM_WAIT() asm volatile("s_waitcnt vmcnt(0)" ::: "memory")
__device__ __forceinline__ unsigned f2bf(float f) { unsigned u = __builtin_bit_cast(unsigned, f); return (u + 0x7fffu + ((u >> 16) & 1u)) >> 16; }
__device__ __forceinline__ unsigned pk2(float lo, float hi) { return f2bf(lo) | (f2bf(hi) << 16); }
__device__ __forceinline__ float bf2f(unsigned b) { return __builtin_bit_cast(float, b << 16); }
__device__ __forceinline__ float bfround(float f) { return bf2f(f2bf(f)); }

#ifndef FFT_HD
#define FFT_HD __host__ __device__ __forceinline__
#endif
#if defined(__clang__)
typedef float cpx __attribute__((ext_vector_type(2)));
#else
struct cpx { float x, y; };
#endif
#if defined(__HIP_DEVICE_COMPILE__)
#define FFT_PK2(name, T2, C2, I1, I2) \
    __device__ __forceinline__ cpx name(cpx a, T2 b) { cpx t, r; asm(I1 : "=v"(t) : "v"(a), C2(b)); asm(I2 : "=v"(r) : "v"(a), C2(b), "v"(t)); return r; }
FFT_PK2(cmul,  cpx, "v", "v_pk_mul_f32 %0, %1, %2 op_sel:[0,0] op_sel_hi:[1,0]", "v_pk_fma_f32 %0, %1, %2, %3 op_sel:[1,1,0] op_sel_hi:[0,1,1] neg_lo:[1,0,0]")
FFT_PK2(cmulc, cpx, "v", "v_pk_mul_f32 %0, %1, %2 op_sel:[0,0] op_sel_hi:[1,0]", "v_pk_fma_f32 %0, %1, %2, %3 op_sel:[1,1,0] op_sel_hi:[0,1,1] neg_hi:[1,0,0]")
FFT_PK2(cmul_k,  cpx, "s", "v_pk_mul_f32 %0, %1, %2 op_sel:[0,0] op_sel_hi:[1,0]", "v_pk_fma_f32 %0, %1, %2, %3 op_sel:[1,1,0] op_sel_hi:[0,1,1] neg_lo:[1,0,0]")
FFT_PK2(cmulc_k, cpx, "s", "v_pk_mul_f32 %0, %1, %2 op_sel:[0,0] op_sel_hi:[1,0]", "v_pk_fma_f32 %0, %1, %2, %3 op_sel:[1,1,0] op_sel_hi:[0,1,1] neg_hi:[1,0,0]")
#define FFT_PK1(name, I1) __device__ __forceinline__ cpx name(cpx u, cpx v) { cpx r; asm(I1 : "=v"(r) : "v"(u), "v"(v)); return r; }
FFT_PK1(sub_mi, "v_pk_add_f32 %0, %1, %2 op_sel:[1,1] op_sel_hi:[0,0] neg_lo:[0,1] neg_hi:[1,0]")
FFT_PK1(add_iv, "v_pk_add_f32 %0, %1, %2 op_sel:[0,1] op_sel_hi:[1,0] neg_lo:[0,1]")
FFT_PK1(sub_iv, "v_pk_add_f32 %0, %1, %2 op_sel:[0,1] op_sel_hi:[1,0] neg_hi:[0,1]")
#else
FFT_HD cpx cmul(cpx a, cpx b) { return cpx{a.x * b.x - a.y * b.y, a.x * b.y + a.y * b.x}; }
FFT_HD cpx cmulc(cpx a, cpx b) { return cpx{a.x * b.x + a.y * b.y, a.y * b.x - a.x * b.y}; }
FFT_HD cpx cmul_k(cpx a, cpx b) { return cmul(a, b); }
FFT_HD cpx cmulc_k(cpx a, cpx b) { return cmulc(a, b); }
FFT_HD cpx sub_mi(cpx u, cpx v) { return cpx{u.y - v.y, v.x - u.x}; }
FFT_HD cpx add_iv(cpx u, cpx v) { return cpx{u.x - v.y, u.y + v.x}; }
FFT_HD cpx sub_iv(cpx u, cpx v) { return cpx{u.x + v.y, u.y - v.x}; }
#endif
#if defined(__clang__)
FFT_HD cpx cadd(cpx a, cpx b) { return a + b; }
FFT_HD cpx csub(cpx a, cpx b) { return a - b; }
#else
FFT_HD cpx cadd(cpx a, cpx b) { return cpx{a.x + b.x, a.y + b.y}; }
FFT_HD cpx csub(cpx a, cpx b) { return cpx{a.x - b.x, a.y - b.y}; }
#endif
FFT_HD int pidx(int i) { return i + (i >> 5); }
FFT_HD cpx cis_neg_rev(float rev) {
    const float x8 = rev * 8.0f; int oct = (int)x8; oct = oct > 7 ? 7 : oct; const float f = x8 - (float)oct;
    const float a = (oct & 1) ? (1.0f - f) : f, phi = a * 0.78539816339744831f, p2 = phi * phi;
    const float s = phi * (1.0f + p2 * (-1.6666666666666666e-1f + p2 * (8.3333333333333332e-3f + p2 * (-1.9841269841269841e-4f + p2 * 2.7557319223985893e-6f))));
    const float c = 1.0f + p2 * (-0.5f + p2 * (4.1666666666666664e-2f + p2 * (-1.3888888888888889e-3f + p2 * (2.4801587301587302e-5f + p2 * -2.7557319223985888e-7f))));
    const bool sw = ((oct + 1) & 2) != 0;
    float cc = sw ? s : c, ss = sw ? c : s;
    if (oct >= 2 && oct <= 5) cc = -cc;
    if (oct >= 4) ss = -ss;
    return cpx{cc, -ss};
}
FFT_HD float sin_acc(float x) { float rev = x * 0.15915494309189535f; rev -= floorf(rev); const cpx e = cis_neg_rev(rev); return -e.y; }
FFT_HD float cos_rev(float rev) { rev -= floorf(rev); return cis_neg_rev(rev).x; }
FFT_HD float sin_rev(float rev) { rev -= floorf(rev); return -cis_neg_rev(rev).y; }
FFT_HD cpx w16(int k) {
    constexpr float C1 = 0.92387953251128674f, S1 = 0.38268343236508977f, R2 = 0.70710678118654752f;
    switch (k) { case 0: return cpx{1.f, 0.f}; case 1: return cpx{C1, -S1}; case 2: return cpx{R2, -R2}; case 3: return cpx{S1, -C1};
                 case 4: return cpx{0.f, -1.f}; case 5: return cpx{-S1, -C1}; case 6: return cpx{-R2, -R2}; default: return cpx{-C1, -S1}; }
}
template <int R> FFT_HD constexpr int bitrev(int i) { int r = 0; for (int b = 1, c = R >> 1; b < R; b <<= 1, c >>= 1) if (i & b) r |= c; return r; }
template <int K> FFT_HD void dif_bf(cpx& x, cpx& y) { const cpx u = x, v = y; x = cadd(u, v); if constexpr (K == 0) y = csub(u, v); else if constexpr (K == 4) y = sub_mi(u, v); else y = cmul_k(csub(u, v), w16(K)); }
template <int K> FFT_HD void dit_bf(cpx& x, cpx& y) { const cpx u = x, t = y; if constexpr (K == 4) { x = add_iv(u, t); y = sub_iv(u, t); } else { cpx v = t; if constexpr (K != 0) v = cmulc_k(t, w16(K)); x = cadd(u, v); y = csub(u, v); } }
template <int R> FFT_HD void dif_regs(cpx (&a)[R]);
template <> FFT_HD void dif_regs<16>(cpx (&a)[16]) {
    dif_bf<0>(a[0], a[8]); dif_bf<1>(a[1], a[9]); dif_bf<2>(a[2], a[10]); dif_bf<3>(a[3], a[11]); dif_bf<4>(a[4], a[12]); dif_bf<5>(a[5], a[13]); dif_bf<6>(a[6], a[14]); dif_bf<7>(a[7], a[15]);
    dif_bf<0>(a[0], a[4]); dif_bf<2>(a[1], a[5]); dif_bf<4>(a[2], a[6]); dif_bf<6>(a[3], a[7]); dif_bf<0>(a[8], a[12]); dif_bf<2>(a[9], a[13]); dif_bf<4>(a[10], a[14]); dif_bf<6>(a[11], a[15]);
    dif_bf<0>(a[0], a[2]); dif_bf<4>(a[1], a[3]); dif_bf<0>(a[4], a[6]); dif_bf<4>(a[5], a[7]); dif_bf<0>(a[8], a[10]); dif_bf<4>(a[9], a[11]); dif_bf<0>(a[12], a[14]); dif_bf<4>(a[13], a[15]);
    dif_bf<0>(a[0], a[1]); dif_bf<0>(a[2], a[3]); dif_bf<0>(a[4], a[5]); dif_bf<0>(a[6], a[7]); dif_bf<0>(a[8], a[9]); dif_bf<0>(a[10], a[11]); dif_bf<0>(a[12], a[13]); dif_bf<0>(a[14], a[15]);
}
template <> FFT_HD void dif_regs<4>(cpx (&a)[4]) {
    dif_bf<0>(a[0], a[2]); dif_bf<4>(a[1], a[3]);
    dif_bf<0>(a[0], a[1]); dif_bf<0>(a[2], a[3]);
}
template <int R> FFT_HD void dit_regs(cpx (&a)[R]);
template <> FFT_HD void dit_regs<16>(cpx (&a)[16]) {
    dit_bf<0>(a[0], a[1]); dit_bf<0>(a[2], a[3]); dit_bf<0>(a[4], a[5]); dit_bf<0>(a[6], a[7]); dit_bf<0>(a[8], a[9]); dit_bf<0>(a[10], a[11]); dit_bf<0>(a[12], a[13]); dit_bf<0>(a[14], a[15]);
    dit_bf<0>(a[0], a[2]); dit_bf<4>(a[1], a[3]); dit_bf<0>(a[4], a[6]); dit_bf<4>(a[5], a[7]); dit_bf<0>(a[8], a[10]); dit_bf<4>(a[9], a[11]); dit_bf<0>(a[12], a[14]); dit_bf<4>(a[13], a[15]);
    dit_bf<0>(a[0], a[4]); dit_bf<2>(a[1], a[5]); dit_bf<4>(a[2], a[6]); dit_bf<6>(a[3], a[7]); dit_bf<0>(a[8], a[12]); dit_bf<2>(a[9], a[13]); dit_bf<4>(a[10], a[14]); dit_bf<6>(a[11], a[15]);
    dit_bf<0>(a[0], a[8]); dit_bf<1>(a[1], a[9]); dit_bf<2>(a[2], a[10]); dit_bf<3>(a[3], a[11]); dit_bf<4>(a[4], a[12]); dit_bf<5>(a[5], a[13]); dit_bf<6>(a[6], a[14]); dit_bf<7>(a[7], a[15]);
}
template <> FFT_HD void dit_regs<4>(cpx (&a)[4]) {
    dit_bf<0>(a[0], a[1]); dit_bf<0>(a[2], a[3]);
    dit_bf<0>(a[0], a[2]); dit_bf<4>(a[1], a[3]);
}
template <int R> FFT_HD void twiddle_powers(cpx w1, cpx (&pw)[R]) {
    pw[0] = cpx{1.f, 0.f}; pw[1] = w1; pw[2] = cmul(w1, w1); pw[3] = cmul(pw[2], w1);
    if constexpr (R > 4) { pw[4] = cmul(pw[2], pw[2]); pw[5] = cmul(pw[4], pw[1]); pw[6] = cmul(pw[4], pw[2]); pw[7] = cmul(pw[4], pw[3]); }
    if constexpr (R > 8) { pw[8] = cmul(pw[4], pw[4]);
#pragma unroll
        for (int k = 1; k < 8; ++k) pw[8 + k] = cmul(pw[8], pw[k]); }
}
template <int R, bool INV, int LOGM, class P> FFT_HD void fft_pass(P X, int tid, int nthr) {
    constexpr int LOGR = (R == 16) ? 4 : 2, logs = LOGM - LOGR, s = 1 << logs;
    constexpr bool SHARED_TW = (s <= 512);
    cpx pw[R];
    if (logs > 0 && SHARED_TW) twiddle_powers<R>(cis_neg_rev((float)(tid & (s - 1)) * (1.0f / (float)(1 << LOGM))), pw);
#pragma unroll 2
    for (int blk = tid; blk < 16384 / R; blk += nthr) {
        const int base = blk & (s - 1), idx0 = ((blk >> logs) << LOGM) + base;
        P X0 = X + pidx(idx0);
        cpx a[R];
        if (logs > 0 && !SHARED_TW) twiddle_powers<R>(cis_neg_rev((float)base * (1.0f / (float)(1 << LOGM))), pw);
        if (!INV) {
#pragma unroll
            for (int j = 0; j < R; ++j) a[j] = X0[j * s + ((j * s) >> 5)];
            dif_regs<R>(a);
#pragma unroll
            for (int i = 0; i < R; ++i) { const int k1 = bitrev<R>(i); cpx v = a[i]; if (logs > 0 && k1 != 0) v = cmul(v, pw[k1]); X0[k1 * s + ((k1 * s) >> 5)] = v; }
        } else {
#pragma unroll
            for (int i = 0; i < R; ++i) { const int k1 = bitrev<R>(i); cpx v = X0[k1 * s + ((k1 * s) >> 5)]; if (logs > 0 && k1 != 0) v = cmulc(v, pw[k1]); a[i] = v; }
            dit_regs<R>(a);
#pragma unroll
            for (int j = 0; j < R; ++j) X0[j * s + ((j * s) >> 5)] = a[j];
        }
    }
}
template <int R, int NB, class HP> FFT_HD void fft_mid_load(HP H, int tid, int nthr, int nmask, cpx (&h)[NB][R]) {
#pragma unroll
    for (int b = 0; b < NB; ++b) { const int p0 = ((tid + b * nthr) * R) & nmask;
#pragma unroll
        for (int k = 0; k < R; ++k) h[b][k] = H[p0 + k]; }
}
template <int R, int NB, class P> FFT_HD void fft_mid_apply(P X, const cpx (&h)[NB][R], int tid, int nthr) {
#pragma unroll
    for (int b = 0; b < NB; ++b) { P X0 = X + pidx((tid + b * nthr) * R); cpx a[R];
#pragma unroll
        for (int j = 0; j < R; ++j) a[j] = X0[j];
        dif_regs<R>(a);
#pragma unroll
        for (int i = 0; i < R; ++i) a[i] = cmul(a[i], h[b][bitrev<R>(i)]);
        dit_regs<R>(a);
#pragma unroll
        for (int j = 0; j < R; ++j) X0[j] = a[j]; }
}
template <int LOGN> FFT_HD int mirror_pos(int p) {
    if (LOGN == 14) { const int k = (p >> 10) | (((p >> 6) & 15) << 4) | (((p >> 2) & 15) << 8) | ((p & 3) << 12), km = (16384 - k) & 16383;
                      return ((km & 15) << 10) | (((km >> 4) & 15) << 6) | (((km >> 8) & 15) << 2) | (km >> 12); }
    else { const int k = (p >> 8) | (((p >> 4) & 15) << 4) | ((p & 15) << 8), km = (4096 - k) & 4095;
           return ((km & 15) << 8) | (((km >> 4) & 15) << 4) | (km >> 8); }
}
FFT_HD void split_two_real(cpx A, cpx B, cpx& H0, cpx& H1) { H0 = cpx{0.5f * (A.x + B.x), 0.5f * (A.y - B.y)}; H1 = cpx{0.5f * (A.y + B.y), 0.5f * (B.x - A.x)}; }
struct Frame {
    LAS unsigned char* lds;
    int tid, lane, wave;
    int vcu, G, bx;
    unsigned char* ws; float* z;
};
__device__ __forceinline__ Frame make_frame(unsigned char* lds_generic, unsigned char* ws, float* out, int wave0) {
    Frame F;
    int lane; asm volatile("v_mbcnt_lo_u32_b32 %0, -1, 0\n\tv_mbcnt_hi_u32_b32 %0, -1, %0" : "=v"(lane));
    int bx = blockIdx.x, G = gridDim.x;
    asm volatile("" : "+v"(lane)); asm volatile("" : "+s"(bx)); asm volatile("" : "+s"(G)); asm volatile("" : "+s"(wave0));
    const int tid = wave0 * 64 + lane;
    unsigned long long w = (unsigned long long)ws, o = (unsigned long long)out; asm volatile("" : "+s"(w)); asm volatile("" : "+s"(o));
    F.lds = (LAS unsigned char*)lds_generic;
    F.tid = tid; F.lane = lane; F.wave = wave0;
    F.G = G; F.bx = bx; F.vcu = (G % 8 == 0) ? (bx % 8) * (G / 8) + bx / 8 : bx;
    F.ws = (unsigned char*)(GAS unsigned char*)w; F.z = (float*)(GAS float*)o;
    return F;
}
__device__ __forceinline__ const float* inp(const Frame& F, int i) {
    const LAS unsigned* t = (const LAS unsigned*)(F.lds + PTR_OFF) + 2 * i;
    const unsigned lo = __builtin_amdgcn_readfirstlane(t[0]), hi = __builtin_amdgcn_readfirstlane(t[1]);
    return (const float*)(const GAS float*)(((unsigned long long)hi << 32) | lo);
}
__device__ __forceinline__ float wave_sum(float v) { return pg8::wave_sum64(v); }
__device__ __forceinline__ void block_sum2(Frame& F, float& a, float& b) {
    LAS float* scr = (LAS float*)(F.lds + SCR_OFF);
    a = wave_sum(a); b = wave_sum(b);
    __syncthreads();
    if (F.lane == 0) { scr[F.wave * 2] = a; scr[F.wave * 2 + 1] = b; }
    __syncthreads();
    float sa = 0.f, sb = 0.f;
#pragma unroll
    for (int w = 0; w < NWAVES; ++w) { sa += scr[w * 2]; sb += scr[w * 2 + 1]; }
    a = sa; b = sb;
}

__device__ __forceinline__ void phase_init(Frame& F) {
    const int gw = F.vcu * NWAVES + F.wave, NGW = F.G * NWAVES;
    bf16* zb = (bf16*)(F.ws + WS_ZB); float* stats = (float*)(F.ws + WS_STATS);
    const float* x0 = inp(F, 0); const float* x1 = inp(F, 1);
    for (int m = gw; m < T; m += NGW) {
        const float* src = (m < T_PROMPT) ? x0 + (size_t)m * D : x1 + (size_t)(m - T_PROMPT) * D;
        const GAS f32x4* s4 = (const GAS f32x4*)src + F.lane; GAS v2u* b4 = (GAS v2u*)(zb + (size_t)m * D) + F.lane; GAS unsigned short* l4 = (GAS unsigned short*)(F.ws + WS_ZL) + (size_t)m * (D / 4) + F.lane;
#pragma unroll
        for (int j = 0; j < 8; ++j) { const f32x4 v = s4[64 * j];
            v2u o; o.x = (pg8::z20_zb(v.x) >> 16) | (pg8::z20_zb(v.y) & 0xffff0000u); o.y = (pg8::z20_zb(v.z) >> 16) | (pg8::z20_zb(v.w) & 0xffff0000u); b4[64 * j] = o;
            l4[64 * j] = (unsigned short)((pg8::z20_c(v.x, 0) | pg8::z20_c(v.y, 1)) | (pg8::z20_c(v.z, 2) | pg8::z20_c(v.w, 3))); }
        if (F.lane == 0) { stats[2 * m] = 0.f; stats[2 * m + 1] = 1.f; }
    }
    const int gt = F.vcu * (NWAVES * 64) + F.tid;
    if (gt < 8192) ((float*)(F.ws + WS_IDG))[gt] = 1.f;
    if (gt < 32768) ((float*)(F.ws + WS_IDB))[gt] = 0.f;
}

struct ConvJob { const float* W; int K, N; bf16* WT; const float* gk; const float* bk; float* cvec; float* dvec; const float* ebias; int mode; };
__device__ __forceinline__ void conv_item(const float* W, int K, int N, bf16* WT, const float* gk, const float* bk, float* cvec, float* dvec, const float* ebias, int mode, int nb, int kbeg, int kend, LAS float* scr, int lane) {
    const int n0 = 32 * nb;
    const float colscale = (mode == 2 && n0 < 6144) ? QSCALE : 1.0f;
    int rbase = n0;
    if (mode == 1) { rbase = (n0 < FF) ? (n0 / 128) * 256 + (n0 % 128) : ((n0 - FF) / 128) * 256 + 128 + ((n0 - FF) % 128); }
    float cs[32], ds[32];
#pragma unroll
    for (int i = 0; i < 32; ++i) { cs[i] = 0.f; ds[i] = 0.f; }
    f32x4 wv[8], wn[8];
    const float* wp = W + (size_t)(kbeg + lane) * N + n0;
#pragma unroll
    for (int j = 0; j < 8; ++j) wv[j] = *(const GAS f32x4*)(wp + 4 * j);
    float g = gk[kbeg + lane], b = bk[kbeg + lane];
    bf16* op = WT + (size_t)rbase * K + lane;
    for (int k0 = kbeg; k0 < kend; k0 += 64) {
        const int k1 = (k0 + 64 < kend) ? k0 + 64 : k0;
        const float* wq = W + (size_t)(k1 + lane) * N + n0;
#pragma unroll
        for (int j = 0; j < 8; ++j) wn[j] = *(const GAS f32x4*)(wq + 4 * j);
        const float gnx = gk[k1 + lane], bnx = bk[k1 + lane];
#pragma unroll
        for (int j = 0; j < 8; ++j)
#pragma unroll
            for (int e = 0; e < 4; ++e) { const int i = 4 * j + e; const float w = wv[j][e] * colscale; const unsigned vb = f2bf(w * g); const float v = bf2f(vb);
                cs[i] += v; ds[i] += b * w; op[(size_t)i * K + k0] = (bf16)vb; }
#pragma unroll
        for (int j = 0; j < 8; ++j) wv[j] = wn[j];
        g = gnx; b = bnx;
    }
    float myc = 0.f, myd = 0.f;
#pragma unroll
    for (int i = 0; i < 32; ++i) { const float c = wave_sum(cs[i]), d = wave_sum(ds[i]); myc = (lane == i) ? c : myc; myd = (lane == i) ? d : myd; }
    if (lane < 32) { cvec[rbase + lane] = myc; dvec[rbase + lane] = myd + ebias[n0 + lane]; }
}
__device__ __forceinline__ void filt_pos(Frame& F, int jl, int var, int t) {
    const int L = var ? 2048 : 8192, lane = F.lane;
    const float* w1 = inp(F, 12) + (size_t)jl * 33 * 64; const float* b1 = inp(F, 13) + jl * 64; const float* w2 = inp(F, 14) + (size_t)jl * 64 * 64; const float* b2 = inp(F, 15) + jl * 64; const float* fr = inp(F, 16) + jl * 64;
    float feat = 0.f;
    if (lane == 0) feat = (float)t / (float)(L - 1);
    else if (lane < 33) { const int bi = (lane - 1) & 15; const float band = 1e-4f + (float)bi * ((15.0f - 1e-4f) / 15.0f); const float rev = band * ((float)t / (float)L);
        feat = (lane < 17) ? cos_rev(rev) : -sin_rev(rev); }
    float acc = b1[lane];
    for (int k = 0; k < 33; ++k) acc += __builtin_bit_cast(float, __builtin_amdgcn_readlane(__builtin_bit_cast(int, feat), k)) * w1[k * 64 + lane];
    const float fq = fr[lane];
    const float h1 = sin_acc(fq * acc);
    float acc2 = b2[lane];
    for (int k = 0; k < 64; ++k) acc2 += __builtin_bit_cast(float, __builtin_amdgcn_readlane(__builtin_bit_cast(int, h1), k)) * w2[k * 64 + lane];
    const float h2 = sin_acc(fq * acc2);
    bf16* hrow = (bf16*)(F.ws + WS_H2B) + (size_t)((var ? 8192 : 0) + t) * 256;
    hrow[lane] = (bf16)f2bf(h2); hrow[64 + lane] = 0; hrow[128 + lane] = 0; hrow[192 + lane] = 0;
}
__device__ __forceinline__ void phase_convert(Frame& F, int layer) {
    LAS float* scr = (LAS float*)(F.lds + RING_OFF + F.wave * 16384);
    const int gw = F.vcu * NWAVES + F.wave, NGW = F.G * NWAVES;
    const int jl = layer >> 1; const bool hy = (layer & 1) != 0;
    const float* ln_g = inp(F, 2); const float* ln_b = inp(F, 3);
    const float* ones = (const float*)(F.ws + WS_IDG); const float* zeros = (const float*)(F.ws + WS_IDB); float* dump = (float*)(F.ws + WS_DUMP);
    float* cd = (float*)(F.ws + WS_CD);
    float* c1 = cd, *d1 = cd + NFF2, *cm = cd + 2 * NFF2, *dm = cm + NQKV, *c2 = dm + NQKV, *d2 = c2 + NFF2;
    const int nb1 = (D / 32) * 4, nb0 = NFF2 / 32, nb4 = (hy ? NHY : NQKV) / 32, nb5 = D / 32;
    const int total = 2 * nb1 + 2 * nb0 + nb4 + nb5;
    for (int it = gw; it < total; it += NGW) {
        int r = it;
        if (r < 2 * nb1) { const int f = r / nb1; r -= f * nb1;
            conv_item(inp(F, 5) + (size_t)(layer * 2 + f) * FF * D, FF, D, (bf16*)(F.ws + (f ? W_OUT2 : W_OUT1)), ones, zeros, dump, dump + NQKV, zeros, 0, r >> 2, (r & 3) * 1408, (r & 3) * 1408 + 1408, scr, F.lane); continue; }
        r -= 2 * nb1;
        if (r < 2 * nb0) { const int f = r / nb0; r -= f * nb0;
            const float* gk = f ? ln_g + (size_t)(layer * 3 + 1) * D : (layer ? ln_g + (size_t)((layer - 1) * 3 + 2) * D : ones);
            const float* bk = f ? ln_b + (size_t)(layer * 3 + 1) * D : (layer ? ln_b + (size_t)((layer - 1) * 3 + 2) * D : zeros);
            conv_item(inp(F, 4) + (size_t)(layer * 2 + f) * D * NFF2, D, NFF2, (bf16*)(F.ws + (f ? W_IN2 : W_IN1)), gk, bk, f ? c2 : c1, f ? d2 : d1, zeros, 1, r, 0, D, scr, F.lane); continue; }
        r -= 2 * nb0;
        if (r < nb4) {
            const float* gk = ln_g + (size_t)(layer * 3) * D; const float* bk = ln_b + (size_t)(layer * 3) * D;
            if (hy) conv_item(inp(F, 8) + (size_t)jl * D * NHY, D, NHY, (bf16*)(F.ws + W_MIN), gk, bk, cm, dm, inp(F, 9) + (size_t)jl * NHY, 0, r, 0, D, scr, F.lane);
            else conv_item(inp(F, 6) + (size_t)jl * D * NQKV, D, NQKV, (bf16*)(F.ws + W_MIN), gk, bk, cm, dm, zeros, 2, r, 0, D, scr, F.lane);
            continue; }
        r -= nb4;
        conv_item((hy ? inp(F, 19) : inp(F, 7)) + (size_t)jl * D * D, D, D, (bf16*)(F.ws + W_MOUT), ones, zeros, dump, dump + NQKV, zeros, 0, r, 0, D, scr, F.lane);
    }
    if (hy) {
        for (int p = gw; p < 8192 + 2048; p += NGW) { if (p < 8192) filt_pos(F, jl, 0, p); else filt_pos(F, jl, 1, p - 8192); }
        const float* w3 = inp(F, 17) + (size_t)jl * 64 * 8192; bf16* w3T = (bf16*)(F.ws + WS_W3T);
        for (int n = gw; n < 8192; n += NGW) { bf16* r = w3T + (size_t)n * 256; r[F.lane] = (bf16)f2bf(w3[(size_t)F.lane * 8192 + n]); r[64 + F.lane] = 0; r[128 + F.lane] = 0; r[192 + F.lane] = 0; }
    }
}

__device__ __forceinline__ void phase_finalize(Frame& F) {
    const float* part = (const float*)(F.ws + WS_PART); float* stats = (float*)(F.ws + WS_STATS);
    for (int row = F.vcu * (NWAVES * 64) + F.tid; row < T; row += F.G * NWAVES * 64) {
        const GAS f32x4* p = (const GAS f32x4*)(part + (size_t)row * 128);
        float s = 0.f, q = 0.f;
#pragma unroll 8
        for (int j = 0; j < 32; ++j) { const f32x4 v = p[j]; s += v.x + v.z; q += v.y + v.w; }
        const float mean = s * (1.0f / D); const float var = fmaxf(q * (1.0f / D) - mean * mean, 0.f);
        *(GAS f32x2*)(stats + 2 * (size_t)row) = (f32x2){mean, 1.0f / sqrtf(var + LN_EPS)};
    }
}

#ifdef DBG_CHECK
__device__ __forceinline__ void phase_check_qkv(Frame& F) {
    const int gw = F.vcu * NWAVES + F.wave, NGW = F.G * NWAVES;
    const float* W = inp(F, 6); const float* g = inp(F, 2); const float* b = inp(F, 3);
    const float* stats = (const float*)(F.ws + WS_STATS); const bf16* QKV = (const bf16*)(F.ws + WS_BIG + BIG_QKV);
#ifndef DBG_ROW0
#define DBG_ROW0 0
#define DBG_ROW1 T
#endif
#ifndef DBG_COL0
#define DBG_COL0 0
#define DBG_COL1 NQKV
#endif
    float worst = 0.f; unsigned nbad = 0;
#ifdef CHK_ROWS
    {
        const bf16* zbp = (const bf16*)(F.ws + WS_ZB);
        for (int s = gw; s < 8192; s += NGW) {
            const unsigned hsh = (unsigned)s * 2654435761u; const int row = (int)(hsh % (unsigned)T);
            float sm = 0.f, sq = 0.f, dz = 0.f;
            for (int k = F.lane; k < D; k += 64) { const float v = F.z[(size_t)row * D + k]; sm += v; sq += v * v; dz = fmaxf(dz, fabsf(bf2f(zbp[(size_t)row * D + k]) - v)); }
            sm = wave_sum(sm); sq = wave_sum(sq); dz = fmaxf(dz, pg8::xor32_max(dz)); dz = fmaxf(dz, pg8::swz_xor<16>(dz)); dz = fmaxf(dz, pg8::swz_xor<8>(dz)); dz = fmaxf(dz, pg8::swz_xor<4>(dz)); dz = fmaxf(dz, pg8::swz_xor<2>(dz)); dz = fmaxf(dz, pg8::swz_xor<1>(dz));
            const float mean = sm * (1.0f / D), var = sq * (1.0f / D) - mean * mean, rstd = 1.0f / sqrtf(var + LN_EPS);
            const bool bad = (CHK_ROWS == 1) ? (fabsf(mean - stats[2 * row]) > CHK_MTOL || fabsf(rstd - stats[2 * row + 1]) > CHK_RTOL * rstd) : (dz > 0.05f);
            nbad += bad ? 1u : 0u;
        }
        if (F.lane == 0 && nbad) atomicAdd((unsigned*)(F.ws + WS_CTL) + 15000, nbad);
        return;
    }
#endif
    for (int s = gw; s < 8192; s += NGW) {
        const unsigned hsh = (unsigned)s * 2654435761u; const int row = DBG_ROW0 + (int)(hsh % (unsigned)(DBG_ROW1 - DBG_ROW0)), col = DBG_COL0 + (int)((hsh >> 7) % (unsigned)(DBG_COL1 - DBG_COL0));
#ifdef CHK_HYP
        const float mean = 0.f, rstd = 1.f;
#else
        const float mean = stats[2 * row], rstd = stats[2 * row + 1];
#endif
        float acc = 0.f;
        for (int k = F.lane; k < D; k += 64) acc += ((F.z[(size_t)row * D + k] - mean) * rstd * g[k] + b[k]) * W[(size_t)k * NQKV + col];
        acc = wave_sum(acc) * (col < 6144 ? QSCALE : 1.0f);
        const float got = bf2f(QKV[(size_t)row * NQKV + col]);
        worst = fmaxf(worst, fabsf(got - acc)); nbad += (fabsf(got - acc) > DBG_THR) ? 1u : 0u;
    }
#ifdef DBG_COUNT
    if (F.lane == 0 && nbad) atomicAdd((unsigned*)(F.ws + WS_CTL) + 15000, nbad);
#else
    if (F.lane == 0) atomicMax((unsigned*)(F.ws + WS_CTL) + 15000, __builtin_bit_cast(unsigned, worst));
#endif
}
#endif
__device__ __forceinline__ void phase_final_ln(Frame& F) {
    const int gw = F.vcu * NWAVES + F.wave, NGW = F.G * NWAVES;
    const float* g = inp(F, 2) + (size_t)(3 * 3 + 2) * D; const float* b = inp(F, 3) + (size_t)(3 * 3 + 2) * D;
    for (int m = gw; m < T; m += NGW) {
        GAS f32x4* d4 = (GAS f32x4*)(F.z + (size_t)m * D) + F.lane; const GAS f32x4* g4 = (const GAS f32x4*)g + F.lane; const GAS f32x4* b4 = (const GAS f32x4*)b + F.lane;
        f32x4 v[8]; float s = 0.f, q = 0.f;
#pragma unroll
        for (int j = 0; j < 8; ++j) {
            const v2u zr = ((const GAS v2u*)((const bf16*)(F.ws + WS_ZB) + (size_t)m * D) + F.lane)[64 * j]; const unsigned qc = ((const GAS unsigned short*)(F.ws + WS_ZL) + (size_t)m * (D / 4) + F.lane)[64 * j];
            v[j] = (f32x4){pg8::z20_dec(zr.x << 16, qc, 0), pg8::z20_dec(zr.x & 0xffff0000u, qc, 1), pg8::z20_dec(zr.y << 16, qc, 2), pg8::z20_dec(zr.y & 0xffff0000u, qc, 3)};
            s += (v[j].x + v[j].y) + (v[j].z + v[j].w); q += (v[j].x * v[j].x + v[j].y * v[j].y) + (v[j].z * v[j].z + v[j].w * v[j].w); }
        s = wave_sum(s); q = wave_sum(q);
        const float mean = s * (1.0f / D), var = fmaxf(q * (1.0f / D) - mean * mean, 0.f), rstd = 1.0f / sqrtf(var + LN_EPS);
#pragma unroll
        for (int j = 0; j < 8; ++j) d4[64 * j] = (v[j] - mean) * rstd * g4[64 * j] + b4[64 * j];
    }
}

__device__ __forceinline__ void phase_transpose(Frame& F, const bf16* src, int R, int C, bf16* dst) {
    LAS unsigned char* scr = F.lds + RING_OFF + F.wave * 16384;
    const int gw = F.vcu * NWAVES + F.wave, NGW = F.G * NWAVES, tr = R / 64, tc = C / 64, lane = F.lane;
    const size_t sp = (size_t)C, dp = (size_t)R;
    v4u cur[8], nxt[8];
    int it = gw;
    if (it < tr * tc) { const int r0 = 64 * (it / tc), c0 = 64 * (it % tc);
#pragma unroll
        for (int i = 0; i < 8; ++i) cur[i] = *(const GAS v4u*)(src + (size_t)(r0 + (lane >> 3) + 8 * i) * sp + c0 + 8 * (lane & 7)); }
    for (; it < tr * tc; it += NGW) {
        const int r0 = 64 * (it / tc), c0 = 64 * (it % tc);
        const int itn = (it + NGW < tr * tc) ? it + NGW : it;
        { const int rn = 64 * (itn / tc), cn = 64 * (itn % tc);
#pragma unroll
          for (int i = 0; i < 8; ++i) nxt[i] = *(const GAS v4u*)(src + (size_t)(rn + (lane >> 3) + 8 * i) * sp + cn + 8 * (lane & 7)); }
#pragma unroll
        for (int i = 0; i < 8; ++i) { const int row = (lane >> 3) + 8 * i, ch = lane & 7;
            LAS unsigned* w = (LAS unsigned*)(scr + row * 132 + ch * 16); w[0] = cur[i].x; w[1] = cur[i].y; w[2] = cur[i].z; w[3] = cur[i].w; }
        LDS_WAIT(); asm volatile("" ::: "memory");
        const LAS unsigned short* rd = (const LAS unsigned short*)(scr + lane * 132);
#pragma unroll 8
        for (int c = 0; c < 64; ++c) dst[(size_t)(c0 + c) * dp + r0 + lane] = rd[c];
        LDS_WAIT(); asm volatile("" ::: "memory");
#pragma unroll
        for (int i = 0; i < 8; ++i) cur[i] = nxt[i];
    }
}
template <int LOGN> __device__ __forceinline__ void fft_forward(LAS cpx* X, int tid) {
    fft_pass<16, false, LOGN>(X, tid, NWAVES * 64); __syncthreads();
    fft_pass<16, false, LOGN - 4>(X, tid, NWAVES * 64); __syncthreads();
    fft_pass<16, false, LOGN - 8>(X, tid, NWAVES * 64); __syncthreads();
    if constexpr (LOGN == 14) { fft_pass<4, false, 2>(X, tid, NWAVES * 64); __syncthreads(); }
}
template <int LOGN> __device__ __forceinline__ void fft_inverse(LAS cpx* X, int tid) {
    if constexpr (LOGN == 14) { fft_pass<4, true, 2>(X, tid, NWAVES * 64); __syncthreads(); }
    fft_pass<16, true, LOGN - 8>(X, tid, NWAVES * 64); __syncthreads();
    fft_pass<16, true, LOGN - 4>(X, tid, NWAVES * 64); __syncthreads();
    fft_pass<16, true, LOGN>(X, tid, NWAVES * 64); __syncthreads();
}
template <int LOGN> __device__ __forceinline__ void conv_fft(LAS cpx* X, const GAS cpx* H, int tid) {
    constexpr int R = (LOGN == 14) ? 4 : 16, NB = 16384 / R / (NWAVES * 64);
    fft_pass<16, false, LOGN>(X, tid, NWAVES * 64); __syncthreads();
    if constexpr (LOGN == 14) { fft_pass<16, false, LOGN - 4>(X, tid, NWAVES * 64); __syncthreads(); }
    cpx h[NB][R];
    fft_mid_load<R, NB>(H, tid, NWAVES * 64, (1 << LOGN) - 1, h);
    fft_pass<16, false, (LOGN == 14) ? LOGN - 8 : LOGN - 4>(X, tid, NWAVES * 64); __syncthreads();
    fft_mid_apply<R, NB>(X, h, tid, NWAVES * 64); __syncthreads();
}
template <int LOGN> __device__ __forceinline__ void fft_tail(LAS cpx* X, int tid) {
    if constexpr (LOGN == 14) { fft_pass<16, true, LOGN - 8>(X, tid, NWAVES * 64); __syncthreads(); }
    fft_pass<16, true, LOGN - 4>(X, tid, NWAVES * 64); __syncthreads();
    fft_pass<16, true, LOGN>(X, tid, NWAVES * 64); __syncthreads();
}
template <int VAR> __device__ __forceinline__ void spec_unit(Frame& F, int jl, int c) {
    constexpr int L = VAR ? 2048 : 8192, N = 2 * L, LOGN = VAR ? 12 : 14, TPS = VAR ? 128 : 512, NP = L / TPS;
    LAS cpx* X = (LAS cpx*)(F.lds + RING_OFF);
    int tid = F.tid; asm volatile("" : "+v"(tid));
    const int seg = tid / TPS, lt = tid % TPS, ch = c + seg;
    const float* taps = (const float*)(F.ws + WS_TAPS) + (size_t)ch * 10240 + (VAR ? 8192 : 0);
    float acc[NP][4];
    float n0 = 0.f, n1 = 0.f;
#pragma unroll
    for (int k = 0; k < NP; ++k) {
#pragma unroll
        for (int f = 0; f < 4; ++f) acc[k][f] = taps[(size_t)f * 2048 * 10240 + lt + TPS * k];
        n0 += fabsf(acc[k][0]) + fabsf(acc[k][1]); n1 += fabsf(acc[k][2]) + fabsf(acc[k][3]); }
    if (VAR == 0) block_sum2(F, n0, n1);
    else {
        LAS float* scr = (LAS float*)(F.lds + SCR_OFF);
        n0 = wave_sum(n0); n1 = wave_sum(n1);
        __syncthreads();
        if (F.lane == 0) { scr[F.wave * 2] = n0; scr[F.wave * 2 + 1] = n1; }
        __syncthreads();
        n0 = scr[4 * seg] + scr[4 * seg + 2]; n1 = scr[4 * seg + 1] + scr[4 * seg + 3];
    }
    const float i0 = 1.0f / n0, i1 = 1.0f / n1;
    __syncthreads();
#pragma unroll
    for (int k = 0; k < NP; ++k) { const int t = lt + TPS * k; const cpx hf = cpx{acc[k][0] * i0, acc[k][2] * i1}, hb = cpx{acc[k][1] * i0, acc[k][3] * i1};
        if (t == 0) { float zf = 0.f; asm volatile("" : "+v"(zf));
                      X[pidx(seg * N)] = cadd(hf, hb); X[pidx(seg * N + L)] = cpx{zf, zf}; }
        else { X[pidx(seg * N + t)] = hf; X[pidx(seg * N + N - t)] = hb; } }
    __syncthreads();
    fft_forward<LOGN>(X, tid);
    cpx* spec = (cpx*)(F.ws + WS_BIG + (VAR ? BIG_SPEC1 : BIG_SPEC0));
    GAS cpx* d0 = (GAS cpx*)(spec + ((size_t)0 * D + ch) * N); GAS cpx* d1 = (GAS cpx*)(spec + ((size_t)1 * D + ch) * N);
#pragma unroll 4
    for (int pl = lt; pl < N; pl += TPS) { cpx H0, H1; split_two_real(X[pidx(seg * N + pl)], X[pidx(seg * N + mirror_pos<LOGN>(pl))], H0, H1); d0[pl] = H0; d1[pl] = H1; }
}
__device__ __forceinline__ void phase_spectra(Frame& F, int jl) {
    for (int u = F.vcu; u < D + D / 4; u += F.G) { if (u < D) spec_unit<0>(F, jl, u); else spec_unit<1>(F, jl, 4 * (u - D)); }
    __syncthreads();
}
__device__ __forceinline__ void load_conv16(const bf16* seq, int t0, int L, float w0, float w1, float w2, float cb, float (&out)[16]) {
    const v4u a = *(const GAS v4u*)(seq + t0), b = *(const GAS v4u*)(seq + t0 + 8);
    float u[18];
    u[0] = (t0 > 0) ? bf2f(seq[t0 - 1]) : 0.f; u[17] = (t0 + 16 < L) ? bf2f(seq[t0 + 16]) : 0.f;
    u[1] = bf2f(a.x & 0xffffu); u[2] = bf2f(a.x >> 16); u[3] = bf2f(a.y & 0xffffu); u[4] = bf2f(a.y >> 16); u[5] = bf2f(a.z & 0xffffu); u[6] = bf2f(a.z >> 16); u[7] = bf2f(a.w & 0xffffu); u[8] = bf2f(a.w >> 16);
    u[9] = bf2f(b.x & 0xffffu); u[10] = bf2f(b.x >> 16); u[11] = bf2f(b.y & 0xffffu); u[12] = bf2f(b.y >> 16); u[13] = bf2f(b.z & 0xffffu); u[14] = bf2f(b.z >> 16); u[15] = bf2f(b.w & 0xffffu); u[16] = bf2f(b.w >> 16);
#pragma unroll
    for (int i = 0; i < 16; ++i) out[i] = w0 * u[i] + w1 * u[i + 1] + w2 * u[i + 2] + cb;
}
template <int VAR> __device__ __forceinline__ void conv_unit(Frame& F, int jl, int c, int pair) {
    constexpr int L = VAR ? 2048 : 8192, N = 2 * L, LOGN = VAR ? 12 : 14, TPS = VAR ? 128 : 512;
    LAS cpx* X = (LAS cpx*)(F.lds + RING_OFF);
    int tid = F.tid; asm volatile("" : "+v"(tid));
    const int seg = tid / TPS, t0 = (tid % TPS) * 16;
    const int rowA = VAR ? T_PROMPT + (2 * seg) * L : (2 * pair) * L, rowB = rowA + L;
    const bf16* UT = (const bf16*)(F.ws + WS_BIG + BIG_UT); bf16* Z2T = (bf16*)(F.ws + WS_BIG + BIG_Z2T);
    const float* cw = inp(F, 10) + (size_t)jl * 3 * NHY; const float* cbv = inp(F, 11) + (size_t)jl * NHY; const float* skip = inp(F, 18) + (size_t)jl * 2 * D;
    const cpx* spec = (const cpx*)(F.ws + WS_BIG + (VAR ? BIG_SPEC1 : BIG_SPEC0));
#ifndef CONV_SCALE
#define CONV_SCALE 1.0f
#endif
    const float invN = CONV_SCALE / (float)N;
    float va[16], vb[16];
    { const int ch = c; const float w0 = cw[ch], w1 = cw[NHY + ch], w2 = cw[2 * NHY + ch], cb = cbv[ch];
      load_conv16(UT + (size_t)ch * T + rowA, t0, L, w0, w1, w2, cb, va); load_conv16(UT + (size_t)ch * T + rowB, t0, L, w0, w1, w2, cb, vb); }
    __syncthreads();
#pragma unroll
    for (int i = 0; i < 16; ++i) { X[pidx(seg * N + t0 + i)] = cpx{va[i], vb[i]}; X[pidx(seg * N + L + t0 + i)] = cpx{0.f, 0.f}; }
    __syncthreads();
    conv_fft<LOGN>(X, (const GAS cpx*)(spec + ((size_t)0 * D + c) * N), tid);
    fft_tail<LOGN>(X, tid);
    {   float ga[16], gb[16];
        const int ch = D + c; const float w0 = cw[ch], w1 = cw[NHY + ch], w2 = cw[2 * NHY + ch], cb = cbv[ch];
        load_conv16(UT + (size_t)ch * T + rowA, t0, L, w0, w1, w2, cb, ga); load_conv16(UT + (size_t)ch * T + rowB, t0, L, w0, w1, w2, cb, gb);
        const float sk = skip[c];
#pragma unroll
        for (int i = 0; i < 16; ++i) { const cpx y = X[pidx(seg * N + t0 + i)]; va[i] = ga[i] * (y.x * invN + sk * va[i]); vb[i] = gb[i] * (y.y * invN + sk * vb[i]); }
#pragma unroll
        for (int i = 0; i < 16; ++i) { X[pidx(seg * N + t0 + i)] = cpx{va[i], vb[i]}; X[pidx(seg * N + L + t0 + i)] = cpx{0.f, 0.f}; }
    }
    __syncthreads();
    conv_fft<LOGN>(X, (const GAS cpx*)(spec + ((size_t)1 * D + c) * N), tid);
    fft_tail<LOGN>(X, tid);
    {   float ga[16], gb[16];
        const int ch = 2 * D + c; const float w0 = cw[ch], w1 = cw[NHY + ch], w2 = cw[2 * NHY + ch], cb = cbv[ch];
        load_conv16(UT + (size_t)ch * T + rowA, t0, L, w0, w1, w2, cb, ga); load_conv16(UT + (size_t)ch * T + rowB, t0, L, w0, w1, w2, cb, gb);
        const float sk = skip[D + c];
        float ra[16], rb[16];
#pragma unroll
        for (int i = 0; i < 16; ++i) { const cpx y = X[pidx(seg * N + t0 + i)]; ra[i] = ga[i] * (y.x * invN + sk * va[i]); rb[i] = gb[i] * (y.y * invN + sk * vb[i]); }
        v4u o0, o1;
        o0.x = pk2(ra[0], ra[1]); o0.y = pk2(ra[2], ra[3]); o0.z = pk2(ra[4], ra[5]); o0.w = pk2(ra[6], ra[7]); o1.x = pk2(ra[8], ra[9]); o1.y = pk2(ra[10], ra[11]); o1.z = pk2(ra[12], ra[13]); o1.w = pk2(ra[14], ra[15]);
        GAS v4u* da = (GAS v4u*)(Z2T + (size_t)c * T + rowA + t0); da[0] = o0; da[1] = o1;
        o0.x = pk2(rb[0], rb[1]); o0.y = pk2(rb[2], rb[3]); o0.z = pk2(rb[4], rb[5]); o0.w = pk2(rb[6], rb[7]); o1.x = pk2(rb[8], rb[9]); o1.y = pk2(rb[10], rb[11]); o1.z = pk2(rb[12], rb[13]); o1.w = pk2(rb[14], rb[15]);
        GAS v4u* db = (GAS v4u*)(Z2T + (size_t)c * T + rowB + t0); db[0] = o0; db[1] = o1;
    }
}
__device__ __forceinline__ void phase_conv(Frame& F, int jl) {
    for (int u = F.vcu; u < 3 * D; u += F.G) { if (u < 2 * D) conv_unit<0>(F, jl, u >> 1, u & 1); else conv_unit<1>(F, jl, u - 2 * D, 0); }
    __syncthreads();
}
__device__ __forceinline__ unsigned voff_b(unsigned row, unsigned ch) { return 256u * row + 16u * (ch ^ (((row & 3u) << 2) | ((row >> 2) & 3u))); }
__device__ __forceinline__ s16x4 vtr(const LAS unsigned char* p) { typedef short v4i16_t __attribute__((ext_vector_type(4))); return __builtin_bit_cast(s16x4, __builtin_amdgcn_ds_read_tr16_b64_v4i16((LAS v4i16_t*)p)); }
__device__ __forceinline__ unsigned cvtpk(float lo, float hi) { typedef __bf16 bf16x2_t __attribute__((ext_vector_type(2))); f32x2 v = {lo, hi}; bf16x2_t b = __builtin_convertvector(v, bf16x2_t); return __builtin_bit_cast(unsigned, b); }
__device__ __forceinline__ void dma16(const void* gsrc, LAS unsigned char* lds_dst) {
    unsigned keep; const unsigned dst = __builtin_amdgcn_readfirstlane((unsigned)(unsigned long long)lds_dst);
    asm volatile("s_mov_b32 %0, m0\n\ts_mov_b32 m0, %2\n\ts_nop 0\n\tglobal_load_lds_dwordx4 %1, off\n\ts_mov_b32 m0, %0" : "=&s"(keep) : "v"(gsrc), "s"(dst) : "memory");
}
struct TileDesc { int g, kt0; };
constexpr int ATT_NT = 28;
__device__ __forceinline__ TileDesc attn_tile(int it, int T0w) {
    TileDesc t;
    if (it < 12) { t.g = 0; t.kt0 = (T0w & ~255) - 64 + 32 * it; }
    else if (it < 18) { t.g = 1; t.kt0 = T0w - 256 + 128 * (it - 12); }
    else { const int e = it - 18, ch = e / 5, tl = e % 5; t.g = 2; t.kt0 = T0w + 8 * ch - 1024 + 512 * tl; }
    return t;
}
__device__ __forceinline__ void attn_wave_task(const bf16* QKV, bf16* AO, LAS unsigned char* ring, int blk, int h, int w, int lane) {
    LAS unsigned char* vimg = ring + w * 16384;
    const int r = lane & 31, hh = lane >> 5;
    const int T0 = blk * 256;
    int seq_start, seq_len;
    if (T0 < T_PROMPT) { seq_start = T0 & ~8191; seq_len = 8192; } else { seq_start = T_PROMPT + ((T0 - T_PROMPT) & ~2047); seq_len = 2048; }
    const int seq_end = seq_start + seq_len;
    const int T0w = T0 + w, qt = T0w + 8 * r;
    const float slope2 = __builtin_amdgcn_exp2f(-0.5f * (float)(h + 1)) * LOG2E;
    f32x16 o[4];
#pragma unroll
    for (int dt = 0; dt < 4; ++dt)
#pragma unroll
        for (int i = 0; i < 16; ++i) o[dt][i] = 0.f;
    float m_run = -1e30f, l_run = 0.f;
    bf16x8 qf[8], kf[8];
    const bf16* hb = QKV + h * 128;
    auto issue_tile = [&](const TileDesc& td, LAS unsigned char* img_dst) {
        const int d = 1 << (2 * td.g);
        const bf16* Kb = hb + 6144 + td.g * 2048; const bf16* Vb = hb + 12288 + td.g * 2048;
#pragma unroll
        for (int i = 0; i < 8; ++i) { const int row = 4 * i + (lane >> 4); int vt = td.kt0 + row * d; vt = vt < seq_start ? seq_start : (vt >= seq_end ? seq_end - 1 : vt);
            const int lch = (lane & 15) ^ (((row & 3) << 2) | ((row >> 2) & 3));
            dma16(Vb + (size_t)vt * NQKV + 8 * lch, img_dst + i * 1024); }
        int kt = td.kt0 + r * d; kt = kt < seq_start ? seq_start : (kt >= seq_end ? seq_end - 1 : kt);
        const bf16* kp = Kb + (size_t)kt * NQKV + 8 * hh;
#pragma unroll
        for (int s = 0; s < 8; ++s) kf[s] = *(const GAS bf16x8*)(kp + 16 * s);
    };
    auto load_q = [&](int g) { const bf16* qp = hb + g * 2048 + (size_t)qt * NQKV + 8 * hh;
#pragma unroll
        for (int s = 0; s < 8; ++s) qf[s] = *(const GAS bf16x8*)(qp + 16 * s); };
    auto coop_issue = [&](int t) {
        const int row = 4 * w + (lane >> 4); int vt = T0 - 64 + 32 * t + row; vt = vt < seq_start ? seq_start : (vt >= seq_end ? seq_end - 1 : vt);
        const int lck = (lane & 15) ^ (row & 15), lcv = (lane & 15) ^ (((row & 3) << 2) | ((row >> 2) & 3));
        const int sl = t % 3;
        dma16(hb + 6144 + (size_t)vt * NQKV + 8 * lck, ring + (2 * sl) * 16384 + 8192 + w * 1024);
        dma16(hb + 12288 + (size_t)vt * NQKV + 8 * lcv, ring + (2 * sl + 1) * 16384 + 8192 + w * 1024);
    };
    auto pv_tile = [&](const LAS unsigned char* img, const bf16x8 (&pb)[2]) {
        const int q4 = (lane & 15) >> 2, p4 = lane & 3, blk16 = (lane >> 4) & 1;
#pragma unroll
        for (int dt = 0; dt < 4; ++dt)
#pragma unroll
            for (int s2 = 0; s2 < 2; ++s2) {
                const unsigned chn = 4 * dt + 2 * blk16 + (p4 >> 1);
                const s16x4 lo = vtr(img + voff_b(16 * s2 + 4 * hh + q4, chn) + 8 * (p4 & 1));
                const s16x4 hi = vtr(img + voff_b(16 * s2 + 8 + 4 * hh + q4, chn) + 8 * (p4 & 1));
                const bf16x8 va = __builtin_shufflevector(lo, hi, 0, 1, 2, 3, 4, 5, 6, 7);
                o[dt] = __builtin_amdgcn_mfma_f32_32x32x16_bf16(va, pb[s2], o[dt], 0, 0, 0);
            }
    };
    TileDesc cur = attn_tile(0, T0w);
    __builtin_amdgcn_s_barrier();
    coop_issue(0);
    load_q(0);
    bf16x8 pprev[2]; const LAS unsigned char* img_prev = vimg;
#pragma unroll
    for (int s2 = 0; s2 < 2; ++s2)
#pragma unroll
        for (int e = 0; e < 8; ++e) pprev[s2][e] = 0;
    for (int it = 0; it < ATT_NT; ++it) {
        if (it < 12) {
            VM_WAIT();
            __builtin_amdgcn_s_barrier();
            if (it + 1 < 12) coop_issue(it + 1);
            const LAS unsigned char* kimg = ring + (2 * (it % 3)) * 16384 + 8192 + 256 * r;
#pragma unroll
            for (int s = 0; s < 8; ++s) kf[s] = *(const LAS bf16x8*)(kimg + 16 * ((2 * s + hh) ^ (r & 15)));
        }
        const int d = 1 << (2 * cur.g), win = 64 * d, kt0 = cur.kt0;
        f32x16 st;
#pragma unroll
        for (int i = 0; i < 16; ++i) st[i] = 0.f;
#pragma unroll
        for (int s = 0; s < 8; ++s) st = __builtin_amdgcn_mfma_f32_32x32x16_bf16(kf[s], qf[s], st, 0, 0, 0);
        if (it > 0) pv_tile(img_prev, pprev);
        if (it == 12) __builtin_amdgcn_s_barrier();
        if (it + 1 < ATT_NT) { const TileDesc nx = attn_tile(it + 1, T0w); if (nx.g != cur.g) load_q(nx.g); if (it + 1 >= 12) issue_tile(nx, vimg + ((it + 1) & 1) * 8192); cur = nx; }
        const int dl0 = kt0 + 4 * hh * d - qt;
        const bool res_ok = (dl0 & (d - 1)) == 0;
        const int lo_i = max(-win, seq_start - qt), hi_i = min(win, seq_end - 1 - qt);
        const float flo = res_ok ? (float)lo_i : 1e30f, fhi = (float)hi_i, fdl0 = (float)dl0, fd = (float)d;
        float mloc = -1e30f;
#pragma unroll
        for (int i = 0; i < 16; ++i) { const float fdl = fdl0 + (float)((i & 3) + 8 * (i >> 2)) * fd;
            const float s = st[i] - slope2 * __builtin_fabsf(fdl);
            const bool ok = (fdl >= flo) && (fdl <= fhi);
            const float sm = ok ? s : -1e30f; st[i] = sm; mloc = fmaxf(mloc, sm); }
        mloc = pg8::xor32_max(mloc);
        const bool fire = __any(mloc > m_run + 8.0f);
        const float m_new = fire ? fmaxf(m_run, mloc) : m_run;
        const float m_use = fmaxf(m_new, -1e20f);
        float ls = 0.f;
#pragma unroll
        for (int i = 0; i < 16; ++i) { const float pv = __builtin_amdgcn_exp2f(st[i] - m_use); st[i] = pv; ls += pv; }
        ls = pg8::xor32_sum(ls);
        if (fire) {
            const float alpha = __builtin_amdgcn_exp2f(m_run - m_new);
            l_run *= alpha;
#pragma unroll
            for (int dt = 0; dt < 4; ++dt)
#pragma unroll
                for (int i = 0; i < 16; ++i) o[dt][i] *= alpha;
        }
        l_run += ls; m_run = m_new;
#pragma unroll
        for (int s2 = 0; s2 < 2; ++s2) { v4u w; w.x = cvtpk(st[8 * s2 + 0], st[8 * s2 + 1]); w.y = cvtpk(st[8 * s2 + 2], st[8 * s2 + 3]); w.z = cvtpk(st[8 * s2 + 4], st[8 * s2 + 5]); w.w = cvtpk(st[8 * s2 + 6], st[8 * s2 + 7]); pprev[s2] = __builtin_bit_cast(bf16x8, w); }
        img_prev = (it < 12) ? ring + (2 * (it % 3) + 1) * 16384 + 8192 : vimg + (it & 1) * 8192;
    }
    pv_tile(img_prev, pprev);
    const float inv = 1.0f / l_run;
    bf16* op = AO + (size_t)qt * D + h * 128 + 4 * hh;
#pragma unroll
    for (int dt = 0; dt < 4; ++dt)
#pragma unroll
        for (int i4 = 0; i4 < 4; ++i4) { v2u w; w.x = cvtpk(o[dt][4 * i4] * inv, o[dt][4 * i4 + 1] * inv); w.y = cvtpk(o[dt][4 * i4 + 2] * inv, o[dt][4 * i4 + 3] * inv);
            *(GAS v2u*)(op + 32 * dt + 8 * i4) = w; }
}
__device__ __forceinline__ void phase_attention(Frame& F, int rev) {
    const bf16* QKV = (const bf16*)(F.ws + WS_BIG + BIG_QKV); bf16* AO = (bf16*)(F.ws + WS_BIG + BIG_AO);
    LAS unsigned char* vimg = F.lds + RING_OFF;
    for (int j = F.vcu; j < (T / 256) * 16; j += F.G) {
        const int jj = rev ? (T / 256) * 16 - 1 - j : j; int h = jj & 15, blk = jj >> 4;
        if (F.G == 256) { const int n = jj >> 8, x = (jj >> 5) & 7, i = jj & 31; h = 2 * x + (i & 1); blk = 16 * n + (i >> 1); }
        attn_wave_task(QKV, AO, vimg, blk, h, F.wave, F.lane);
    }
}

#ifdef ATTN_NAIVE
__device__ __forceinline__ void phase_attention_naive(Frame& F) {
    const bf16* QKV = (const bf16*)(F.ws + WS_BIG + BIG_QKV); bf16* AO = (bf16*)(F.ws + WS_BIG + BIG_AO);
    const int gw = F.vcu * NWAVES + F.wave, NGW = F.G * NWAVES, lane = F.lane;
    for (int p = gw; p < T * 16; p += NGW) {
        const int tok = p >> 4, h = p & 15;
        int seq_start, seq_len;
        if (tok < T_PROMPT) { seq_start = tok & ~8191; seq_len = 8192; } else { seq_start = T_PROMPT + ((tok - T_PROMPT) & ~2047); seq_len = 2048; }
        const int seq_end = seq_start + seq_len;
        const float slope2 = __builtin_amdgcn_exp2f(-0.5f * (float)(h + 1)) * LOG2E;
        float m = -1e30f, l = 0.f, o0 = 0.f, o1 = 0.f;
        for (int g = 0; g < 3; ++g) {
            const int d = 1 << (2 * g);
            const unsigned qw = *(const GAS unsigned*)(QKV + (size_t)tok * NQKV + g * 2048 + h * 128 + 2 * lane);
            const float q0 = bf2f(qw & 0xffffu), q1 = bf2f(qw >> 16);
            for (int j = -64; j <= 64; ++j) {
                const int kt = tok + j * d;
                if (kt < seq_start || kt >= seq_end) continue;
                const unsigned kw = *(const GAS unsigned*)(QKV + (size_t)kt * NQKV + 6144 + g * 2048 + h * 128 + 2 * lane);
                const unsigned vw = *(const GAS unsigned*)(QKV + (size_t)kt * NQKV + 12288 + g * 2048 + h * 128 + 2 * lane);
                const float s = wave_sum(q0 * bf2f(kw & 0xffffu) + q1 * bf2f(kw >> 16)) - slope2 * (float)((j < 0 ? -j : j) * d);
                const float mn = fmaxf(m, s), al = __builtin_amdgcn_exp2f(m - mn), pv = __builtin_amdgcn_exp2f(s - mn);
                l = l * al + pv; o0 = o0 * al + pv * bf2f(vw & 0xffffu); o1 = o1 * al + pv * bf2f(vw >> 16); m = mn;
            }
        }
        const float inv = 1.0f / l;
        *(GAS unsigned*)(AO + (size_t)tok * D + h * 128 + 2 * lane) = pk2(o0 * inv, o1 * inv);
    }
}
#endif
constexpr int NPHASE = 54;
#ifndef FFN1_IN_REV
#define FFN1_IN_REV 0
#endif
#ifndef FFN1_OUT_REV
#define FFN1_OUT_REV 1
#endif
#ifndef MIX_IN_REV
#define MIX_IN_REV 0
#endif
#ifndef MIX_OUT_REV
#define MIX_OUT_REV 0
#endif
#ifndef FFN2_OUT_REV
#define FFN2_OUT_REV 0
#endif
#ifndef FFN2_IN_REV
#define FFN2_IN_REV 1
#endif
#ifndef FFN_OUT_REV
#define FFN_OUT_REV 1
#endif
#ifndef WGM_QKV
#define WGM_QKV 4
#endif
#ifndef WGM_HY
#define WGM_HY 4
#endif
#ifndef WGM_E3
#define WGM_E3 4
#endif
#ifndef WGM_IN
#define WGM_IN 4
#endif
#ifndef DUP_PHASE
#define DUP_PHASE (-1)
#define DUP_N 0
#endif
#define REPS(id) for (int rep_ = 0; rep_ < ((DUP_PHASE) == (id) ? 1 + (DUP_N) : 1); ++rep_)
#ifndef ZERO_HY
#define ZERO_HY 0
#endif
#ifndef ZERO_AT
#define ZERO_AT 0
#endif
#ifndef AT_SCALE
#define AT_SCALE 1.0f
#endif
#ifndef HY_SCALE
#define HY_SCALE 1.0f
#endif
#define MIXSCALE(hy) ((hy) ? (ZERO_HY ? 0.0f : HY_SCALE) : (ZERO_AT ? 0.0f : AT_SCALE))
struct Args { const float* in[21]; float* out; unsigned char* ws; int ph_lo, ph_hi; };
static_assert(sizeof(Args) == 21 * 8 + 8 + 8 + 8, "Args has no padding");
__global__ void __launch_bounds__(NWAVES * 64, 2) fwd_kernel(Args args) {
    extern __shared__ __attribute__((aligned(16))) unsigned char lds[];
    unsigned char* const ws0 = args.ws;
    const int wave0 = __builtin_amdgcn_readfirstlane(threadIdx.x >> 6);
    volatile LAS unsigned* MISC = (volatile LAS unsigned*)((LAS unsigned char*)lds + MISC_OFF);
    if (threadIdx.x < 64) MISC[threadIdx.x] = 0u;
    if (threadIdx.x == 64) {
#pragma unroll
        for (int i = 0; i < 21; ++i) ((LAS unsigned long long*)((LAS unsigned char*)lds + PTR_OFF))[i] = (unsigned long long)args.in[i];
    }
    __syncthreads();
    XcdBarrier bar = xcd_barrier_post((unsigned*)(ws0 + WS_CTL), MISC);
#define FRAME() Frame F = make_frame(lds, args.ws, args.out, wave0)
    const int lo = args.ph_lo, hi = args.ph_hi;
#define RUN(id) (lo <= (id) && (id) < hi)
#define SEAM(id) do { if ((id) + 1 < hi) xcd_barrier(bar); } while (0)

#define ZB ((bf16*)(F.ws + WS_ZB))
#define STATS ((float*)(F.ws + WS_STATS))
#define PART ((float*)(F.ws + WS_PART))
#define CDV(off) ((float*)(F.ws + WS_CD) + (off))
#define HID ((bf16*)(F.ws + WS_BIG + BIG_HID))
    constexpr int O_C1 = 0, O_D1 = NFF2, O_CM = 2 * NFF2, O_DM = 2 * NFF2 + NQKV, O_C2 = 2 * NFF2 + 2 * NQKV, O_D2 = 3 * NFF2 + 2 * NQKV;

    if (RUN(0)) { FRAME(); phase_init(F); SEAM(0); }

#pragma unroll
    for (int layer = 0; layer < DEPTH; ++layer) {
        const int pb = 1 + 13 * layer; const bool hy = (layer & 1) != 0; const int jl = layer >> 1;
#define REVF(idx) ((7 * layer + (idx) + 1) & 1)
        if (RUN(pb + 0)) { FRAME(); REPS(0) phase_convert(F, layer); SEAM(pb + 0); }

        if (RUN(pb + 1)) {
            if (hy) {
                FRAME();
                pg8::Gemm gt{(const bf16*)(F.ws + WS_W3T), (const bf16*)(F.ws + WS_H2B), 8192, 10240, 256}; pg8::StaticOrder St; St.init(8192, 10240, F.G, F.bx);
                pg8::EpiTaps Et{(float*)(F.ws + WS_TAPS), MIN_DECAY, (MAX_DECAY - MIN_DECAY) / 2047.0f};
                pg8::gemm_phase<pg8::EpiTaps, pg8::StaticOrder, PG8_ALIGN, PG8_SP2>(F.lds + RING_OFF, gt, St, Et, F.tid);
            }
            FRAME();
            pg8::Gemm g{ZB, (const bf16*)(F.ws + W_IN1), T, NFF2, D}; pg8::StaticOrder S; S.init(T, NFF2, F.G, F.bx, FFN1_IN_REV, WGM_IN);
            pg8::EpiSwiglu E{HID, FF, STATS, CDV(O_C1), CDV(O_D1)};
            REPS(1) pg8::gemm_phase<pg8::EpiSwiglu, pg8::StaticOrder, PG8_ALIGN, PG8_SP2>(F.lds + RING_OFF, g, S, E, F.tid);
            SEAM(pb + 1);
        }
        if (RUN(pb + 2)) {
            FRAME();
            pg8::Gemm g{HID, (const bf16*)(F.ws + W_OUT1), T, D, FF}; pg8::StaticOrder S; S.init(T, D, F.G, F.bx, FFN1_OUT_REV, WGM_E3);
            const float* g0 = layer ? inp(F, 2) + (size_t)((layer - 1) * 3 + 2) * D : (const float*)(F.ws + WS_IDG); const float* b0 = layer ? inp(F, 3) + (size_t)((layer - 1) * 3 + 2) * D : (const float*)(F.ws + WS_IDB);
            pg8::EpiResid E{(unsigned*)(F.ws + WS_ZL), ZB, STATS, g0, b0, (const float*)(F.ws + WS_IDB), PART, 0.5f, (LAS float*)(F.lds + EPI_OFF)};
            pg8::gemm_phase<pg8::EpiResid, pg8::StaticOrder, PG8_ALIGN, PG8_SP2>(F.lds + RING_OFF, g, S, E, F.tid);
            SEAM(pb + 2);
        }
        if (RUN(pb + 3)) { FRAME(); REPS(3) phase_finalize(F); SEAM(pb + 3); }

        if (RUN(pb + 4)) {
            if (!hy) { FRAME();
                pg8::Gemm g{ZB, (const bf16*)(F.ws + W_MIN), T, NQKV, D}; pg8::StaticOrder S; S.init(T, NQKV, F.G, F.bx, MIX_IN_REV, WGM_QKV);
                pg8::EpiLnBf16 E{(bf16*)(F.ws + WS_BIG + BIG_QKV), NQKV, STATS, CDV(O_CM), CDV(O_DM)};
                REPS(4) pg8::gemm_phase<pg8::EpiLnBf16, pg8::StaticOrder, PG8_ALIGN, PG8_SP2>(F.lds + RING_OFF, g, S, E, F.tid);
            } else { FRAME();
                pg8::Gemm g{(const bf16*)(F.ws + W_MIN), ZB, NHY, T, D}; pg8::StaticOrder S; S.init(NHY, T, F.G, F.bx, 0, WGM_HY);
                pg8::EpiLnBf16T E{(bf16*)(F.ws + WS_BIG + BIG_UT), T, STATS, CDV(O_CM), CDV(O_DM)};
                REPS(4) pg8::gemm_phase<pg8::EpiLnBf16T, pg8::StaticOrder, PG8_ALIGN, PG8_SP2>(F.lds + RING_OFF, g, S, E, F.tid);
            }
            if (hy) { FRAME(); REPS(15) phase_spectra(F, jl); }
            SEAM(pb + 4);
        }
        if (RUN(pb + 5) && !hy) {
            FRAME();
#ifdef ATTN_NAIVE
            if (!hy) phase_attention_naive(F);
#else
            if (!hy) { REPS(5) phase_attention(F, 0); }
#endif
            SEAM(pb + 5);
        }
        if (hy) {
            if (RUN(pb + 6)) { FRAME(); REPS(6) phase_conv(F, jl); SEAM(pb + 6); }
            if (RUN(pb + 7)) { FRAME(); REPS(7) phase_transpose(F, (const bf16*)(F.ws + WS_BIG + BIG_Z2T), D, T, (bf16*)(F.ws + WS_BIG + BIG_Z2)); SEAM(pb + 7); }
        }
        if (RUN(pb + 8)) {
            FRAME();
            const bf16* A = hy ? (const bf16*)(F.ws + WS_BIG + BIG_Z2) : (const bf16*)(F.ws + WS_BIG + BIG_AO);
            pg8::Gemm g{A, (const bf16*)(F.ws + W_MOUT), T, D, D}; pg8::StaticOrder S; S.init(T, D, F.G, F.bx, MIX_OUT_REV, WGM_E3);
            pg8::EpiResid E{(unsigned*)(F.ws + WS_ZL), ZB, STATS, inp(F, 2) + (size_t)(layer * 3) * D, inp(F, 3) + (size_t)(layer * 3) * D, hy ? inp(F, 20) + (size_t)jl * D : (const float*)(F.ws + WS_IDB), PART, MIXSCALE(hy), (LAS float*)(F.lds + EPI_OFF)};
            pg8::gemm_phase<pg8::EpiResid, pg8::StaticOrder, PG8_ALIGN, PG8_SP2>(F.lds + RING_OFF, g, S, E, F.tid);
            SEAM(pb + 8);
        }
        if (RUN(pb + 9)) { FRAME(); phase_finalize(F); SEAM(pb + 9); }

        if (RUN(pb + 10)) {
            FRAME();
            pg8::Gemm g{ZB, (const bf16*)(F.ws + W_IN2), T, NFF2, D}; pg8::StaticOrder S; S.init(T, NFF2, F.G, F.bx, FFN2_IN_REV, WGM_IN);
            pg8::EpiSwiglu E{HID, FF, STATS, CDV(O_C2), CDV(O_D2)};
            pg8::gemm_phase<pg8::EpiSwiglu, pg8::StaticOrder, PG8_ALIGN, PG8_SP2>(F.lds + RING_OFF, g, S, E, F.tid);
            SEAM(pb + 10);
        }
        if (RUN(pb + 11)) {
            FRAME();
            pg8::Gemm g{HID, (const bf16*)(F.ws + W_OUT2), T, D, FF}; pg8::StaticOrder S; S.init(T, D, F.G, F.bx, FFN2_OUT_REV, WGM_E3);
            pg8::EpiResid E{(unsigned*)(F.ws + WS_ZL), ZB, STATS, inp(F, 2) + (size_t)(layer * 3 + 1) * D, inp(F, 3) + (size_t)(layer * 3 + 1) * D, (const float*)(F.ws + WS_IDB), PART, 0.5f, (LAS float*)(F.lds + EPI_OFF)};
            pg8::gemm_phase<pg8::EpiResid, pg8::StaticOrder, PG8_ALIGN, PG8_SP2>(F.lds + RING_OFF, g, S, E, F.tid);
            SEAM(pb + 11);
        }
        if (RUN(pb + 12) && layer + 1 < DEPTH) { FRAME(); phase_finalize(F); SEAM(pb + 12); }
    }
#ifdef DBG_CHECK
    if (RUN(NPHASE - 2)) { FRAME(); phase_check_qkv(F); SEAM(NPHASE - 2); }
#endif
    if (RUN(NPHASE - 1)) { FRAME(); phase_final_ln(F); }
#undef REVF
#undef RUN
#undef SEAM
#undef FRAME
}


#ifdef PHASE_PROBE
#define PROBE_FRAME() extern __shared__ __attribute__((aligned(16))) unsigned char lds[]; Frame F = make_frame(lds, args.ws, args.out, __builtin_amdgcn_readfirstlane(threadIdx.x >> 6));
__global__ void __launch_bounds__(NWAVES * 64, 2) probe_init(Args args) { PROBE_FRAME(); phase_init(F); }
__global__ void __launch_bounds__(NWAVES * 64, 2) probe_convert(Args args) { PROBE_FRAME(); phase_convert(F, args.ph_lo); }
__global__ void __launch_bounds__(NWAVES * 64, 2) probe_finalize(Args args) { PROBE_FRAME(); phase_finalize(F); phase_final_ln(F); }
__global__ void __launch_bounds__(NWAVES * 64, 2) probe_transpose(Args args) { PROBE_FRAME(); phase_transpose(F, (const bf16*)(F.ws + WS_BIG + BIG_U), T, NHY, (bf16*)(F.ws + WS_BIG + BIG_UT)); }
__global__ void __launch_bounds__(NWAVES * 64, 2) probe_spectra(Args args) { PROBE_FRAME(); phase_spectra(F, args.ph_lo); }
__global__ void __launch_bounds__(NWAVES * 64, 2) probe_conv(Args args) { PROBE_FRAME(); phase_conv(F, args.ph_lo); }
__global__ void __launch_bounds__(NWAVES * 64, 2) probe_attn(Args args) { PROBE_FRAME(); phase_attention(F, args.ph_lo); }
__global__ void __launch_bounds__(NWAVES * 64, 2) probe_gemm_swiglu(Args args) { PROBE_FRAME(); pg8::Gemm g{(const bf16*)F.ws, (const bf16*)(F.ws + W_IN1), T, NFF2, D}; pg8::StaticOrder S; S.init(T, NFF2, F.G, F.bx, 0, WGM_IN); pg8::EpiSwiglu E{(bf16*)(F.ws + WS_BIG), FF, (float*)(F.ws + WS_STATS), (float*)(F.ws + WS_CD), (float*)(F.ws + WS_CD)}; pg8::gemm_phase<pg8::EpiSwiglu, pg8::StaticOrder, PG8_ALIGN, PG8_SP2>(F.lds + RING_OFF, g, S, E, F.tid); }
__global__ void __launch_bounds__(NWAVES * 64, 2) probe_gemm_resid(Args args) { PROBE_FRAME(); pg8::Gemm g{(const bf16*)F.ws, (const bf16*)(F.ws + W_IN1), T, D, FF}; pg8::StaticOrder S; S.init(T, D, F.G, F.bx); pg8::EpiResid E{(unsigned*)(F.ws + WS_ZL), (bf16*)(F.ws + WS_ZB), (float*)(F.ws + WS_STATS), inp(F, 2), inp(F, 3), args.ph_lo ? inp(F, 20) : (const float*)(F.ws + WS_IDB), (float*)(F.ws + WS_PART), 0.5f, (LAS float*)(F.lds + EPI_OFF)}; pg8::gemm_phase<pg8::EpiResid, pg8::StaticOrder, PG8_ALIGN, PG8_SP2>(F.lds + RING_OFF, g, S, E, F.tid); }
__global__ void __launch_bounds__(NWAVES * 64, 2) probe_gemm_ln(Args args) { PROBE_FRAME(); pg8::Gemm g{(const bf16*)F.ws, (const bf16*)(F.ws + W_IN1), T, NQKV, D}; pg8::StaticOrder S; S.init(T, NQKV, F.G, F.bx, 0, WGM_IN); pg8::EpiLnBf16 E{(bf16*)(F.ws + WS_BIG), NQKV, (float*)(F.ws + WS_STATS), (float*)(F.ws + WS_CD), (float*)(F.ws + WS_CD)}; pg8::gemm_phase<pg8::EpiLnBf16, pg8::StaticOrder, PG8_ALIGN, PG8_SP2>(F.lds + RING_OFF, g, S, E, F.tid); }
#endif
#ifndef MK_MULTI
#define MK_MULTI 0
#endif
extern "C" void kernel_launch(void* const* d_in, const int* in_sizes, int n_in, void* d_out, int out_size, void* d_ws, size_t ws_size, hipStream_t stream) {
    static int grid = 0;
    if (grid == 0) {
        if (n_in != 21 || out_size != T * D || ws_size < WS_END) { fprintf(stderr, "kernel_launch: unexpected shapes (n_in %d, out %d, ws %zu, need %zu)\n", n_in, out_size, ws_size, (size_t)WS_END); grid = -1; return; }
        int dev = 0, cus = 0, per_cu = 0;
        if (hipGetDevice(&dev) != hipSuccess || hipDeviceGetAttribute(&cus, hipDeviceAttributeMultiprocessorCount, dev) != hipSuccess) { grid = -1; return; }
        if (hipFuncSetAttribute((const void*)fwd_kernel, hipFuncAttributeMaxDynamicSharedMemorySize, LDS_BYTES) != hipSuccess) { fprintf(stderr, "kernel_launch: hipFuncSetAttribute failed\n"); grid = -1; return; }
        if (hipOccupancyMaxActiveBlocksPerMultiprocessor(&per_cu, (const void*)fwd_kernel, NWAVES * 64, LDS_BYTES) != hipSuccess || per_cu < 1) fprintf(stderr, "kernel_launch: occupancy query reports %d\n", per_cu);
        (void)hipGetLastError();
        grid = cus;
    }
    if (grid < 0) return;
    if (hipMemsetAsync((char*)d_ws + WS_CTL, 0, CTL_ZERO_BYTES, stream) != hipSuccess) return;
    Args a{};
    for (int i = 0; i < 21; ++i) a.in[i] = (const float*)d_in[i];
    a.out = (float*)d_out; a.ws = (unsigned char*)d_ws;
#ifndef STOP_AFTER
#define STOP_AFTER (NPHASE - 1)
#endif
#ifdef DBG_CHECK
#define DBGCHK_ON 1
#else
#define DBGCHK_ON 0
#endif
#if MK_MULTI
    for (int p = 0; p < NPHASE; ++p) { if (p >= STOP_AFTER && p != NPHASE - 1 && !(DBGCHK_ON && p == NPHASE - 2)) continue; a.ph_lo = p; a.ph_hi = p + 1; hipLaunchKernelGGL(fwd_kernel, dim3(grid), dim3(NWAVES * 64), LDS_BYTES, stream, a); }
#else
    a.ph_lo = 0; a.ph_hi = NPHASE;
    hipLaunchKernelGGL(fwd_kernel, dim3(grid), dim3(NWAVES * 64), LDS_BYTES, stream, a);
#endif
}
```
